# Optimizing an MI355X kernel written in HIP

```python
import jax, jax.numpy as jnp
from jax import lax
import numpy as np

D_MODEL = 1024
BATCH = 2
SEQ = 16384
DEPTH = 2

GRID_W = 64
CTX_LEN = 256
EPS = 1e-6

N_HEADS = 8
N_KV_HEADS = 2
HEAD_DIM = 64
GQA_GROUP = N_HEADS // N_KV_HEADS
WINDOW = 128
BLOCK = 128
ROPE_BASE = 10000.0
Q_DIM = N_HEADS * HEAD_DIM
KV_DIM = N_KV_HEADS * HEAD_DIM

FNET_GROUPS = 4
FNET_GROUP_DIM = 128
FNET_WIDTH = FNET_GROUPS * FNET_GROUP_DIM

CONV_DIM = 512
CONV_K = 3

N_BRANCH = 3

Q_OFF = 0
K_OFF = Q_OFF + Q_DIM
V_OFF = K_OFF + KV_DIM
F_OFF = V_OFF + KV_DIM
CX_OFF = F_OFF + FNET_WIDTH
CB_OFF = CX_OFF + CONV_DIM
CC_OFF = CB_OFF + CONV_DIM
GATE_OFF = CC_OFF + CONV_DIM
IN_DIM = GATE_OFF + N_BRANCH * D_MODEL

D_FF = 2816
N_EXPERTS = 8
TOP_K = 2
D_EXPERT = 3584
N_DENSE = (DEPTH + 1) // 2
N_MOE = DEPTH // 2

kernel_name = "hybrid_gated_parallel_dit_block"


def rms_norm(x, g):
    xf = x.astype(jnp.float32)
    y = xf * lax.rsqrt(jnp.mean(xf * xf, axis=-1, keepdims=True) + EPS)
    return (y * g.astype(jnp.float32)).astype(x.dtype)


def axial_rope_tables(n_tokens):
    rows = n_tokens // GRID_W
    row = jnp.repeat(jnp.arange(rows), GRID_W).astype(jnp.float32)
    col = jnp.tile(jnp.arange(GRID_W), rows).astype(jnp.float32)
    half = HEAD_DIM // 2
    inv_freq = 1.0 / (ROPE_BASE ** (jnp.arange(0, half, 2, dtype=jnp.float32) / half))
    ang = jnp.concatenate([row[:, None] * inv_freq, col[:, None] * inv_freq], axis=-1)
    return jnp.cos(ang), jnp.sin(ang)


def apply_rope(x, cos, sin):
    xf = x.astype(jnp.float32).reshape(x.shape[:-1] + (HEAD_DIM // 2, 2))
    x0, x1 = xf[..., 0], xf[..., 1]
    cs = cos[None, :, None, :]
    sn = sin[None, :, None, :]
    out = jnp.stack([x0 * cs - x1 * sn, x0 * sn + x1 * cs], axis=-1).reshape(x.shape)
    return out.astype(x.dtype)


def latent_window_attention(q, k, v, kc, vc, sink):
    B, S = q.shape[0], q.shape[1]
    nb = S // BLOCK
    scale = HEAD_DIM ** -0.5
    qb = q.reshape(B, nb, BLOCK, N_KV_HEADS, GQA_GROUP, HEAD_DIM).transpose(1, 0, 2, 3, 4, 5)
    pad = ((0, 0), (BLOCK, BLOCK), (0, 0), (0, 0))
    kp = jnp.pad(k, pad)
    vp = jnp.pad(v, pad)
    sink_l = sink.astype(jnp.float32).reshape(1, N_KV_HEADS, GQA_GROUP, 1, 1)
    rel = jnp.arange(3 * BLOCK)[None, :] - BLOCK - jnp.arange(BLOCK)[:, None]
    band = jnp.abs(rel) <= WINDOW

    def block_fn(args):
        i, qi = args
        start = i * BLOCK
        ki = lax.dynamic_slice_in_dim(kp, start, 3 * BLOCK, axis=1)
        vi = lax.dynamic_slice_in_dim(vp, start, 3 * BLOCK, axis=1)
        kpos = start - BLOCK + jnp.arange(3 * BLOCK)
        mask = band & ((kpos >= 0) & (kpos < S))[None, :]
        s_loc = jnp.einsum('bqhgd,bkhd->bhgqk', qi, ki, preferred_element_type=jnp.float32) * scale
        s_loc = jnp.where(mask, s_loc, -jnp.inf)
        s_ctx = jnp.einsum('bqhgd,bkhd->bhgqk', qi, kc, preferred_element_type=jnp.float32) * scale
        s_sink = jnp.broadcast_to(sink_l, s_ctx.shape[:-1] + (1,))
        p = jax.nn.softmax(jnp.concatenate([s_loc, s_ctx, s_sink], axis=-1), axis=-1)
        p_loc = p[..., :3 * BLOCK].astype(v.dtype)
        p_ctx = p[..., 3 * BLOCK:3 * BLOCK + kc.shape[1]].astype(vc.dtype)
        return (jnp.einsum('bhgqk,bkhd->bqhgd', p_loc, vi)
                + jnp.einsum('bhgqk,bkhd->bqhgd', p_ctx, vc))

    out = lax.map(block_fn, (jnp.arange(nb), qb))
    return out.transpose(1, 0, 2, 3, 4, 5).reshape(B, S, Q_DIM)


def context_attention(qc, kc, vc, sink):
    B, L = qc.shape[0], qc.shape[1]
    scale = HEAD_DIM ** -0.5
    qg = qc.reshape(B, L, N_KV_HEADS, GQA_GROUP, HEAD_DIM)
    s = jnp.einsum('bqhgd,bkhd->bhgqk', qg, kc, preferred_element_type=jnp.float32) * scale
    s_sink = jnp.broadcast_to(sink.astype(jnp.float32).reshape(1, N_KV_HEADS, GQA_GROUP, 1, 1), s.shape[:-1] + (1,))
    p = jax.nn.softmax(jnp.concatenate([s, s_sink], axis=-1), axis=-1)
    o = jnp.einsum('bhgqk,bkhd->bqhgd', p[..., :L].astype(vc.dtype), vc)
    return o.reshape(B, L, Q_DIM)


def fourier_mix(u):
    B, N = u.shape[0], u.shape[1]
    ug = u.astype(jnp.float32).reshape(B, N, FNET_GROUPS, FNET_GROUP_DIM)
    f = jnp.fft.fft2(ug, axes=(1, 3), norm="ortho").real
    return f.reshape(B, N, FNET_WIDTH).astype(u.dtype)


def short_conv_mix(xin, bg, cg, w_conv):
    u = cg * xin
    up = jnp.pad(u, ((0, 0), (1, 1), (0, 0)))
    y = up[:, :-2] * w_conv[0] + up[:, 1:-1] * w_conv[1] + up[:, 2:] * w_conv[2]
    return bg * y


def merge_branches(z, attn, w_conv, w_attn_o, w_fnet, w_conv_out, w_o):
    y_attn = attn @ w_attn_o
    y_fnet = fourier_mix(z[..., F_OFF:F_OFF + FNET_WIDTH]) @ w_fnet
    y_conv = short_conv_mix(z[..., CX_OFF:CX_OFF + CONV_DIM], z[..., CB_OFF:CB_OFF + CONV_DIM],
                            z[..., CC_OFF:CC_OFF + CONV_DIM], w_conv) @ w_conv_out
    gates = jax.nn.sigmoid(z[..., GATE_OFF:].astype(jnp.float32)).astype(z.dtype)
    gates = gates.reshape(z.shape[:-1] + (N_BRANCH, D_MODEL))
    merged = gates[..., 0, :] * y_attn + gates[..., 1, :] * y_fnet + gates[..., 2, :] * y_conv
    return merged @ w_o


def swiglu(h, w_gate, w_up, w_down):
    return (jax.nn.silu(h @ w_gate) * (h @ w_up)) @ w_down


def moe_swiglu(h, w_router, b_router, w_gate, w_up, w_down):
    logits = jnp.einsum('bsd,de->bse', h, w_router, preferred_element_type=jnp.float32) + b_router.astype(jnp.float32)
    top_val, top_idx = lax.top_k(logits, TOP_K)
    top_w = jax.nn.softmax(top_val, axis=-1)
    gates = jnp.sum(jax.nn.one_hot(top_idx, N_EXPERTS, dtype=jnp.float32) * top_w[..., None], axis=-2)
    gates = gates.astype(h.dtype)
    out = gates[..., 0:1] * swiglu(h, w_gate[0], w_up[0], w_down[0])
    for e in range(1, N_EXPERTS):
        out = out + gates[..., e:e + 1] * swiglu(h, w_gate[e], w_up[e], w_down[e])
    return out


def setup_inputs(seed: int = 0) -> dict:
    key = jax.random.key(seed)
    ks = jax.random.split(key, 32)
    D = D_MODEL
    nrm = lambda k, shape, s: jax.random.normal(k, shape, jnp.float32) * s
    gain = lambda k: 1.0 + nrm(k, (DEPTH, D), 0.05)
    return {
        "x": nrm(ks[0], (BATCH, SEQ, D), 1.0),
        "c": nrm(ks[1], (BATCH, D), 1.0),
        "ctx": nrm(ks[2], (BATCH, CTX_LEN, D), 1.0),
        "c_ctx": nrm(ks[3], (D,), 1.0),
        "w_mod": nrm(ks[4], (DEPTH, D, 6 * D), 0.5 * D ** -0.5),
        "b_mod": nrm(ks[5], (DEPTH, 6 * D), 0.02),
        "g_pre_mix": gain(ks[6]),
        "g_post_mix": gain(ks[7]),
        "g_pre_ffn": gain(ks[8]),
        "g_post_ffn": gain(ks[9]),
        "w_in": nrm(ks[10], (DEPTH, D, IN_DIM), D ** -0.5),
        "attn_sink": nrm(ks[11], (DEPTH, N_HEADS), 0.5),
        "w_conv": nrm(ks[12], (DEPTH, CONV_K, CONV_DIM), CONV_K ** -0.5),
        "w_attn_o": nrm(ks[13], (DEPTH, Q_DIM, D), Q_DIM ** -0.5),
        "w_fnet": nrm(ks[14], (DEPTH, FNET_WIDTH, D), FNET_WIDTH ** -0.5),
        "w_conv_out": nrm(ks[15], (DEPTH, CONV_DIM, D), CONV_DIM ** -0.5),
        "w_o": nrm(ks[16], (DEPTH, D, D), D ** -0.5),
        "w_ff_gate": nrm(ks[17], (N_DENSE, D, D_FF), D ** -0.5),
        "w_ff_up": nrm(ks[18], (N_DENSE, D, D_FF), D ** -0.5),
        "w_ff_down": nrm(ks[19], (N_DENSE, D_FF, D), D_FF ** -0.5),
        "w_router": nrm(ks[20], (N_MOE, D, N_EXPERTS), D ** -0.5),
        "b_router": nrm(ks[21], (N_MOE, N_EXPERTS), 0.01),
        "w_exp_gate": nrm(ks[22], (N_MOE, N_EXPERTS, D, D_EXPERT), D ** -0.5),
        "w_exp_up": nrm(ks[23], (N_MOE, N_EXPERTS, D, D_EXPERT), D ** -0.5),
        "w_exp_down": nrm(ks[24], (N_MOE, N_EXPERTS, D_EXPERT, D), D_EXPERT ** -0.5),
    }


def reference(x, c, ctx, c_ctx, w_mod, b_mod, g_pre_mix, g_post_mix, g_pre_ffn, g_post_ffn,
              w_in, attn_sink, w_conv, w_attn_o, w_fnet, w_conv_out, w_o,
              w_ff_gate, w_ff_up, w_ff_down, w_router, b_router, w_exp_gate, w_exp_up, w_exp_down):
    B, S = x.shape[0], x.shape[1]
    L = ctx.shape[1]
    D = D_MODEL
    cos, sin = axial_rope_tables(S)
    hctx = ctx
    for l in range(DEPTH):
        last = l == DEPTH - 1
        mod = jax.nn.silu(c) @ w_mod[l] + b_mod[l]
        sh1, sc1, ga1, sh2, sc2, ga2 = [m[:, None, :] for m in jnp.split(mod, 6, axis=-1)]
        if last:
            cmod = jax.nn.silu(c_ctx) @ w_mod[l][:, :2 * D] + b_mod[l][:2 * D]
            csh1, csc1 = jnp.split(cmod, 2, axis=-1)
        else:
            cmod = jax.nn.silu(c_ctx) @ w_mod[l] + b_mod[l]
            csh1, csc1, cga1, csh2, csc2, cga2 = jnp.split(cmod, 6, axis=-1)

        hc = rms_norm(hctx, g_pre_mix[l]) * (1 + csc1) + csh1
        if last:
            zc_kv = hc @ w_in[l][:, K_OFF:F_OFF]
        else:
            zc = hc @ w_in[l]
            zc_kv = zc[..., K_OFF:F_OFF]
        kc = zc_kv[..., :KV_DIM].reshape(B, L, N_KV_HEADS, HEAD_DIM)
        vc = zc_kv[..., KV_DIM:].reshape(B, L, N_KV_HEADS, HEAD_DIM)

        h = rms_norm(x, g_pre_mix[l]) * (1 + sc1) + sh1
        z = h @ w_in[l]
        q = apply_rope(z[..., Q_OFF:K_OFF].reshape(B, S, N_HEADS, HEAD_DIM), cos, sin)
        k = apply_rope(z[..., K_OFF:V_OFF].reshape(B, S, N_KV_HEADS, HEAD_DIM), cos, sin)
        v = z[..., V_OFF:F_OFF].reshape(B, S, N_KV_HEADS, HEAD_DIM)
        attn = latent_window_attention(q, k, v, kc, vc, attn_sink[l])
        mix = merge_branches(z, attn, w_conv[l], w_attn_o[l], w_fnet[l], w_conv_out[l], w_o[l])
        x = x + ga1 * rms_norm(mix, g_post_mix[l])

        h2 = rms_norm(x, g_pre_ffn[l]) * (1 + sc2) + sh2
        if l % 2 == 0:
            f = swiglu(h2, w_ff_gate[l // 2], w_ff_up[l // 2], w_ff_down[l // 2])
        else:
            f = moe_swiglu(h2, w_router[l // 2], b_router[l // 2], w_exp_gate[l // 2],
                           w_exp_up[l // 2], w_exp_down[l // 2])
        x = x + ga2 * rms_norm(f, g_post_ffn[l])

        if not last:
            qc = zc[..., Q_OFF:K_OFF].reshape(B, L, N_HEADS, HEAD_DIM)
            attn_c = context_attention(qc, kc, vc, attn_sink[l])
            mix_c = merge_branches(zc, attn_c, w_conv[l], w_attn_o[l], w_fnet[l], w_conv_out[l], w_o[l])
            hctx = hctx + cga1 * rms_norm(mix_c, g_post_mix[l])
            hc2 = rms_norm(hctx, g_pre_ffn[l]) * (1 + csc2) + csh2
            if l % 2 == 0:
                fc = swiglu(hc2, w_ff_gate[l // 2], w_ff_up[l // 2], w_ff_down[l // 2])
            else:
                fc = moe_swiglu(hc2, w_router[l // 2], b_router[l // 2], w_exp_gate[l // 2],
                                w_exp_up[l // 2], w_exp_down[l // 2])
            hctx = hctx + cga2 * rms_norm(fc, g_post_ffn[l])
    return x
```

```cpp
#include <hip/hip_runtime.h>
#include <cstdio>
#include <cstdint>
#include <cmath>
namespace pg8 {
#define PG8_LAS __attribute__((address_space(3)))
typedef unsigned short bf16_t;
typedef short bf16x8 __attribute__((ext_vector_type(8)));
typedef float f32x4 __attribute__((ext_vector_type(4)));
typedef unsigned u32x4 __attribute__((ext_vector_type(4)));
constexpr int BM = 256, BK = 64, HALF = 128, HTB = HALF * BK * 2  , STAGE_BYTES = 8 * HTB, NXCD = 8, WGM = 8;

__host__ __device__ __forceinline__ int lds_byte(int r, int c) { const int st = (r >> 4) * 2 + (c >> 5), rr = r & 15, cc = c & 31, ob = rr * 64 + cc * 2; return st * 1024 + (ob ^ (((ob >> 9) & 1) << 5)); }
__host__ __device__ __forceinline__ void stage_rc(int b, int& R, int& C) { const int st = b / 1024, sb = b % 1024, swz = sb ^ (((sb >> 9) & 1) << 5); R = (st >> 1) * 16 + swz / 64; C = (st & 1) * 32 + (swz % 64) / 2; }
__host__ __device__ __forceinline__ int perm32(int rho) { const int n = rho >> 4, i = rho & 15; return 8 * (i >> 2) + 4 * n + (i & 3); }

struct Unit { int pm, pn; };
struct Gemm { const bf16_t* A; const bf16_t* Bt; int M, N, K; };

struct StaticOrder {
    int nM, nN, nwg, G, c;
    __host__ __device__ void init(int M, int N, int G_, int c_) { nM = M / BM; nN = N / BM; nwg = nM * nN; G = G_; c = c_; }
    __host__ __device__ bool next(int i, Unit& u) const {
        const long L = (long)i * G + c; if (L >= nwg) return false;
        int wgid = (int)L; { const int q = nwg / NXCD, r = nwg % NXCD, xcd = wgid % NXCD, off = wgid / NXCD; wgid = (xcd < r ? xcd * (q + 1) : r * (q + 1) + (xcd - r) * q) + off; }
        const int nig = WGM * nN, gid = wgid / nig, fm = gid * WGM, gsz = (nM - fm) < WGM ? (nM - fm) : WGM;
        u.pm = fm + ((wgid % nig) % gsz); u.pn = (wgid % nig) / gsz; return true;
    }
    __device__ __forceinline__ void a_ready(const Unit&) const {}
    __device__ __forceinline__ void done(const Unit&) const {}
};

__device__ __forceinline__ unsigned cvt_pk_bf16(float lo, float hi) { unsigned r; asm volatile("v_cvt_pk_bf16_f32 %0, %1, %2" : "=v"(r) : "v"(lo), "v"(hi)); return r; }
struct RectOrder {
    int nM, nN, nwg, G, c, pm0, ne, epm0, epn;
    __device__ __forceinline__ void init(int nM_, int nN_, int G_, int c_, int pm0_ = 0, int ne_ = 0, int epm0_ = 0, int epn_ = 0) { nM = nM_; nN = nN_; nwg = nM * nN; G = G_; c = c_; pm0 = pm0_; ne = ne_; epm0 = epm0_; epn = epn_; }
    __device__ __forceinline__ bool next(int i, Unit& u) const {
        const long L = (long)i * G + c;
        if (L >= nwg) { const long x = L - nwg; if (x >= ne) return false; u.pm = epm0 + (int)x; u.pn = epn; return true; }
        int wgid = (int)L; { const int q = nwg / NXCD, r = nwg % NXCD, xcd = wgid % NXCD, off = wgid / NXCD; wgid = (xcd < r ? xcd * (q + 1) : r * (q + 1) + (xcd - r) * q) + off; }
        const int nig = WGM * nN, gid = wgid / nig, fm = gid * WGM, gsz = (nM - fm) < WGM ? (nM - fm) : WGM;
        u.pm = pm0 + fm + ((wgid % nig) % gsz); u.pn = (wgid % nig) / gsz; return true;
    }
    __device__ __forceinline__ void a_ready(const Unit&) const {}
    __device__ __forceinline__ void done(const Unit&) const {}
};
struct MoeOrder {
    int tc, nN, tile0, G, c; const PG8_LAS int* tbl;
    __device__ __forceinline__ bool next(int i, Unit& u) const {
        const long L = (long)i * G + c; if (L >= (long)tc * nN) return false;
        const int pml = (int)(L % tc), j = (int)(L / tc), t = tile0 + pml;
        int e = 0;
#pragma unroll
        for (int k = 1; k < 8; ++k) e += (t >= __builtin_amdgcn_readfirstlane(tbl[k])) ? 1 : 0;
        u.pm = pml; u.pn = e * nN + j; return true;
    }
    __device__ __forceinline__ void a_ready(const Unit&) const {}
    __device__ __forceinline__ void done(const Unit&) const {}
};

__device__ __forceinline__ float bflo(unsigned u) { return __uint_as_float(u << 16); }
__device__ __forceinline__ float bfhi(unsigned u) { return __uint_as_float(u & 0xffff0000u); }
__device__ __forceinline__ float sigm(float x) { return __builtin_amdgcn_rcpf(1.0f + __builtin_amdgcn_exp2f(-1.4426950408889634f * x)); }
__device__ __forceinline__ u32x4 pack8(const f32x4 a, const f32x4 b) { u32x4 w; w.x = cvt_pk_bf16(a[0], a[1]); w.y = cvt_pk_bf16(a[2], a[3]); w.z = cvt_pk_bf16(b[0], b[1]); w.w = cvt_pk_bf16(b[2], b[3]); return w; }

struct EpiPlain {
    static constexpr bool PERM = true, AFTER_DRAIN = false;
    bf16_t* O; int ld, nmod, row_off;
    __device__ __forceinline__ void operator()(const f32x4 (&acc)[2][2][4][2], const Unit& u, int wr, int wc, int fr, int fq) const {
        const int row0 = row_off + u.pm * BM + wr * 64 + fr, col0 = (u.pn % nmod) * BM + wc * 32 + 8 * fq;
#pragma unroll
        for (int ai = 0; ai < 2; ++ai)
#pragma unroll
            for (int m = 0; m < 4; ++m) { bf16_t* rowp = O + (size_t)(row0 + ai * HALF + m * 16) * ld + col0;
#pragma unroll
                for (int bj = 0; bj < 2; ++bj) *(u32x4*)(rowp + bj * HALF) = pack8(acc[ai][bj][m][0], acc[ai][bj][m][1]); }
    }
};
template <bool FIRST> struct EpiMerge {
    static constexpr bool PERM = true, AFTER_DRAIN = false;
    bf16_t* MG; const bf16_t* GT; int gcol0;
    __device__ __forceinline__ void operator()(const f32x4 (&acc)[2][2][4][2], const Unit& u, int wr, int wc, int fr, int fq) const {
        const int row0 = u.pm * BM + wr * 64 + fr, col0 = u.pn * BM + wc * 32 + 8 * fq;
#pragma unroll
        for (int ai = 0; ai < 2; ++ai)
#pragma unroll
            for (int m = 0; m < 4; ++m) { const size_t row = (size_t)(row0 + ai * HALF + m * 16);
#pragma unroll
                for (int bj = 0; bj < 2; ++bj) {
                    const u32x4 g = *(const u32x4*)(GT + row * 3072 + gcol0 + col0 + bj * HALF);
                    f32x4 v0 = acc[ai][bj][m][0], v1 = acc[ai][bj][m][1];
                    v0[0] *= bflo(g.x); v0[1] *= bfhi(g.x); v0[2] *= bflo(g.y); v0[3] *= bfhi(g.y); v1[0] *= bflo(g.z); v1[1] *= bfhi(g.z); v1[2] *= bflo(g.w); v1[3] *= bfhi(g.w);
                    bf16_t* dst = MG + row * 1024 + col0 + bj * HALF;
                    if (!FIRST) { const u32x4 o = *(const u32x4*)dst;
                        v0[0] += bflo(o.x); v0[1] += bfhi(o.x); v0[2] += bflo(o.y); v0[3] += bfhi(o.y); v1[0] += bflo(o.z); v1[1] += bfhi(o.z); v1[2] += bflo(o.w); v1[3] += bfhi(o.w); }
                    *(u32x4*)dst = pack8(v0, v1); } }
    }
};
struct EpiSwiglu {
    static constexpr bool PERM = true, AFTER_DRAIN = false;
    bf16_t* H; int ld, nmod;
    __device__ __forceinline__ void operator()(const f32x4 (&acc)[2][2][4][2], const Unit& u, int wr, int wc, int fr, int fq) const {
        const int row0 = u.pm * BM + wr * 64 + fr, col0 = (u.pn % nmod) * HALF + wc * 32 + 8 * fq;
#pragma unroll
        for (int ai = 0; ai < 2; ++ai)
#pragma unroll
            for (int m = 0; m < 4; ++m) {
                f32x4 h0, h1;
#pragma unroll
                for (int j = 0; j < 4; ++j) { const float g0 = acc[ai][0][m][0][j], g1 = acc[ai][0][m][1][j];
                    h0[j] = g0 * sigm(g0) * acc[ai][1][m][0][j]; h1[j] = g1 * sigm(g1) * acc[ai][1][m][1][j]; }
                *(u32x4*)(H + (size_t)(row0 + ai * HALF + m * 16) * ld + col0) = pack8(h0, h1); }
    }
};
struct EpiIn {
    static constexpr bool PERM = true, AFTER_DRAIN = false;
    unsigned char* ws; size_t oQ, oKV, oFAB, oCIN, oGT, oROPE; float qscale;
    __device__ __forceinline__ void operator()(const f32x4 (&acc)[2][2][4][2], const Unit& u, int wr, int wc, int fr, int fq) const {
        const int pn = u.pn, lc0 = wc * 32 + 8 * fq, row0 = u.pm * BM + wr * 64 + fr;
        const bool ctxrow = u.pm >= 128;
        bf16_t* const Q = (bf16_t*)(ws + oQ); bf16_t* const KV = (bf16_t*)(ws + oKV); bf16_t* const FAB = (bf16_t*)(ws + oFAB); bf16_t* const CIN = (bf16_t*)(ws + oCIN); bf16_t* const GT = (bf16_t*)(ws + oGT);
        const float* const rope = (const float*)(ws + oROPE);
#pragma unroll
        for (int bj = 0; bj < 2; ++bj) {
            const int cc = bj * HALF + lc0;
            int mode, ld, dcol; bf16_t* dst;
            if (pn < 2) { mode = 2; dst = Q; ld = 512; dcol = pn * 256 + cc; }
            else if (pn == 2) { dst = KV; ld = 256; dcol = cc; mode = (bj == 0) ? 3 : 0; }
            else if (pn < 7) { mode = 0; dst = FAB; ld = 1024; dcol = (pn - 3) * 256 + cc; }
            else if (pn < 13) { mode = 0; dst = CIN; ld = 1536; dcol = (pn - 7) * 256 + cc; }
            else { mode = 1; dst = GT; ld = 3072; dcol = (pn - 13) * 256 + cc; }
            if (mode == 0) {
#pragma unroll
                for (int ai = 0; ai < 2; ++ai)
#pragma unroll
                    for (int m = 0; m < 4; ++m) *(u32x4*)(dst + (size_t)(row0 + ai * HALF + m * 16) * ld + dcol) = pack8(acc[ai][bj][m][0], acc[ai][bj][m][1]);
            } else if (mode == 1) {
#pragma unroll
                for (int ai = 0; ai < 2; ++ai)
#pragma unroll
                    for (int m = 0; m < 4; ++m) { f32x4 v0 = acc[ai][bj][m][0], v1 = acc[ai][bj][m][1];
#pragma unroll
                        for (int j = 0; j < 4; ++j) { v0[j] = sigm(v0[j]); v1[j] = sigm(v1[j]); }
                        *(u32x4*)(dst + (size_t)(row0 + ai * HALF + m * 16) * ld + dcol) = pack8(v0, v1); }
            } else {
                const float qs = (mode == 2) ? qscale : 1.0f;
                const int i0 = (dcol & 63) >> 1;
#pragma unroll
                for (int ai = 0; ai < 2; ++ai)
#pragma unroll
                    for (int m = 0; m < 4; ++m) { const int row = row0 + ai * HALF + m * 16; f32x4 v0 = acc[ai][bj][m][0], v1 = acc[ai][bj][m][1];
                        if (!ctxrow) { const int s = row & 16383, pos = (i0 < 16) ? (s >> 6) : (s & 63);
                            const float* t = rope + (size_t)(pos * 16 + (i0 & 15)) * 2; const f32x4 t0 = *(const f32x4*)t, t1 = *(const f32x4*)(t + 4);
                            f32x4 r0, r1;
                            r0[0] = v0[0] * t0[0] - v0[1] * t0[1]; r0[1] = v0[0] * t0[1] + v0[1] * t0[0]; r0[2] = v0[2] * t0[2] - v0[3] * t0[3]; r0[3] = v0[2] * t0[3] + v0[3] * t0[2];
                            r1[0] = v1[0] * t1[0] - v1[1] * t1[1]; r1[1] = v1[0] * t1[1] + v1[1] * t1[0]; r1[2] = v1[2] * t1[2] - v1[3] * t1[3]; r1[3] = v1[2] * t1[3] + v1[3] * t1[2];
                            v0 = r0; v1 = r1; }
                        v0 = v0 * qs; v1 = v1 * qs;
                        *(u32x4*)(dst + (size_t)(row0 + ai * HALF + m * 16) * ld + dcol) = pack8(v0, v1); }
            }
        }
    }
};

template <class Epi, class Sched, bool ALIGN_EPI = false, bool SP2 = false>
__device__ __forceinline__ void gemm_phase(PG8_LAS unsigned char* lds, const Gemm g, const Sched& S, const Epi& E) {
    int tid_ = threadIdx.x; asm volatile("" : "+v"(tid_));
    const int tid = tid_, wid = __builtin_amdgcn_readfirstlane(tid >> 6), lane = tid & 63, wr = wid >> 2, wc = wid & 3, fr = lane & 15, fq = lane >> 4;
    const int K = g.K, nt = K / BK;
    unsigned voffA[2], voffB[2];
#pragma unroll
    for (int i = 0; i < 2; ++i) { int R, C; stage_rc(tid * 16 + i * 8192, R, C); const int Rb = Epi::PERM ? ((R & ~31) + perm32(R & 31)) : R;
        voffA[i] = (unsigned)(R * K + C) * 2u; voffB[i] = (unsigned)(Rb * K + C) * 2u; }
    const size_t kstep = (size_t)(BK * 2);
    const size_t hstep = (size_t)HALF * K * 2;
    const size_t tstep = 2 * hstep;
    const unsigned ldsw = (unsigned)wid * 1024u;
    const int aoff = lds_byte(wr * 64 + fr, fq * 8), boff = lds_byte(wc * 32 + fr, fq * 8);
#define PG8_SA(b, h) (((b) * 2 + (h)) * HTB)
#define PG8_SB(b, h) ((4 + (b) * 2 + (h)) * HTB)
#define PG8_STAGE(bufoff, gbase, voff) do { _Pragma("unroll") for (int _i = 0; _i < 2; ++_i) \
        __builtin_amdgcn_global_load_lds((const unsigned*)((const char*)(gbase) + (voff)[_i]), (PG8_LAS unsigned*)(lds + (bufoff) + ldsw + _i * 8192), 16, 0, 0); } while (0)
#define PG8_LDA(dst, b, h) do { _Pragma("unroll") for (int m = 0; m < 4; ++m) _Pragma("unroll") for (int k = 0; k < 2; ++k) dst[m][k] = *(const PG8_LAS bf16x8*)(lds + PG8_SA(b, h) + aoff + m * 2048 + k * 1024); } while (0)
#define PG8_LDB(dst, b, h) do { _Pragma("unroll") for (int n = 0; n < 2; ++n) _Pragma("unroll") for (int k = 0; k < 2; ++k) dst[n][k] = *(const PG8_LAS bf16x8*)(lds + PG8_SB(b, h) + boff + n * 2048 + k * 1024); } while (0)
#define PG8_MMA(ai, bj, At, Bt) do { __builtin_amdgcn_s_setprio(1); _Pragma("unroll") for (int m = 0; m < 4; ++m) _Pragma("unroll") for (int n = 0; n < 2; ++n) _Pragma("unroll") for (int k = 0; k < 2; ++k) \
        acc[ai][bj][m][n] = __builtin_amdgcn_mfma_f32_16x16x32_bf16(Bt[n][k], At[m][k], acc[ai][bj][m][n], 0, 0, 0); __builtin_amdgcn_s_setprio(0); } while (0)
#define PG8_WAIT_V(n) asm volatile("s_waitcnt vmcnt(" #n ")" ::: "memory")
#define PG8_WAIT_L(n) asm volatile("s_waitcnt lgkmcnt(" #n ")" ::: "memory")
#define PG8_BAR __builtin_amdgcn_s_barrier()
#define PG8_SCHED __builtin_amdgcn_sched_barrier(0)
    Unit cur, nxt; int ui = 0;
    if (!S.next(0, cur)) return;
    f32x4 acc[2][2][4][2];
#pragma unroll
    for (int a = 0; a < 2; ++a)
#pragma unroll
        for (int b = 0; b < 2; ++b)
#pragma unroll
            for (int m = 0; m < 4; ++m)
#pragma unroll
                for (int n = 0; n < 2; ++n) acc[a][b][m][n] = (f32x4){0.f, 0.f, 0.f, 0.f};
    bf16x8 At[4][2], B0[2][2], B1[2][2];
    const char* cA = (const char*)g.A + (size_t)cur.pm * tstep; const char* cB = (const char*)g.Bt + (size_t)cur.pn * tstep;
    S.a_ready(cur);
    if constexpr (SP2) {
        PG8_STAGE(PG8_SB(0, 0), cB, voffB); PG8_STAGE(PG8_SB(0, 1), cB + hstep, voffB); PG8_STAGE(PG8_SA(0, 0), cA, voffA); PG8_STAGE(PG8_SA(0, 1), cA + hstep, voffA);
        if (wr == 1) PG8_BAR;
        PG8_WAIT_V(2); PG8_BAR;
        PG8_STAGE(PG8_SB(1, 0), cB + kstep, voffB); PG8_STAGE(PG8_SA(1, 0), cA + kstep, voffA); PG8_STAGE(PG8_SB(1, 1), cB + hstep + kstep, voffB);
        PG8_WAIT_V(6); PG8_BAR;
    } else {
        PG8_STAGE(PG8_SB(0, 0), cB, voffB); PG8_STAGE(PG8_SA(0, 0), cA, voffA); PG8_STAGE(PG8_SB(0, 1), cB + hstep, voffB); PG8_STAGE(PG8_SA(0, 1), cA + hstep, voffA);
        if (wr == 1) PG8_BAR;
        PG8_WAIT_V(4); PG8_BAR;
        PG8_STAGE(PG8_SB(1, 0), cB + kstep, voffB); PG8_STAGE(PG8_SA(1, 0), cA + kstep, voffA); PG8_STAGE(PG8_SB(1, 1), cB + hstep + kstep, voffB);
        PG8_WAIT_V(6); PG8_BAR;
    }
    for (;;) {
        const bool has_next = S.next(ui + 1, nxt);
        const char* nA = has_next ? (const char*)g.A + (size_t)nxt.pm * tstep : cA; const char* nB = has_next ? (const char*)g.Bt + (size_t)nxt.pn * tstep : cB;
        for (int t = 0; t < nt; t += 2) {
            const bool last = (t == nt - 2);
            const char* a1 = cA + (size_t)(t + 1) * kstep;
            const char* a2 = last ? nA : cA + (size_t)(t + 2) * kstep; const char* b2 = last ? nB : cB + (size_t)(t + 2) * kstep;
            const char* a3 = a2 + kstep; const char* b3 = b2 + kstep;
            if (last && has_next) S.a_ready(nxt);
            if constexpr (SP2) {
            PG8_LDB(B0, 0, 0); PG8_LDB(B1, 0, 1); PG8_SCHED; PG8_LDA(At, 0, 0); PG8_STAGE(PG8_SA(1, 1), a1 + hstep, voffA);
            PG8_WAIT_V(8); PG8_WAIT_L(0); PG8_BAR; PG8_MMA(0, 0, At, B0); PG8_MMA(0, 1, At, B1); PG8_BAR; PG8_SCHED;
            PG8_LDA(At, 0, 1); PG8_STAGE(PG8_SB(0, 0), b2, voffB); PG8_STAGE(PG8_SB(0, 1), b2 + hstep, voffB); PG8_STAGE(PG8_SA(0, 0), a2, voffA);
            PG8_WAIT_V(8); PG8_WAIT_L(0); PG8_BAR; PG8_MMA(1, 0, At, B0); PG8_MMA(1, 1, At, B1); PG8_BAR; PG8_SCHED;
            PG8_LDB(B0, 1, 0); PG8_LDB(B1, 1, 1); PG8_SCHED; PG8_LDA(At, 1, 0); PG8_STAGE(PG8_SA(0, 1), a2 + hstep, voffA);
            PG8_WAIT_V(8); PG8_WAIT_L(0); PG8_BAR; PG8_MMA(0, 0, At, B0); PG8_MMA(0, 1, At, B1); PG8_BAR; PG8_SCHED;
            PG8_LDA(At, 1, 1); PG8_STAGE(PG8_SB(1, 0), b3, voffB); PG8_STAGE(PG8_SB(1, 1), b3 + hstep, voffB); PG8_STAGE(PG8_SA(1, 0), a3, voffA);
            PG8_WAIT_V(8); PG8_WAIT_L(0); PG8_BAR; PG8_MMA(1, 0, At, B0); PG8_MMA(1, 1, At, B1); PG8_BAR; PG8_SCHED;
            } else {
            PG8_LDB(B0, 0, 0); PG8_SCHED; PG8_LDA(At, 0, 0); PG8_STAGE(PG8_SA(1, 1), a1 + hstep, voffA);
            PG8_WAIT_L(8); PG8_BAR; PG8_WAIT_L(0); PG8_MMA(0, 0, At, B0); PG8_BAR; PG8_SCHED;
            PG8_LDB(B1, 0, 1); PG8_STAGE(PG8_SB(0, 0), b2, voffB);
            PG8_BAR; PG8_WAIT_L(0); PG8_MMA(0, 1, At, B1); PG8_BAR;
            PG8_LDA(At, 0, 1); PG8_STAGE(PG8_SA(0, 0), a2, voffA);
            PG8_BAR; PG8_WAIT_L(0); PG8_MMA(1, 0, At, B0); PG8_BAR; PG8_SCHED;
            PG8_STAGE(PG8_SB(0, 1), b2 + hstep, voffB);
            PG8_WAIT_V(6); PG8_BAR; PG8_MMA(1, 1, At, B1); PG8_BAR;
            PG8_LDB(B0, 1, 0); PG8_SCHED; PG8_LDA(At, 1, 0); PG8_STAGE(PG8_SA(0, 1), a2 + hstep, voffA);
            PG8_WAIT_L(8); PG8_BAR; PG8_WAIT_L(0); PG8_MMA(0, 0, At, B0); PG8_BAR; PG8_SCHED;
            PG8_LDB(B1, 1, 1); PG8_STAGE(PG8_SB(1, 0), b3, voffB);
            PG8_BAR; PG8_WAIT_L(0); PG8_MMA(0, 1, At, B1); PG8_BAR;
            PG8_LDA(At, 1, 1); PG8_STAGE(PG8_SA(1, 0), a3, voffA);
            PG8_BAR; PG8_WAIT_L(0); PG8_MMA(1, 0, At, B0); PG8_BAR; PG8_SCHED;
            PG8_STAGE(PG8_SB(1, 1), b3 + hstep, voffB);
            PG8_WAIT_V(6); PG8_BAR; PG8_MMA(1, 1, At, B1); PG8_BAR;
            }
        }
        if constexpr (ALIGN_EPI) { if (wr == 0) PG8_BAR; }
        if constexpr (!Epi::AFTER_DRAIN) { E(acc, cur, wr, wc, fr, fq); S.done(cur); }
        if (!has_next) break;
#pragma unroll
        for (int a = 0; a < 2; ++a)
#pragma unroll
            for (int b = 0; b < 2; ++b)
#pragma unroll
                for (int m = 0; m < 4; ++m)
#pragma unroll
                    for (int n = 0; n < 2; ++n) acc[a][b][m][n] = (f32x4){0.f, 0.f, 0.f, 0.f};
        cur = nxt; cA = nA; cB = nB; ++ui;
        if constexpr (ALIGN_EPI) { if (wr == 1) PG8_BAR; }
    }
    PG8_WAIT_V(0);
    if constexpr (!ALIGN_EPI) { if (wr == 0) PG8_BAR; }
    PG8_BAR;
    if constexpr (Epi::AFTER_DRAIN) { E.fused(acc, cur, wr, wc, fr, fq, lds, wid, lane); S.done(cur); }
#undef PG8_SA
#undef PG8_SB
#undef PG8_STAGE
#undef PG8_LDA
#undef PG8_LDB
#undef PG8_MMA
#undef PG8_WAIT_V
#undef PG8_WAIT_L
#undef PG8_BAR
#undef PG8_SCHED
}
}
#define GAS __attribute__((address_space(1)))
#define LAS __attribute__((address_space(3)))
typedef pg8::bf16_t bf16_t;
typedef pg8::bf16x8 bf16x8;
typedef pg8::f32x4 f32x4;
typedef pg8::u32x4 u32x4;
typedef float f32x16 __attribute__((ext_vector_type(16)));
typedef float f32x2 __attribute__((ext_vector_type(2)));
typedef short s16x4 __attribute__((ext_vector_type(4)));
typedef unsigned u32x2 __attribute__((ext_vector_type(2)));
typedef GAS unsigned gu32;

typedef const __attribute__((address_space(4))) unsigned char* kptr_t;
__device__ __forceinline__ kptr_t kbase() { kptr_t p = (kptr_t)__builtin_amdgcn_kernarg_segment_ptr(); asm volatile("" : "+s"(p)); return p; }
#define IN_(i) (*(const float* const __attribute__((address_space(4)))*)(kbase() + 8 * (i)))
#define OUT_ (*(float* const __attribute__((address_space(4)))*)(kbase() + 200))
#define WS_ (*(unsigned char* const __attribute__((address_space(4)))*)(kbase() + 208))
constexpr int NWAVES = 8, NTHREADS = 512;
constexpr int D = 1024, SEQ = 16384, M_LAT = 32768, CTXL = 256, M_CTX = 512, MT = M_LAT + M_CTX;
constexpr int ZN = 6400, DFF = 2816, DEXP = 3584, NEXP = 8, NMOD = 6144;
constexpr float EPS = 1e-6f, LOG2E = 1.4426950408889634f, QSCALE = 0.125f * LOG2E;
constexpr int CHUNK_TILES = 64, CHUNK_ROWS = CHUNK_TILES * 256;

constexpr size_t MiB = 1u << 20;
constexpr size_t WS_CTL = 0, CTL_BYTES = 1 * MiB;
constexpr size_t WS_MODV = 1 * MiB;
constexpr size_t WS_ROPE = 1 * MiB + 256 * 1024;
constexpr size_t WS_G1 = 1 * MiB + 512 * 1024;
constexpr size_t WS_G2 = 1 * MiB + 768 * 1024;
constexpr size_t WS_HCTX = 2 * MiB;
constexpr size_t WS_ASG = 4 * MiB;
constexpr size_t WS_ELIST = 5 * MiB;
constexpr size_t WS_WIN = 8 * MiB, WIN_BYTES = (size_t)ZN * D * 2;
constexpr size_t WS_WY = 33 * MiB;
constexpr size_t WS_WO = 39 * MiB;
constexpr size_t WS_WFF_UP = 43 * MiB;
constexpr size_t WS_WFF_DN = 54 * MiB;
constexpr size_t WS_HN = 60 * MiB;
constexpr size_t WS_Q = 125 * MiB;
constexpr size_t WS_KV = WS_Q + (size_t)MT * 512 * 2;
constexpr size_t WS_FAB = 174 * MiB;
constexpr size_t WS_CIN = 239 * MiB;
constexpr size_t WS_GT = WS_CIN + (size_t)MT * 1536 * 2;
constexpr size_t WS_COUT = 532 * MiB;
constexpr size_t WS_MIX = WS_GT;
constexpr size_t WS_HID0 = 125 * MiB;
constexpr size_t WS_F0 = 402 * MiB;
constexpr size_t WS_EXUP = 125 * MiB;
constexpr size_t WS_EXDN = 237 * MiB;
constexpr size_t WS_H2G = 293 * MiB;
constexpr size_t WS_HIDX = 325 * MiB;
constexpr size_t WS_YEXP = 437 * MiB;
constexpr size_t WS_NEED = 570 * MiB;
static_assert(WS_KV + (size_t)MT * 256 * 2 <= WS_FAB && WS_FAB + (size_t)MT * 1024 * 2 <= WS_CIN && WS_GT + (size_t)MT * 3072 * 2 <= WS_COUT && WS_COUT + (size_t)MT * 512 * 2 <= WS_NEED, "ws map (mixer)");
static_assert(WS_HN + (size_t)MT * 1024 * 2 <= WS_Q && WS_WFF_DN + (size_t)1024 * DFF * 2 <= WS_HN && WS_WFF_UP + (size_t)2 * DFF * 1024 * 2 <= WS_WFF_DN, "ws map (weights)");
static_assert(WS_HID0 + (size_t)MT * DFF * 2 <= WS_MIX && WS_MIX + (size_t)MT * 1024 * 2 <= WS_F0 && WS_EXDN + (size_t)8 * 1024 * DEXP * 2 <= WS_H2G && WS_EXDN + (size_t)8 * 1024 * DEXP * 2 <= WS_MIX, "ws map (ffn)");
static_assert(WS_H2G + (size_t)CHUNK_ROWS * 1024 * 2 <= WS_HIDX && WS_HIDX + (size_t)CHUNK_ROWS * DEXP * 2 <= WS_YEXP && WS_YEXP + (size_t)264 * 256 * 1024 * 2 <= WS_NEED, "ws map (moe)");
constexpr int CW_BAR = 4096;
constexpr int CW_CNT = 8192;

constexpr int RING_BYTES = 131072;
constexpr int MISC_OFF = RING_BYTES + 320;
constexpr int LDSX_OFF = RING_BYTES + 1024;
constexpr int LDS_BYTES = 147456;

#define LDS_WAIT() asm volatile("s_waitcnt lgkmcnt(0)" ::: "memory")
#define VM_WAIT() asm volatile("s_waitcnt vmcnt(0)" ::: "memory")

#define XB_TMO      128
#define XB_XCNT(j)  (256  + 64 * (j))
#define XB_XSUB(j)  (1280 + 64 * (j))
#define XB_XGEN(j)  (2304 + 64 * (j))
#define XB_TOP      3328
#define XB_TOPGEN   3392
#define XCD_BAR_WORDS 3456
#define XB_SPIN_CAP (1u << 22)

__device__ __forceinline__ unsigned xb_ld(unsigned* p)              { return __hip_atomic_load(p, __ATOMIC_RELAXED, __HIP_MEMORY_SCOPE_AGENT); }
__device__ __forceinline__ unsigned xb_add(unsigned* p, unsigned v) { return __hip_atomic_fetch_add(p, v, __ATOMIC_RELAXED, __HIP_MEMORY_SCOPE_AGENT); }
__device__ __forceinline__ unsigned xb_xcc_id() { return (unsigned)__builtin_amdgcn_s_getreg((3 << 11) | 20) & 0xFu; }
#define XB_SPIN(cond, bar) do { unsigned _sp = 0; while (cond) { __builtin_amdgcn_s_sleep(1); \
    if ((++_sp & 255u) == 0u) { if (xb_ld(&(bar)[XB_TMO])) break; if (_sp > XB_SPIN_CAP) { atomicAdd(&(bar)[XB_TMO], 1u); break; } } } } while (0)

struct XcdBarrier {
    unsigned* bar; unsigned x;
    volatile LAS unsigned* st;
};

__device__ __forceinline__ XcdBarrier xcd_barrier_post(unsigned* bar, volatile LAS unsigned* st) {
    XcdBarrier b; b.bar = bar; b.x = xb_xcc_id(); b.st = st;
    if (threadIdx.x == 0) (void)xb_add(&bar[XB_XCNT(b.x)], 1u);
    return b;
}
__device__ __forceinline__ void xcd_barrier_complete(unsigned* bar, unsigned x, unsigned& nloc, unsigned& nx) {
    const unsigned G = gridDim.x * gridDim.y * gridDim.z;
    unsigned sum, cnt, mine, sp = 0u;
    for (;;) {
        sum = 0u; cnt = 0u; mine = 0u;
#pragma unroll
        for (unsigned j = 0; j < 16; ++j) { const unsigned c = xb_ld(&bar[XB_XCNT(j)]); sum += c; cnt += (c > 0u) ? 1u : 0u; mine = (j == x) ? c : mine; }
        if (sum == G) break;
        __builtin_amdgcn_s_sleep(1);
        if ((++sp & 255u) == 0u) { if (xb_ld(&bar[XB_TMO])) break; if (sp > XB_SPIN_CAP) { atomicAdd(&bar[XB_TMO], 1u); break; } }
    }
    nloc = mine > 0u ? mine : 1u; nx = cnt > 0u ? cnt : 1u;
}

__device__ __forceinline__ void xcd_barrier(const XcdBarrier& b) {
    asm volatile("s_waitcnt vmcnt(0)" ::: "memory");
    __syncthreads();
    if (threadIdx.x == 0) {
        unsigned* bar = b.bar;
        __builtin_amdgcn_s_waitcnt(0);
        unsigned nloc = b.st[0], nx = b.st[1];
        if (nloc == 0u) { xcd_barrier_complete(bar, b.x, nloc, nx); b.st[0] = nloc; b.st[1] = nx; }
        const unsigned old = xb_add(&bar[XB_XSUB(b.x)], 1u);
        const unsigned gen = old / nloc;
        if (old + 1u == (gen + 1u) * nloc) {
            __builtin_amdgcn_fence(__ATOMIC_RELEASE, "agent");
            asm volatile("s_waitcnt vmcnt(0)" ::: "memory");
            const unsigned og = xb_add(&bar[XB_TOP], 1u);
            const unsigned tg = og / nx;
            if (og + 1u == (tg + 1u) * nx) xb_add(&bar[XB_TOPGEN], 1u);
            else XB_SPIN(xb_ld(&bar[XB_TOPGEN]) == tg, bar);
            __builtin_amdgcn_fence(__ATOMIC_ACQUIRE, "agent");
            xb_add(&bar[XB_XGEN(b.x)], 1u);
            asm volatile("s_waitcnt vmcnt(0)" ::: "memory");
        } else {
            XB_SPIN(xb_ld(&bar[XB_XGEN(b.x)]) == gen, bar);
            __builtin_amdgcn_fence(__ATOMIC_ACQUIRE, "agent");
            asm volatile("s_waitcnt vmcnt(0)" ::: "memory");
        }
    }
    __syncthreads();
}

struct Params { const float* in[25]; float* out; unsigned char* ws; };
struct Ctx {
    LAS unsigned char* lds;
    int tid, lane, wave, vcu, G;
};
__device__ __forceinline__ Ctx opaque(const Ctx& c) { Ctx o = c; asm volatile("" : "+v"(o.tid), "+v"(o.lane)); asm volatile("" : "+s"(o.wave), "+s"(o.vcu), "+s"(o.G)); return o; }
__device__ __forceinline__ float wave_sum(float v) {
#pragma unroll
    for (int o = 1; o < 64; o <<= 1) v += __shfl_xor(v, o);
    return v;
}
__device__ __forceinline__ unsigned pk2(float lo, float hi) { return pg8::cvt_pk_bf16(lo, hi); }
__device__ __forceinline__ float bflo(unsigned u) { return __uint_as_float(u << 16); }
__device__ __forceinline__ float bfhi(unsigned u) { return __uint_as_float(u & 0xffff0000u); }

__device__ __forceinline__ void tr_item(const float* W, int ldw, int k0, int n0, bf16_t* WT, int ldt, int drow0, LAS float* scr, int lane) {
#pragma unroll 8
    for (int i = 0; i < 32; ++i) { const int kk = 2 * i + (lane >> 5); scr[kk * 33 + (lane & 31)] = W[(size_t)(k0 + kk) * ldw + n0 + (lane & 31)]; }
    LDS_WAIT(); asm volatile("" ::: "memory");
    const int c = lane & 7;
#pragma unroll
    for (int j = 0; j < 4; ++j) { const int n = (lane >> 3) + 8 * j; const LAS float* s = scr + (8 * c) * 33 + n;
        u32x4 o; o.x = pk2(s[0 * 33], s[1 * 33]); o.y = pk2(s[2 * 33], s[3 * 33]); o.z = pk2(s[4 * 33], s[5 * 33]); o.w = pk2(s[6 * 33], s[7 * 33]);
        *(GAS u32x4*)(WT + (size_t)(drow0 + n) * ldt + k0 + 8 * c) = o; }
    LDS_WAIT(); asm volatile("" ::: "memory");
}
__device__ __forceinline__ int gu_row(int n0, int up) { return (n0 >> 7) * 256 + up * 128 + (n0 & 127); }

__device__ __forceinline__ void p0_convert_item(int it, LAS float* scr, int lane) {
    unsigned char* ws = WS_;
    if (it < 5376) { const int l = it / 2688, r = it % 2688, kb = r / 168, j = r % 168; const int n0 = j < 24 ? 32 * j : 1280 + 32 * (j - 24);
        tr_item(IN_(10) + (size_t)l * D * 5888, 5888, 64 * kb, n0, (bf16_t*)(ws + WS_WIN + l * WIN_BYTES), D, n0 < 768 ? n0 : n0 + 512, scr, lane); return; }
    it -= 5376;
    if (it < 1536) { const int mi = it / 256, r = it % 256, l = mi / 3, i = mi % 3, kb = r / 32, nb = r % 32;
        tr_item(IN_(13 + i) + (size_t)l * 512 * 1024, 1024, 64 * kb, 32 * nb, (bf16_t*)(ws + WS_WY) + (size_t)(l * 3 + i) * 1024 * 512, 512, 32 * nb, scr, lane); return; }
    it -= 1536;
    if (it < 1024) { const int l = it / 512, r = it % 512, kb = r / 32, nb = r % 32;
        tr_item(IN_(16) + (size_t)l * D * D, D, 64 * kb, 32 * nb, (bf16_t*)(ws + WS_WO) + (size_t)l * D * D, D, 32 * nb, scr, lane); return; }
    it -= 1024;
    if (it < 2816) { const int up = it / 1408, r = it % 1408, kb = r / 88, nb = r % 88;
        tr_item(IN_(17 + up), DFF, 64 * kb, 32 * nb, (bf16_t*)(ws + WS_WFF_UP), D, gu_row(32 * nb, up), scr, lane); return; }
    it -= 2816;
    { const int kb = it / 32, nb = it % 32; tr_item(IN_(19), D, 64 * kb, 32 * nb, (bf16_t*)(ws + WS_WFF_DN), DFF, 32 * nb, scr, lane); }
}
constexpr int P0_ITEMS = 5376 + 1536 + 1024 + 2816 + 1408;
__device__ __forceinline__ void expert_convert_item(int it, LAS float* scr, int lane) {
    unsigned char* ws = WS_;
    const int e = it / 5376, r0 = it % 5376, which = r0 / 1792, r = r0 % 1792;
    if (which < 2) { const int kb = r / 112, nb = r % 112;
        tr_item(IN_(22 + which) + (size_t)e * D * DEXP, DEXP, 64 * kb, 32 * nb, (bf16_t*)(ws + WS_EXUP) + (size_t)e * 7168 * D, D, gu_row(32 * nb, which), scr, lane); }
    else { const int kb = r / 32, nb = r % 32;
        tr_item(IN_(24) + (size_t)e * DEXP * D, D, 64 * kb, 32 * nb, (bf16_t*)(ws + WS_EXDN) + (size_t)e * D * DEXP, DEXP, 32 * nb, scr, lane); }
}
constexpr int EXP_ITEMS = 8 * 5376;

__device__ __forceinline__ void p0_prologue(const Ctx& C0) {
    const Ctx C = opaque(C0);
    unsigned char* ws = WS_;
    LAS float* sil = (LAS float*)(C.lds + LDSX_OFF);
    LAS float* tab = (LAS float*)(C.lds + LDSX_OFF + 12288);
    for (int i = C.tid; i < 3072; i += NTHREADS) { const float v = i < 2048 ? IN_(1)[i] : IN_(3)[i - 2048]; sil[i] = v / (1.0f + __expf(-v)); }
    if (C.tid < 128) { float s, c; sincospif((float)C.tid / 64.0f, &s, &c); tab[2 * C.tid] = c; tab[2 * C.tid + 1] = s; }
    __syncthreads();
    if (C.wave == 0 && C.vcu < 192) {
        const int l = C.vcu / 96, col = (C.vcu % 96) * 64 + C.lane; const float* w = IN_(4) + (size_t)l * D * NMOD + col;
        float a0 = 0.f, a1 = 0.f, a2 = 0.f;
        for (int k = 0; k < D; k += 16) { float wv[16];
#pragma unroll
            for (int j = 0; j < 16; ++j) wv[j] = w[(size_t)(k + j) * NMOD];
#pragma unroll
            for (int j = 0; j < 16; ++j) { a0 += sil[k + j] * wv[j]; a1 += sil[1024 + k + j] * wv[j]; a2 += sil[2048 + k + j] * wv[j]; } }
        const float b = IN_(5)[l * NMOD + col]; float* mv = (float*)(ws + WS_MODV) + (size_t)l * 3 * NMOD + col;
        mv[0] = a0 + b; mv[NMOD] = a1 + b; mv[2 * NMOD] = a2 + b;
    }
    for (int idx = C.vcu * NTHREADS + C.tid; idx < 4096 + 65536 + 32768; idx += C.G * NTHREADS) {
        if (idx < 4096) { const int pos = idx >> 4, f = idx & 15; const float inv = 1.0f / powf(10000.0f, (float)(2 * f) / 32.0f), ang = (float)pos * inv;
            float* t = (float*)(ws + WS_ROPE) + 2 * idx; t[0] = cosf(ang); t[1] = sinf(ang); }
        else if (idx < 4096 + 65536) { const int i = idx - 4096, m = i >> 8, k = i & 255, k1 = m >> 1, part = m & 1, n1 = k & 127, isb = k >> 7; const int p = (k1 * n1) & 127;
            float s, c; sincospif((float)p / 64.0f, &s, &c); const float v = part == 0 ? (isb ? -s : c) : (isb ? -c : -s);
            ((bf16_t*)(ws + WS_G1))[i] = (bf16_t)pk2(v * 0.08838834764831845f, 0.f); }
        else { const int i = idx - 4096 - 65536, k2 = i >> 8, k = i & 255, n2 = k & 127, isi = k >> 7; const int p = (k2 * n2) & 127;
            float s, c; sincospif((float)p / 64.0f, &s, &c); ((bf16_t*)(ws + WS_G2))[i] = (bf16_t)pk2((isi ? s : c) * 0.08838834764831845f, 0.f); }
    }
    LAS float* scr = (LAS float*)(C.lds + C.wave * 16384);
    const int gw = C.vcu * NWAVES + C.wave, NGW = C.G * NWAVES;
    for (int it = gw; it < P0_ITEMS; it += NGW) p0_convert_item(it, scr, C.lane);
    LAS float* wf = scr + 2304;
    for (int t = gw; t < 2 * 1024 * 4; t += NGW) {
        const int l = t >> 12, k = (t >> 2) & 1023, g = t & 3; const float* src = IN_(10) + (size_t)l * D * 5888 + (size_t)k * 5888 + 768 + g * 128;
        wf[C.lane] = src[C.lane]; wf[C.lane + 64] = src[C.lane + 64];
        LDS_WAIT(); asm volatile("" ::: "memory");
        float aA0 = 0.f, aB0 = 0.f, aA1 = 0.f, aB1 = 0.f; const int j0 = C.lane, j1 = C.lane + 64;
#pragma unroll 4
        for (int c = 0; c < 128; ++c) { const float w = wf[c]; const int i0 = (c * j0) & 127, i1 = (c * j1) & 127;
            aA0 += w * tab[2 * i0]; aB0 += w * tab[2 * i0 + 1]; aA1 += w * tab[2 * i1]; aB1 += w * tab[2 * i1 + 1]; }
        bf16_t* wt = (bf16_t*)(ws + WS_WIN + l * WIN_BYTES); const float sc = 0.08838834764831845f;
        wt[(size_t)(768 + g * 128 + j0) * D + k] = (bf16_t)pk2(aA0 * sc, 0.f); wt[(size_t)(768 + g * 128 + j1) * D + k] = (bf16_t)pk2(aA1 * sc, 0.f);
        wt[(size_t)(1280 + g * 128 + j0) * D + k] = (bf16_t)pk2(aB0 * sc, 0.f); wt[(size_t)(1280 + g * 128 + j1) * D + k] = (bf16_t)pk2(aB1 * sc, 0.f);
        LDS_WAIT(); asm volatile("" ::: "memory");
    }
}

__device__ __forceinline__ void norm_row(const float* xin, float* xout, bool has_br, const f32x4 (&br)[4], const float* gpost, const float* ga,
                                         const float* gpre, const float* sc, const float* sh, bf16_t* hn, int lane, f32x4 (&h2f)[4]) {
    f32x4 x[4];
#pragma unroll
    for (int j = 0; j < 4; ++j) x[j] = *(const GAS f32x4*)(xin + 4 * lane + 256 * j);
    if (has_br) {
        float ss = 0.f;
#pragma unroll
        for (int j = 0; j < 4; ++j) ss += (br[j][0] * br[j][0] + br[j][1] * br[j][1]) + (br[j][2] * br[j][2] + br[j][3] * br[j][3]);
        const float rstd = 1.0f / sqrtf(wave_sum(ss) * (1.0f / D) + EPS);
#pragma unroll
        for (int j = 0; j < 4; ++j) { const f32x4 gp = *(const GAS f32x4*)(gpost + 4 * lane + 256 * j), gg = *(const GAS f32x4*)(ga + 4 * lane + 256 * j); x[j] = x[j] + gg * (br[j] * rstd * gp); }
    }
    if (xout) {
#pragma unroll
        for (int j = 0; j < 4; ++j) *(GAS f32x4*)(xout + 4 * lane + 256 * j) = x[j];
    }
    if (hn) {
        float ss = 0.f;
#pragma unroll
        for (int j = 0; j < 4; ++j) ss += (x[j][0] * x[j][0] + x[j][1] * x[j][1]) + (x[j][2] * x[j][2] + x[j][3] * x[j][3]);
        const float rstd = 1.0f / sqrtf(wave_sum(ss) * (1.0f / D) + EPS);
#pragma unroll
        for (int j = 0; j < 4; ++j) { const f32x4 gp = *(const GAS f32x4*)(gpre + 4 * lane + 256 * j), s1 = *(const GAS f32x4*)(sc + 4 * lane + 256 * j), s0 = *(const GAS f32x4*)(sh + 4 * lane + 256 * j);
            const f32x4 h = (x[j] * rstd * gp) * (s1 + 1.0f) + s0; h2f[j] = h;
            u32x2 w; w.x = pk2(h[0], h[1]); w.y = pk2(h[2], h[3]); *(GAS u32x2*)(hn + 4 * lane + 256 * j) = w; }
    }
}
__device__ __forceinline__ void load_br(const bf16_t* p, int lane, f32x4 (&br)[4]) {
#pragma unroll
    for (int j = 0; j < 4; ++j) { const u32x2 w = *(const GAS u32x2*)(p + 4 * lane + 256 * j); br[j] = (f32x4){bflo(w.x), bfhi(w.x), bflo(w.y), bfhi(w.y)}; }
}
__device__ __forceinline__ int mod_set(int row) { return row >= M_LAT ? 2 : (row >> 14); }

__device__ __forceinline__ void phase_norm0(const Ctx& C0) {
    const Ctx C = opaque(C0);
    const int gw = C.vcu * NWAVES + C.wave, NGW = C.G * NWAVES; const float* modv = (const float*)(WS_ + WS_MODV);
    bf16_t* HN = (bf16_t*)(WS_ + WS_HN); const float* gpre = IN_(6); const float* x0 = IN_(0); const float* c0 = IN_(2);
    for (int row = gw; row < MT; row += NGW) {
        const float* xin = row < M_LAT ? x0 + (size_t)row * D : c0 + (size_t)(row - M_LAT) * D;
        const float* mv = modv + (size_t)mod_set(row) * NMOD; f32x4 br[4], h2f[4];
#pragma unroll
        for (int j = 0; j < 4; ++j) br[j] = (f32x4){0.f, 0.f, 0.f, 0.f};
        norm_row(xin, nullptr, false, br, nullptr, nullptr, gpre, mv + 1024, mv, HN + (size_t)row * D, C.lane, h2f);
    }
}
__device__ __forceinline__ void phase_norm_mid(const Ctx& C0, int l) {
    const Ctx C = opaque(C0);
    const int gw = C.vcu * NWAVES + C.wave, NGW = C.G * NWAVES; const float* modl = (const float*)(WS_ + WS_MODV) + (size_t)l * 3 * NMOD;
    bf16_t* HN = (bf16_t*)(WS_ + WS_HN); const bf16_t* MIX = (const bf16_t*)(WS_ + WS_MIX);
    LAS unsigned* lcnt = (LAS unsigned*)(C.lds + LDSX_OFF);
    LAS unsigned* stage = (LAS unsigned*)(C.lds + LDSX_OFF + 256);
    const bool moe = (l == 1);
    const float* xsrc = (l == 0) ? IN_(0) : OUT_; float* xdst = OUT_; const float* csrc = IN_(2); float* hctx = (float*)(WS_ + WS_HCTX);
    const float* gpost = IN_(7) + l * D; const float* gpre = IN_(8) + l * D; const float* wrt = IN_(20); const float* brt = IN_(21);
    if (moe) { if (C.tid < 16) lcnt[C.tid] = 0u; __syncthreads(); }
    const int nrows = (l == 0) ? MT : M_LAT; int it = 0;
    for (int row = gw; row < nrows; row += NGW, ++it) {
        const bool lat = row < M_LAT;
        const float* xin = lat ? xsrc + (size_t)row * D : csrc + (size_t)(row - M_LAT) * D;
        float* xout = lat ? xdst + (size_t)row * D : hctx + (size_t)(row - M_LAT) * D;
        const float* mv = modl + (size_t)mod_set(row) * NMOD; f32x4 br[4], h2f[4];
        load_br(MIX + (size_t)row * D, C.lane, br);
        norm_row(xin, xout, true, br, gpost, mv + 2048, gpre, mv + 4096, mv + 3072, HN + (size_t)row * D, C.lane, h2f);
        if (moe) {
            float lg[8];
#pragma unroll
            for (int e = 0; e < 8; ++e) lg[e] = 0.f;
#pragma unroll
            for (int j = 0; j < 4; ++j)
#pragma unroll
                for (int q = 0; q < 4; ++q) { const float* wr = wrt + (size_t)(4 * C.lane + 256 * j + q) * 8; const f32x4 w0 = *(const GAS f32x4*)wr, w1 = *(const GAS f32x4*)(wr + 4); const float h = h2f[j][q];
                    lg[0] += h * w0[0]; lg[1] += h * w0[1]; lg[2] += h * w0[2]; lg[3] += h * w0[3]; lg[4] += h * w1[0]; lg[5] += h * w1[1]; lg[6] += h * w1[2]; lg[7] += h * w1[3]; }
#pragma unroll
            for (int e = 0; e < 8; ++e) lg[e] = wave_sum(lg[e]) + brt[e];
            int e0 = 0; float v0 = lg[0];
#pragma unroll
            for (int e = 1; e < 8; ++e) if (lg[e] > v0) { v0 = lg[e]; e0 = e; }
            int e1 = -1; float v1 = -INFINITY;
#pragma unroll
            for (int e = 0; e < 8; ++e) if (e != e0 && lg[e] > v1) { v1 = lg[e]; e1 = e; }
            const float w1 = 1.0f / (1.0f + __expf(v0 - v1)), w0 = 1.0f - w1;
            if (C.lane == 0) { const unsigned p0 = atomicAdd((unsigned*)&lcnt[e0], 1u), p1 = atomicAdd((unsigned*)&lcnt[e1], 1u);
                LAS unsigned* st = stage + (C.wave * 24 + it) * 6; st[0] = (unsigned)e0; st[1] = p0; st[2] = __float_as_uint(w0); st[3] = (unsigned)e1; st[4] = p1; st[5] = __float_as_uint(w1); }
        }
    }
    if (moe) {
        __syncthreads();
        if (C.tid < 8) lcnt[8 + C.tid] = __hip_atomic_fetch_add((unsigned*)(WS_ + WS_CTL) + CW_CNT + 64 * C.tid, lcnt[C.tid], __ATOMIC_RELAXED, __HIP_MEMORY_SCOPE_AGENT);
        __syncthreads();
        if (C.lane == 0) { int i2 = 0; int* elist = (int*)(WS_ + WS_ELIST); unsigned* asg = (unsigned*)(WS_ + WS_ASG);
            for (int row = gw; row < nrows; row += NGW, ++i2) { const LAS unsigned* st = stage + (C.wave * 24 + i2) * 6;
                const unsigned e0 = st[0], p0 = st[1] + lcnt[8 + e0], e1 = st[3], p1 = st[4] + lcnt[8 + e1];
                elist[e0 * M_LAT + p0] = row; elist[e1 * M_LAT + p1] = row;
                unsigned* a = asg + (size_t)row * 8; a[0] = e0; a[1] = p0; a[2] = st[2]; a[3] = e1; a[4] = p1; a[5] = st[5]; } }
    }
}
__device__ __forceinline__ void phase_norm_end(const Ctx& C0, int l) {
    const Ctx C = opaque(C0);
    const LAS int* tbl = (const LAS int*)(C.lds + MISC_OFF) + 16;
    const int gw = C.vcu * NWAVES + C.wave, NGW = C.G * NWAVES; const float* modl = (const float*)(WS_ + WS_MODV) + (size_t)l * 3 * NMOD;
    const float* modn = (const float*)(WS_ + WS_MODV) + (size_t)3 * NMOD;
    bf16_t* HN = (bf16_t*)(WS_ + WS_HN);
    const int nrows = (l == 0) ? MT : M_LAT;
    float* xlat = OUT_; float* hctx = (float*)(WS_ + WS_HCTX); const bf16_t* F0 = (const bf16_t*)(WS_ + WS_F0); const unsigned* asg = (const unsigned*)(WS_ + WS_ASG);
    const bf16_t* Y = (const bf16_t*)(WS_ + WS_YEXP); const float* gpost = IN_(9) + l * D; const float* gpre = IN_(6) + D;
    for (int row = gw; row < nrows; row += NGW) {
        const bool lat = row < M_LAT;
        float* xio = lat ? xlat + (size_t)row * D : hctx + (size_t)(row - M_LAT) * D;
        const int set = mod_set(row); const float* mv = modl + (size_t)set * NMOD; f32x4 br[4], h2f[4];
        if (l == 0) load_br(F0 + (size_t)row * D, C.lane, br);
        else {
            const unsigned* a = asg + (size_t)row * 8;
            const int e0 = (int)a[0], e1 = (int)a[3]; const float w0 = __uint_as_float(a[2]), w1 = __uint_as_float(a[5]);
            const int t0 = tbl[e0], t1 = tbl[e1];
            f32x4 b0[4], b1[4];
            load_br(Y + ((size_t)t0 * 256 + a[1]) * D, C.lane, b0); load_br(Y + ((size_t)t1 * 256 + a[4]) * D, C.lane, b1);
#pragma unroll
            for (int j = 0; j < 4; ++j) br[j] = b0[j] * w0 + b1[j] * w1;
        }
        const bool next = (l == 0);
        norm_row(xio, xio, true, br, gpost, mv + 5120, gpre, modn + (size_t)set * NMOD + 1024, modn + (size_t)set * NMOD, next ? HN + (size_t)row * D : nullptr, C.lane, h2f);
    }
}

constexpr int AT_S = 144;
__device__ __forceinline__ int crow(int r, int h) { return (r & 3) + 8 * (r >> 2) + 4 * h; }
__device__ __forceinline__ void phase_attention(const Ctx& C0, int l, bool with_ctx_q) {
    const Ctx C = opaque(C0);
    bf16_t* Q = (bf16_t*)(WS_ + WS_Q); const bf16_t* KV = (const bf16_t*)(WS_ + WS_KV);
    LAS unsigned char* Kt = C.lds; LAS unsigned char* Vt = C.lds + 64 * AT_S;
    int lane_ = C.lane; asm volatile("" : "+v"(lane_)); const int lane = lane_, w = C.wave, r32 = lane & 31, hh = lane >> 5, qq = (lane & 15) >> 2, pp = lane & 3, blk = (lane >> 4) & 1;
    const int nunits = 1024 + (with_ctx_q ? 16 : 0); const float* sinks = IN_(11) + l * 8;
    for (int unit = C.vcu; unit < nunits; unit += C.G) {
        int b, head, hkv, qrowbase, q0, lo, nloc;
        if (unit < 1024) { const int g = unit & 3, qb = (unit >> 2) & 63; hkv = (unit >> 8) & 1; b = unit >> 9; head = hkv * 4 + g; q0 = qb * 256; qrowbase = b * SEQ + q0;
            lo = q0 - 128 < 0 ? 0 : q0 - 128; const int hi = q0 + 384 > SEQ ? SEQ : q0 + 384; nloc = (hi - lo) >> 6; }
        else { const int x = unit - 1024; b = x >> 3; head = x & 7; hkv = head >> 2; q0 = 0; lo = 0; nloc = 0; qrowbase = M_LAT + b * CTXL; }
        const int ntiles = nloc + 4, qw = q0 + 32 * w;
        bf16x8 qf[4];
        { const bf16_t* qp = Q + (size_t)(qrowbase + 32 * w + r32) * 512 + head * 64 + 8 * hh;
#pragma unroll
          for (int s = 0; s < 4; ++s) qf[s] = *(const GAS bf16x8*)(qp + 16 * s); }
        float m_run = sinks[head] * LOG2E, l_run = hh == 0 ? 1.0f : 0.0f;
        f32x16 o0, o1;
#pragma unroll
        for (int i = 0; i < 16; ++i) { o0[i] = 0.f; o1[i] = 0.f; }
        for (int t = 0; t < ntiles; ++t) {
            const bool local = t < nloc; const int kpos = lo + 64 * t;
            const int krow0 = local ? b * SEQ + kpos : M_LAT + b * CTXL + 64 * (t - nloc);
            __syncthreads();
            { const int row = C.tid >> 3, ch = C.tid & 7; const bf16_t* src = KV + (size_t)(krow0 + row) * 256 + hkv * 64 + ch * 8;
              const u32x4 kx = *(const GAS u32x4*)src, vx = *(const GAS u32x4*)(src + 128);
              *(LAS u32x4*)(Kt + row * AT_S + ch * 16) = kx; *(LAS u32x4*)(Vt + row * AT_S + ch * 16) = vx; }
            __syncthreads();
            const bool relevant = !local || (kpos + 63 >= qw - 128 && kpos <= qw + 31 + 128);
            if (relevant) {
                f32x16 p0, p1;
#pragma unroll
                for (int i = 0; i < 16; ++i) { p0[i] = 0.f; p1[i] = 0.f; }
#pragma unroll
                for (int s = 0; s < 4; ++s) {
                    const bf16x8 k0 = *(const LAS bf16x8*)(Kt + r32 * AT_S + (16 * s + 8 * hh) * 2), k1 = *(const LAS bf16x8*)(Kt + (32 + r32) * AT_S + (16 * s + 8 * hh) * 2);
                    p0 = __builtin_amdgcn_mfma_f32_32x32x16_bf16(k0, qf[s], p0, 0, 0, 0); p1 = __builtin_amdgcn_mfma_f32_32x32x16_bf16(k1, qf[s], p1, 0, 0, 0);
                }
                if (local) { const int qpos = qw + r32;
#pragma unroll
                    for (int i = 0; i < 16; ++i) { const int d0 = kpos + crow(i, hh) - qpos, d1 = d0 + 32;
                        if (d0 > 128 || d0 < -128) p0[i] = -INFINITY; if (d1 > 128 || d1 < -128) p1[i] = -INFINITY; } }
                float mt = fmaxf(p0[0], p1[0]);
#pragma unroll
                for (int i = 1; i < 16; ++i) mt = fmaxf(mt, fmaxf(p0[i], p1[i]));
                mt = fmaxf(mt, __shfl_xor(mt, 32));
                const float mn = fmaxf(m_run, mt), alpha = __builtin_amdgcn_exp2f(m_run - mn); m_run = mn;
                float ls = 0.f;
#pragma unroll
                for (int i = 0; i < 16; ++i) { p0[i] = __builtin_amdgcn_exp2f(p0[i] - mn); p1[i] = __builtin_amdgcn_exp2f(p1[i] - mn); ls += p0[i] + p1[i]; }
                l_run = l_run * alpha + ls;
#pragma unroll
                for (int i = 0; i < 16; ++i) { o0[i] *= alpha; o1[i] *= alpha; }
#pragma unroll
                for (int kb = 0; kb < 2; ++kb)
#pragma unroll
                    for (int s2 = 0; s2 < 2; ++s2) {
                        u32x4 pw;
                        if (kb == 0) { pw.x = pk2(p0[8 * s2 + 0], p0[8 * s2 + 1]); pw.y = pk2(p0[8 * s2 + 2], p0[8 * s2 + 3]); pw.z = pk2(p0[8 * s2 + 4], p0[8 * s2 + 5]); pw.w = pk2(p0[8 * s2 + 6], p0[8 * s2 + 7]); }
                        else { pw.x = pk2(p1[8 * s2 + 0], p1[8 * s2 + 1]); pw.y = pk2(p1[8 * s2 + 2], p1[8 * s2 + 3]); pw.z = pk2(p1[8 * s2 + 4], p1[8 * s2 + 5]); pw.w = pk2(p1[8 * s2 + 6], p1[8 * s2 + 7]); }
                        const bf16x8 pb = __builtin_bit_cast(bf16x8, pw);
                        const int kbase = 32 * kb + 16 * s2 + 4 * hh + qq;
#pragma unroll
                        for (int c = 0; c < 2; ++c) {
                            const LAS unsigned char* va = Vt + kbase * AT_S + (32 * c + 16 * blk + 4 * pp) * 2;
                            const s16x4 vlo = __builtin_amdgcn_ds_read_tr16_b64_v4i16((LAS s16x4*)va), vhi = __builtin_amdgcn_ds_read_tr16_b64_v4i16((LAS s16x4*)(va + 8 * AT_S));
                            const bf16x8 vf = __builtin_shufflevector(vlo, vhi, 0, 1, 2, 3, 4, 5, 6, 7);
                            if (c == 0) o0 = __builtin_amdgcn_mfma_f32_32x32x16_bf16(vf, pb, o0, 0, 0, 0); else o1 = __builtin_amdgcn_mfma_f32_32x32x16_bf16(vf, pb, o1, 0, 0, 0);
                        }
                    }
            }
        }
        const float linv = 1.0f / (l_run + __shfl_xor(l_run, 32));
        bf16_t* op = Q + (size_t)(qrowbase + 32 * w + r32) * 512 + head * 64 + 4 * hh;
#pragma unroll
        for (int g = 0; g < 4; ++g) {
            u32x2 a, c2; a.x = pk2(o0[4 * g] * linv, o0[4 * g + 1] * linv); a.y = pk2(o0[4 * g + 2] * linv, o0[4 * g + 3] * linv);
            c2.x = pk2(o1[4 * g] * linv, o1[4 * g + 1] * linv); c2.y = pk2(o1[4 * g + 2] * linv, o1[4 * g + 3] * linv);
            *(GAS u32x2*)(op + 8 * g) = a; *(GAS u32x2*)(op + 32 + 8 * g) = c2; }
    }
    __syncthreads();
}

constexpr int FT_S = 144;
__device__ __forceinline__ void phase_fft1(const Ctx& C0) {
    const Ctx C = opaque(C0);
    const bf16_t* FAB = (const bf16_t*)(WS_ + WS_FAB); bf16_t* TP = (bf16_t*)(WS_ + WS_HN); const bf16_t* G1 = (const bf16_t*)(WS_ + WS_G1);
    LAS unsigned char* X = C.lds;
    int lane_ = C.lane; asm volatile("" : "+v"(lane_)); const int lane = lane_, w = C.wave, r32 = lane & 31, hh = lane >> 5, qq = (lane & 15) >> 2, pp = lane & 3, blk = (lane >> 4) & 1;
    bf16x8 gf[16];
#pragma unroll
    for (int s = 0; s < 16; ++s) gf[s] = *(const GAS bf16x8*)(G1 + (size_t)(32 * w + r32) * 256 + 16 * s + 8 * hh);
    for (int unit = C.vcu; unit < 2048; unit += C.G) {
        const int b = unit >> 10, n2 = (unit >> 3) & 127, cb = unit & 7;
        __syncthreads();
#pragma unroll
        for (int i = 0; i < 4; ++i) { const int idx = C.tid + NTHREADS * i, k = idx >> 3, ch = idx & 7;
            const bf16_t* src = FAB + (size_t)(b * SEQ + 128 * (k & 127) + n2) * 1024 + (k >> 7) * 512 + cb * 64 + ch * 8;
            *(LAS u32x4*)(X + k * FT_S + ch * 16) = *(const GAS u32x4*)src; }
        __syncthreads();
        float tc[8], ts[8];
#pragma unroll
        for (int i = 0; i < 8; ++i) { const int k1 = 16 * w + (crow(2 * i, hh) >> 1); sincospif((float)(k1 * n2) * (1.0f / 8192.0f), &ts[i], &tc[i]); }
#pragma unroll
        for (int cbk = 0; cbk < 2; ++cbk) {
            f32x16 acc;
#pragma unroll
            for (int i = 0; i < 16; ++i) acc[i] = 0.f;
#pragma unroll
            for (int s = 0; s < 16; ++s) {
                const LAS unsigned char* xa = X + (16 * s + 8 * hh + qq) * FT_S + (32 * cbk + 16 * blk + 4 * pp) * 2;
                const s16x4 lo = __builtin_amdgcn_ds_read_tr16_b64_v4i16((LAS s16x4*)xa), hi = __builtin_amdgcn_ds_read_tr16_b64_v4i16((LAS s16x4*)(xa + 4 * FT_S));
                acc = __builtin_amdgcn_mfma_f32_32x32x16_bf16(gf[s], __builtin_shufflevector(lo, hi, 0, 1, 2, 3, 4, 5, 6, 7), acc, 0, 0, 0);
            }
#pragma unroll
            for (int i = 0; i < 8; ++i) { const int k1 = 16 * w + (crow(2 * i, hh) >> 1); const float re = acc[2 * i], im = acc[2 * i + 1];
                const float tr = re * tc[i] + im * ts[i], ti = im * tc[i] - re * ts[i];
                bf16_t* dst = TP + (size_t)(b * SEQ + 128 * k1 + n2) * 1024 + cb * 64 + 32 * cbk + r32;
                dst[0] = (bf16_t)pk2(tr, 0.f); dst[512] = (bf16_t)pk2(ti, 0.f); }
        }
    }
    __syncthreads();
}
__device__ __forceinline__ void phase_fft2(const Ctx& C0) {
    const Ctx C = opaque(C0);
    const bf16_t* TP = (const bf16_t*)(WS_ + WS_HN); bf16_t* FN = (bf16_t*)(WS_ + WS_FAB); const bf16_t* G2 = (const bf16_t*)(WS_ + WS_G2);
    LAS unsigned char* X = C.lds;
    int lane_ = C.lane; asm volatile("" : "+v"(lane_)); const int lane = lane_, w = C.wave, r32 = lane & 31, hh = lane >> 5, qq = (lane & 15) >> 2, pp = lane & 3, blk = (lane >> 4) & 1;
    const int rs = w & 3, cbk = w >> 2;
    bf16x8 gf[16];
#pragma unroll
    for (int s = 0; s < 16; ++s) gf[s] = *(const GAS bf16x8*)(G2 + (size_t)(32 * rs + r32) * 256 + 16 * s + 8 * hh);
    for (int unit = C.vcu; unit < 2048; unit += C.G) {
        const int b = unit >> 10, k1 = (unit >> 3) & 127, cb = unit & 7;
        __syncthreads();
#pragma unroll
        for (int i = 0; i < 4; ++i) { const int idx = C.tid + NTHREADS * i, k = idx >> 3, ch = idx & 7;
            const bf16_t* src = TP + (size_t)(b * SEQ + 128 * k1 + (k & 127)) * 1024 + (k >> 7) * 512 + cb * 64 + ch * 8;
            *(LAS u32x4*)(X + k * FT_S + ch * 16) = *(const GAS u32x4*)src; }
        __syncthreads();
        f32x16 acc;
#pragma unroll
        for (int i = 0; i < 16; ++i) acc[i] = 0.f;
#pragma unroll
        for (int s = 0; s < 16; ++s) {
            const LAS unsigned char* xa = X + (16 * s + 8 * hh + qq) * FT_S + (32 * cbk + 16 * blk + 4 * pp) * 2;
            const s16x4 lo = __builtin_amdgcn_ds_read_tr16_b64_v4i16((LAS s16x4*)xa), hi = __builtin_amdgcn_ds_read_tr16_b64_v4i16((LAS s16x4*)(xa + 4 * FT_S));
            acc = __builtin_amdgcn_mfma_f32_32x32x16_bf16(gf[s], __builtin_shufflevector(lo, hi, 0, 1, 2, 3, 4, 5, 6, 7), acc, 0, 0, 0);
        }
#pragma unroll
        for (int i = 0; i < 16; ++i) { const int k2 = 32 * rs + crow(i, hh);
            FN[(size_t)(b * SEQ + k1 + 128 * k2) * 512 + cb * 64 + 32 * cbk + r32] = (bf16_t)pk2(acc[i], 0.f); }
    }
    __syncthreads();
}
__device__ __forceinline__ void phase_ctx_dft(const Ctx& C0) {
    const Ctx C = opaque(C0);
    const bf16_t* FAB = (const bf16_t*)(WS_ + WS_FAB); bf16_t* FN = (bf16_t*)(WS_ + WS_FAB);
    LAS float* tab = (LAS float*)(C.lds + LDSX_OFF);
    if (C.tid < 256) { float s, c; sincospif((float)C.tid / 128.0f, &s, &c); tab[2 * C.tid] = c; tab[2 * C.tid + 1] = s; }
    __syncthreads();
    for (int o = C.vcu * NTHREADS + C.tid; o < M_CTX * 512; o += C.G * NTHREADS) {
        const int c = o & 511, k = (o >> 9) & 255, b = o >> 17; const bf16_t* a = FAB + (size_t)(M_LAT + b * CTXL) * 1024 + c;
        float acc = 0.f;
#pragma unroll 8
        for (int n = 0; n < 256; ++n) { const int i = (k * n) & 255; const unsigned short av = a[(size_t)n * 1024], bv = a[(size_t)n * 1024 + 512];
            acc += __uint_as_float((unsigned)av << 16) * tab[2 * i] - __uint_as_float((unsigned)bv << 16) * tab[2 * i + 1]; }
        FN[(size_t)(M_LAT + b * CTXL + k) * 512 + c] = (bf16_t)pk2(acc * 0.0625f, 0.f);
    }
    __syncthreads();
}
__device__ __forceinline__ void unpack8(const u32x4 w, float (&f)[8]) { f[0] = bflo(w.x); f[1] = bfhi(w.x); f[2] = bflo(w.y); f[3] = bfhi(w.y); f[4] = bflo(w.z); f[5] = bfhi(w.z); f[6] = bflo(w.w); f[7] = bfhi(w.w); }
__device__ __forceinline__ void phase_conv(const Ctx& C0, int l, int nrows) {
    const Ctx C = opaque(C0);
    const bf16_t* CIN = (const bf16_t*)(WS_ + WS_CIN); bf16_t* CO = (bf16_t*)(WS_ + WS_COUT); const float* wc = IN_(12) + l * 3 * 512;
    for (int it = C.vcu * NTHREADS + C.tid; it < nrows * 64; it += C.G * NTHREADS) {
        const int row = it >> 6, c0 = (it & 63) * 8; const bool lat = row < M_LAT;
        const int s = lat ? (row & (SEQ - 1)) : ((row - M_LAT) & (CTXL - 1)), last = lat ? SEQ - 1 : CTXL - 1;
        const bf16_t* p = CIN + (size_t)row * 1536 + c0;
        float xm[8], cm[8], x0[8], cc0[8], xp[8], cp[8], bb[8];
        const u32x4 z = (u32x4){0u, 0u, 0u, 0u};
        unpack8(s > 0 ? *(const GAS u32x4*)(p - 1536) : z, xm); unpack8(s > 0 ? *(const GAS u32x4*)(p - 1536 + 1024) : z, cm);
        unpack8(*(const GAS u32x4*)p, x0); unpack8(*(const GAS u32x4*)(p + 1024), cc0); unpack8(*(const GAS u32x4*)(p + 512), bb);
        unpack8(s < last ? *(const GAS u32x4*)(p + 1536) : z, xp); unpack8(s < last ? *(const GAS u32x4*)(p + 1536 + 1024) : z, cp);
        float y[8];
#pragma unroll
        for (int j = 0; j < 8; ++j) y[j] = bb[j] * (xm[j] * cm[j] * wc[c0 + j] + x0[j] * cc0[j] * wc[512 + c0 + j] + xp[j] * cp[j] * wc[1024 + c0 + j]);
        u32x4 o; o.x = pk2(y[0], y[1]); o.y = pk2(y[2], y[3]); o.z = pk2(y[4], y[5]); o.w = pk2(y[6], y[7]);
        *(GAS u32x4*)(CO + (size_t)row * 512 + c0) = o;
    }
}
__device__ __forceinline__ void phase_moe_gather(const Ctx& C0, int chunk, int ntiles) {
    const Ctx C = opaque(C0);
    const bf16_t* HN = (const bf16_t*)(WS_ + WS_HN); bf16_t* H2G = (bf16_t*)(WS_ + WS_H2G); const int* EL = (const int*)(WS_ + WS_ELIST);
    const LAS int* tbl = (const LAS int*)(C.lds + MISC_OFF) + 16;
    const int gw = C.vcu * NWAVES + C.wave, NGW = C.G * NWAVES;
    for (int rl = gw; rl < CHUNK_ROWS; rl += NGW) {
        const int R = chunk * CHUNK_ROWS + rl, t = R >> 8; if (t >= ntiles) break;
        int e = 0;
#pragma unroll
        for (int k = 1; k < 8; ++k) e += (t >= tbl[k]) ? 1 : 0;
        const int pos = R - tbl[e] * 256, ce = tbl[8 + e];
        u32x4 v0 = (u32x4){0u, 0u, 0u, 0u}, v1 = v0;
        if (pos < ce) { const int tok = EL[e * M_LAT + pos]; const bf16_t* src = HN + (size_t)tok * D + C.lane * 16; v0 = *(const GAS u32x4*)src; v1 = *(const GAS u32x4*)(src + 8); }
        bf16_t* dst = H2G + (size_t)rl * D + C.lane * 16; *(GAS u32x4*)dst = v0; *(GAS u32x4*)(dst + 8) = v1;
    }
}

__global__ void __launch_bounds__(NTHREADS, 2) dit_fwd(Params P) {
    extern __shared__ __attribute__((aligned(16))) unsigned char lds_raw[];
    Ctx C;
    C.lds = (LAS unsigned char*)lds_raw;
    C.tid = threadIdx.x; C.lane = C.tid & 63; C.wave = __builtin_amdgcn_readfirstlane(C.tid >> 6);
    C.G = gridDim.x; { const int bx = blockIdx.x; C.vcu = (C.G % 8 == 0) ? (bx % 8) * (C.G / 8) + bx / 8 : bx; }
    volatile LAS unsigned* MISC = (volatile LAS unsigned*)(C.lds + MISC_OFF);
    if (C.tid < 32) MISC[C.tid] = 0u;
    __syncthreads();
    (void)xcd_barrier_post((unsigned*)(WS_ + WS_CTL) + CW_BAR, MISC + 8);
#define GRID_BAR() do { XcdBarrier b_; b_.bar = (unsigned*)(WS_ + WS_CTL) + CW_BAR; b_.x = xb_xcc_id(); b_.st = (volatile LAS unsigned*)(C.lds + MISC_OFF) + 8; xcd_barrier(b_); } while (0)
    LAS unsigned char* ring = C.lds;
    const int bid = (int)blockIdx.x;

    p0_prologue(C);
    GRID_BAR();
    phase_norm0(C);
    GRID_BAR();

    for (int l = 0; l < 2; ++l) {
        const int nM = (l == 0) ? MT / 256 : M_LAT / 256;
        {
            unsigned char* ws = WS_;
            pg8::Gemm g{(const bf16_t*)(ws + WS_HN), (const bf16_t*)(ws + WS_WIN + l * WIN_BYTES), MT, ZN, D};
            pg8::RectOrder S; if (l == 0) S.init(MT / 256, ZN / 256, C.G, bid); else S.init(M_LAT / 256, ZN / 256, C.G, bid, 0, 2, M_LAT / 256, 2);
            pg8::EpiIn E{ws, WS_Q, WS_KV, WS_FAB, WS_CIN, WS_GT, WS_ROPE, QSCALE};
            pg8::gemm_phase<pg8::EpiIn, pg8::RectOrder, true, true>(ring, g, S, E);
        }
        GRID_BAR();
        phase_attention(C, l, l == 0);
        phase_fft1(C);
        phase_conv(C, l, nM * 256);
        GRID_BAR();
        phase_fft2(C);
        if (l == 0) phase_ctx_dft(C);
        GRID_BAR();
        {
            unsigned char* ws = WS_;
            pg8::RectOrder S; S.init(nM, 4, C.G, bid);
            const bf16_t* WY = (const bf16_t*)(ws + WS_WY) + (size_t)l * 3 * 1024 * 512; bf16_t* HN = (bf16_t*)(ws + WS_HN);
            { pg8::Gemm g{(const bf16_t*)(ws + WS_Q), WY, MT, D, 512}; pg8::EpiMerge<true> E{HN, (const bf16_t*)(ws + WS_GT), 0};
              pg8::gemm_phase<pg8::EpiMerge<true>, pg8::RectOrder, true, true>(ring, g, S, E); }
            { pg8::Gemm g{(const bf16_t*)(ws + WS_FAB), WY + (size_t)1024 * 512, MT, D, 512}; pg8::EpiMerge<false> E{HN, (const bf16_t*)(ws + WS_GT), 1024};
              pg8::gemm_phase<pg8::EpiMerge<false>, pg8::RectOrder, true, true>(ring, g, S, E); }
            { pg8::Gemm g{(const bf16_t*)(ws + WS_COUT), WY + (size_t)2 * 1024 * 512, MT, D, 512}; pg8::EpiMerge<false> E{HN, (const bf16_t*)(ws + WS_GT), 2048};
              pg8::gemm_phase<pg8::EpiMerge<false>, pg8::RectOrder, true, true>(ring, g, S, E); }
        }
        GRID_BAR();
        {
            unsigned char* ws = WS_;
            pg8::Gemm g{(const bf16_t*)(ws + WS_HN), (const bf16_t*)(ws + WS_WO) + (size_t)l * D * D, MT, D, D}; pg8::RectOrder S; S.init(nM, 4, C.G, bid);
            pg8::EpiPlain E{(bf16_t*)(ws + WS_MIX), D, 4, 0};
            pg8::gemm_phase<pg8::EpiPlain, pg8::RectOrder, true, true>(ring, g, S, E);
        }
        GRID_BAR();
        if (l == 1) {
            LAS float* scr = (LAS float*)(C.lds + C.wave * 16384);
            for (int it = C.vcu * NWAVES + C.wave; it < EXP_ITEMS; it += C.G * NWAVES) expert_convert_item(it, scr, C.lane);
        }
        phase_norm_mid(C, l);
        GRID_BAR();
        if (l == 0) {
            { unsigned char* ws = WS_;
              pg8::Gemm g{(const bf16_t*)(ws + WS_HN), (const bf16_t*)(ws + WS_WFF_UP), MT, 2 * DFF, D}; pg8::RectOrder S; S.init(nM, 2 * DFF / 256, C.G, bid);
              pg8::EpiSwiglu E{(bf16_t*)(ws + WS_HID0), DFF, 2 * DFF / 256};
              pg8::gemm_phase<pg8::EpiSwiglu, pg8::RectOrder, true, true>(ring, g, S, E); }
            GRID_BAR();
            { unsigned char* ws = WS_;
              pg8::Gemm g{(const bf16_t*)(ws + WS_HID0), (const bf16_t*)(ws + WS_WFF_DN), MT, D, DFF}; pg8::RectOrder S; S.init(nM, 4, C.G, bid);
              pg8::EpiPlain E{(bf16_t*)(ws + WS_F0), D, 4, 0};
              pg8::gemm_phase<pg8::EpiPlain, pg8::RectOrder, true, true>(ring, g, S, E); }
            GRID_BAR();
        } else {
            if (C.tid == 0) { const unsigned* ctl = (const unsigned*)(WS_ + WS_CTL); unsigned tb = 0u;
                for (int e = 0; e < 8; ++e) { const unsigned c = __hip_atomic_load(ctl + CW_CNT + 64 * e, __ATOMIC_RELAXED, __HIP_MEMORY_SCOPE_AGENT); MISC[16 + e] = tb; MISC[24 + e] = c; tb += (c + 255u) >> 8; } }
            __syncthreads();
            const int T = __builtin_amdgcn_readfirstlane((int)(MISC[23] + ((MISC[31] + 255u) >> 8))), nchunks = (T + CHUNK_TILES - 1) / CHUNK_TILES;
            const LAS int* tbl = (const LAS int*)(C.lds + MISC_OFF) + 16;
            for (int ch = 0; ch < nchunks; ++ch) {
                const int tc = (T - ch * CHUNK_TILES) < CHUNK_TILES ? (T - ch * CHUNK_TILES) : CHUNK_TILES;
                phase_moe_gather(C, ch, T);
                GRID_BAR();
                { unsigned char* ws = WS_;
                  pg8::Gemm g{(const bf16_t*)(ws + WS_H2G), (const bf16_t*)(ws + WS_EXUP), CHUNK_ROWS, 8 * 7168, D};
                  pg8::MoeOrder S{tc, 28, ch * CHUNK_TILES, C.G, bid, tbl};
                  pg8::EpiSwiglu E{(bf16_t*)(ws + WS_HIDX), DEXP, 28};
                  pg8::gemm_phase<pg8::EpiSwiglu, pg8::MoeOrder, true, true>(ring, g, S, E); }
                GRID_BAR();
                { unsigned char* ws = WS_;
                  pg8::Gemm g{(const bf16_t*)(ws + WS_HIDX), (const bf16_t*)(ws + WS_EXDN), CHUNK_ROWS, 8 * 1024, DEXP};
                  pg8::MoeOrder S{tc, 4, ch * CHUNK_TILES, C.G, bid, tbl};
                  pg8::EpiPlain E{(bf16_t*)(ws + WS_YEXP), D, 4, ch * CHUNK_ROWS};
                  pg8::gemm_phase<pg8::EpiPlain, pg8::MoeOrder, true, true>(ring, g, S, E); }
                GRID_BAR();
            }
        }
        phase_norm_end(C, l);
        if (l == 0) GRID_BAR();
    }
#undef GRID_BAR
}

extern "C" void kernel_launch(void* const* d_in, const int* in_sizes, int n_in, void* d_out, int out_size, void* d_ws, size_t ws_size, hipStream_t stream) {
    static int grid = 0;
    if (grid == 0) {
        if (n_in != 25 || in_sizes[0] != M_LAT * D || out_size != M_LAT * D || ws_size < WS_NEED) {
            fprintf(stderr, "kernel_launch: built for 25 inputs, x/out of %d floats, >= %zu bytes of workspace; got n_in %d, in0 %d, out %d, ws %zu; nothing launched\n", M_LAT * D, (size_t)WS_NEED, n_in, n_in > 0 ? in_sizes[0] : -1, out_size, ws_size);
            grid = -1; return; }
        int dev = 0, cus = 0, per_cu = 0;
        if (hipGetDevice(&dev) != hipSuccess || hipDeviceGetAttribute(&cus, hipDeviceAttributeMultiprocessorCount, dev) != hipSuccess) { fprintf(stderr, "kernel_launch: device query failed\n"); grid = -1; return; }
        if (hipFuncSetAttribute((const void*)dit_fwd, hipFuncAttributeMaxDynamicSharedMemorySize, LDS_BYTES) != hipSuccess) { fprintf(stderr, "kernel_launch: hipFuncSetAttribute failed\n"); grid = -1; return; }
        if (hipOccupancyMaxActiveBlocksPerMultiprocessor(&per_cu, (const void*)dit_fwd, NTHREADS, LDS_BYTES) != hipSuccess || per_cu < 1) { fprintf(stderr, "kernel_launch: occupancy query says %d workgroups per CU; nothing launched\n", per_cu); (void)hipGetLastError(); grid = -1; return; }
        (void)hipGetLastError();
        grid = cus;
        if (grid < 192 || grid > 304) { fprintf(stderr, "kernel_launch: unexpected CU count %d\n", cus); grid = -1; return; }
    }
    if (grid < 0) return;
    if (hipMemsetAsync((char*)d_ws + WS_CTL, 0, CTL_BYTES, stream) != hipSuccess) { fprintf(stderr, "kernel_launch: memset failed\n"); return; }
    Params p{};
    for (int i = 0; i < 25; ++i) p.in[i] = (const float*)d_in[i];
    p.out = (float*)d_out; p.ws = (unsigned char*)d_ws;
    hipLaunchKernelGGL(dit_fwd, dim3(grid), dim3(NTHREADS), LDS_BYTES, stream, p);
    const hipError_t le = hipPeekAtLastError();
    if (le != hipSuccess) fprintf(stderr, "kernel_launch: launch failed: %s\n", hipGetErrorName(le));
}
```

```cpp
#include <hip/hip_runtime.h>
#include <cstdio>
#include <cstdint>
#include <cmath>
namespace pg8 {
#define PG8_LAS __attribute__((address_space(3)))
typedef unsigned short bf16_t;
typedef short bf16x8 __attribute__((ext_vector_type(8)));
typedef float f32x4 __attribute__((ext_vector_type(4)));
typedef unsigned u32x4 __attribute__((ext_vector_type(4)));
constexpr int BM = 256, BK = 64, HALF = 128, HTB = HALF * BK * 2  , STAGE_BYTES = 8 * HTB, NXCD = 8, WGM = 8;

__host__ __device__ __forceinline__ int lds_byte(int r, int c) { const int st = (r >> 4) * 2 + (c >> 5), rr = r & 15, cc = c & 31, ob = rr * 64 + cc * 2; return st * 1024 + (ob ^ (((ob >> 9) & 1) << 5)); }
__host__ __device__ __forceinline__ void stage_rc(int b, int& R, int& C) { const int st = b / 1024, sb = b % 1024, swz = sb ^ (((sb >> 9) & 1) << 5); R = (st >> 1) * 16 + swz / 64; C = (st & 1) * 32 + (swz % 64) / 2; }
__host__ __device__ __forceinline__ int perm32(int rho) { const int n = rho >> 4, i = rho & 15; return 8 * (i >> 2) + 4 * n + (i & 3); }

struct Unit { int pm, pn; };
struct Gemm { const bf16_t* A; const bf16_t* Bt; int M, N, K; };

struct StaticOrder {
    int nM, nN, nwg, G, c;
    __host__ __device__ void init(int M, int N, int G_, int c_) { nM = M / BM; nN = N / BM; nwg = nM * nN; G = G_; c = c_; }
    __host__ __device__ bool next(int i, Unit& u) const {
        const long L = (long)i * G + c; if (L >= nwg) return false;
        int wgid = (int)L; { const int q = nwg / NXCD, r = nwg % NXCD, xcd = wgid % NXCD, off = wgid / NXCD; wgid = (xcd < r ? xcd * (q + 1) : r * (q + 1) + (xcd - r) * q) + off; }
        const int nig = WGM * nN, gid = wgid / nig, fm = gid * WGM, gsz = (nM - fm) < WGM ? (nM - fm) : WGM;
        u.pm = fm + ((wgid % nig) % gsz); u.pn = (wgid % nig) / gsz; return true;
    }
    __device__ __forceinline__ void a_ready(const Unit&) const {}
    __device__ __forceinline__ void done(const Unit&) const {}
};

__device__ __forceinline__ unsigned cvt_pk_bf16(float lo, float hi) { unsigned r; asm volatile("v_cvt_pk_bf16_f32 %0, %1, %2" : "=v"(r) : "v"(lo), "v"(hi)); return r; }
struct RectOrder {
    int nM, nN, nwg, G, c, pm0, ne, epm0, epn;
    __device__ __forceinline__ void init(int nM_, int nN_, int G_, int c_, int pm0_ = 0, int ne_ = 0, int epm0_ = 0, int epn_ = 0) { nM = nM_; nN = nN_; nwg = nM * nN; G = G_; c = c_; pm0 = pm0_; ne = ne_; epm0 = epm0_; epn = epn_; }
    __device__ __forceinline__ bool next(int i, Unit& u) const {
        const long L = (long)i * G + c;
        if (L >= nwg) { const long x = L - nwg; if (x >= ne) return false; u.pm = epm0 + (int)x; u.pn = epn; return true; }
        int wgid = (int)L; { const int q = nwg / NXCD, r = nwg % NXCD, xcd = wgid % NXCD, off = wgid / NXCD; wgid = (xcd < r ? xcd * (q + 1) : r * (q + 1) + (xcd - r) * q) + off; }
        const int nig = WGM * nN, gid = wgid / nig, fm = gid * WGM, gsz = (nM - fm) < WGM ? (nM - fm) : WGM;
        u.pm = pm0 + fm + ((wgid % nig) % gsz); u.pn = (wgid % nig) / gsz; return true;
    }
    __device__ __forceinline__ void a_ready(const Unit&) const {}
    __device__ __forceinline__ void done(const Unit&) const {}
};
struct MoeOrder {
    int tc, nN, tile0, G, c; const PG8_LAS int* tbl;
    __device__ __forceinline__ bool next(int i, Unit& u) const {
        const int L = i * G + c; if (L >= tc * nN) return false;
        const int j = L / tc, pml = L - j * tc, t = tile0 + pml;
        int e = 0;
#pragma unroll
        for (int k = 1; k < 8; ++k) e += (t >= __builtin_amdgcn_readfirstlane(tbl[k])) ? 1 : 0;
        u.pm = __builtin_amdgcn_readfirstlane(pml); u.pn = __builtin_amdgcn_readfirstlane(e * nN + j); return true;
    }
    __device__ __forceinline__ void a_ready(const Unit&) const {}
    __device__ __forceinline__ void done(const Unit&) const {}
};

__device__ __forceinline__ float bflo(unsigned u) { return __uint_as_float(u << 16); }
__device__ __forceinline__ float bfhi(unsigned u) { return __uint_as_float(u & 0xffff0000u); }
__device__ __forceinline__ float sigm(float x) { return __builtin_amdgcn_rcpf(1.0f + __builtin_amdgcn_exp2f(-1.4426950408889634f * x)); }
__device__ __forceinline__ u32x4 pack8(const f32x4 a, const f32x4 b) { u32x4 w; w.x = cvt_pk_bf16(a[0], a[1]); w.y = cvt_pk_bf16(a[2], a[3]); w.z = cvt_pk_bf16(b[0], b[1]); w.w = cvt_pk_bf16(b[2], b[3]); return w; }

struct EpiPlain {
    static constexpr bool PERM = true, AFTER_DRAIN = false;
    bf16_t* O; int ld, nmod, row_off; float scale;
    __device__ __forceinline__ void operator()(const f32x4 (&acc)[2][2][4][2], const Unit& u, int wr, int wc, int fr, int fq) const {
        const int row0 = row_off + u.pm * BM + wr * 64 + fr, col0 = (u.pn % nmod) * BM + wc * 32 + 8 * fq;
#pragma unroll
        for (int ai = 0; ai < 2; ++ai)
#pragma unroll
            for (int m = 0; m < 4; ++m) { bf16_t* rowp = O + (size_t)(row0 + ai * HALF + m * 16) * ld + col0;
#pragma unroll
                for (int bj = 0; bj < 2; ++bj) *(u32x4*)(rowp + bj * HALF) = pack8(acc[ai][bj][m][0] * scale, acc[ai][bj][m][1] * scale); }
    }
};
template <bool FIRST> struct EpiMerge {
    static constexpr bool PERM = true, AFTER_DRAIN = false;
    bf16_t* MG; const bf16_t* GT; int gcol0;
    __device__ __forceinline__ void operator()(const f32x4 (&acc)[2][2][4][2], const Unit& u, int wr, int wc, int fr, int fq) const {
        const int row0 = u.pm * BM + wr * 64 + fr, col0 = u.pn * BM + wc * 32 + 8 * fq;
#pragma unroll
        for (int ai = 0; ai < 2; ++ai)
#pragma unroll
            for (int m = 0; m < 4; ++m) { const size_t row = (size_t)(row0 + ai * HALF + m * 16);
#pragma unroll
                for (int bj = 0; bj < 2; ++bj) {
                    const u32x4 g = *(const u32x4*)(GT + row * 3072 + gcol0 + col0 + bj * HALF);
                    f32x4 v0 = acc[ai][bj][m][0], v1 = acc[ai][bj][m][1];
                    v0[0] *= bflo(g.x); v0[1] *= bfhi(g.x); v0[2] *= bflo(g.y); v0[3] *= bfhi(g.y); v1[0] *= bflo(g.z); v1[1] *= bfhi(g.z); v1[2] *= bflo(g.w); v1[3] *= bfhi(g.w);
                    bf16_t* dst = MG + row * 1024 + col0 + bj * HALF;
                    if (!FIRST) { const u32x4 o = *(const u32x4*)dst;
                        v0[0] += bflo(o.x); v0[1] += bfhi(o.x); v0[2] += bflo(o.y); v0[3] += bfhi(o.y); v1[0] += bflo(o.z); v1[1] += bfhi(o.z); v1[2] += bflo(o.w); v1[3] += bfhi(o.w); }
                    *(u32x4*)dst = pack8(v0, v1); } }
    }
};
__device__ __forceinline__ unsigned pack4_fp8(float a, float b, float c, float d) { int p = 0; p = __builtin_amdgcn_cvt_pk_fp8_f32(a, b, p, false); p = __builtin_amdgcn_cvt_pk_fp8_f32(c, d, p, true); return (unsigned)p; }
template <bool F8> struct EpiSwiglu {
    static constexpr bool PERM = true, AFTER_DRAIN = false;
    void* H; int ld, nmod; float scale;
    __device__ __forceinline__ void operator()(const f32x4 (&acc)[2][2][4][2], const Unit& u, int wr, int wc, int fr, int fq) const {
        const int row0 = u.pm * BM + wr * 64 + fr, col0 = (u.pn % nmod) * HALF + wc * 32 + 8 * fq;
#pragma unroll
        for (int ai = 0; ai < 2; ++ai)
#pragma unroll
            for (int m = 0; m < 4; ++m) {
                f32x4 h0, h1;
#pragma unroll
                for (int j = 0; j < 4; ++j) { const float g0 = acc[ai][0][m][0][j] * scale, g1 = acc[ai][0][m][1][j] * scale;
                    h0[j] = g0 * sigm(g0) * (acc[ai][1][m][0][j] * scale); h1[j] = g1 * sigm(g1) * (acc[ai][1][m][1][j] * scale); }
                const size_t off = (size_t)(row0 + ai * HALF + m * 16) * ld + col0;
                if constexpr (F8) { typedef unsigned u32x2_ __attribute__((ext_vector_type(2))); u32x2_ w; w.x = pack4_fp8(h0[0], h0[1], h0[2], h0[3]); w.y = pack4_fp8(h1[0], h1[1], h1[2], h1[3]); *(u32x2_*)((unsigned char*)H + off) = w; }
                else *(u32x4*)((bf16_t*)H + off) = pack8(h0, h1); }
    }
};
struct EpiIn {
    static constexpr bool PERM = true, AFTER_DRAIN = false;
    unsigned char* ws; size_t oQ, oKV, oFAB, oCIN, oGT, oROPE; float qscale;
    __device__ __forceinline__ void operator()(const f32x4 (&acc)[2][2][4][2], const Unit& u, int wr, int wc, int fr, int fq) const {
        const int pn = u.pn, lc0 = wc * 32 + 8 * fq, row0 = u.pm * BM + wr * 64 + fr;
        const bool ctxrow = u.pm >= 128;
        bf16_t* const Q = (bf16_t*)(ws + oQ); bf16_t* const KV = (bf16_t*)(ws + oKV); bf16_t* const FAB = (bf16_t*)(ws + oFAB); bf16_t* const CIN = (bf16_t*)(ws + oCIN); bf16_t* const GT = (bf16_t*)(ws + oGT);
        const float* const rope = (const float*)(ws + oROPE);
#pragma unroll
        for (int bj = 0; bj < 2; ++bj) {
            const int cc = bj * HALF + lc0;
            int mode, ld, dcol; bf16_t* dst;
            if (pn < 2) { mode = 2; dst = Q; ld = 512; dcol = pn * 256 + cc; }
            else if (pn == 2) { dst = KV; ld = 256; dcol = cc; mode = (bj == 0) ? 3 : 0; }
            else if (pn < 7) { mode = 0; dst = FAB; ld = 1024; dcol = (pn - 3) * 256 + cc; }
            else if (pn < 13) { mode = 0; dst = CIN; ld = 1536; dcol = (pn - 7) * 256 + cc; }
            else { mode = 1; dst = GT; ld = 3072; dcol = (pn - 13) * 256 + cc; }
            if (mode == 0) {
#pragma unroll
                for (int ai = 0; ai < 2; ++ai)
#pragma unroll
                    for (int m = 0; m < 4; ++m) *(u32x4*)(dst + (size_t)(row0 + ai * HALF + m * 16) * ld + dcol) = pack8(acc[ai][bj][m][0], acc[ai][bj][m][1]);
            } else if (mode == 1) {
#pragma unroll
                for (int ai = 0; ai < 2; ++ai)
#pragma unroll
                    for (int m = 0; m < 4; ++m) { f32x4 v0 = acc[ai][bj][m][0], v1 = acc[ai][bj][m][1];
#pragma unroll
                        for (int j = 0; j < 4; ++j) { v0[j] = sigm(v0[j]); v1[j] = sigm(v1[j]); }
                        *(u32x4*)(dst + (size_t)(row0 + ai * HALF + m * 16) * ld + dcol) = pack8(v0, v1); }
            } else {
                const float qs = (mode == 2) ? qscale : 1.0f;
                const int i0 = (dcol & 63) >> 1;
#pragma unroll
                for (int ai = 0; ai < 2; ++ai)
#pragma unroll
                    for (int m = 0; m < 4; ++m) { const int row = row0 + ai * HALF + m * 16; f32x4 v0 = acc[ai][bj][m][0], v1 = acc[ai][bj][m][1];
                        if (!ctxrow) { const int s = row & 16383, pos = (i0 < 16) ? (s >> 6) : (s & 63);
                            const float* t = rope + (size_t)(pos * 16 + (i0 & 15)) * 2; const f32x4 t0 = *(const f32x4*)t, t1 = *(const f32x4*)(t + 4);
                            f32x4 r0, r1;
                            r0[0] = v0[0] * t0[0] - v0[1] * t0[1]; r0[1] = v0[0] * t0[1] + v0[1] * t0[0]; r0[2] = v0[2] * t0[2] - v0[3] * t0[3]; r0[3] = v0[2] * t0[3] + v0[3] * t0[2];
                            r1[0] = v1[0] * t1[0] - v1[1] * t1[1]; r1[1] = v1[0] * t1[1] + v1[1] * t1[0]; r1[2] = v1[2] * t1[2] - v1[3] * t1[3]; r1[3] = v1[2] * t1[3] + v1[3] * t1[2];
                            v0 = r0; v1 = r1; }
                        v0 = v0 * qs; v1 = v1 * qs;
                        *(u32x4*)(dst + (size_t)(row0 + ai * HALF + m * 16) * ld + dcol) = pack8(v0, v1); }
            }
        }
    }
};

template <class Epi, class Sched, bool ALIGN_EPI = false, bool SP2 = false, bool FP8 = false>
__device__ __forceinline__ void gemm_phase(PG8_LAS unsigned char* lds, const Gemm g, const Sched& S, const Epi& E, int wave_id  ) {
    unsigned z_ = 0u; asm volatile("" : "+v"(z_)); int wid_ = wave_id; asm volatile("" : "+s"(wid_));
    const int lane_ = (int)__builtin_amdgcn_mbcnt_hi(~0u, __builtin_amdgcn_mbcnt_lo(~0u, z_));
    const int wid = wid_, lane = lane_, tid = wid * 64 + lane, wr = wid >> 2, wc = wid & 3, fr = lane & 15, fq = lane >> 4;
    const int K = g.K, pitch = FP8 ? K : 2 * K  , nt = pitch / 128;
    unsigned voffA, voffB;
    { int R, C; stage_rc(tid * 16, R, C); const int Rb = Epi::PERM ? ((R & ~31) + perm32(R & 31)) : R;
        voffA = (unsigned)(R * pitch + C * 2); voffB = (unsigned)(Rb * pitch + C * 2); }
    const size_t pstep = (size_t)64 * pitch;
    const size_t kstep = (size_t)(BK * 2);
    const size_t hstep = (size_t)HALF * pitch;
    const size_t tstep = 2 * hstep;
    const unsigned ldsw = (unsigned)wid * 1024u;
    const int aoff = lds_byte(wr * 64 + fr, fq * 8), boff = lds_byte(wc * 32 + fr, fq * 8);
#define PG8_SA(b, h) (((b) * 2 + (h)) * HTB)
#define PG8_SB(b, h) ((4 + (b) * 2 + (h)) * HTB)
#define PG8_STAGE(bufoff, gbase, voff) do { _Pragma("unroll") for (int _i = 0; _i < 2; ++_i) \
        __builtin_amdgcn_global_load_lds((const unsigned*)((const char*)(gbase) + _i * pstep + (voff)), (PG8_LAS unsigned*)(lds + (bufoff) + ldsw + _i * 8192), 16, 0, 0); } while (0)
#define PG8_LDA(dst, b, h) do { _Pragma("unroll") for (int m = 0; m < 4; ++m) _Pragma("unroll") for (int k = 0; k < 2; ++k) dst[m][k] = *(const PG8_LAS bf16x8*)(lds + PG8_SA(b, h) + aoff + m * 2048 + k * 1024); } while (0)
#define PG8_LDB(dst, b, h) do { _Pragma("unroll") for (int n = 0; n < 2; ++n) _Pragma("unroll") for (int k = 0; k < 2; ++k) dst[n][k] = *(const PG8_LAS bf16x8*)(lds + PG8_SB(b, h) + boff + n * 2048 + k * 1024); } while (0)
#define PG8_MMA(ai, bj, At, Bt) do { __builtin_amdgcn_s_setprio(1); _Pragma("unroll") for (int m = 0; m < 4; ++m) _Pragma("unroll") for (int n = 0; n < 2; ++n) { \
        if constexpr (FP8) { typedef int i32x4_ __attribute__((ext_vector_type(4))); \
            acc[ai][bj][m][n] = __builtin_amdgcn_mfma_scale_f32_16x16x128_f8f6f4(__builtin_shufflevector(__builtin_bit_cast(i32x4_, Bt[n][0]), __builtin_bit_cast(i32x4_, Bt[n][1]), 0, 1, 2, 3, 4, 5, 6, 7), \
                __builtin_shufflevector(__builtin_bit_cast(i32x4_, At[m][0]), __builtin_bit_cast(i32x4_, At[m][1]), 0, 1, 2, 3, 4, 5, 6, 7), acc[ai][bj][m][n], 0, 0, 0, 0, 0, 0); } \
        else { _Pragma("unroll") for (int k = 0; k < 2; ++k) acc[ai][bj][m][n] = __builtin_amdgcn_mfma_f32_16x16x32_bf16(Bt[n][k], At[m][k], acc[ai][bj][m][n], 0, 0, 0); } } \
        __builtin_amdgcn_s_setprio(0); } while (0)
#define PG8_WAIT_V(n) asm volatile("s_waitcnt vmcnt(" #n ")" ::: "memory")
#define PG8_WAIT_L(n) asm volatile("s_waitcnt lgkmcnt(" #n ")" ::: "memory")
#define PG8_BAR __builtin_amdgcn_s_barrier()
#define PG8_SCHED __builtin_amdgcn_sched_barrier(0)
    Unit cur, nxt; int ui = 0;
    if (!S.next(0, cur)) return;
    f32x4 acc[2][2][4][2];
#pragma unroll
    for (int a = 0; a < 2; ++a)
#pragma unroll
        for (int b = 0; b < 2; ++b)
#pragma unroll
            for (int m = 0; m < 4; ++m)
#pragma unroll
                for (int n = 0; n < 2; ++n) acc[a][b][m][n] = (f32x4){0.f, 0.f, 0.f, 0.f};
    bf16x8 At[4][2], B0[2][2], B1[2][2];
    const char* cA = (const char*)g.A + (size_t)cur.pm * tstep; const char* cB = (const char*)g.Bt + (size_t)cur.pn * tstep;
    S.a_ready(cur);
    if constexpr (SP2) {
        PG8_STAGE(PG8_SB(0, 0), cB, voffB); PG8_STAGE(PG8_SB(0, 1), cB + hstep, voffB); PG8_STAGE(PG8_SA(0, 0), cA, voffA); PG8_STAGE(PG8_SA(0, 1), cA + hstep, voffA);
        if (wr == 1) PG8_BAR;
        PG8_WAIT_V(2); PG8_BAR;
        PG8_STAGE(PG8_SB(1, 0), cB + kstep, voffB); PG8_STAGE(PG8_SA(1, 0), cA + kstep, voffA); PG8_STAGE(PG8_SB(1, 1), cB + hstep + kstep, voffB);
        PG8_WAIT_V(6); PG8_BAR;
    } else {
        PG8_STAGE(PG8_SB(0, 0), cB, voffB); PG8_STAGE(PG8_SA(0, 0), cA, voffA); PG8_STAGE(PG8_SB(0, 1), cB + hstep, voffB); PG8_STAGE(PG8_SA(0, 1), cA + hstep, voffA);
        if (wr == 1) PG8_BAR;
        PG8_WAIT_V(4); PG8_BAR;
        PG8_STAGE(PG8_SB(1, 0), cB + kstep, voffB); PG8_STAGE(PG8_SA(1, 0), cA + kstep, voffA); PG8_STAGE(PG8_SB(1, 1), cB + hstep + kstep, voffB);
        PG8_WAIT_V(6); PG8_BAR;
    }
    for (;;) {
        const bool has_next = S.next(ui + 1, nxt);
        const char* nA = has_next ? (const char*)g.A + (size_t)nxt.pm * tstep : cA; const char* nB = has_next ? (const char*)g.Bt + (size_t)nxt.pn * tstep : cB;
#pragma unroll 1
        for (int t = 0; t < nt; t += 2) {
            const bool last = (t == nt - 2);
            const char* a1 = cA + (size_t)(t + 1) * kstep;
            const char* a2 = last ? nA : cA + (size_t)(t + 2) * kstep; const char* b2 = last ? nB : cB + (size_t)(t + 2) * kstep;
            const char* a3 = a2 + kstep; const char* b3 = b2 + kstep;
            if (last && has_next) S.a_ready(nxt);
            if constexpr (SP2) {
            PG8_LDB(B0, 0, 0); PG8_LDB(B1, 0, 1); PG8_SCHED; PG8_LDA(At, 0, 0); PG8_STAGE(PG8_SA(1, 1), a1 + hstep, voffA);
            PG8_WAIT_V(8); PG8_WAIT_L(0); PG8_BAR; PG8_MMA(0, 0, At, B0); PG8_MMA(0, 1, At, B1); PG8_BAR; PG8_SCHED;
            PG8_LDA(At, 0, 1); PG8_STAGE(PG8_SB(0, 0), b2, voffB); PG8_STAGE(PG8_SB(0, 1), b2 + hstep, voffB); PG8_STAGE(PG8_SA(0, 0), a2, voffA);
            PG8_WAIT_V(8); PG8_WAIT_L(0); PG8_BAR; PG8_MMA(1, 0, At, B0); PG8_MMA(1, 1, At, B1); PG8_BAR; PG8_SCHED;
            PG8_LDB(B0, 1, 0); PG8_LDB(B1, 1, 1); PG8_SCHED; PG8_LDA(At, 1, 0); PG8_STAGE(PG8_SA(0, 1), a2 + hstep, voffA);
            PG8_WAIT_V(8); PG8_WAIT_L(0); PG8_BAR; PG8_MMA(0, 0, At, B0); PG8_MMA(0, 1, At, B1); PG8_BAR; PG8_SCHED;
            PG8_LDA(At, 1, 1); PG8_STAGE(PG8_SB(1, 0), b3, voffB); PG8_STAGE(PG8_SB(1, 1), b3 + hstep, voffB); PG8_STAGE(PG8_SA(1, 0), a3, voffA);
            PG8_WAIT_V(8); PG8_WAIT_L(0); PG8_BAR; PG8_MMA(1, 0, At, B0); PG8_MMA(1, 1, At, B1); PG8_BAR; PG8_SCHED;
            } else {
            PG8_LDB(B0, 0, 0); PG8_SCHED; PG8_LDA(At, 0, 0); PG8_STAGE(PG8_SA(1, 1), a1 + hstep, voffA);
            PG8_WAIT_L(8); PG8_BAR; PG8_WAIT_L(0); PG8_MMA(0, 0, At, B0); PG8_BAR; PG8_SCHED;
            PG8_LDB(B1, 0, 1); PG8_STAGE(PG8_SB(0, 0), b2, voffB);
            PG8_BAR; PG8_WAIT_L(0); PG8_MMA(0, 1, At, B1); PG8_BAR;
            PG8_LDA(At, 0, 1); PG8_STAGE(PG8_SA(0, 0), a2, voffA);
            PG8_BAR; PG8_WAIT_L(0); PG8_MMA(1, 0, At, B0); PG8_BAR; PG8_SCHED;
            PG8_STAGE(PG8_SB(0, 1), b2 + hstep, voffB);
            PG8_WAIT_V(6); PG8_BAR; PG8_MMA(1, 1, At, B1); PG8_BAR;
            PG8_LDB(B0, 1, 0); PG8_SCHED; PG8_LDA(At, 1, 0); PG8_STAGE(PG8_SA(0, 1), a2 + hstep, voffA);
            PG8_WAIT_L(8); PG8_BAR; PG8_WAIT_L(0); PG8_MMA(0, 0, At, B0); PG8_BAR; PG8_SCHED;
            PG8_LDB(B1, 1, 1); PG8_STAGE(PG8_SB(1, 0), b3, voffB);
            PG8_BAR; PG8_WAIT_L(0); PG8_MMA(0, 1, At, B1); PG8_BAR;
            PG8_LDA(At, 1, 1); PG8_STAGE(PG8_SA(1, 0), a3, voffA);
            PG8_BAR; PG8_WAIT_L(0); PG8_MMA(1, 0, At, B0); PG8_BAR; PG8_SCHED;
            PG8_STAGE(PG8_SB(1, 1), b3 + hstep, voffB);
            PG8_WAIT_V(6); PG8_BAR; PG8_MMA(1, 1, At, B1); PG8_BAR;
            }
        }
        if constexpr (ALIGN_EPI) { if (wr == 0) PG8_BAR; }
        if constexpr (!Epi::AFTER_DRAIN) { unsigned ze_ = 0u; asm volatile("" : "+v"(ze_)); const int le_ = (int)__builtin_amdgcn_mbcnt_hi(~0u, __builtin_amdgcn_mbcnt_lo(~0u, ze_));
            E(acc, cur, wr, wc, le_ & 15, le_ >> 4); S.done(cur); }
        if (!has_next) break;
#pragma unroll
        for (int a = 0; a < 2; ++a)
#pragma unroll
            for (int b = 0; b < 2; ++b)
#pragma unroll
                for (int m = 0; m < 4; ++m)
#pragma unroll
                    for (int n = 0; n < 2; ++n) acc[a][b][m][n] = (f32x4){0.f, 0.f, 0.f, 0.f};
        cur = nxt; cA = nA; cB = nB; ++ui;
        if constexpr (ALIGN_EPI) { if (wr == 1) PG8_BAR; }
    }
    PG8_WAIT_V(0);
    if constexpr (!ALIGN_EPI) { if (wr == 0) PG8_BAR; }
    PG8_BAR;
    if constexpr (Epi::AFTER_DRAIN) { E.fused(acc, cur, wr, wc, fr, fq, lds, wid, lane); S.done(cur); }
#undef PG8_SA
#undef PG8_SB
#undef PG8_STAGE
#undef PG8_LDA
#undef PG8_LDB
#undef PG8_MMA
#undef PG8_WAIT_V
#undef PG8_WAIT_L
#undef PG8_BAR
#undef PG8_SCHED
}
}
#define GAS __attribute__((address_space(1)))
#define LAS __attribute__((address_space(3)))
typedef pg8::bf16_t bf16_t;
typedef pg8::bf16x8 bf16x8;
typedef pg8::f32x4 f32x4;
typedef pg8::u32x4 u32x4;
typedef float f32x16 __attribute__((ext_vector_type(16)));
typedef float f32x2 __attribute__((ext_vector_type(2)));
typedef short s16x4 __attribute__((ext_vector_type(4)));
typedef unsigned u32x2 __attribute__((ext_vector_type(2)));
typedef GAS unsigned gu32;

typedef const __attribute__((address_space(4))) unsigned char* kptr_t;
__device__ __forceinline__ kptr_t kbase() { kptr_t p = (kptr_t)__builtin_amdgcn_kernarg_segment_ptr(); asm volatile("" : "+s"(p)); return p; }
#define IN_(i) (*(const float* const __attribute__((address_space(4)))*)(kbase() + 8 * (i)))
#define OUT_ (*(float* const __attribute__((address_space(4)))*)(kbase() + 200))
#define WS_ (*(unsigned char* const __attribute__((address_space(4)))*)(kbase() + 208))
constexpr int NWAVES = 8, NTHREADS = 512;
constexpr int D = 1024, SEQ = 16384, M_LAT = 32768, CTXL = 256, M_CTX = 512, MT = M_LAT + M_CTX;
constexpr int ZN = 6400, DFF = 2816, DEXP = 3584, NEXP = 8, NMOD = 6144;
constexpr float EPS = 1e-6f, LOG2E = 1.4426950408889634f, QSCALE = 0.125f * LOG2E;
constexpr int CHUNK_TILES = 128, CHUNK_ROWS = CHUNK_TILES * 256;
constexpr float WSCALE8 = 64.0f;

constexpr size_t MiB = 1u << 20;
constexpr size_t WS_CTL = 0, CTL_BYTES = 1 * MiB;
constexpr size_t WS_MODV = 1 * MiB;
constexpr size_t WS_ROPE = 1 * MiB + 256 * 1024;
constexpr size_t WS_G1 = 1 * MiB + 512 * 1024;
constexpr size_t WS_G2 = 1 * MiB + 768 * 1024;
constexpr size_t WS_HCTX = 2 * MiB;
constexpr size_t WS_ASG = 4 * MiB;
constexpr size_t WS_ELIST = 5 * MiB;
constexpr size_t WS_WIN = 8 * MiB, WIN_BYTES = (size_t)ZN * D * 2;
constexpr size_t WS_WY = 33 * MiB;
constexpr size_t WS_WO = 39 * MiB;
constexpr size_t WS_WFF_UP = 43 * MiB;
constexpr size_t WS_WFF_DN = 54 * MiB;
constexpr size_t WS_HN = 60 * MiB;
constexpr size_t WS_Q = 125 * MiB;
constexpr size_t WS_KV = WS_Q + (size_t)MT * 512 * 2;
constexpr size_t WS_FAB = 174 * MiB;
constexpr size_t WS_CIN = 239 * MiB;
constexpr size_t WS_GT = WS_CIN + (size_t)MT * 1536 * 2;
constexpr size_t WS_COUT = 532 * MiB;
constexpr size_t WS_MIX = WS_GT;
constexpr size_t WS_HID0 = 125 * MiB;
constexpr size_t WS_F0 = 402 * MiB;
constexpr size_t WS_EXUP = 125 * MiB;
constexpr size_t WS_EXDN = 181 * MiB;
constexpr size_t WS_H2G = 209 * MiB;
constexpr size_t WS_HIDX = 241 * MiB;
constexpr size_t WS_YEXP = 437 * MiB;
constexpr size_t WS_ATT = 570 * MiB;
constexpr size_t WS_NEED = 603 * MiB;
static_assert(WS_KV + (size_t)MT * 256 * 2 <= WS_FAB && WS_FAB + (size_t)MT * 1024 * 2 <= WS_CIN && WS_GT + (size_t)MT * 3072 * 2 <= WS_COUT && WS_COUT + (size_t)MT * 512 * 2 <= WS_ATT && WS_ATT + (size_t)MT * 512 * 2 <= WS_NEED, "ws map (mixer)");
static_assert(WS_HN + (size_t)MT * 1024 * 2 <= WS_Q && WS_WFF_DN + (size_t)1024 * DFF * 2 <= WS_HN && WS_WFF_UP + (size_t)2 * DFF * 1024 * 2 <= WS_WFF_DN, "ws map (weights)");
static_assert(WS_HID0 + (size_t)MT * DFF * 2 <= WS_MIX && WS_MIX + (size_t)MT * 1024 * 2 <= WS_F0 && WS_EXUP + (size_t)8 * 7168 * 1024 <= WS_EXDN && WS_EXDN + (size_t)8 * 1024 * DEXP <= WS_H2G && WS_EXDN + (size_t)8 * 1024 * DEXP <= WS_MIX, "ws map (ffn)");
static_assert(WS_H2G + (size_t)CHUNK_ROWS * 1024 <= WS_HIDX && WS_HIDX + (size_t)CHUNK_ROWS * DEXP <= WS_YEXP && WS_YEXP + (size_t)264 * 256 * 1024 * 2 <= WS_ATT, "ws map (moe)");
constexpr int CW_BAR = 4096;
constexpr int CW_CNT = 8192;

constexpr int RING_BYTES = 131072;
constexpr int MISC_OFF = RING_BYTES + 320;
constexpr int LDSX_OFF = RING_BYTES + 1024;
constexpr int LDS_BYTES = 147456;

#define LDS_WAIT() asm volatile("s_waitcnt lgkmcnt(0)" ::: "memory")
#define VM_WAIT() asm volatile("s_waitcnt vmcnt(0)" ::: "memory")

#define XB_TMO      128
#define XB_XCNT(j)  (256  + 64 * (j))
#define XB_XSUB(j)  (1280 + 64 * (j))
#define XB_XGEN(j)  (2304 + 64 * (j))
#define XB_TOP      3328
#define XB_TOPGEN   3392
#define XCD_BAR_WORDS 3456
#define XB_SPIN_CAP (1u << 22)

__device__ __forceinline__ unsigned xb_ld(unsigned* p)              { return __hip_atomic_load(p, __ATOMIC_RELAXED, __HIP_MEMORY_SCOPE_AGENT); }
__device__ __forceinline__ unsigned xb_add(unsigned* p, unsigned v) { return __hip_atomic_fetch_add(p, v, __ATOMIC_RELAXED, __HIP_MEMORY_SCOPE_AGENT); }
__device__ __forceinline__ unsigned xb_xcc_id() { return (unsigned)__builtin_amdgcn_s_getreg((3 << 11) | 20) & 0xFu; }
#define XB_SPIN(cond, bar) do { unsigned _sp = 0; while (cond) { __builtin_amdgcn_s_sleep(1); \
    if ((++_sp & 255u) == 0u) { if (xb_ld(&(bar)[XB_TMO])) break; if (_sp > XB_SPIN_CAP) { atomicAdd(&(bar)[XB_TMO], 1u); break; } } } } while (0)

struct XcdBarrier {
    unsigned* bar; unsigned x;
    volatile LAS unsigned* st;
};

__device__ __forceinline__ XcdBarrier xcd_barrier_post(unsigned* bar, volatile LAS unsigned* st) {
    XcdBarrier b; b.bar = bar; b.x = xb_xcc_id(); b.st = st;
    if (threadIdx.x == 0) (void)xb_add(&bar[XB_XCNT(b.x)], 1u);
    return b;
}
__device__ __forceinline__ void xcd_barrier_complete(unsigned* bar, unsigned x, unsigned& nloc, unsigned& nx) {
    const unsigned G = gridDim.x * gridDim.y * gridDim.z;
    unsigned sum, cnt, mine, sp = 0u;
    for (;;) {
        sum = 0u; cnt = 0u; mine = 0u;
#pragma unroll
        for (unsigned j = 0; j < 16; ++j) { const unsigned c = xb_ld(&bar[XB_XCNT(j)]); sum += c; cnt += (c > 0u) ? 1u : 0u; mine = (j == x) ? c : mine; }
        if (sum == G) break;
        __builtin_amdgcn_s_sleep(1);
        if ((++sp & 255u) == 0u) { if (xb_ld(&bar[XB_TMO])) break; if (sp > XB_SPIN_CAP) { atomicAdd(&bar[XB_TMO], 1u); break; } }
    }
    nloc = mine > 0u ? mine : 1u; nx = cnt > 0u ? cnt : 1u;
}

__device__ __forceinline__ void xcd_barrier(const XcdBarrier& b) {
    asm volatile("s_waitcnt vmcnt(0)" ::: "memory");
    __syncthreads();
    if (threadIdx.x == 0) {
        unsigned* bar = b.bar;
        __builtin_amdgcn_s_waitcnt(0);
        unsigned nloc = b.st[0], nx = b.st[1];
        if (nloc == 0u) { xcd_barrier_complete(bar, b.x, nloc, nx); b.st[0] = nloc; b.st[1] = nx; }
        const unsigned old = xb_add(&bar[XB_XSUB(b.x)], 1u);
        const unsigned gen = old / nloc;
        if (old + 1u == (gen + 1u) * nloc) {
            __builtin_amdgcn_fence(__ATOMIC_RELEASE, "agent");
            asm volatile("s_waitcnt vmcnt(0)" ::: "memory");
            const unsigned og = xb_add(&bar[XB_TOP], 1u);
            const unsigned tg = og / nx;
            if (og + 1u == (tg + 1u) * nx) xb_add(&bar[XB_TOPGEN], 1u);
            else XB_SPIN(xb_ld(&bar[XB_TOPGEN]) == tg, bar);
            __builtin_amdgcn_fence(__ATOMIC_ACQUIRE, "agent");
            xb_add(&bar[XB_XGEN(b.x)], 1u);
            asm volatile("s_waitcnt vmcnt(0)" ::: "memory");
        } else {
            XB_SPIN(xb_ld(&bar[XB_XGEN(b.x)]) == gen, bar);
            __builtin_amdgcn_fence(__ATOMIC_ACQUIRE, "agent");
            asm volatile("s_waitcnt vmcnt(0)" ::: "memory");
        }
    }
    __syncthreads();
}

struct Params { const float* in[25]; float* out; unsigned char* ws; };
struct Ctx {
    LAS unsigned char* lds;
    int tid, lane, wave, vcu, G;
};
__device__ __forceinline__ Ctx opaque(const Ctx& c) { Ctx o = c; asm volatile("" : "+s"(o.wave), "+s"(o.vcu), "+s"(o.G));
    unsigned z = 0u; asm volatile("" : "+v"(z)); o.lane = (int)__builtin_amdgcn_mbcnt_hi(~0u, __builtin_amdgcn_mbcnt_lo(~0u, z)); o.tid = o.wave * 64 + o.lane; return o; }
template <int O> __device__ __forceinline__ float lane_xor(float v) { return __int_as_float(__builtin_amdgcn_ds_swizzle(__float_as_int(v), (O << 10) | 0x1f)); }
__device__ __forceinline__ float half_sum(float v) { const auto r = __builtin_amdgcn_permlane32_swap(__float_as_uint(v), __float_as_uint(v), false, false); return __uint_as_float(r[0]) + __uint_as_float(r[1]); }
__device__ __forceinline__ float half_max(float v) { const auto r = __builtin_amdgcn_permlane32_swap(__float_as_uint(v), __float_as_uint(v), false, false); return fmaxf(__uint_as_float(r[0]), __uint_as_float(r[1])); }
__device__ __forceinline__ float wave_sum(float v) {
    v += lane_xor<1>(v); v += lane_xor<2>(v); v += lane_xor<4>(v); v += lane_xor<8>(v); v += lane_xor<16>(v);
    return half_sum(v);
}
__device__ __forceinline__ unsigned pk2(float lo, float hi) { return pg8::cvt_pk_bf16(lo, hi); }
__device__ __forceinline__ float bflo(unsigned u) { return __uint_as_float(u << 16); }
__device__ __forceinline__ float bfhi(unsigned u) { return __uint_as_float(u & 0xffff0000u); }

__device__ __forceinline__ void tr_item(const float* W, int ldw, int k0, int n0, bf16_t* WT, int ldt, int drow0, LAS float* scr, int lane) {
#pragma unroll 8
    for (int i = 0; i < 32; ++i) { const int kk = 2 * i + (lane >> 5); scr[kk * 33 + (lane & 31)] = W[(size_t)(k0 + kk) * ldw + n0 + (lane & 31)]; }
    LDS_WAIT(); asm volatile("" ::: "memory");
    const int c = lane & 7;
#pragma unroll
    for (int j = 0; j < 4; ++j) { const int n = (lane >> 3) + 8 * j; const LAS float* s = scr + (8 * c) * 33 + n;
        u32x4 o; o.x = pk2(s[0 * 33], s[1 * 33]); o.y = pk2(s[2 * 33], s[3 * 33]); o.z = pk2(s[4 * 33], s[5 * 33]); o.w = pk2(s[6 * 33], s[7 * 33]);
        *(GAS u32x4*)(WT + (size_t)(drow0 + n) * ldt + k0 + 8 * c) = o; }
    LDS_WAIT(); asm volatile("" ::: "memory");
}
__device__ __forceinline__ void tr_item8(const float* W, int ldw, int k0, int n0, unsigned char* WT, int ldt, int drow0, float scale, LAS float* scr, int lane) {
#pragma unroll 8
    for (int i = 0; i < 32; ++i) { const int kk = 2 * i + (lane >> 5); scr[kk * 33 + (lane & 31)] = W[(size_t)(k0 + kk) * ldw + n0 + (lane & 31)]; }
    LDS_WAIT(); asm volatile("" ::: "memory");
    const int c = lane & 7;
#pragma unroll
    for (int j = 0; j < 4; ++j) { const int n = (lane >> 3) + 8 * j; const LAS float* s = scr + (8 * c) * 33 + n;
        u32x2 o; o.x = pg8::pack4_fp8(s[0 * 33] * scale, s[1 * 33] * scale, s[2 * 33] * scale, s[3 * 33] * scale); o.y = pg8::pack4_fp8(s[4 * 33] * scale, s[5 * 33] * scale, s[6 * 33] * scale, s[7 * 33] * scale);
        *(GAS u32x2*)(WT + (size_t)(drow0 + n) * ldt + k0 + 8 * c) = o; }
    LDS_WAIT(); asm volatile("" ::: "memory");
}
__device__ __forceinline__ int gu_row(int n0, int up) { return (n0 >> 7) * 256 + up * 128 + (n0 & 127); }

__device__ __forceinline__ void p0_convert_item(int it, LAS float* scr, int lane) {
    unsigned char* ws = WS_;
    if (it < 5376) { const int l = it / 2688, r = it % 2688, kb = r / 168, j = r % 168; const int n0 = j < 24 ? 32 * j : 1280 + 32 * (j - 24);
        tr_item(IN_(10) + (size_t)l * D * 5888, 5888, 64 * kb, n0, (bf16_t*)(ws + WS_WIN + l * WIN_BYTES), D, n0 < 768 ? n0 : n0 + 512, scr, lane); return; }
    it -= 5376;
    if (it < 1536) { const int mi = it / 256, r = it % 256, l = mi / 3, i = mi % 3, kb = r / 32, nb = r % 32;
        tr_item(IN_(13 + i) + (size_t)l * 512 * 1024, 1024, 64 * kb, 32 * nb, (bf16_t*)(ws + WS_WY) + (size_t)(l * 3 + i) * 1024 * 512, 512, 32 * nb, scr, lane); return; }
    it -= 1536;
    if (it < 1024) { const int l = it / 512, r = it % 512, kb = r / 32, nb = r % 32;
        tr_item(IN_(16) + (size_t)l * D * D, D, 64 * kb, 32 * nb, (bf16_t*)(ws + WS_WO) + (size_t)l * D * D, D, 32 * nb, scr, lane); return; }
    it -= 1024;
    if (it < 2816) { const int up = it / 1408, r = it % 1408, kb = r / 88, nb = r % 88;
        tr_item(IN_(17 + up), DFF, 64 * kb, 32 * nb, (bf16_t*)(ws + WS_WFF_UP), D, gu_row(32 * nb, up), scr, lane); return; }
    it -= 2816;
    { const int kb = it / 32, nb = it % 32; tr_item(IN_(19), D, 64 * kb, 32 * nb, (bf16_t*)(ws + WS_WFF_DN), DFF, 32 * nb, scr, lane); }
}
constexpr int P0_ITEMS = 5376 + 1536 + 1024 + 2816 + 1408;
__device__ __forceinline__ void expert_convert_item(int it, LAS float* scr, int lane) {
    unsigned char* ws = WS_;
    const int e = it / 5376, r0 = it % 5376, which = r0 / 1792, r = r0 % 1792;
    if (which < 2) { const int kb = r / 112, nb = r % 112;
        tr_item8(IN_(22 + which) + (size_t)e * D * DEXP, DEXP, 64 * kb, 32 * nb, ws + WS_EXUP + (size_t)e * 7168 * D, D, gu_row(32 * nb, which), WSCALE8, scr, lane); }
    else { const int kb = r / 32, nb = r % 32;
        tr_item8(IN_(24) + (size_t)e * DEXP * D, D, 64 * kb, 32 * nb, ws + WS_EXDN + (size_t)e * D * DEXP, DEXP, 32 * nb, WSCALE8, scr, lane); }
}
constexpr int EXP_ITEMS = 8 * 5376;
__device__ __forceinline__ void phase_expert_convert(const Ctx& C0) {
    const Ctx C = opaque(C0);
    LAS float* scr = (LAS float*)(C.lds + C.wave * 16384);
    for (int it = C.vcu * NWAVES + C.wave; it < EXP_ITEMS; it += C.G * NWAVES) expert_convert_item(it, scr, C.lane);
}

__device__ __forceinline__ void p0_prologue(const Ctx& C0) {
    const Ctx C = opaque(C0);
    unsigned char* ws = WS_;
    LAS float* sil = (LAS float*)(C.lds + LDSX_OFF);
    LAS float* tab = (LAS float*)(C.lds + LDSX_OFF + 12288);
    for (int i = C.tid; i < 3072; i += NTHREADS) { const float v = i < 2048 ? IN_(1)[i] : IN_(3)[i - 2048]; sil[i] = v / (1.0f + __expf(-v)); }
    if (C.tid < 128) { float s, c; sincospif((float)C.tid / 64.0f, &s, &c); tab[2 * C.tid] = c; tab[2 * C.tid + 1] = s; }
    __syncthreads();
    if (C.wave == 0 && C.vcu < 192) {
        const int l = C.vcu / 96, col = (C.vcu % 96) * 64 + C.lane; const float* w = IN_(4) + (size_t)l * D * NMOD + col;
        float a0 = 0.f, a1 = 0.f, a2 = 0.f;
        for (int k = 0; k < D; k += 16) { float wv[16];
#pragma unroll
            for (int j = 0; j < 16; ++j) wv[j] = w[(size_t)(k + j) * NMOD];
#pragma unroll
            for (int j = 0; j < 16; ++j) { a0 += sil[k + j] * wv[j]; a1 += sil[1024 + k + j] * wv[j]; a2 += sil[2048 + k + j] * wv[j]; } }
        const float b = IN_(5)[l * NMOD + col]; float* mv = (float*)(ws + WS_MODV) + (size_t)l * 3 * NMOD + col;
        mv[0] = a0 + b; mv[NMOD] = a1 + b; mv[2 * NMOD] = a2 + b;
    }
    for (int idx = C.vcu * NTHREADS + C.tid; idx < 4096 + 65536 + 32768; idx += C.G * NTHREADS) {
        if (idx < 4096) { const int pos = idx >> 4, f = idx & 15; const float inv = 1.0f / powf(10000.0f, (float)(2 * f) / 32.0f), ang = (float)pos * inv;
            float* t = (float*)(ws + WS_ROPE) + 2 * idx; t[0] = cosf(ang); t[1] = sinf(ang); }
        else if (idx < 4096 + 65536) { const int i = idx - 4096, m = i >> 8, k = i & 255, k1 = m >> 1, part = m & 1, n1 = k & 127, isb = k >> 7; const int p = (k1 * n1) & 127;
            float s, c; sincospif((float)p / 64.0f, &s, &c); const float v = part == 0 ? (isb ? -s : c) : (isb ? -c : -s);
            ((bf16_t*)(ws + WS_G1))[i] = (bf16_t)pk2(v * 0.08838834764831845f, 0.f); }
        else { const int i = idx - 4096 - 65536, k2 = i >> 8, k = i & 255, n2 = k & 127, isi = k >> 7; const int p = (k2 * n2) & 127;
            float s, c; sincospif((float)p / 64.0f, &s, &c); ((bf16_t*)(ws + WS_G2))[i] = (bf16_t)pk2((isi ? s : c) * 0.08838834764831845f, 0.f); }
    }
    LAS float* scr = (LAS float*)(C.lds + C.wave * 16384);
    const int gw = C.vcu * NWAVES + C.wave, NGW = C.G * NWAVES;
    for (int it = gw; it < P0_ITEMS; it += NGW) p0_convert_item(it, scr, C.lane);
    LAS float* wf = scr + 2304;
    for (int t = gw; t < 2 * 1024 * 4; t += NGW) {
        const int l = t >> 12, k = (t >> 2) & 1023, g = t & 3; const float* src = IN_(10) + (size_t)l * D * 5888 + (size_t)k * 5888 + 768 + g * 128;
        wf[C.lane] = src[C.lane]; wf[C.lane + 64] = src[C.lane + 64];
        LDS_WAIT(); asm volatile("" ::: "memory");
        float aA0 = 0.f, aB0 = 0.f, aA1 = 0.f, aB1 = 0.f; const int j0 = C.lane, j1 = C.lane + 64;
#pragma unroll 4
        for (int c = 0; c < 128; ++c) { const float w = wf[c]; const int i0 = (c * j0) & 127, i1 = (c * j1) & 127;
            aA0 += w * tab[2 * i0]; aB0 += w * tab[2 * i0 + 1]; aA1 += w * tab[2 * i1]; aB1 += w * tab[2 * i1 + 1]; }
        bf16_t* wt = (bf16_t*)(ws + WS_WIN + l * WIN_BYTES); const float sc = 0.08838834764831845f;
        wt[(size_t)(768 + g * 128 + j0) * D + k] = (bf16_t)pk2(aA0 * sc, 0.f); wt[(size_t)(768 + g * 128 + j1) * D + k] = (bf16_t)pk2(aA1 * sc, 0.f);
        wt[(size_t)(1280 + g * 128 + j0) * D + k] = (bf16_t)pk2(aB0 * sc, 0.f); wt[(size_t)(1280 + g * 128 + j1) * D + k] = (bf16_t)pk2(aB1 * sc, 0.f);
        LDS_WAIT(); asm volatile("" ::: "memory");
    }
}

__device__ __forceinline__ void norm_row(const float* xin, float* xout, bool has_br, const f32x4 (&br)[4], const float* gpost, const float* ga,
                                         const float* gpre, const float* sc, const float* sh, bf16_t* hn, int lane, f32x4 (&h2f)[4], bool hn_fp8 = false) {
    f32x4 x[4];
#pragma unroll
    for (int j = 0; j < 4; ++j) x[j] = *(const GAS f32x4*)(xin + 4 * lane + 256 * j);
    if (has_br) {
        float ss = 0.f;
#pragma unroll
        for (int j = 0; j < 4; ++j) ss += (br[j][0] * br[j][0] + br[j][1] * br[j][1]) + (br[j][2] * br[j][2] + br[j][3] * br[j][3]);
        const float rstd = 1.0f / sqrtf(wave_sum(ss) * (1.0f / D) + EPS);
#pragma unroll
        for (int j = 0; j < 4; ++j) { const f32x4 gp = *(const GAS f32x4*)(gpost + 4 * lane + 256 * j), gg = *(const GAS f32x4*)(ga + 4 * lane + 256 * j); x[j] = x[j] + gg * (br[j] * rstd * gp); }
    }
    if (xout) {
#pragma unroll
        for (int j = 0; j < 4; ++j) *(GAS f32x4*)(xout + 4 * lane + 256 * j) = x[j];
    }
    if (hn) {
        float ss = 0.f;
#pragma unroll
        for (int j = 0; j < 4; ++j) ss += (x[j][0] * x[j][0] + x[j][1] * x[j][1]) + (x[j][2] * x[j][2] + x[j][3] * x[j][3]);
        const float rstd = 1.0f / sqrtf(wave_sum(ss) * (1.0f / D) + EPS);
#pragma unroll
        for (int j = 0; j < 4; ++j) { const f32x4 gp = *(const GAS f32x4*)(gpre + 4 * lane + 256 * j), s1 = *(const GAS f32x4*)(sc + 4 * lane + 256 * j), s0 = *(const GAS f32x4*)(sh + 4 * lane + 256 * j);
            const f32x4 h = (x[j] * rstd * gp) * (s1 + 1.0f) + s0; h2f[j] = h;
            if (hn_fp8) *(GAS unsigned*)((unsigned char*)hn + 4 * lane + 256 * j) = pg8::pack4_fp8(h[0], h[1], h[2], h[3]);
            else { u32x2 w; w.x = pk2(h[0], h[1]); w.y = pk2(h[2], h[3]); *(GAS u32x2*)(hn + 4 * lane + 256 * j) = w; } }
    }
}
__device__ __forceinline__ void load_br(const bf16_t* p, int lane, f32x4 (&br)[4]) {
#pragma unroll
    for (int j = 0; j < 4; ++j) { const u32x2 w = *(const GAS u32x2*)(p + 4 * lane + 256 * j); br[j] = (f32x4){bflo(w.x), bfhi(w.x), bflo(w.y), bfhi(w.y)}; }
}
__device__ __forceinline__ int mod_set(int row) { return row >= M_LAT ? 2 : (row >> 14); }

__device__ __forceinline__ void phase_norm0(const Ctx& C0) {
    const Ctx C = opaque(C0);
    const int gw = C.vcu * NWAVES + C.wave, NGW = C.G * NWAVES; const float* modv = (const float*)(WS_ + WS_MODV);
    bf16_t* HN = (bf16_t*)(WS_ + WS_HN); const float* gpre = IN_(6); const float* x0 = IN_(0); const float* c0 = IN_(2);
    for (int row = gw; row < MT; row += NGW) {
        const float* xin = row < M_LAT ? x0 + (size_t)row * D : c0 + (size_t)(row - M_LAT) * D;
        const float* mv = modv + (size_t)mod_set(row) * NMOD; f32x4 br[4], h2f[4];
#pragma unroll
        for (int j = 0; j < 4; ++j) br[j] = (f32x4){0.f, 0.f, 0.f, 0.f};
        norm_row(xin, nullptr, false, br, nullptr, nullptr, gpre, mv + 1024, mv, HN + (size_t)row * D, C.lane, h2f);
    }
}
__device__ __forceinline__ void phase_norm_mid(const Ctx& C0, int l) {
    const Ctx C = opaque(C0);
    const int gw = C.vcu * NWAVES + C.wave, NGW = C.G * NWAVES; const float* modl = (const float*)(WS_ + WS_MODV) + (size_t)l * 3 * NMOD;
    bf16_t* HN = (bf16_t*)(WS_ + WS_HN); const bf16_t* MIX = (const bf16_t*)(WS_ + WS_MIX);
    LAS unsigned* lcnt = (LAS unsigned*)(C.lds + LDSX_OFF);
    LAS unsigned* stage = (LAS unsigned*)(C.lds + LDSX_OFF + 256);
    const bool moe = (l == 1);
    const float* xsrc = (l == 0) ? IN_(0) : OUT_; float* xdst = OUT_; const float* csrc = IN_(2); float* hctx = (float*)(WS_ + WS_HCTX);
    const float* gpost = IN_(7) + l * D; const float* gpre = IN_(8) + l * D; const float* wrt = IN_(20); const float* brt = IN_(21);
    if (moe) { if (C.tid < 16) lcnt[C.tid] = 0u; __syncthreads(); }
    const int nrows = (l == 0) ? MT : M_LAT; int it = 0;
    for (int row = gw; row < nrows; row += NGW, ++it) {
        const bool lat = row < M_LAT;
        const float* xin = lat ? xsrc + (size_t)row * D : csrc + (size_t)(row - M_LAT) * D;
        float* xout = lat ? xdst + (size_t)row * D : hctx + (size_t)(row - M_LAT) * D;
        const float* mv = modl + (size_t)mod_set(row) * NMOD; f32x4 br[4], h2f[4];
        load_br(MIX + (size_t)row * D, C.lane, br);
        norm_row(xin, xout, true, br, gpost, mv + 2048, gpre, mv + 4096, mv + 3072, moe ? (bf16_t*)((unsigned char*)HN + (size_t)row * D) : HN + (size_t)row * D, C.lane, h2f, moe);
        if (moe) {
            float lg[8];
#pragma unroll
            for (int e = 0; e < 8; ++e) lg[e] = 0.f;
#pragma unroll
            for (int j = 0; j < 4; ++j)
#pragma unroll
                for (int q = 0; q < 4; ++q) { const float* wr = wrt + (size_t)(4 * C.lane + 256 * j + q) * 8; const f32x4 w0 = *(const GAS f32x4*)wr, w1 = *(const GAS f32x4*)(wr + 4); const float h = h2f[j][q];
                    lg[0] += h * w0[0]; lg[1] += h * w0[1]; lg[2] += h * w0[2]; lg[3] += h * w0[3]; lg[4] += h * w1[0]; lg[5] += h * w1[1]; lg[6] += h * w1[2]; lg[7] += h * w1[3]; }
#pragma unroll
            for (int e = 0; e < 8; ++e) lg[e] = wave_sum(lg[e]) + brt[e];
            int e0 = 0; float v0 = lg[0];
#pragma unroll
            for (int e = 1; e < 8; ++e) if (lg[e] > v0) { v0 = lg[e]; e0 = e; }
            int e1 = -1; float v1 = -INFINITY;
#pragma unroll
            for (int e = 0; e < 8; ++e) if (e != e0 && lg[e] > v1) { v1 = lg[e]; e1 = e; }
            const float w1 = 1.0f / (1.0f + __expf(v0 - v1)), w0 = 1.0f - w1;
            if (C.lane == 0) { const unsigned p0 = atomicAdd((unsigned*)&lcnt[e0], 1u), p1 = atomicAdd((unsigned*)&lcnt[e1], 1u);
                LAS unsigned* st = stage + (C.wave * 24 + it) * 6; st[0] = (unsigned)e0; st[1] = p0; st[2] = __float_as_uint(w0); st[3] = (unsigned)e1; st[4] = p1; st[5] = __float_as_uint(w1); }
        }
    }
    if (moe) {
        __syncthreads();
        if (C.tid < 8) lcnt[8 + C.tid] = __hip_atomic_fetch_add((unsigned*)(WS_ + WS_CTL) + CW_CNT + 64 * C.tid, lcnt[C.tid], __ATOMIC_RELAXED, __HIP_MEMORY_SCOPE_AGENT);
        __syncthreads();
        if (C.lane == 0) { int i2 = 0; int* elist = (int*)(WS_ + WS_ELIST); unsigned* asg = (unsigned*)(WS_ + WS_ASG);
            for (int row = gw; row < nrows; row += NGW, ++i2) { const LAS unsigned* st = stage + (C.wave * 24 + i2) * 6;
                const unsigned e0 = st[0], p0 = st[1] + lcnt[8 + e0], e1 = st[3], p1 = st[4] + lcnt[8 + e1];
                elist[e0 * M_LAT + p0] = row; elist[e1 * M_LAT + p1] = row;
                unsigned* a = asg + (size_t)row * 8; a[0] = e0; a[1] = p0; a[2] = st[2]; a[3] = e1; a[4] = p1; a[5] = st[5]; } }
    }
}
__device__ __forceinline__ void phase_norm_end(const Ctx& C0, int l) {
    const Ctx C = opaque(C0);
    const LAS int* tbl = (const LAS int*)(C.lds + MISC_OFF) + 16;
    const int gw = C.vcu * NWAVES + C.wave, NGW = C.G * NWAVES; const float* modl = (const float*)(WS_ + WS_MODV) + (size_t)l * 3 * NMOD;
    const float* modn = (const float*)(WS_ + WS_MODV) + (size_t)3 * NMOD;
    bf16_t* HN = (bf16_t*)(WS_ + WS_HN);
    const int nrows = (l == 0) ? MT : M_LAT;
    float* xlat = OUT_; float* hctx = (float*)(WS_ + WS_HCTX); const bf16_t* F0 = (const bf16_t*)(WS_ + WS_F0); const unsigned* asg = (const unsigned*)(WS_ + WS_ASG);
    const bf16_t* Y = (const bf16_t*)(WS_ + WS_YEXP); const float* gpost = IN_(9) + l * D; const float* gpre = IN_(6) + D;
    for (int row = gw; row < nrows; row += NGW) {
        const bool lat = row < M_LAT;
        float* xio = lat ? xlat + (size_t)row * D : hctx + (size_t)(row - M_LAT) * D;
        const int set = mod_set(row); const float* mv = modl + (size_t)set * NMOD; f32x4 br[4], h2f[4];
        if (l == 0) load_br(F0 + (size_t)row * D, C.lane, br);
        else {
            const unsigned* a = asg + (size_t)row * 8;
            const int e0 = (int)a[0], e1 = (int)a[3]; const float w0 = __uint_as_float(a[2]), w1 = __uint_as_float(a[5]);
            const int t0 = tbl[e0], t1 = tbl[e1];
            f32x4 b0[4], b1[4];
            load_br(Y + ((size_t)t0 * 256 + a[1]) * D, C.lane, b0); load_br(Y + ((size_t)t1 * 256 + a[4]) * D, C.lane, b1);
#pragma unroll
            for (int j = 0; j < 4; ++j) br[j] = b0[j] * w0 + b1[j] * w1;
        }
        const bool next = (l == 0);
        norm_row(xio, xio, true, br, gpost, mv + 5120, gpre, modn + (size_t)set * NMOD + 1024, modn + (size_t)set * NMOD, next ? HN + (size_t)row * D : nullptr, C.lane, h2f);
    }
}

constexpr int AT_S = 144;
__device__ __forceinline__ int crow(int r, int h) { return (r & 3) + 8 * (r >> 2) + 4 * h; }
__device__ __forceinline__ void phase_attention(const Ctx& C0, int l, bool with_ctx_q) {
    const Ctx C = opaque(C0);
    const bf16_t* Q = (const bf16_t*)(WS_ + WS_Q); const bf16_t* KV = (const bf16_t*)(WS_ + WS_KV); bf16_t* AO = (bf16_t*)(WS_ + WS_ATT);
    LAS unsigned char* Kt = C.lds; LAS unsigned char* Vt = C.lds + 64 * AT_S;
    int lane_ = C.lane; asm volatile("" : "+v"(lane_)); const int lane = lane_, w = C.wave, r32 = lane & 31, hh = lane >> 5, qq = (lane & 15) >> 2, pp = lane & 3, blk = (lane >> 4) & 1;
    const int nunits = 1024 + (with_ctx_q ? 16 : 0); const float* sinks = IN_(11) + l * 8;
    for (int unit = C.vcu; unit < nunits; unit += C.G) {
        int b, head, hkv, qrowbase, q0, lo, nloc;
        if (unit < 1024) { const int g = unit & 3, qb = (unit >> 2) & 63; hkv = (unit >> 8) & 1; b = unit >> 9; head = hkv * 4 + g; q0 = qb * 256; qrowbase = b * SEQ + q0;
            lo = q0 - 128 < 0 ? 0 : q0 - 128; const int hi = q0 + 384 > SEQ ? SEQ : q0 + 384; nloc = (hi - lo) >> 6; }
        else { const int x = unit - 1024; b = x >> 3; head = x & 7; hkv = head >> 2; q0 = 0; lo = 0; nloc = 0; qrowbase = M_LAT + b * CTXL; }
        const int ntiles = nloc + 4, qw = q0 + 32 * w;
        bf16x8 qf[4];
        { const bf16_t* qp = Q + (size_t)(qrowbase + 32 * w + r32) * 512 + head * 64 + 8 * hh;
#pragma unroll
          for (int s = 0; s < 4; ++s) qf[s] = *(const GAS bf16x8*)(qp + 16 * s); }
        float m_run = sinks[head] * LOG2E, l_run = hh == 0 ? 1.0f : 0.0f;
        f32x16 o0, o1;
#pragma unroll
        for (int i = 0; i < 16; ++i) { o0[i] = 0.f; o1[i] = 0.f; }
        for (int t = 0; t < ntiles; ++t) {
            const bool local = t < nloc; const int kpos = lo + 64 * t;
            const int krow0 = local ? b * SEQ + kpos : M_LAT + b * CTXL + 64 * (t - nloc);
            __syncthreads();
            { const int row = C.tid >> 3, ch = C.tid & 7; const bf16_t* src = KV + (size_t)(krow0 + row) * 256 + hkv * 64 + ch * 8;
              const u32x4 kx = *(const GAS u32x4*)src, vx = *(const GAS u32x4*)(src + 128);
              *(LAS u32x4*)(Kt + row * AT_S + ch * 16) = kx; *(LAS u32x4*)(Vt + row * AT_S + ch * 16) = vx; }
            __syncthreads();
            const bool relevant = !local || (kpos + 63 >= qw - 128 && kpos <= qw + 31 + 128);
            if (relevant) {
                f32x16 p0, p1;
#pragma unroll
                for (int i = 0; i < 16; ++i) { p0[i] = 0.f; p1[i] = 0.f; }
#pragma unroll
                for (int s = 0; s < 4; ++s) {
                    const bf16x8 k0 = *(const LAS bf16x8*)(Kt + r32 * AT_S + (16 * s + 8 * hh) * 2), k1 = *(const LAS bf16x8*)(Kt + (32 + r32) * AT_S + (16 * s + 8 * hh) * 2);
                    p0 = __builtin_amdgcn_mfma_f32_32x32x16_bf16(k0, qf[s], p0, 0, 0, 0); p1 = __builtin_amdgcn_mfma_f32_32x32x16_bf16(k1, qf[s], p1, 0, 0, 0);
                }
                if (local) { const int qpos = qw + r32;
#pragma unroll
                    for (int i = 0; i < 16; ++i) { const int d0 = kpos + crow(i, hh) - qpos, d1 = d0 + 32;
                        if (d0 > 128 || d0 < -128) p0[i] = -INFINITY; if (d1 > 128 || d1 < -128) p1[i] = -INFINITY; } }
                float mt = fmaxf(p0[0], p1[0]);
#pragma unroll
                for (int i = 1; i < 16; ++i) mt = fmaxf(mt, fmaxf(p0[i], p1[i]));
                mt = half_max(mt);
                const float mn = fmaxf(m_run, mt), alpha = __builtin_amdgcn_exp2f(m_run - mn); m_run = mn;
                float ls = 0.f;
#pragma unroll
                for (int i = 0; i < 16; ++i) { p0[i] = __builtin_amdgcn_exp2f(p0[i] - mn); p1[i] = __builtin_amdgcn_exp2f(p1[i] - mn); ls += p0[i] + p1[i]; }
                l_run = l_run * alpha + ls;
#pragma unroll
                for (int i = 0; i < 16; ++i) { o0[i] *= alpha; o1[i] *= alpha; }
#pragma unroll
                for (int kb = 0; kb < 2; ++kb)
#pragma unroll
                    for (int s2 = 0; s2 < 2; ++s2) {
                        u32x4 pw;
                        if (kb == 0) { pw.x = pk2(p0[8 * s2 + 0], p0[8 * s2 + 1]); pw.y = pk2(p0[8 * s2 + 2], p0[8 * s2 + 3]); pw.z = pk2(p0[8 * s2 + 4], p0[8 * s2 + 5]); pw.w = pk2(p0[8 * s2 + 6], p0[8 * s2 + 7]); }
                        else { pw.x = pk2(p1[8 * s2 + 0], p1[8 * s2 + 1]); pw.y = pk2(p1[8 * s2 + 2], p1[8 * s2 + 3]); pw.z = pk2(p1[8 * s2 + 4], p1[8 * s2 + 5]); pw.w = pk2(p1[8 * s2 + 6], p1[8 * s2 + 7]); }
                        const bf16x8 pb = __builtin_bit_cast(bf16x8, pw);
                        const int kbase = 32 * kb + 16 * s2 + 4 * hh + qq;
#pragma unroll
                        for (int c = 0; c < 2; ++c) {
                            const LAS unsigned char* va = Vt + kbase * AT_S + (32 * c + 16 * blk + 4 * pp) * 2;
                            const s16x4 vlo = __builtin_amdgcn_ds_read_tr16_b64_v4i16((LAS s16x4*)va), vhi = __builtin_amdgcn_ds_read_tr16_b64_v4i16((LAS s16x4*)(va + 8 * AT_S));
                            const bf16x8 vf = __builtin_shufflevector(vlo, vhi, 0, 1, 2, 3, 4, 5, 6, 7);
                            if (c == 0) o0 = __builtin_amdgcn_mfma_f32_32x32x16_bf16(vf, pb, o0, 0, 0, 0); else o1 = __builtin_amdgcn_mfma_f32_32x32x16_bf16(vf, pb, o1, 0, 0, 0);
                        }
                    }
            }
        }
        const float linv = 1.0f / half_sum(l_run);
        bf16_t* op = AO + (size_t)(qrowbase + 32 * w + r32) * 512 + head * 64 + 4 * hh;
#pragma unroll
        for (int g = 0; g < 4; ++g) {
            u32x2 a, c2; a.x = pk2(o0[4 * g] * linv, o0[4 * g + 1] * linv); a.y = pk2(o0[4 * g + 2] * linv, o0[4 * g + 3] * linv);
            c2.x = pk2(o1[4 * g] * linv, o1[4 * g + 1] * linv); c2.y = pk2(o1[4 * g + 2] * linv, o1[4 * g + 3] * linv);
            *(GAS u32x2*)(op + 8 * g) = a; *(GAS u32x2*)(op + 32 + 8 * g) = c2; }
    }
    __syncthreads();
}

constexpr int FT_S = 144;
__device__ __forceinline__ void phase_fft1(const Ctx& C0) {
    const Ctx C = opaque(C0);
    const bf16_t* FAB = (const bf16_t*)(WS_ + WS_FAB); bf16_t* TP = (bf16_t*)(WS_ + WS_HN); const bf16_t* G1 = (const bf16_t*)(WS_ + WS_G1);
    LAS unsigned char* X = C.lds;
    int lane_ = C.lane; asm volatile("" : "+v"(lane_)); const int lane = lane_, w = C.wave, r32 = lane & 31, hh = lane >> 5, qq = (lane & 15) >> 2, pp = lane & 3, blk = (lane >> 4) & 1;
    bf16x8 gf[16];
#pragma unroll
    for (int s = 0; s < 16; ++s) gf[s] = *(const GAS bf16x8*)(G1 + (size_t)(32 * w + r32) * 256 + 16 * s + 8 * hh);
    for (int unit = C.vcu; unit < 2048; unit += C.G) {
        const int b = unit >> 10, n2 = (unit >> 3) & 127, cb = unit & 7;
        __syncthreads();
#pragma unroll
        for (int i = 0; i < 4; ++i) { const int idx = C.tid + NTHREADS * i, k = idx >> 3, ch = idx & 7;
            const bf16_t* src = FAB + (size_t)(b * SEQ + 128 * (k & 127) + n2) * 1024 + (k >> 7) * 512 + cb * 64 + ch * 8;
            *(LAS u32x4*)(X + k * FT_S + ch * 16) = *(const GAS u32x4*)src; }
        __syncthreads();
        float tc[8], ts[8];
#pragma unroll
        for (int i = 0; i < 8; ++i) { const int k1 = 16 * w + (crow(2 * i, hh) >> 1); sincospif((float)(k1 * n2) * (1.0f / 8192.0f), &ts[i], &tc[i]); }
#pragma unroll
        for (int cbk = 0; cbk < 2; ++cbk) {
            f32x16 acc;
#pragma unroll
            for (int i = 0; i < 16; ++i) acc[i] = 0.f;
#pragma unroll
            for (int s = 0; s < 16; ++s) {
                const LAS unsigned char* xa = X + (16 * s + 8 * hh + qq) * FT_S + (32 * cbk + 16 * blk + 4 * pp) * 2;
                const s16x4 lo = __builtin_amdgcn_ds_read_tr16_b64_v4i16((LAS s16x4*)xa), hi = __builtin_amdgcn_ds_read_tr16_b64_v4i16((LAS s16x4*)(xa + 4 * FT_S));
                acc = __builtin_amdgcn_mfma_f32_32x32x16_bf16(gf[s], __builtin_shufflevector(lo, hi, 0, 1, 2, 3, 4, 5, 6, 7), acc, 0, 0, 0);
            }
#pragma unroll
            for (int i = 0; i < 8; ++i) { const int k1 = 16 * w + (crow(2 * i, hh) >> 1); const float re = acc[2 * i], im = acc[2 * i + 1];
                const float tr = re * tc[i] + im * ts[i], ti = im * tc[i] - re * ts[i];
                bf16_t* dst = TP + (size_t)(b * SEQ + 128 * k1 + n2) * 1024 + cb * 64 + 32 * cbk + r32;
                dst[0] = (bf16_t)pk2(tr, 0.f); dst[512] = (bf16_t)pk2(ti, 0.f); }
        }
    }
    __syncthreads();
}
__device__ __forceinline__ void phase_fft2(const Ctx& C0) {
    const Ctx C = opaque(C0);
    const bf16_t* TP = (const bf16_t*)(WS_ + WS_HN); bf16_t* FN = (bf16_t*)(WS_ + WS_FAB); const bf16_t* G2 = (const bf16_t*)(WS_ + WS_G2);
    LAS unsigned char* X = C.lds;
    int lane_ = C.lane; asm volatile("" : "+v"(lane_)); const int lane = lane_, w = C.wave, r32 = lane & 31, hh = lane >> 5, qq = (lane & 15) >> 2, pp = lane & 3, blk = (lane >> 4) & 1;
    const int rs = w & 3, cbk = w >> 2;
    bf16x8 gf[16];
#pragma unroll
    for (int s = 0; s < 16; ++s) gf[s] = *(const GAS bf16x8*)(G2 + (size_t)(32 * rs + r32) * 256 + 16 * s + 8 * hh);
    for (int unit = C.vcu; unit < 2048; unit += C.G) {
        const int b = unit >> 10, k1 = (unit >> 3) & 127, cb = unit & 7;
        __syncthreads();
#pragma unroll
        for (int i = 0; i < 4; ++i) { const int idx = C.tid + NTHREADS * i, k = idx >> 3, ch = idx & 7;
            const bf16_t* src = TP + (size_t)(b * SEQ + 128 * k1 + (k & 127)) * 1024 + (k >> 7) * 512 + cb * 64 + ch * 8;
            *(LAS u32x4*)(X + k * FT_S + ch * 16) = *(const GAS u32x4*)src; }
        __syncthreads();
        f32x16 acc;
#pragma unroll
        for (int i = 0; i < 16; ++i) acc[i] = 0.f;
#pragma unroll
        for (int s = 0; s < 16; ++s) {
            const LAS unsigned char* xa = X + (16 * s + 8 * hh + qq) * FT_S + (32 * cbk + 16 * blk + 4 * pp) * 2;
            const s16x4 lo = __builtin_amdgcn_ds_read_tr16_b64_v4i16((LAS s16x4*)xa), hi = __builtin_amdgcn_ds_read_tr16_b64_v4i16((LAS s16x4*)(xa + 4 * FT_S));
            acc = __builtin_amdgcn_mfma_f32_32x32x16_bf16(gf[s], __builtin_shufflevector(lo, hi, 0, 1, 2, 3, 4, 5, 6, 7), acc, 0, 0, 0);
        }
#pragma unroll
        for (int i = 0; i < 16; ++i) { const int k2 = 32 * rs + crow(i, hh);
            FN[(size_t)(b * SEQ + k1 + 128 * k2) * 512 + cb * 64 + 32 * cbk + r32] = (bf16_t)pk2(acc[i], 0.f); }
    }
    __syncthreads();
}
__device__ __forceinline__ void phase_ctx_dft(const Ctx& C0) {
    const Ctx C = opaque(C0);
    const bf16_t* FAB = (const bf16_t*)(WS_ + WS_FAB); bf16_t* FN = (bf16_t*)(WS_ + WS_FAB);
    LAS float* tab = (LAS float*)(C.lds + LDSX_OFF);
    if (C.tid < 256) { float s, c; sincospif((float)C.tid / 128.0f, &s, &c); tab[2 * C.tid] = c; tab[2 * C.tid + 1] = s; }
    __syncthreads();
    for (int o = C.vcu * NTHREADS + C.tid; o < M_CTX * 512; o += C.G * NTHREADS) {
        const int c = o & 511, k = (o >> 9) & 255, b = o >> 17; const bf16_t* a = FAB + (size_t)(M_LAT + b * CTXL) * 1024 + c;
        float acc = 0.f;
#pragma unroll 8
        for (int n = 0; n < 256; ++n) { const int i = (k * n) & 255; const unsigned short av = a[(size_t)n * 1024], bv = a[(size_t)n * 1024 + 512];
            acc += __uint_as_float((unsigned)av << 16) * tab[2 * i] - __uint_as_float((unsigned)bv << 16) * tab[2 * i + 1]; }
        FN[(size_t)(M_LAT + b * CTXL + k) * 512 + c] = (bf16_t)pk2(acc * 0.0625f, 0.f);
    }
    __syncthreads();
}
__device__ __forceinline__ void unpack8(const u32x4 w, float (&f)[8]) { f[0] = bflo(w.x); f[1] = bfhi(w.x); f[2] = bflo(w.y); f[3] = bfhi(w.y); f[4] = bflo(w.z); f[5] = bfhi(w.z); f[6] = bflo(w.w); f[7] = bfhi(w.w); }
__device__ __forceinline__ void phase_conv(const Ctx& C0, int l, int nrows) {
    const Ctx C = opaque(C0);
    const bf16_t* CIN = (const bf16_t*)(WS_ + WS_CIN); bf16_t* CO = (bf16_t*)(WS_ + WS_COUT); const float* wc = IN_(12) + l * 3 * 512;
    for (int it = C.vcu * NTHREADS + C.tid; it < nrows * 64; it += C.G * NTHREADS) {
        const int row = it >> 6, c0 = (it & 63) * 8; const bool lat = row < M_LAT;
        const int s = lat ? (row & (SEQ - 1)) : ((row - M_LAT) & (CTXL - 1)), last = lat ? SEQ - 1 : CTXL - 1;
        const bf16_t* p = CIN + (size_t)row * 1536 + c0;
        float xm[8], cm[8], x0[8], cc0[8], xp[8], cp[8], bb[8];
        const u32x4 z = (u32x4){0u, 0u, 0u, 0u};
        unpack8(s > 0 ? *(const GAS u32x4*)(p - 1536) : z, xm); unpack8(s > 0 ? *(const GAS u32x4*)(p - 1536 + 1024) : z, cm);
        unpack8(*(const GAS u32x4*)p, x0); unpack8(*(const GAS u32x4*)(p + 1024), cc0); unpack8(*(const GAS u32x4*)(p + 512), bb);
        unpack8(s < last ? *(const GAS u32x4*)(p + 1536) : z, xp); unpack8(s < last ? *(const GAS u32x4*)(p + 1536 + 1024) : z, cp);
        float y[8];
#pragma unroll
        for (int j = 0; j < 8; ++j) y[j] = bb[j] * (xm[j] * cm[j] * wc[c0 + j] + x0[j] * cc0[j] * wc[512 + c0 + j] + xp[j] * cp[j] * wc[1024 + c0 + j]);
        u32x4 o; o.x = pk2(y[0], y[1]); o.y = pk2(y[2], y[3]); o.z = pk2(y[4], y[5]); o.w = pk2(y[6], y[7]);
        *(GAS u32x4*)(CO + (size_t)row * 512 + c0) = o;
    }
}
__device__ __forceinline__ void phase_moe_gather(const Ctx& C0, int chunk, int ntiles) {
    const Ctx C = opaque(C0);
    const unsigned char* HN = WS_ + WS_HN; unsigned char* H2G = WS_ + WS_H2G; const int* EL = (const int*)(WS_ + WS_ELIST);
    const LAS int* tbl = (const LAS int*)(C.lds + MISC_OFF) + 16;
    const int gw = C.vcu * NWAVES + C.wave, NGW = C.G * NWAVES;
    for (int rl = gw; rl < CHUNK_ROWS; rl += NGW) {
        const int R = chunk * CHUNK_ROWS + rl, t = R >> 8; if (t >= ntiles) break;
        int e = 0;
#pragma unroll
        for (int k = 1; k < 8; ++k) e += (t >= tbl[k]) ? 1 : 0;
        const int pos = R - tbl[e] * 256, ce = tbl[8 + e];
        u32x4 v0 = (u32x4){0u, 0u, 0u, 0u};
        if (pos < ce) { const int tok = EL[e * M_LAT + pos]; v0 = *(const GAS u32x4*)(HN + (size_t)tok * D + C.lane * 16); }
        *(GAS u32x4*)(H2G + (size_t)rl * D + C.lane * 16) = v0;
    }
}

#ifndef REP_PRO
#define REP_PRO 1
#endif
#ifndef REP_GEMM
#define REP_GEMM 1
#endif
#ifndef REP_ATT
#define REP_ATT 1
#endif
#ifndef REP_MIX
#define REP_MIX 1
#endif
#define REPEAT(N) for (int rep_ = 0; rep_ < (N); ++rep_)
__global__ void __launch_bounds__(NTHREADS, 2) dit_fwd(Params P) {
    extern __shared__ __attribute__((aligned(16))) unsigned char lds_raw[];
    Ctx C;
    C.lds = (LAS unsigned char*)lds_raw;
    C.wave = __builtin_amdgcn_readfirstlane((int)threadIdx.x >> 6); C.lane = 0; C.tid = 0;
    C.G = gridDim.x; { const int bx = blockIdx.x; C.vcu = (C.G % 8 == 0) ? (bx % 8) * (C.G / 8) + bx / 8 : bx; }
    volatile LAS unsigned* MISC = (volatile LAS unsigned*)(C.lds + MISC_OFF);
    if (threadIdx.x < 32) MISC[threadIdx.x] = 0u;
    __syncthreads();
    (void)xcd_barrier_post((unsigned*)(WS_ + WS_CTL) + CW_BAR, MISC + 8);
#define GRID_BAR() do { XcdBarrier b_; b_.bar = (unsigned*)(WS_ + WS_CTL) + CW_BAR; b_.x = xb_xcc_id(); b_.st = (volatile LAS unsigned*)(C.lds + MISC_OFF) + 8; xcd_barrier(b_); } while (0)
    LAS unsigned char* ring = C.lds;
    const int bid = (int)blockIdx.x;

    REPEAT(REP_PRO) p0_prologue(C);
    GRID_BAR();
    phase_norm0(C);
    GRID_BAR();

    for (int l = 0; l < 2; ++l) {
        const int nM = (l == 0) ? MT / 256 : M_LAT / 256;
        REPEAT(REP_GEMM) {
            unsigned char* ws = WS_;
            pg8::Gemm g{(const bf16_t*)(ws + WS_HN), (const bf16_t*)(ws + WS_WIN + l * WIN_BYTES), MT, ZN, D};
            pg8::RectOrder S; if (l == 0) S.init(MT / 256, ZN / 256, C.G, bid); else S.init(M_LAT / 256, ZN / 256, C.G, bid, 0, 2, M_LAT / 256, 2);
            pg8::EpiIn E{ws, WS_Q, WS_KV, WS_FAB, WS_CIN, WS_GT, WS_ROPE, QSCALE};
            pg8::gemm_phase<pg8::EpiIn, pg8::RectOrder, true, true>(ring, g, S, E, C.wave);
        }
        GRID_BAR();
        REPEAT(REP_ATT) phase_attention(C, l, l == 0);
        REPEAT(REP_MIX) { phase_fft1(C); phase_conv(C, l, nM * 256); }
        GRID_BAR();
        REPEAT(REP_MIX) { phase_fft2(C); if (l == 0) phase_ctx_dft(C); }
        GRID_BAR();
        REPEAT(REP_GEMM) {
            unsigned char* ws = WS_;
            pg8::RectOrder S; S.init(nM, 4, C.G, bid);
            const bf16_t* WY = (const bf16_t*)(ws + WS_WY) + (size_t)l * 3 * 1024 * 512; bf16_t* HN = (bf16_t*)(ws + WS_HN);
            { pg8::Gemm g{(const bf16_t*)(ws + WS_ATT), WY, MT, D, 512}; pg8::EpiMerge<true> E{HN, (const bf16_t*)(ws + WS_GT), 0};
              pg8::gemm_phase<pg8::EpiMerge<true>, pg8::RectOrder, true, true>(ring, g, S, E, C.wave); }
            { pg8::Gemm g{(const bf16_t*)(ws + WS_FAB), WY + (size_t)1024 * 512, MT, D, 512}; pg8::EpiMerge<false> E{HN, (const bf16_t*)(ws + WS_GT), 1024};
              pg8::gemm_phase<pg8::EpiMerge<false>, pg8::RectOrder, true, true>(ring, g, S, E, C.wave); }
            { pg8::Gemm g{(const bf16_t*)(ws + WS_COUT), WY + (size_t)2 * 1024 * 512, MT, D, 512}; pg8::EpiMerge<false> E{HN, (const bf16_t*)(ws + WS_GT), 2048};
              pg8::gemm_phase<pg8::EpiMerge<false>, pg8::RectOrder, true, true>(ring, g, S, E, C.wave); }
        }
        GRID_BAR();
        REPEAT(REP_GEMM) {
            unsigned char* ws = WS_;
            pg8::Gemm g{(const bf16_t*)(ws + WS_HN), (const bf16_t*)(ws + WS_WO) + (size_t)l * D * D, MT, D, D}; pg8::RectOrder S; S.init(nM, 4, C.G, bid);
            pg8::EpiPlain E{(bf16_t*)(ws + WS_MIX), D, 4, 0, 1.0f};
            pg8::gemm_phase<pg8::EpiPlain, pg8::RectOrder, true, true>(ring, g, S, E, C.wave);
        }
        GRID_BAR();
        if (l == 1) phase_expert_convert(C);
        phase_norm_mid(C, l);
        GRID_BAR();
        if (l == 0) {
            REPEAT(REP_GEMM) { unsigned char* ws = WS_;
              pg8::Gemm g{(const bf16_t*)(ws + WS_HN), (const bf16_t*)(ws + WS_WFF_UP), MT, 2 * DFF, D}; pg8::RectOrder S; S.init(nM, 2 * DFF / 256, C.G, bid);
              pg8::EpiSwiglu<false> E{(void*)(ws + WS_HID0), DFF, 2 * DFF / 256, 1.0f};
              pg8::gemm_phase<pg8::EpiSwiglu<false>, pg8::RectOrder, true, true>(ring, g, S, E, C.wave); }
            GRID_BAR();
            REPEAT(REP_GEMM) { unsigned char* ws = WS_;
              pg8::Gemm g{(const bf16_t*)(ws + WS_HID0), (const bf16_t*)(ws + WS_WFF_DN), MT, D, DFF}; pg8::RectOrder S; S.init(nM, 4, C.G, bid);
              pg8::EpiPlain E{(bf16_t*)(ws + WS_F0), D, 4, 0, 1.0f};
              pg8::gemm_phase<pg8::EpiPlain, pg8::RectOrder, true, true>(ring, g, S, E, C.wave); }
            GRID_BAR();
        } else {
            if (threadIdx.x == 0) { const unsigned* ctl = (const unsigned*)(WS_ + WS_CTL); unsigned tb = 0u;
                for (int e = 0; e < 8; ++e) { const unsigned c = __hip_atomic_load(ctl + CW_CNT + 64 * e, __ATOMIC_RELAXED, __HIP_MEMORY_SCOPE_AGENT); MISC[16 + e] = tb; MISC[24 + e] = c; tb += (c + 255u) >> 8; } }
            __syncthreads();
            const int T = __builtin_amdgcn_readfirstlane((int)(MISC[23] + ((MISC[31] + 255u) >> 8))), nchunks = (T + CHUNK_TILES - 1) / CHUNK_TILES;
            const LAS int* tbl = (const LAS int*)(C.lds + MISC_OFF) + 16;
            for (int ch = 0; ch < nchunks; ++ch) {
                const int tc = (T - ch * CHUNK_TILES) < CHUNK_TILES ? (T - ch * CHUNK_TILES) : CHUNK_TILES;
                phase_moe_gather(C, ch, T);
                GRID_BAR();
                REPEAT(REP_GEMM) { unsigned char* ws = WS_;
                  pg8::Gemm g{(const bf16_t*)(ws + WS_H2G), (const bf16_t*)(ws + WS_EXUP), CHUNK_ROWS, 8 * 7168, D};
                  pg8::MoeOrder S{tc, 28, ch * CHUNK_TILES, C.G, bid, tbl};
                  pg8::EpiSwiglu<true> E{(void*)(ws + WS_HIDX), DEXP, 28, 1.0f / WSCALE8};
                  pg8::gemm_phase<pg8::EpiSwiglu<true>, pg8::MoeOrder, true, true, true>(ring, g, S, E, C.wave); }
                GRID_BAR();
                REPEAT(REP_GEMM) { unsigned char* ws = WS_;
                  pg8::Gemm g{(const bf16_t*)(ws + WS_HIDX), (const bf16_t*)(ws + WS_EXDN), CHUNK_ROWS, 8 * 1024, DEXP};
                  pg8::MoeOrder S{tc, 4, ch * CHUNK_TILES, C.G, bid, tbl};
                  pg8::EpiPlain E{(bf16_t*)(ws + WS_YEXP), D, 4, ch * CHUNK_ROWS, 1.0f / WSCALE8};
                  pg8::gemm_phase<pg8::EpiPlain, pg8::MoeOrder, true, true, true>(ring, g, S, E, C.wave); }
                GRID_BAR();
            }
        }
        phase_norm_end(C, l);
        if (l == 0) GRID_BAR();
    }
#undef GRID_BAR
}

extern "C" void kernel_launch(void* const* d_in, const int* in_sizes, int n_in, void* d_out, int out_size, void* d_ws, size_t ws_size, hipStream_t stream) {
    static int grid = 0;
    if (grid == 0) {
        if (n_in != 25 || in_sizes[0] != M_LAT * D || out_size != M_LAT * D || ws_size < WS_NEED) {
            fprintf(stderr, "kernel_launch: built for 25 inputs, x/out of %d floats, >= %zu bytes of workspace; got n_in %d, in0 %d, out %d, ws %zu; nothing launched\n", M_LAT * D, (size_t)WS_NEED, n_in, n_in > 0 ? in_sizes[0] : -1, out_size, ws_size);
            grid = -1; return; }
        int dev = 0, cus = 0, per_cu = 0;
        if (hipGetDevice(&dev) != hipSuccess || hipDeviceGetAttribute(&cus, hipDeviceAttributeMultiprocessorCount, dev) != hipSuccess) { fprintf(stderr, "kernel_launch: device query failed\n"); grid = -1; return; }
        if (hipFuncSetAttribute((const void*)dit_fwd, hipFuncAttributeMaxDynamicSharedMemorySize, LDS_BYTES) != hipSuccess) { fprintf(stderr, "kernel_launch: hipFuncSetAttribute failed\n"); grid = -1; return; }
        if (hipOccupancyMaxActiveBlocksPerMultiprocessor(&per_cu, (const void*)dit_fwd, NTHREADS, LDS_BYTES) != hipSuccess || per_cu < 1) { fprintf(stderr, "kernel_launch: occupancy query says %d workgroups per CU; nothing launched\n", per_cu); (void)hipGetLastError(); grid = -1; return; }
        (void)hipGetLastError();
        grid = cus;
        if (grid < 192 || grid > 304) { fprintf(stderr, "kernel_launch: unexpected CU count %d\n", cus); grid = -1; return; }
    }
    if (grid < 0) return;
    if (hipMemsetAsync((char*)d_ws + WS_CTL, 0, CTL_BYTES, stream) != hipSuccess) { fprintf(stderr, "kernel_launch: memset failed\n"); return; }
    Params p{};
    for (int i = 0; i < 25; ++i) p.in[i] = (const float*)d_in[i];
    p.out = (float*)d_out; p.ws = (unsigned char*)d_ws;
    hipLaunchKernelGGL(dit_fwd, dim3(grid), dim3(NTHREADS), LDS_BYTES, stream, p);
    const hipError_t le = hipPeekAtLastError();
    if (le != hipSuccess) fprintf(stderr, "kernel_launch: launch failed: %s\n", hipGetErrorName(le));
}
```

```cpp
#include <hip/hip_runtime.h>
#include <cstdio>
#include <cstdint>
#include <cmath>
namespace pg8 {
#define PG8_LAS __attribute__((address_space(3)))
typedef unsigned short bf16_t;
typedef short bf16x8 __attribute__((ext_vector_type(8)));
typedef float f32x4 __attribute__((ext_vector_type(4)));
typedef unsigned u32x4 __attribute__((ext_vector_type(4)));
constexpr int BM = 256, BK = 64, HALF = 128, HTB = HALF * BK * 2  , STAGE_BYTES = 8 * HTB, NXCD = 8, WGM = 8;

__host__ __device__ __forceinline__ int lds_byte(int r, int c) { const int st = (r >> 4) * 2 + (c >> 5), rr = r & 15, cc = c & 31, ob = rr * 64 + cc * 2; return st * 1024 + (ob ^ (((ob >> 9) & 1) << 5)); }
__host__ __device__ __forceinline__ void stage_rc(int b, int& R, int& C) { const int st = b / 1024, sb = b % 1024, swz = sb ^ (((sb >> 9) & 1) << 5); R = (st >> 1) * 16 + swz / 64; C = (st & 1) * 32 + (swz % 64) / 2; }
__host__ __device__ __forceinline__ int perm32(int rho) { const int n = rho >> 4, i = rho & 15; return 8 * (i >> 2) + 4 * n + (i & 3); }

struct Unit { int pm, pn; };
struct Gemm { const bf16_t* A; const bf16_t* Bt; int M, N, K; };

struct StaticOrder {
    int nM, nN, nwg, G, c;
    __host__ __device__ void init(int M, int N, int G_, int c_) { nM = M / BM; nN = N / BM; nwg = nM * nN; G = G_; c = c_; }
    __host__ __device__ bool next(int i, Unit& u) const {
        const long L = (long)i * G + c; if (L >= nwg) return false;
        int wgid = (int)L; { const int q = nwg / NXCD, r = nwg % NXCD, xcd = wgid % NXCD, off = wgid / NXCD; wgid = (xcd < r ? xcd * (q + 1) : r * (q + 1) + (xcd - r) * q) + off; }
        const int nig = WGM * nN, gid = wgid / nig, fm = gid * WGM, gsz = (nM - fm) < WGM ? (nM - fm) : WGM;
        u.pm = fm + ((wgid % nig) % gsz); u.pn = (wgid % nig) / gsz; return true;
    }
    __device__ __forceinline__ void a_ready(const Unit&) const {}
    __device__ __forceinline__ void done(const Unit&) const {}
};

__device__ __forceinline__ unsigned cvt_pk_bf16(float lo, float hi) { unsigned r; asm volatile("v_cvt_pk_bf16_f32 %0, %1, %2" : "=v"(r) : "v"(lo), "v"(hi)); return r; }
struct RectOrder {
    int nM, nN, nwg, G, c, pm0, ne, epm0, epn;
    __device__ __forceinline__ void init(int nM_, int nN_, int G_, int c_, int pm0_ = 0, int ne_ = 0, int epm0_ = 0, int epn_ = 0) { nM = nM_; nN = nN_; nwg = nM * nN; G = G_; c = c_; pm0 = pm0_; ne = ne_; epm0 = epm0_; epn = epn_; }
    __device__ __forceinline__ bool next(int i, Unit& u) const {
        const long L = (long)i * G + c;
        if (L >= nwg) { const long x = L - nwg; if (x >= ne) return false; u.pm = epm0 + (int)x; u.pn = epn; return true; }
        int wgid = (int)L; { const int q = nwg / NXCD, r = nwg % NXCD, xcd = wgid % NXCD, off = wgid / NXCD; wgid = (xcd < r ? xcd * (q + 1) : r * (q + 1) + (xcd - r) * q) + off; }
        const int nig = WGM * nN, gid = wgid / nig, fm = gid * WGM, gsz = (nM - fm) < WGM ? (nM - fm) : WGM;
        u.pm = pm0 + fm + ((wgid % nig) % gsz); u.pn = (wgid % nig) / gsz; return true;
    }
    __device__ __forceinline__ void a_ready(const Unit&) const {}
    __device__ __forceinline__ void done(const Unit&) const {}
};
struct MoeOrder {
    int tc, nN, tile0, G, c; const PG8_LAS int* tbl;
    __device__ __forceinline__ bool next(int i, Unit& u) const {
        const int L = i * G + c; if (L >= tc * nN) return false;
        const int j = L / tc, pml = L - j * tc, t = tile0 + pml;
        int e = 0;
#pragma unroll
        for (int k = 1; k < 8; ++k) e += (t >= __builtin_amdgcn_readfirstlane(tbl[k])) ? 1 : 0;
        u.pm = __builtin_amdgcn_readfirstlane(pml); u.pn = __builtin_amdgcn_readfirstlane(e * nN + j); return true;
    }
    __device__ __forceinline__ void a_ready(const Unit&) const {}
    __device__ __forceinline__ void done(const Unit&) const {}
};

__device__ __forceinline__ float bflo(unsigned u) { return __uint_as_float(u << 16); }
__device__ __forceinline__ float bfhi(unsigned u) { return __uint_as_float(u & 0xffff0000u); }
__device__ __forceinline__ float sigm(float x) { return __builtin_amdgcn_rcpf(1.0f + __builtin_amdgcn_exp2f(-1.4426950408889634f * x)); }
__device__ __forceinline__ u32x4 pack8(const f32x4 a, const f32x4 b) { u32x4 w; w.x = cvt_pk_bf16(a[0], a[1]); w.y = cvt_pk_bf16(a[2], a[3]); w.z = cvt_pk_bf16(b[0], b[1]); w.w = cvt_pk_bf16(b[2], b[3]); return w; }

struct EpiPlain {
    static constexpr bool PERM = true, AFTER_DRAIN = false, IDEMPOTENT = true;
    bf16_t* O; int ld, nmod, row_off; float scale;
    __device__ __forceinline__ void operator()(const f32x4 (&acc)[2][2][4][2], const Unit& u, int wr, int wc, int fr, int fq) const {
        const int row0 = row_off + u.pm * BM + wr * 64 + fr, col0 = (u.pn % nmod) * BM + wc * 32 + 8 * fq;
#pragma unroll
        for (int ai = 0; ai < 2; ++ai)
#pragma unroll
            for (int m = 0; m < 4; ++m) { bf16_t* rowp = O + (size_t)(row0 + ai * HALF + m * 16) * ld + col0;
#pragma unroll
                for (int bj = 0; bj < 2; ++bj) *(u32x4*)(rowp + bj * HALF) = pack8(acc[ai][bj][m][0] * scale, acc[ai][bj][m][1] * scale); }
    }
};
template <bool FIRST> struct EpiMerge {
    static constexpr bool PERM = true, AFTER_DRAIN = false, IDEMPOTENT = FIRST;
    bf16_t* MG; const bf16_t* GT; int gcol0;
    __device__ __forceinline__ void operator()(const f32x4 (&acc)[2][2][4][2], const Unit& u, int wr, int wc, int fr, int fq) const {
        const int row0 = u.pm * BM + wr * 64 + fr, col0 = u.pn * BM + wc * 32 + 8 * fq;
#pragma unroll
        for (int ai = 0; ai < 2; ++ai)
#pragma unroll
            for (int m = 0; m < 4; ++m) { const size_t row = (size_t)(row0 + ai * HALF + m * 16);
#pragma unroll
                for (int bj = 0; bj < 2; ++bj) {
                    const u32x4 g = *(const u32x4*)(GT + row * 3072 + gcol0 + col0 + bj * HALF);
                    f32x4 v0 = acc[ai][bj][m][0], v1 = acc[ai][bj][m][1];
                    v0[0] *= bflo(g.x); v0[1] *= bfhi(g.x); v0[2] *= bflo(g.y); v0[3] *= bfhi(g.y); v1[0] *= bflo(g.z); v1[1] *= bfhi(g.z); v1[2] *= bflo(g.w); v1[3] *= bfhi(g.w);
                    bf16_t* dst = MG + row * 1024 + col0 + bj * HALF;
                    if (!FIRST) { const u32x4 o = *(const u32x4*)dst;
                        v0[0] += bflo(o.x); v0[1] += bfhi(o.x); v0[2] += bflo(o.y); v0[3] += bfhi(o.y); v1[0] += bflo(o.z); v1[1] += bfhi(o.z); v1[2] += bflo(o.w); v1[3] += bfhi(o.w); }
                    *(u32x4*)dst = pack8(v0, v1); } }
    }
};
__device__ __forceinline__ unsigned pack4_fp8(float a, float b, float c, float d) { int p = 0; p = __builtin_amdgcn_cvt_pk_fp8_f32(a, b, p, false); p = __builtin_amdgcn_cvt_pk_fp8_f32(c, d, p, true); return (unsigned)p; }
template <bool F8> struct EpiSwiglu {
    static constexpr bool PERM = true, AFTER_DRAIN = false, IDEMPOTENT = true;
    void* H; int ld, nmod; float scale;
    __device__ __forceinline__ void operator()(const f32x4 (&acc)[2][2][4][2], const Unit& u, int wr, int wc, int fr, int fq) const {
        const int row0 = u.pm * BM + wr * 64 + fr, col0 = (u.pn % nmod) * HALF + wc * 32 + 8 * fq;
#pragma unroll
        for (int ai = 0; ai < 2; ++ai)
#pragma unroll
            for (int m = 0; m < 4; ++m) {
                f32x4 h0, h1;
#pragma unroll
                for (int j = 0; j < 4; ++j) { const float g0 = acc[ai][0][m][0][j] * scale, g1 = acc[ai][0][m][1][j] * scale;
                    h0[j] = g0 * sigm(g0) * (acc[ai][1][m][0][j] * scale); h1[j] = g1 * sigm(g1) * (acc[ai][1][m][1][j] * scale); }
                const size_t off = (size_t)(row0 + ai * HALF + m * 16) * ld + col0;
                if constexpr (F8) { typedef unsigned u32x2_ __attribute__((ext_vector_type(2))); u32x2_ w; w.x = pack4_fp8(h0[0], h0[1], h0[2], h0[3]); w.y = pack4_fp8(h1[0], h1[1], h1[2], h1[3]); *(u32x2_*)((unsigned char*)H + off) = w; }
                else *(u32x4*)((bf16_t*)H + off) = pack8(h0, h1); }
    }
};
struct EpiIn {
    static constexpr bool PERM = true, AFTER_DRAIN = false, IDEMPOTENT = true;
    unsigned char* ws; size_t oQ, oKV, oFAB, oCIN, oGT, oROPE; float qscale;
    __device__ __forceinline__ void operator()(const f32x4 (&acc)[2][2][4][2], const Unit& u, int wr, int wc, int fr, int fq) const {
        const int pn = u.pn, lc0 = wc * 32 + 8 * fq, row0 = u.pm * BM + wr * 64 + fr;
        const bool ctxrow = u.pm >= 128;
        bf16_t* const Q = (bf16_t*)(ws + oQ); bf16_t* const KV = (bf16_t*)(ws + oKV); bf16_t* const FAB = (bf16_t*)(ws + oFAB); bf16_t* const CIN = (bf16_t*)(ws + oCIN); bf16_t* const GT = (bf16_t*)(ws + oGT);
        const float* const rope = (const float*)(ws + oROPE);
#pragma unroll
        for (int bj = 0; bj < 2; ++bj) {
            const int cc = bj * HALF + lc0;
            int mode, ld, dcol; bf16_t* dst;
            if (pn < 2) { mode = 2; dst = Q; ld = 512; dcol = pn * 256 + cc; }
            else if (pn == 2) { dst = KV; ld = 256; dcol = cc; mode = (bj == 0) ? 3 : 0; }
            else if (pn < 7) { mode = 0; dst = FAB; ld = 1024; dcol = (pn - 3) * 256 + cc; }
            else if (pn < 13) { mode = 0; dst = CIN; ld = 1536; dcol = (pn - 7) * 256 + cc; }
            else { mode = 1; dst = GT; ld = 3072; dcol = (pn - 13) * 256 + cc; }
            if (mode == 0) {
#pragma unroll
                for (int ai = 0; ai < 2; ++ai)
#pragma unroll
                    for (int m = 0; m < 4; ++m) *(u32x4*)(dst + (size_t)(row0 + ai * HALF + m * 16) * ld + dcol) = pack8(acc[ai][bj][m][0], acc[ai][bj][m][1]);
            } else if (mode == 1) {
#pragma unroll
                for (int ai = 0; ai < 2; ++ai)
#pragma unroll
                    for (int m = 0; m < 4; ++m) { f32x4 v0 = acc[ai][bj][m][0], v1 = acc[ai][bj][m][1];
#pragma unroll
                        for (int j = 0; j < 4; ++j) { v0[j] = sigm(v0[j]); v1[j] = sigm(v1[j]); }
                        *(u32x4*)(dst + (size_t)(row0 + ai * HALF + m * 16) * ld + dcol) = pack8(v0, v1); }
            } else {
                const float qs = (mode == 2) ? qscale : 1.0f;
                const int i0 = (dcol & 63) >> 1;
#pragma unroll
                for (int ai = 0; ai < 2; ++ai)
#pragma unroll
                    for (int m = 0; m < 4; ++m) { const int row = row0 + ai * HALF + m * 16; f32x4 v0 = acc[ai][bj][m][0], v1 = acc[ai][bj][m][1];
                        if (!ctxrow) { const int s = row & 16383, pos = (i0 < 16) ? (s >> 6) : (s & 63);
                            const float* t = rope + (size_t)(pos * 16 + (i0 & 15)) * 2; const f32x4 t0 = *(const f32x4*)t, t1 = *(const f32x4*)(t + 4);
                            f32x4 r0, r1;
                            r0[0] = v0[0] * t0[0] - v0[1] * t0[1]; r0[1] = v0[0] * t0[1] + v0[1] * t0[0]; r0[2] = v0[2] * t0[2] - v0[3] * t0[3]; r0[3] = v0[2] * t0[3] + v0[3] * t0[2];
                            r1[0] = v1[0] * t1[0] - v1[1] * t1[1]; r1[1] = v1[0] * t1[1] + v1[1] * t1[0]; r1[2] = v1[2] * t1[2] - v1[3] * t1[3]; r1[3] = v1[2] * t1[3] + v1[3] * t1[2];
                            v0 = r0; v1 = r1; }
                        v0 = v0 * qs; v1 = v1 * qs;
                        *(u32x4*)(dst + (size_t)(row0 + ai * HALF + m * 16) * ld + dcol) = pack8(v0, v1); }
            }
        }
    }
};

template <class Epi, class Sched, bool ALIGN_EPI = false, bool SP2 = false, bool FP8 = false>
__device__ __forceinline__ void gemm_phase(PG8_LAS unsigned char* lds, const Gemm g, const Sched& S, const Epi& E, int wave_id  , int stagger_ticks = 0) {
    unsigned z_ = 0u; asm volatile("" : "+v"(z_)); int wid_ = wave_id; asm volatile("" : "+s"(wid_));
    const int lane_ = (int)__builtin_amdgcn_mbcnt_hi(~0u, __builtin_amdgcn_mbcnt_lo(~0u, z_));
    const int wid = wid_, lane = lane_, tid = wid * 64 + lane, wr = wid >> 2, wc = wid & 3, fr = lane & 15, fq = lane >> 4;
    const int K = g.K, pitch = FP8 ? K : 2 * K  , nt = pitch / 128;
    unsigned voffA, voffB;
    { int R, C; stage_rc(tid * 16, R, C); const int Rb = Epi::PERM ? ((R & ~31) + perm32(R & 31)) : R;
        voffA = (unsigned)(R * pitch + C * 2); voffB = (unsigned)(Rb * pitch + C * 2); }
    const size_t pstep = (size_t)64 * pitch;
    const size_t kstep = (size_t)(BK * 2);
    const size_t hstep = (size_t)HALF * pitch;
    const size_t tstep = 2 * hstep;
    const unsigned ldsw = (unsigned)wid * 1024u;
    const int aoff = lds_byte(wr * 64 + fr, fq * 8), boff = lds_byte(wc * 32 + fr, fq * 8);
#define PG8_SA(b, h) (((b) * 2 + (h)) * HTB)
#define PG8_SB(b, h) ((4 + (b) * 2 + (h)) * HTB)
#define PG8_STAGE(bufoff, gbase, voff) do { _Pragma("unroll") for (int _i = 0; _i < 2; ++_i) \
        __builtin_amdgcn_global_load_lds((const unsigned*)((const char*)(gbase) + _i * pstep + (voff)), (PG8_LAS unsigned*)(lds + (bufoff) + ldsw + _i * 8192), 16, 0, 0); } while (0)
#define PG8_LDA(dst, b, h) do { _Pragma("unroll") for (int m = 0; m < 4; ++m) _Pragma("unroll") for (int k = 0; k < 2; ++k) dst[m][k] = *(const PG8_LAS bf16x8*)(lds + PG8_SA(b, h) + aoff + m * 2048 + k * 1024); } while (0)
#define PG8_LDB(dst, b, h) do { _Pragma("unroll") for (int n = 0; n < 2; ++n) _Pragma("unroll") for (int k = 0; k < 2; ++k) dst[n][k] = *(const PG8_LAS bf16x8*)(lds + PG8_SB(b, h) + boff + n * 2048 + k * 1024); } while (0)
#define PG8_MMA(ai, bj, At, Bt) do { __builtin_amdgcn_s_setprio(1); _Pragma("unroll") for (int m = 0; m < 4; ++m) _Pragma("unroll") for (int n = 0; n < 2; ++n) { \
        if constexpr (FP8) { typedef int i32x4_ __attribute__((ext_vector_type(4))); \
            acc[ai][bj][m][n] = __builtin_amdgcn_mfma_scale_f32_16x16x128_f8f6f4(__builtin_shufflevector(__builtin_bit_cast(i32x4_, Bt[n][0]), __builtin_bit_cast(i32x4_, Bt[n][1]), 0, 1, 2, 3, 4, 5, 6, 7), \
                __builtin_shufflevector(__builtin_bit_cast(i32x4_, At[m][0]), __builtin_bit_cast(i32x4_, At[m][1]), 0, 1, 2, 3, 4, 5, 6, 7), acc[ai][bj][m][n], 0, 0, 0, 0, 0, 0); } \
        else { _Pragma("unroll") for (int k = 0; k < 2; ++k) acc[ai][bj][m][n] = __builtin_amdgcn_mfma_f32_16x16x32_bf16(Bt[n][k], At[m][k], acc[ai][bj][m][n], 0, 0, 0); } } \
        __builtin_amdgcn_s_setprio(0); } while (0)
#define PG8_WAIT_V(n) asm volatile("s_waitcnt vmcnt(" #n ")" ::: "memory")
#define PG8_WAIT_L(n) asm volatile("s_waitcnt lgkmcnt(" #n ")" ::: "memory")
#define PG8_BAR __builtin_amdgcn_s_barrier()
#define PG8_SCHED __builtin_amdgcn_sched_barrier(0)
    Unit cur, nxt; int ui = 0;
    if (!S.next(0, cur)) return;
    if (stagger_ticks > 0) { const unsigned long long t0_ = __builtin_amdgcn_s_memrealtime(); while (__builtin_amdgcn_s_memrealtime() - t0_ < (unsigned long long)stagger_ticks) __builtin_amdgcn_s_sleep(4); }
    f32x4 acc[2][2][4][2];
#pragma unroll
    for (int a = 0; a < 2; ++a)
#pragma unroll
        for (int b = 0; b < 2; ++b)
#pragma unroll
            for (int m = 0; m < 4; ++m)
#pragma unroll
                for (int n = 0; n < 2; ++n) acc[a][b][m][n] = (f32x4){0.f, 0.f, 0.f, 0.f};
    bf16x8 At[4][2], B0[2][2], B1[2][2];
    const char* cA = (const char*)g.A + (size_t)cur.pm * tstep; const char* cB = (const char*)g.Bt + (size_t)cur.pn * tstep;
    S.a_ready(cur);
    if constexpr (SP2) {
        PG8_STAGE(PG8_SB(0, 0), cB, voffB); PG8_STAGE(PG8_SB(0, 1), cB + hstep, voffB); PG8_STAGE(PG8_SA(0, 0), cA, voffA); PG8_STAGE(PG8_SA(0, 1), cA + hstep, voffA);
        if (wr == 1) PG8_BAR;
        PG8_WAIT_V(2); PG8_BAR;
        PG8_STAGE(PG8_SB(1, 0), cB + kstep, voffB); PG8_STAGE(PG8_SA(1, 0), cA + kstep, voffA); PG8_STAGE(PG8_SB(1, 1), cB + hstep + kstep, voffB);
        PG8_WAIT_V(6); PG8_BAR;
    } else {
        PG8_STAGE(PG8_SB(0, 0), cB, voffB); PG8_STAGE(PG8_SA(0, 0), cA, voffA); PG8_STAGE(PG8_SB(0, 1), cB + hstep, voffB); PG8_STAGE(PG8_SA(0, 1), cA + hstep, voffA);
        if (wr == 1) PG8_BAR;
        PG8_WAIT_V(4); PG8_BAR;
        PG8_STAGE(PG8_SB(1, 0), cB + kstep, voffB); PG8_STAGE(PG8_SA(1, 0), cA + kstep, voffA); PG8_STAGE(PG8_SB(1, 1), cB + hstep + kstep, voffB);
        PG8_WAIT_V(6); PG8_BAR;
    }
    for (;;) {
        const bool has_next = S.next(ui + 1, nxt);
        const char* nA = has_next ? (const char*)g.A + (size_t)nxt.pm * tstep : cA; const char* nB = has_next ? (const char*)g.Bt + (size_t)nxt.pn * tstep : cB;
#pragma unroll 1
        for (int t = 0; t < nt; t += 2) {
            const bool last = (t == nt - 2);
            const char* a1 = cA + (size_t)(t + 1) * kstep;
            const char* a2 = last ? nA : cA + (size_t)(t + 2) * kstep; const char* b2 = last ? nB : cB + (size_t)(t + 2) * kstep;
            const char* a3 = a2 + kstep; const char* b3 = b2 + kstep;
            if (last && has_next) S.a_ready(nxt);
            if constexpr (SP2) {
            PG8_LDB(B0, 0, 0); PG8_LDB(B1, 0, 1); PG8_SCHED; PG8_LDA(At, 0, 0); PG8_STAGE(PG8_SA(1, 1), a1 + hstep, voffA);
            PG8_WAIT_V(8); PG8_WAIT_L(0); PG8_BAR; PG8_MMA(0, 0, At, B0); PG8_MMA(0, 1, At, B1); PG8_BAR; PG8_SCHED;
            PG8_LDA(At, 0, 1); PG8_STAGE(PG8_SB(0, 0), b2, voffB); PG8_STAGE(PG8_SB(0, 1), b2 + hstep, voffB); PG8_STAGE(PG8_SA(0, 0), a2, voffA);
            PG8_WAIT_V(8); PG8_WAIT_L(0); PG8_BAR; PG8_MMA(1, 0, At, B0); PG8_MMA(1, 1, At, B1); PG8_BAR; PG8_SCHED;
            PG8_LDB(B0, 1, 0); PG8_LDB(B1, 1, 1); PG8_SCHED; PG8_LDA(At, 1, 0); PG8_STAGE(PG8_SA(0, 1), a2 + hstep, voffA);
            PG8_WAIT_V(8); PG8_WAIT_L(0); PG8_BAR; PG8_MMA(0, 0, At, B0); PG8_MMA(0, 1, At, B1); PG8_BAR; PG8_SCHED;
            PG8_LDA(At, 1, 1); PG8_STAGE(PG8_SB(1, 0), b3, voffB); PG8_STAGE(PG8_SB(1, 1), b3 + hstep, voffB); PG8_STAGE(PG8_SA(1, 0), a3, voffA);
            PG8_WAIT_V(8); PG8_WAIT_L(0); PG8_BAR; PG8_MMA(1, 0, At, B0); PG8_MMA(1, 1, At, B1); PG8_BAR; PG8_SCHED;
            } else {
            PG8_LDB(B0, 0, 0); PG8_SCHED; PG8_LDA(At, 0, 0); PG8_STAGE(PG8_SA(1, 1), a1 + hstep, voffA);
            PG8_WAIT_L(8); PG8_BAR; PG8_WAIT_L(0); PG8_MMA(0, 0, At, B0); PG8_BAR; PG8_SCHED;
            PG8_LDB(B1, 0, 1); PG8_STAGE(PG8_SB(0, 0), b2, voffB);
            PG8_BAR; PG8_WAIT_L(0); PG8_MMA(0, 1, At, B1); PG8_BAR;
            PG8_LDA(At, 0, 1); PG8_STAGE(PG8_SA(0, 0), a2, voffA);
            PG8_BAR; PG8_WAIT_L(0); PG8_MMA(1, 0, At, B0); PG8_BAR; PG8_SCHED;
            PG8_STAGE(PG8_SB(0, 1), b2 + hstep, voffB);
            PG8_WAIT_V(6); PG8_BAR; PG8_MMA(1, 1, At, B1); PG8_BAR;
            PG8_LDB(B0, 1, 0); PG8_SCHED; PG8_LDA(At, 1, 0); PG8_STAGE(PG8_SA(0, 1), a2 + hstep, voffA);
            PG8_WAIT_L(8); PG8_BAR; PG8_WAIT_L(0); PG8_MMA(0, 0, At, B0); PG8_BAR; PG8_SCHED;
            PG8_LDB(B1, 1, 1); PG8_STAGE(PG8_SB(1, 0), b3, voffB);
            PG8_BAR; PG8_WAIT_L(0); PG8_MMA(0, 1, At, B1); PG8_BAR;
            PG8_LDA(At, 1, 1); PG8_STAGE(PG8_SA(1, 0), a3, voffA);
            PG8_BAR; PG8_WAIT_L(0); PG8_MMA(1, 0, At, B0); PG8_BAR; PG8_SCHED;
            PG8_STAGE(PG8_SB(1, 1), b3 + hstep, voffB);
            PG8_WAIT_V(6); PG8_BAR; PG8_MMA(1, 1, At, B1); PG8_BAR;
            }
        }
        if constexpr (ALIGN_EPI) { if (wr == 0) PG8_BAR; }
        if constexpr (!Epi::AFTER_DRAIN) { unsigned ze_ = 0u; asm volatile("" : "+v"(ze_)); const int le_ = (int)__builtin_amdgcn_mbcnt_hi(~0u, __builtin_amdgcn_mbcnt_lo(~0u, ze_));
            E(acc, cur, wr, wc, le_ & 15, le_ >> 4);
#if defined(REP_EPI)
            if constexpr (Epi::IDEMPOTENT) { for (int r_ = 1; r_ < REP_EPI; ++r_) { asm volatile("" ::: "memory"); E(acc, cur, wr, wc, le_ & 15, le_ >> 4); } }
#endif
            S.done(cur); }
        if (!has_next) break;
#pragma unroll
        for (int a = 0; a < 2; ++a)
#pragma unroll
            for (int b = 0; b < 2; ++b)
#pragma unroll
                for (int m = 0; m < 4; ++m)
#pragma unroll
                    for (int n = 0; n < 2; ++n) acc[a][b][m][n] = (f32x4){0.f, 0.f, 0.f, 0.f};
        cur = nxt; cA = nA; cB = nB; ++ui;
        if constexpr (ALIGN_EPI) { if (wr == 1) PG8_BAR; }
    }
    PG8_WAIT_V(0);
    if constexpr (!ALIGN_EPI) { if (wr == 0) PG8_BAR; }
    PG8_BAR;
    if constexpr (Epi::AFTER_DRAIN) { E.fused(acc, cur, wr, wc, fr, fq, lds, wid, lane); S.done(cur); }
#undef PG8_SA
#undef PG8_SB
#undef PG8_STAGE
#undef PG8_LDA
#undef PG8_LDB
#undef PG8_MMA
#undef PG8_WAIT_V
#undef PG8_WAIT_L
#undef PG8_BAR
#undef PG8_SCHED
}
}
#define GAS __attribute__((address_space(1)))
#define LAS __attribute__((address_space(3)))
typedef pg8::bf16_t bf16_t;
typedef pg8::bf16x8 bf16x8;
typedef pg8::f32x4 f32x4;
typedef pg8::u32x4 u32x4;
typedef float f32x16 __attribute__((ext_vector_type(16)));
typedef float f32x2 __attribute__((ext_vector_type(2)));
typedef short s16x4 __attribute__((ext_vector_type(4)));
typedef unsigned u32x2 __attribute__((ext_vector_type(2)));
typedef GAS unsigned gu32;

typedef const __attribute__((address_space(4))) unsigned char* kptr_t;
__device__ __forceinline__ kptr_t kbase() { kptr_t p = (kptr_t)__builtin_amdgcn_kernarg_segment_ptr(); asm volatile("" : "+s"(p)); return p; }
#define IN_(i) (*(const float* const __attribute__((address_space(4)))*)(kbase() + 8 * (i)))
#define OUT_ (*(float* const __attribute__((address_space(4)))*)(kbase() + 200))
#define WS_ (*(unsigned char* const __attribute__((address_space(4)))*)(kbase() + 208))
constexpr int NWAVES = 8, NTHREADS = 512;
constexpr int D = 1024, SEQ = 16384, M_LAT = 32768, CTXL = 256, M_CTX = 512, MT = M_LAT + M_CTX;
constexpr int ZN = 6400, DFF = 2816, DEXP = 3584, NEXP = 8, NMOD = 6144;
constexpr float EPS = 1e-6f, LOG2E = 1.4426950408889634f, QSCALE = 0.125f * LOG2E;
constexpr int CHUNK_TILES = 128, CHUNK_ROWS = CHUNK_TILES * 256;
constexpr float WSCALE8 = 64.0f;

constexpr size_t MiB = 1u << 20;
constexpr size_t WS_CTL = 0, CTL_BYTES = 1 * MiB;
constexpr size_t WS_MODV = 6 * MiB + 768 * 1024;
constexpr size_t WS_MODF = 1 * MiB;
constexpr size_t WS_ROPE = 1 * MiB + 256 * 1024;
constexpr size_t WS_G1 = 1 * MiB + 512 * 1024;
constexpr size_t WS_G2 = 1 * MiB + 768 * 1024;
constexpr size_t WS_HCTX = 2 * MiB;
constexpr size_t WS_ASG = 4 * MiB;
constexpr size_t WS_ELIST = 5 * MiB;
constexpr size_t WS_TW = 6 * MiB;
constexpr size_t WS_G3 = 6 * MiB + 512 * 1024;
constexpr size_t WS_WIN = 8 * MiB, WIN_BYTES = (size_t)ZN * D * 2;
constexpr size_t WS_WY = 33 * MiB;
constexpr size_t WS_WO = 39 * MiB;
constexpr size_t WS_WFF_UP = 43 * MiB;
constexpr size_t WS_WFF_DN = 54 * MiB;
constexpr size_t WS_HN = 60 * MiB;
constexpr size_t WS_Q = 125 * MiB;
constexpr size_t WS_KV = WS_Q + (size_t)MT * 512 * 2;
constexpr size_t WS_FAB = 174 * MiB;
constexpr size_t WS_CIN = 239 * MiB;
constexpr size_t WS_GT = WS_CIN + (size_t)MT * 1536 * 2;
constexpr size_t WS_COUT = 532 * MiB;
constexpr size_t WS_MIX = WS_GT;
constexpr size_t WS_HID0 = 125 * MiB;
constexpr size_t WS_F0 = 402 * MiB;
constexpr size_t WS_EXUP = 125 * MiB;
constexpr size_t WS_EXDN = 181 * MiB;
constexpr size_t WS_H2G = 209 * MiB;
constexpr size_t WS_HIDX = 244 * MiB;
constexpr size_t WS_YEXP = 437 * MiB;
constexpr size_t WS_ATT = 570 * MiB;
constexpr size_t WS_NEED = 603 * MiB;
static_assert(WS_KV + (size_t)MT * 256 * 2 <= WS_FAB && WS_FAB + (size_t)MT * 1024 * 2 <= WS_CIN && WS_GT + (size_t)MT * 3072 * 2 <= WS_COUT && WS_COUT + (size_t)MT * 512 * 2 <= WS_ATT && WS_ATT + (size_t)MT * 512 * 2 <= WS_NEED, "ws map (mixer)");
static_assert(WS_HN + (size_t)MT * 1024 * 2 <= WS_Q && WS_WFF_DN + (size_t)1024 * DFF * 2 <= WS_HN && WS_WFF_UP + (size_t)2 * DFF * 1024 * 2 <= WS_WFF_DN, "ws map (weights)");
static_assert(WS_HID0 + (size_t)MT * DFF * 2 <= WS_MIX && WS_MIX + (size_t)MT * 1024 * 2 <= WS_F0 && WS_EXUP + (size_t)8 * 7168 * 1024 <= WS_EXDN && WS_EXDN + (size_t)8 * 1024 * DEXP <= WS_H2G && WS_EXDN + (size_t)8 * 1024 * DEXP <= WS_MIX, "ws map (ffn)");
static_assert(WS_H2G + (size_t)CHUNK_ROWS * 1024 <= WS_HIDX && WS_HIDX + (size_t)CHUNK_ROWS * DEXP <= WS_YEXP && WS_YEXP + (size_t)264 * 256 * 1024 * 2 <= WS_ATT, "ws map (moe)");
constexpr int CW_BAR = 4096;
constexpr int CW_CNT = 8192;

constexpr int RING_BYTES = 131072;
constexpr int MISC_OFF = RING_BYTES + 320;
constexpr int LDSX_OFF = RING_BYTES + 1024;
constexpr int LDS_BYTES = 147456;

#define LDS_WAIT() asm volatile("s_waitcnt lgkmcnt(0)" ::: "memory")
#define VM_WAIT() asm volatile("s_waitcnt vmcnt(0)" ::: "memory")

#define XB_TMO      128
#define XB_XCNT(j)  (256  + 64 * (j))
#define XB_XSUB(j)  (1280 + 64 * (j))
#define XB_XGEN(j)  (2304 + 64 * (j))
#define XB_TOP      3328
#define XB_TOPGEN   3392
#define XCD_BAR_WORDS 3456
#define XB_SPIN_CAP (1u << 22)

__device__ __forceinline__ unsigned xb_ld(unsigned* p)              { return __hip_atomic_load(p, __ATOMIC_RELAXED, __HIP_MEMORY_SCOPE_AGENT); }
__device__ __forceinline__ unsigned xb_add(unsigned* p, unsigned v) { return __hip_atomic_fetch_add(p, v, __ATOMIC_RELAXED, __HIP_MEMORY_SCOPE_AGENT); }
__device__ __forceinline__ unsigned xb_xcc_id() { return (unsigned)__builtin_amdgcn_s_getreg((3 << 11) | 20) & 0xFu; }
#define XB_SPIN(cond, bar) do { unsigned _sp = 0; while (cond) { __builtin_amdgcn_s_sleep(1); \
    if ((++_sp & 255u) == 0u) { if (xb_ld(&(bar)[XB_TMO])) break; if (_sp > XB_SPIN_CAP) { atomicAdd(&(bar)[XB_TMO], 1u); break; } } } } while (0)

struct XcdBarrier {
    unsigned* bar; unsigned x;
    volatile LAS unsigned* st;
};

__device__ __forceinline__ XcdBarrier xcd_barrier_post(unsigned* bar, volatile LAS unsigned* st) {
    XcdBarrier b; b.bar = bar; b.x = xb_xcc_id(); b.st = st;
    if (threadIdx.x == 0) (void)xb_add(&bar[XB_XCNT(b.x)], 1u);
    return b;
}
__device__ __forceinline__ void xcd_barrier_complete(unsigned* bar, unsigned x, unsigned& nloc, unsigned& nx) {
    const unsigned G = gridDim.x * gridDim.y * gridDim.z;
    unsigned sum, cnt, mine, sp = 0u;
    for (;;) {
        sum = 0u; cnt = 0u; mine = 0u;
#pragma unroll
        for (unsigned j = 0; j < 16; ++j) { const unsigned c = xb_ld(&bar[XB_XCNT(j)]); sum += c; cnt += (c > 0u) ? 1u : 0u; mine = (j == x) ? c : mine; }
        if (sum == G) break;
        __builtin_amdgcn_s_sleep(1);
        if ((++sp & 255u) == 0u) { if (xb_ld(&bar[XB_TMO])) break; if (sp > XB_SPIN_CAP) { atomicAdd(&bar[XB_TMO], 1u); break; } }
    }
    nloc = mine > 0u ? mine : 1u; nx = cnt > 0u ? cnt : 1u;
}

__device__ __forceinline__ void xcd_barrier(const XcdBarrier& b) {
    asm volatile("s_waitcnt vmcnt(0)" ::: "memory");
    __syncthreads();
    if (threadIdx.x == 0) {
        unsigned* bar = b.bar;
        __builtin_amdgcn_s_waitcnt(0);
        unsigned nloc = b.st[0], nx = b.st[1];
        if (nloc == 0u) { xcd_barrier_complete(bar, b.x, nloc, nx); b.st[0] = nloc; b.st[1] = nx; }
        const unsigned old = xb_add(&bar[XB_XSUB(b.x)], 1u);
        const unsigned gen = old / nloc;
        if (old + 1u == (gen + 1u) * nloc) {
            __builtin_amdgcn_fence(__ATOMIC_RELEASE, "agent");
            asm volatile("s_waitcnt vmcnt(0)" ::: "memory");
            const unsigned og = xb_add(&bar[XB_TOP], 1u);
            const unsigned tg = og / nx;
            if (og + 1u == (tg + 1u) * nx) xb_add(&bar[XB_TOPGEN], 1u);
            else XB_SPIN(xb_ld(&bar[XB_TOPGEN]) == tg, bar);
            __builtin_amdgcn_fence(__ATOMIC_ACQUIRE, "agent");
            xb_add(&bar[XB_XGEN(b.x)], 1u);
            asm volatile("s_waitcnt vmcnt(0)" ::: "memory");
        } else {
            XB_SPIN(xb_ld(&bar[XB_XGEN(b.x)]) == gen, bar);
            __builtin_amdgcn_fence(__ATOMIC_ACQUIRE, "agent");
            asm volatile("s_waitcnt vmcnt(0)" ::: "memory");
        }
    }
    __syncthreads();
}

struct Params { const float* in[25]; float* out; unsigned char* ws; };
struct Ctx {
    LAS unsigned char* lds;
    int tid, lane, wave, vcu, G;
};
__device__ __forceinline__ Ctx opaque(const Ctx& c) { Ctx o = c; asm volatile("" : "+s"(o.wave), "+s"(o.vcu), "+s"(o.G));
    unsigned z = 0u; asm volatile("" : "+v"(z)); o.lane = (int)__builtin_amdgcn_mbcnt_hi(~0u, __builtin_amdgcn_mbcnt_lo(~0u, z)); o.tid = o.wave * 64 + o.lane; return o; }
template <int O> __device__ __forceinline__ float lane_xor(float v) { return __int_as_float(__builtin_amdgcn_ds_swizzle(__float_as_int(v), (O << 10) | 0x1f)); }
__device__ __forceinline__ float half_sum(float v) { const auto r = __builtin_amdgcn_permlane32_swap(__float_as_uint(v), __float_as_uint(v), false, false); return __uint_as_float(r[0]) + __uint_as_float(r[1]); }
__device__ __forceinline__ float half_max(float v) { const auto r = __builtin_amdgcn_permlane32_swap(__float_as_uint(v), __float_as_uint(v), false, false); return fmaxf(__uint_as_float(r[0]), __uint_as_float(r[1])); }
__device__ __forceinline__ float wave_sum(float v) {
    v += lane_xor<1>(v); v += lane_xor<2>(v); v += lane_xor<4>(v); v += lane_xor<8>(v); v += lane_xor<16>(v);
    return half_sum(v);
}
__device__ __forceinline__ unsigned pk2(float lo, float hi) { return pg8::cvt_pk_bf16(lo, hi); }
__device__ __forceinline__ float bflo(unsigned u) { return __uint_as_float(u << 16); }
__device__ __forceinline__ float bfhi(unsigned u) { return __uint_as_float(u & 0xffff0000u); }

__device__ __forceinline__ void tr_item(const float* W, int ldw, int k0, int n0, bf16_t* WT, int ldt, int drow0, LAS float* scr, int lane) {
#pragma unroll 8
    for (int i = 0; i < 32; ++i) { const int kk = 2 * i + (lane >> 5); scr[kk * 33 + (lane & 31)] = W[(size_t)(k0 + kk) * ldw + n0 + (lane & 31)]; }
    LDS_WAIT(); asm volatile("" ::: "memory");
    const int c = lane & 7;
#pragma unroll
    for (int j = 0; j < 4; ++j) { const int n = (lane >> 3) + 8 * j; const LAS float* s = scr + (8 * c) * 33 + n;
        u32x4 o; o.x = pk2(s[0 * 33], s[1 * 33]); o.y = pk2(s[2 * 33], s[3 * 33]); o.z = pk2(s[4 * 33], s[5 * 33]); o.w = pk2(s[6 * 33], s[7 * 33]);
        *(GAS u32x4*)(WT + (size_t)(drow0 + n) * ldt + k0 + 8 * c) = o; }
    LDS_WAIT(); asm volatile("" ::: "memory");
}
__device__ __forceinline__ void tr_item8(const float* W, int ldw, int k0, int n0, unsigned char* WT, int ldt, int drow0, float scale, LAS float* scr, int lane) {
#pragma unroll 8
    for (int i = 0; i < 32; ++i) { const int kk = 2 * i + (lane >> 5); scr[kk * 33 + (lane & 31)] = W[(size_t)(k0 + kk) * ldw + n0 + (lane & 31)]; }
    LDS_WAIT(); asm volatile("" ::: "memory");
    const int c = lane & 7;
#pragma unroll
    for (int j = 0; j < 4; ++j) { const int n = (lane >> 3) + 8 * j; const LAS float* s = scr + (8 * c) * 33 + n;
        u32x2 o; o.x = pg8::pack4_fp8(s[0 * 33] * scale, s[1 * 33] * scale, s[2 * 33] * scale, s[3 * 33] * scale); o.y = pg8::pack4_fp8(s[4 * 33] * scale, s[5 * 33] * scale, s[6 * 33] * scale, s[7 * 33] * scale);
        *(GAS u32x2*)(WT + (size_t)(drow0 + n) * ldt + k0 + 8 * c) = o; }
    LDS_WAIT(); asm volatile("" ::: "memory");
}
__device__ __forceinline__ int gu_row(int n0, int up) { return (n0 >> 7) * 256 + up * 128 + (n0 & 127); }

__device__ __forceinline__ void p0_convert_item(int it, LAS float* scr, int lane) {
    unsigned char* ws = WS_;
    if (it < 5376) { const int l = it / 2688, r = it % 2688, kb = r / 168, j = r % 168; const int n0 = j < 24 ? 32 * j : 1280 + 32 * (j - 24);
        tr_item(IN_(10) + (size_t)l * D * 5888, 5888, 64 * kb, n0, (bf16_t*)(ws + WS_WIN + l * WIN_BYTES), D, n0 < 768 ? n0 : n0 + 512, scr, lane); return; }
    it -= 5376;
    if (it < 1536) { const int mi = it / 256, r = it % 256, l = mi / 3, i = mi % 3, kb = r / 32, nb = r % 32;
        tr_item(IN_(13 + i) + (size_t)l * 512 * 1024, 1024, 64 * kb, 32 * nb, (bf16_t*)(ws + WS_WY) + (size_t)(l * 3 + i) * 1024 * 512, 512, 32 * nb, scr, lane); return; }
    it -= 1536;
    if (it < 1024) { const int l = it / 512, r = it % 512, kb = r / 32, nb = r % 32;
        tr_item(IN_(16) + (size_t)l * D * D, D, 64 * kb, 32 * nb, (bf16_t*)(ws + WS_WO) + (size_t)l * D * D, D, 32 * nb, scr, lane); return; }
    it -= 1024;
    if (it < 2816) { const int up = it / 1408, r = it % 1408, kb = r / 88, nb = r % 88;
        tr_item(IN_(17 + up), DFF, 64 * kb, 32 * nb, (bf16_t*)(ws + WS_WFF_UP), D, gu_row(32 * nb, up), scr, lane); return; }
    it -= 2816;
    { const int kb = it / 32, nb = it % 32; tr_item(IN_(19), D, 64 * kb, 32 * nb, (bf16_t*)(ws + WS_WFF_DN), DFF, 32 * nb, scr, lane); }
}
constexpr int P0_ITEMS = 5376 + 1536 + 1024 + 2816 + 1408;
__device__ __forceinline__ void expert_convert_item(int it, LAS float* scr, int lane) {
    unsigned char* ws = WS_;
    const int e = it / 5376, r0 = it % 5376, which = r0 / 1792, r = r0 % 1792;
    if (which < 2) { const int kb = r / 112, nb = r % 112;
        tr_item8(IN_(22 + which) + (size_t)e * D * DEXP, DEXP, 64 * kb, 32 * nb, ws + WS_EXUP + (size_t)e * 7168 * D, D, gu_row(32 * nb, which), WSCALE8, scr, lane); }
    else { const int kb = r / 32, nb = r % 32;
        tr_item8(IN_(24) + (size_t)e * DEXP * D, D, 64 * kb, 32 * nb, ws + WS_EXDN + (size_t)e * D * DEXP, DEXP, 32 * nb, WSCALE8, scr, lane); }
}
constexpr int EXP_ITEMS = 8 * 5376;
__device__ __forceinline__ void phase_expert_convert(const Ctx& C0) {
    const Ctx C = opaque(C0);
    LAS float* scr = (LAS float*)(C.lds + C.wave * 16384);
    for (int it = C.vcu * NWAVES + C.wave; it < EXP_ITEMS; it += C.G * NWAVES) expert_convert_item(it, scr, C.lane);
}

__device__ __forceinline__ void p0_prologue(const Ctx& C0) {
    const Ctx C = opaque(C0);
    unsigned char* ws = WS_;
    LAS float* sil = (LAS float*)(C.lds + LDSX_OFF);
    LAS float* tab = (LAS float*)(C.lds + LDSX_OFF + 12288);
    for (int i = C.tid; i < 3072; i += NTHREADS) { const float v = i < 2048 ? IN_(1)[i] : IN_(3)[i - 2048]; sil[i] = v / (1.0f + __expf(-v)); }
    if (C.tid < 128) { float s, c; sincospif((float)C.tid / 64.0f, &s, &c); tab[2 * C.tid] = c; tab[2 * C.tid + 1] = s; }
    __syncthreads();
    { const int gw0 = C.vcu * NWAVES + C.wave, NGW0 = C.G * NWAVES;
      for (int t = gw0; t < 8 * 2 * 96; t += NGW0) {
        const int kc = t / 192, l = (t % 192) / 96, col = (t % 96) * 64 + C.lane; const float* w = IN_(4) + (size_t)l * D * NMOD + (size_t)(kc * 128) * NMOD + col;
        float a0 = 0.f, a1 = 0.f, a2 = 0.f;
        for (int k = 0; k < 128; k += 16) { float wv[16];
#pragma unroll
            for (int j = 0; j < 16; ++j) wv[j] = w[(size_t)(k + j) * NMOD];
#pragma unroll
            for (int j = 0; j < 16; ++j) { const int kk = kc * 128 + k + j; a0 += sil[kk] * wv[j]; a1 += sil[1024 + kk] * wv[j]; a2 += sil[2048 + kk] * wv[j]; } }
        float* mv = (float*)(ws + WS_MODV) + (size_t)((kc * 2 + l) * 3) * NMOD + col;
        mv[0] = a0; mv[NMOD] = a1; mv[2 * NMOD] = a2;
      } }
    for (int idx = C.vcu * NTHREADS + C.tid; idx < 4096 + 65536 + 32768 + 16384 + 131072; idx += C.G * NTHREADS) {
        if (idx < 4096) { const int pos = idx >> 4, f = idx & 15; const float inv = 1.0f / powf(10000.0f, (float)(2 * f) / 32.0f), ang = (float)pos * inv;
            float* t = (float*)(ws + WS_ROPE) + 2 * idx; t[0] = cosf(ang); t[1] = sinf(ang); }
        else if (idx < 4096 + 65536) { const int i = idx - 4096, m = i >> 8, k = i & 255, k1 = m >> 1, part = m & 1, n1 = k & 127, isb = k >> 7; const int p = (k1 * n1) & 127;
            float s, c; sincospif((float)p / 64.0f, &s, &c); const float v = part == 0 ? (isb ? -s : c) : (isb ? -c : -s);
            ((bf16_t*)(ws + WS_G1))[i] = (bf16_t)pk2(v * 0.08838834764831845f, 0.f); }
        else if (idx >= 4096 + 65536 + 32768 + 16384) { const int i = idx - (4096 + 65536 + 32768 + 16384), k = i >> 9, kk = i & 511, n = kk & 255; float s, c; sincospif((float)((k * n) & 255) / 128.0f, &s, &c);
            ((bf16_t*)(ws + WS_G3))[i] = (bf16_t)pk2((kk < 256 ? c : -s) * 0.0625f, 0.f); }
        else if (idx >= 4096 + 65536 + 32768) { const int i = idx - (4096 + 65536 + 32768), n2 = i >> 7, k1 = i & 127; float s, c; sincospif((float)(k1 * n2) * (1.0f / 8192.0f), &s, &c);
            float* t = (float*)(ws + WS_TW) + 2 * i; t[0] = c; t[1] = s; }
        else { const int i = idx - 4096 - 65536, k2 = i >> 8, k = i & 255, n2 = k & 127, isi = k >> 7; const int p = (k2 * n2) & 127;
            float s, c; sincospif((float)p / 64.0f, &s, &c); ((bf16_t*)(ws + WS_G2))[i] = (bf16_t)pk2((isi ? s : c) * 0.08838834764831845f, 0.f); }
    }
    LAS float* scr = (LAS float*)(C.lds + C.wave * 16384);
    const int gw = C.vcu * NWAVES + C.wave, NGW = C.G * NWAVES;
    for (int it = gw; it < P0_ITEMS; it += NGW) p0_convert_item(it, scr, C.lane);
    LAS float* wf = scr + 2304;
    for (int t = gw; t < 2 * 1024 * 4; t += NGW) {
        const int l = t >> 12, k = (t >> 2) & 1023, g = t & 3; const float* src = IN_(10) + (size_t)l * D * 5888 + (size_t)k * 5888 + 768 + g * 128;
        wf[C.lane] = src[C.lane]; wf[C.lane + 64] = src[C.lane + 64];
        LDS_WAIT(); asm volatile("" ::: "memory");
        float aA0 = 0.f, aB0 = 0.f, aA1 = 0.f, aB1 = 0.f; const int j0 = C.lane, j1 = C.lane + 64;
#pragma unroll 4
        for (int c = 0; c < 128; ++c) { const float w = wf[c]; const int i0 = (c * j0) & 127, i1 = (c * j1) & 127;
            aA0 += w * tab[2 * i0]; aB0 += w * tab[2 * i0 + 1]; aA1 += w * tab[2 * i1]; aB1 += w * tab[2 * i1 + 1]; }
        bf16_t* wt = (bf16_t*)(ws + WS_WIN + l * WIN_BYTES); const float sc = 0.08838834764831845f;
        wt[(size_t)(768 + g * 128 + j0) * D + k] = (bf16_t)pk2(aA0 * sc, 0.f); wt[(size_t)(768 + g * 128 + j1) * D + k] = (bf16_t)pk2(aA1 * sc, 0.f);
        wt[(size_t)(1280 + g * 128 + j0) * D + k] = (bf16_t)pk2(aB0 * sc, 0.f); wt[(size_t)(1280 + g * 128 + j1) * D + k] = (bf16_t)pk2(aB1 * sc, 0.f);
        LDS_WAIT(); asm volatile("" ::: "memory");
    }
}

__device__ __forceinline__ void norm_row(const float* xin, float* xout, bool has_br, const f32x4 (&br)[4], const float* gpost, const float* ga,
                                         const float* gpre, const float* sc, const float* sh, bf16_t* hn, int lane, f32x4 (&h2f)[4], bool hn_fp8 = false) {
    f32x4 x[4];
#pragma unroll
    for (int j = 0; j < 4; ++j) x[j] = *(const GAS f32x4*)(xin + 4 * lane + 256 * j);
    if (has_br) {
        float ss = 0.f;
#pragma unroll
        for (int j = 0; j < 4; ++j) ss += (br[j][0] * br[j][0] + br[j][1] * br[j][1]) + (br[j][2] * br[j][2] + br[j][3] * br[j][3]);
        const float rstd = 1.0f / sqrtf(wave_sum(ss) * (1.0f / D) + EPS);
#pragma unroll
        for (int j = 0; j < 4; ++j) { const f32x4 gp = *(const GAS f32x4*)(gpost + 4 * lane + 256 * j), gg = *(const GAS f32x4*)(ga + 4 * lane + 256 * j); x[j] = x[j] + gg * (br[j] * rstd * gp); }
    }
    if (xout) {
#pragma unroll
        for (int j = 0; j < 4; ++j) *(GAS f32x4*)(xout + 4 * lane + 256 * j) = x[j];
    }
    if (hn) {
        float ss = 0.f;
#pragma unroll
        for (int j = 0; j < 4; ++j) ss += (x[j][0] * x[j][0] + x[j][1] * x[j][1]) + (x[j][2] * x[j][2] + x[j][3] * x[j][3]);
        const float rstd = 1.0f / sqrtf(wave_sum(ss) * (1.0f / D) + EPS);
#pragma unroll
        for (int j = 0; j < 4; ++j) { const f32x4 gp = *(const GAS f32x4*)(gpre + 4 * lane + 256 * j), s1 = *(const GAS f32x4*)(sc + 4 * lane + 256 * j), s0 = *(const GAS f32x4*)(sh + 4 * lane + 256 * j);
            const f32x4 h = (x[j] * rstd * gp) * (s1 + 1.0f) + s0; h2f[j] = h;
            if (hn_fp8) *(GAS unsigned*)((unsigned char*)hn + 4 * lane + 256 * j) = pg8::pack4_fp8(h[0], h[1], h[2], h[3]);
            else { u32x2 w; w.x = pk2(h[0], h[1]); w.y = pk2(h[2], h[3]); *(GAS u32x2*)(hn + 4 * lane + 256 * j) = w; } }
    }
}
__device__ __forceinline__ void load_br(const bf16_t* p, int lane, f32x4 (&br)[4]) {
#pragma unroll
    for (int j = 0; j < 4; ++j) { const u32x2 w = *(const GAS u32x2*)(p + 4 * lane + 256 * j); br[j] = (f32x4){bflo(w.x), bfhi(w.x), bflo(w.y), bfhi(w.y)}; }
}
__device__ __forceinline__ int mod_set(int row) { return row >= M_LAT ? 2 : (row >> 14); }

template <bool PARTS> __device__ __forceinline__ f32x4 modv4(const float* modp, const float* modf, const float* bmod, int l, int set, int off) {
    if constexpr (!PARTS) return *(const GAS f32x4*)(modf + (size_t)(l * 3 + set) * NMOD + off);
    else { f32x4 s = *(const GAS f32x4*)(bmod + l * NMOD + off); const float* p = modp + (size_t)(l * 3 + set) * NMOD + off; f32x4 v[8];
#pragma unroll
        for (int kc = 0; kc < 8; ++kc) v[kc] = *(const GAS f32x4*)(p + (size_t)kc * 6 * NMOD);
#pragma unroll
        for (int kc = 0; kc < 8; ++kc) s = s + v[kc];
        return s; }
}
template <int MODE> __device__ __forceinline__ void phase_norm(const Ctx& C0, int l) {
    constexpr int NR = (MODE == 3) ? 2 : 4;
    const Ctx C = opaque(C0);
    const int gw = C.vcu * NWAVES + C.wave, NGW = C.G * NWAVES, lane = C.lane;
    unsigned char* const ws = WS_;
    const float* const modv = (const float*)(ws + WS_MODV); const float* const bmod = IN_(5);
    const float* const modf = (const float*)(ws + WS_MODF);
    if (MODE == 0) {
        float* mf = (float*)(ws + WS_MODF);
        for (int i = C.vcu * NTHREADS + C.tid; i < 2 * 3 * NMOD; i += C.G * NTHREADS) { const int li = i / (3 * NMOD), c = i % NMOD; float s = bmod[li * NMOD + c]; float v[8];
#pragma unroll
            for (int kc = 0; kc < 8; ++kc) v[kc] = modv[(size_t)kc * 6 * NMOD + i];
#pragma unroll
            for (int kc = 0; kc < 8; ++kc) s += v[kc];
            mf[i] = s; }
    }
    constexpr bool moe = (MODE == 4), comb = (MODE == 3), mid = (MODE == 1 || MODE == 4);
    const bool has_hn = (MODE != 3);
    const int nsets = (MODE == 0 || l == 0) ? 3 : 2;
    const float* const xsrc_lat = (MODE == 0 || MODE == 1) ? IN_(0) : (const float*)OUT_;
    float* const xdst_lat = OUT_;
    const float* const xsrc_ctx = (MODE == 2) ? (const float*)(ws + WS_HCTX) : IN_(2);
    float* const xdst_ctx = (float*)(ws + WS_HCTX);
    const bf16_t* const brbuf = mid ? (const bf16_t*)(ws + WS_MIX) : (const bf16_t*)(ws + WS_F0);
    const float* const gpost = mid ? IN_(7) + l * D : IN_(9) + l * D;
    const float* const gpre = (MODE == 0) ? IN_(6) : mid ? IN_(8) + l * D : IN_(6) + D;
    const int ga_off = mid ? 2048 : 5120, hl = (MODE == 2 || MODE == 3) ? 1 : l, sc_off = mid ? 4096 : 1024, sh_off = mid ? 3072 : 0;
    bf16_t* const HN = (bf16_t*)(ws + WS_HN);
    LAS unsigned* const lcnt = (LAS unsigned*)(C.lds + LDSX_OFF);
    LAS unsigned* const stage = (LAS unsigned*)(C.lds + LDSX_OFF + 256);
    LAS float* const wrl = (LAS float*)C.lds;
    const LAS int* const tbl = (const LAS int*)(C.lds + MISC_OFF) + 16;
    if (moe) { if (C.tid < 16) lcnt[C.tid] = 0u; const float* wsrc = IN_(20);
        __syncthreads();
        for (int i = C.tid; i < 2048; i += NTHREADS) *(LAS f32x4*)(wrl + 4 * i) = *(const GAS f32x4*)(wsrc + 4 * i);
        __syncthreads(); }
    const float* const brt = IN_(21);
    const unsigned* const asg = (const unsigned*)(ws + WS_ASG); const bf16_t* const Y = (const bf16_t*)(ws + WS_YEXP);
    int it = 0;
    for (int set = 0; set < nsets; ++set) {
        f32x4 vA[4], vB[4], vS[4];
#pragma unroll
        for (int j = 0; j < 4; ++j) { const int c = 4 * lane + 256 * j;
            if (MODE != 0) vA[j] = modv4<MODE == 0>(modv, modf, bmod, l, set, ga_off + c) * *(const GAS f32x4*)(gpost + c); else vA[j] = (f32x4){0.f, 0.f, 0.f, 0.f};
            if (has_hn) { vB[j] = *(const GAS f32x4*)(gpre + c) * (modv4<MODE == 0>(modv, modf, bmod, hl, set, sc_off + c) + 1.0f); vS[j] = modv4<MODE == 0>(modv, modf, bmod, hl, set, sh_off + c); }
            else { vB[j] = (f32x4){0.f, 0.f, 0.f, 0.f}; vS[j] = vB[j]; } }
        const int base = set < 2 ? set * SEQ : M_LAT, n = set < 2 ? SEQ : M_CTX;
        const float* const xs = set < 2 ? xsrc_lat + (size_t)base * D : xsrc_ctx; float* const xd = set < 2 ? xdst_lat + (size_t)base * D : xdst_ctx;
        for (int i0 = gw; i0 < n; i0 += NGW * NR) {
            f32x4 x[NR][4]; u32x2 bw[NR][4], bw2[NR][4]; float cw0[NR], cw1[NR];
#pragma unroll
            for (int k = 0; k < NR; ++k) { const int ri = i0 + NGW * k; if (ri < n) {
#pragma unroll
                for (int j = 0; j < 4; ++j) x[k][j] = *(const GAS f32x4*)(xs + (size_t)ri * D + 4 * lane + 256 * j);
                if (MODE != 0) {
                    if (comb) { const unsigned* a = asg + (size_t)(base + ri) * 8; const int e0 = (int)a[0], e1 = (int)a[3]; cw0[k] = __uint_as_float(a[2]); cw1[k] = __uint_as_float(a[5]);
                        const bf16_t* y0 = Y + ((size_t)tbl[e0] * 256 + a[1]) * D, * y1 = Y + ((size_t)tbl[e1] * 256 + a[4]) * D;
#pragma unroll
                        for (int j = 0; j < 4; ++j) { bw[k][j] = *(const GAS u32x2*)(y0 + 4 * lane + 256 * j); bw2[k][j] = *(const GAS u32x2*)(y1 + 4 * lane + 256 * j); } }
                    else {
#pragma unroll
                        for (int j = 0; j < 4; ++j) bw[k][j] = *(const GAS u32x2*)(brbuf + (size_t)(base + ri) * D + 4 * lane + 256 * j); } } }
              else {
#pragma unroll
                for (int j = 0; j < 4; ++j) { x[k][j] = (f32x4){0.f, 0.f, 0.f, 0.f}; bw[k][j] = (u32x2){0u, 0u}; bw2[k][j] = (u32x2){0u, 0u}; } cw0[k] = 0.f; cw1[k] = 0.f; } }
            if (MODE != 0) {
                float ss[NR]; f32x4 br[NR][4];
#pragma unroll
                for (int k = 0; k < NR; ++k) { ss[k] = 0.f;
#pragma unroll
                    for (int j = 0; j < 4; ++j) { f32x4 b = (f32x4){bflo(bw[k][j].x), bfhi(bw[k][j].x), bflo(bw[k][j].y), bfhi(bw[k][j].y)};
                        if (comb) { const f32x4 b2 = (f32x4){bflo(bw2[k][j].x), bfhi(bw2[k][j].x), bflo(bw2[k][j].y), bfhi(bw2[k][j].y)}; b = b * cw0[k] + b2 * cw1[k]; }
                        br[k][j] = b; ss[k] += (b[0] * b[0] + b[1] * b[1]) + (b[2] * b[2] + b[3] * b[3]); } }
#pragma unroll
                for (int k = 0; k < NR; ++k) ss[k] = wave_sum(ss[k]);
#pragma unroll
                for (int k = 0; k < NR; ++k) { const float rstd = 1.0f / sqrtf(ss[k] * (1.0f / D) + EPS);
#pragma unroll
                    for (int j = 0; j < 4; ++j) x[k][j] = x[k][j] + vA[j] * (br[k][j] * rstd); }
#pragma unroll
                for (int k = 0; k < NR; ++k) { const int ri = i0 + NGW * k; if (ri < n) {
#pragma unroll
                    for (int j = 0; j < 4; ++j) *(GAS f32x4*)(xd + (size_t)ri * D + 4 * lane + 256 * j) = x[k][j]; } }
            }
            if (has_hn) {
                float s2[NR];
#pragma unroll
                for (int k = 0; k < NR; ++k) { s2[k] = 0.f;
#pragma unroll
                    for (int j = 0; j < 4; ++j) s2[k] += (x[k][j][0] * x[k][j][0] + x[k][j][1] * x[k][j][1]) + (x[k][j][2] * x[k][j][2] + x[k][j][3] * x[k][j][3]); }
#pragma unroll
                for (int k = 0; k < NR; ++k) s2[k] = wave_sum(s2[k]);
#pragma unroll
                for (int k = 0; k < NR; ++k) { const int ri = i0 + NGW * k; const float rstd = 1.0f / sqrtf(s2[k] * (1.0f / D) + EPS);
#pragma unroll
                    for (int j = 0; j < 4; ++j) x[k][j] = (x[k][j] * rstd) * vB[j] + vS[j];
                    if (ri < n) {
                        if (moe) {
#pragma unroll
                            for (int j = 0; j < 4; ++j) *(GAS unsigned*)((unsigned char*)HN + (size_t)(base + ri) * D + 4 * lane + 256 * j) = pg8::pack4_fp8(x[k][j][0], x[k][j][1], x[k][j][2], x[k][j][3]); }
                        else {
#pragma unroll
                            for (int j = 0; j < 4; ++j) { u32x2 w; w.x = pk2(x[k][j][0], x[k][j][1]); w.y = pk2(x[k][j][2], x[k][j][3]); *(GAS u32x2*)(HN + (size_t)(base + ri) * D + 4 * lane + 256 * j) = w; } } } }
                if (moe) {
#pragma unroll
                    for (int k = 0; k < NR; ++k) { const int ri = i0 + NGW * k; if (ri < n) {
                        float lg[8];
#pragma unroll
                        for (int e = 0; e < 8; ++e) lg[e] = 0.f;
#pragma unroll
                        for (int j = 0; j < 4; ++j)
#pragma unroll
                            for (int q = 0; q < 4; ++q) { const LAS float* wr = wrl + (4 * lane + 256 * j + q) * 8; const f32x4 w0 = *(const LAS f32x4*)wr, w1 = *(const LAS f32x4*)(wr + 4); const float h = x[k][j][q];
                                lg[0] += h * w0[0]; lg[1] += h * w0[1]; lg[2] += h * w0[2]; lg[3] += h * w0[3]; lg[4] += h * w1[0]; lg[5] += h * w1[1]; lg[6] += h * w1[2]; lg[7] += h * w1[3]; }
                        float w4[4];
#pragma unroll
                        for (int j = 0; j < 4; ++j) { const auto r = __builtin_amdgcn_permlane32_swap(__float_as_uint(lg[j]), __float_as_uint(lg[4 + j]), false, false); w4[j] = __uint_as_float(r[0]) + __uint_as_float(r[1]); }
                        const bool b4 = (lane & 16) != 0, b3 = (lane & 8) != 0;
                        float w2[2];
#pragma unroll
                        for (int j = 0; j < 2; ++j) { const float keep = b4 ? w4[2 + j] : w4[j], send = b4 ? w4[j] : w4[2 + j]; w2[j] = keep + lane_xor<16>(send); }
                        float w1v; { const float keep = b3 ? w2[1] : w2[0], send = b3 ? w2[0] : w2[1]; w1v = keep + lane_xor<8>(send); }
                        w1v += lane_xor<4>(w1v); w1v += lane_xor<2>(w1v); w1v += lane_xor<1>(w1v);
                        float lgt[8];
#pragma unroll
                        for (int e = 0; e < 8; ++e) lgt[e] = __int_as_float(__builtin_amdgcn_readlane(__float_as_int(w1v), 8 * e)) + brt[e];
                        int e0 = 0; float v0 = lgt[0];
#pragma unroll
                        for (int e = 1; e < 8; ++e) if (lgt[e] > v0) { v0 = lgt[e]; e0 = e; }
                        int e1 = -1; float v1 = -INFINITY;
#pragma unroll
                        for (int e = 0; e < 8; ++e) if (e != e0 && lgt[e] > v1) { v1 = lgt[e]; e1 = e; }
                        const float pw1 = 1.0f / (1.0f + __expf(v0 - v1)), pw0 = 1.0f - pw1;
                        if (lane == 0) { const unsigned p0 = atomicAdd((unsigned*)&lcnt[e0], 1u), p1 = atomicAdd((unsigned*)&lcnt[e1], 1u);
                            LAS unsigned* st = stage + (C.wave * 24 + it) * 6; st[0] = (unsigned)e0; st[1] = p0; st[2] = __float_as_uint(pw0); st[3] = (unsigned)e1; st[4] = p1; st[5] = __float_as_uint(pw1); }
                        ++it; } }
                }
            }
        }
    }
    if (moe) {
        __syncthreads();
        if (C.tid < 8) lcnt[8 + C.tid] = __hip_atomic_fetch_add((unsigned*)(ws + WS_CTL) + CW_CNT + 64 * C.tid, lcnt[C.tid], __ATOMIC_RELAXED, __HIP_MEMORY_SCOPE_AGENT);
        __syncthreads();
        if (lane == 0) { int i2 = 0; int* elist = (int*)(ws + WS_ELIST); unsigned* asgw = (unsigned*)(ws + WS_ASG);
            for (int set = 0; set < 2; ++set)
                for (int i0 = gw; i0 < SEQ; i0 += NGW * NR)
                    for (int k = 0; k < NR; ++k) { const int ri = i0 + NGW * k; if (ri < SEQ) { const int row = set * SEQ + ri; const LAS unsigned* st = stage + (C.wave * 24 + i2) * 6; ++i2;
                        const unsigned e0 = st[0], p0 = st[1] + lcnt[8 + e0], e1 = st[3], p1 = st[4] + lcnt[8 + e1];
                        elist[e0 * M_LAT + p0] = row; elist[e1 * M_LAT + p1] = row;
                        unsigned* a = asgw + (size_t)row * 8; a[0] = e0; a[1] = p0; a[2] = st[2]; a[3] = e1; a[4] = p1; a[5] = st[5]; } } }
    }
}

constexpr int AT_S = 144;
__device__ __forceinline__ int crow(int r, int h) { return (r & 3) + 8 * (r >> 2) + 4 * h; }
__device__ __forceinline__ void phase_attention(const Ctx& C0, int l, bool with_ctx_q) {
    const Ctx C = opaque(C0);
    const bf16_t* Q = (const bf16_t*)(WS_ + WS_Q); const bf16_t* KV = (const bf16_t*)(WS_ + WS_KV); bf16_t* AO = (bf16_t*)(WS_ + WS_ATT);
    LAS unsigned char* Kt = C.lds; LAS unsigned char* Vt = C.lds + 64 * AT_S;
    int lane_ = C.lane; asm volatile("" : "+v"(lane_)); const int lane = lane_, w = C.wave, r32 = lane & 31, hh = lane >> 5, qq = (lane & 15) >> 2, pp = lane & 3, blk = (lane >> 4) & 1;
    const int nunits = 1024 + (with_ctx_q ? 16 : 0); const float* sinks = IN_(11) + l * 8;
    for (int unit = C.vcu; unit < nunits; unit += C.G) {
        int b, head, hkv, qrowbase, q0, lo, nloc;
        if (unit < 1024) { const int g = unit & 3, qb = (unit >> 2) & 63; hkv = (unit >> 8) & 1; b = unit >> 9; head = hkv * 4 + g; q0 = qb * 256; qrowbase = b * SEQ + q0;
            lo = q0 - 128 < 0 ? 0 : q0 - 128; const int hi = q0 + 384 > SEQ ? SEQ : q0 + 384; nloc = (hi - lo) >> 6; }
        else { const int x = unit - 1024; b = x >> 3; head = x & 7; hkv = head >> 2; q0 = 0; lo = 0; nloc = 0; qrowbase = M_LAT + b * CTXL; }
        const int ntiles = nloc + 4, qw = q0 + 32 * w;
        bf16x8 qf[4];
        { const bf16_t* qp = Q + (size_t)(qrowbase + 32 * w + r32) * 512 + head * 64 + 8 * hh;
#pragma unroll
          for (int s = 0; s < 4; ++s) qf[s] = *(const GAS bf16x8*)(qp + 16 * s); }
        float m_run = sinks[head] * LOG2E, l_run = hh == 0 ? 1.0f : 0.0f;
        f32x16 o0, o1;
#pragma unroll
        for (int i = 0; i < 16; ++i) { o0[i] = 0.f; o1[i] = 0.f; }
        for (int t = 0; t < ntiles; ++t) {
            const bool local = t < nloc; const int kpos = lo + 64 * t;
            const int krow0 = local ? b * SEQ + kpos : M_LAT + b * CTXL + 64 * (t - nloc);
            __syncthreads();
            { const int row = C.tid >> 3, ch = C.tid & 7; const bf16_t* src = KV + (size_t)(krow0 + row) * 256 + hkv * 64 + ch * 8;
              const u32x4 kx = *(const GAS u32x4*)src, vx = *(const GAS u32x4*)(src + 128);
              *(LAS u32x4*)(Kt + row * AT_S + ch * 16) = kx; *(LAS u32x4*)(Vt + row * AT_S + ch * 16) = vx; }
            __syncthreads();
            const bool relevant = !local || (kpos + 63 >= qw - 128 && kpos <= qw + 31 + 128);
            if (relevant) {
                f32x16 p0, p1;
#pragma unroll
                for (int i = 0; i < 16; ++i) { p0[i] = 0.f; p1[i] = 0.f; }
#pragma unroll
                for (int s = 0; s < 4; ++s) {
                    const bf16x8 k0 = *(const LAS bf16x8*)(Kt + r32 * AT_S + (16 * s + 8 * hh) * 2), k1 = *(const LAS bf16x8*)(Kt + (32 + r32) * AT_S + (16 * s + 8 * hh) * 2);
                    p0 = __builtin_amdgcn_mfma_f32_32x32x16_bf16(k0, qf[s], p0, 0, 0, 0); p1 = __builtin_amdgcn_mfma_f32_32x32x16_bf16(k1, qf[s], p1, 0, 0, 0);
                }
                if (local) { const int qpos = qw + r32;
#pragma unroll
                    for (int i = 0; i < 16; ++i) { const int d0 = kpos + crow(i, hh) - qpos, d1 = d0 + 32;
                        if (d0 > 128 || d0 < -128) p0[i] = -INFINITY; if (d1 > 128 || d1 < -128) p1[i] = -INFINITY; } }
                float mt = fmaxf(p0[0], p1[0]);
#pragma unroll
                for (int i = 1; i < 16; ++i) mt = fmaxf(mt, fmaxf(p0[i], p1[i]));
                mt = half_max(mt);
                const float mn = fmaxf(m_run, mt), alpha = __builtin_amdgcn_exp2f(m_run - mn); m_run = mn;
                float ls = 0.f;
#pragma unroll
                for (int i = 0; i < 16; ++i) { p0[i] = __builtin_amdgcn_exp2f(p0[i] - mn); p1[i] = __builtin_amdgcn_exp2f(p1[i] - mn); ls += p0[i] + p1[i]; }
                l_run = l_run * alpha + ls;
#pragma unroll
                for (int i = 0; i < 16; ++i) { o0[i] *= alpha; o1[i] *= alpha; }
#pragma unroll
                for (int kb = 0; kb < 2; ++kb)
#pragma unroll
                    for (int s2 = 0; s2 < 2; ++s2) {
                        u32x4 pw;
                        if (kb == 0) { pw.x = pk2(p0[8 * s2 + 0], p0[8 * s2 + 1]); pw.y = pk2(p0[8 * s2 + 2], p0[8 * s2 + 3]); pw.z = pk2(p0[8 * s2 + 4], p0[8 * s2 + 5]); pw.w = pk2(p0[8 * s2 + 6], p0[8 * s2 + 7]); }
                        else { pw.x = pk2(p1[8 * s2 + 0], p1[8 * s2 + 1]); pw.y = pk2(p1[8 * s2 + 2], p1[8 * s2 + 3]); pw.z = pk2(p1[8 * s2 + 4], p1[8 * s2 + 5]); pw.w = pk2(p1[8 * s2 + 6], p1[8 * s2 + 7]); }
                        const bf16x8 pb = __builtin_bit_cast(bf16x8, pw);
                        const int kbase = 32 * kb + 16 * s2 + 4 * hh + qq;
#pragma unroll
                        for (int c = 0; c < 2; ++c) {
                            const LAS unsigned char* va = Vt + kbase * AT_S + (32 * c + 16 * blk + 4 * pp) * 2;
                            const s16x4 vlo = __builtin_amdgcn_ds_read_tr16_b64_v4i16((LAS s16x4*)va), vhi = __builtin_amdgcn_ds_read_tr16_b64_v4i16((LAS s16x4*)(va + 8 * AT_S));
                            const bf16x8 vf = __builtin_shufflevector(vlo, vhi, 0, 1, 2, 3, 4, 5, 6, 7);
                            if (c == 0) o0 = __builtin_amdgcn_mfma_f32_32x32x16_bf16(vf, pb, o0, 0, 0, 0); else o1 = __builtin_amdgcn_mfma_f32_32x32x16_bf16(vf, pb, o1, 0, 0, 0);
                        }
                    }
            }
        }
        const float linv = 1.0f / half_sum(l_run);
        bf16_t* op = AO + (size_t)(qrowbase + 32 * w + r32) * 512 + head * 64 + 4 * hh;
#pragma unroll
        for (int g = 0; g < 4; ++g) {
            u32x2 a, c2; a.x = pk2(o0[4 * g] * linv, o0[4 * g + 1] * linv); a.y = pk2(o0[4 * g + 2] * linv, o0[4 * g + 3] * linv);
            c2.x = pk2(o1[4 * g] * linv, o1[4 * g + 1] * linv); c2.y = pk2(o1[4 * g + 2] * linv, o1[4 * g + 3] * linv);
            *(GAS u32x2*)(op + 8 * g) = a; *(GAS u32x2*)(op + 32 + 8 * g) = c2; }
    }
    __syncthreads();
}

constexpr int FT_S = 144, FT_TILE = 256 * FT_S;
__device__ __forceinline__ float quad_swap1(float v) { return __int_as_float(__builtin_amdgcn_mov_dpp(__float_as_int(v), 0xB1, 0xF, 0xF, true)); }
template <int STAGE> __device__ __forceinline__ void phase_fft(const Ctx& C0) {
    const Ctx C = opaque(C0);
    unsigned char* const ws = WS_;
    const bf16_t* const SRC = (const bf16_t*)(ws + (STAGE == 1 ? WS_FAB : WS_HN)); const bf16_t* const GM = (const bf16_t*)(ws + (STAGE == 1 ? WS_G1 : WS_G2)); const float* const TW = (const float*)(ws + WS_TW);
    bf16_t* const DST = (bf16_t*)(ws + (STAGE == 1 ? WS_HN : WS_FAB));
    const int lane = C.lane, w = C.wave, r32 = lane & 31, hh = lane >> 5, qq = (lane & 15) >> 2, pp = lane & 3, blk = (lane >> 4) & 1;
    const int mrow = STAGE == 1 ? 32 * w + r32 : 32 * (w & 3) + r32;
    bf16x8 gf[16];
#pragma unroll
    for (int s = 0; s < 16; ++s) gf[s] = *(const GAS bf16x8*)(GM + (size_t)mrow * 256 + 16 * s + 8 * hh);
    u32x4 pf[4];
#define FFT_LOAD(unit_) do { const int b_ = (unit_) >> 10, q_ = ((unit_) >> 3) & 127, cb_ = (unit_) & 7; _Pragma("unroll") for (int i = 0; i < 4; ++i) { const int idx = C.tid + NTHREADS * i, k = idx >> 3, ch = idx & 7; \
        const int srow = b_ * SEQ + (STAGE == 1 ? 128 * (k & 127) + q_ : 128 * q_ + (k & 127)); pf[i] = *(const GAS u32x4*)(SRC + (size_t)srow * 1024 + (k >> 7) * 512 + cb_ * 64 + ch * 8); } } while (0)
    for (int unit = C.vcu; unit < 2048; unit += C.G) {
        const int b = unit >> 10, q = (unit >> 3) & 127, cb = unit & 7;
        LAS unsigned char* X = C.lds;
        __syncthreads();
        FFT_LOAD(unit);
#pragma unroll
        for (int i = 0; i < 4; ++i) { const int idx = C.tid + NTHREADS * i, k = idx >> 3, ch = idx & 7; *(LAS u32x4*)(X + k * FT_S + ch * 16) = pf[i]; }
        __syncthreads();
        if (STAGE == 1) {
            const int k1 = mrow >> 1, part = mrow & 1; const f32x2 tw = *(const GAS f32x2*)(TW + 2 * (q * 128 + k1)); const float tc = tw.x, ts = part ? -tw.y : tw.y;
            bf16_t* const drow = DST + (size_t)(b * SEQ + 128 * k1 + q) * 1024 + part * 512 + cb * 64 + 4 * hh;
#pragma unroll
            for (int cbk = 0; cbk < 2; ++cbk) {
                f32x16 acc;
#pragma unroll
                for (int i = 0; i < 16; ++i) acc[i] = 0.f;
#pragma unroll
                for (int s = 0; s < 16; ++s) {
                    const LAS unsigned char* xa = X + (16 * s + 8 * hh + qq) * FT_S + (32 * cbk + 16 * blk + 4 * pp) * 2;
                    const s16x4 lo = __builtin_amdgcn_ds_read_tr16_b64_v4i16((LAS s16x4*)xa), hi = __builtin_amdgcn_ds_read_tr16_b64_v4i16((LAS s16x4*)(xa + 4 * FT_S));
                    acc = __builtin_amdgcn_mfma_f32_32x32x16_bf16(__builtin_shufflevector(lo, hi, 0, 1, 2, 3, 4, 5, 6, 7), gf[s], acc, 0, 0, 0);
                }
#pragma unroll
                for (int g = 0; g < 4; ++g) { float o[4];
#pragma unroll
                    for (int j = 0; j < 4; ++j) { const float own = acc[4 * g + j]; o[j] = own * tc + lane_xor<1>(own) * ts; }
                    u32x2 wv; wv.x = pk2(o[0], o[1]); wv.y = pk2(o[2], o[3]); *(GAS u32x2*)(drow + 32 * cbk + 8 * g) = wv; }
            }
        } else {
            const int cbk = w >> 2;
            f32x16 acc;
#pragma unroll
            for (int i = 0; i < 16; ++i) acc[i] = 0.f;
#pragma unroll
            for (int s = 0; s < 16; ++s) {
                const LAS unsigned char* xa = X + (16 * s + 8 * hh + qq) * FT_S + (32 * cbk + 16 * blk + 4 * pp) * 2;
                const s16x4 lo = __builtin_amdgcn_ds_read_tr16_b64_v4i16((LAS s16x4*)xa), hi = __builtin_amdgcn_ds_read_tr16_b64_v4i16((LAS s16x4*)(xa + 4 * FT_S));
                acc = __builtin_amdgcn_mfma_f32_32x32x16_bf16(__builtin_shufflevector(lo, hi, 0, 1, 2, 3, 4, 5, 6, 7), gf[s], acc, 0, 0, 0);
            }
            bf16_t* const drow = DST + (size_t)(b * SEQ + q + 128 * mrow) * 512 + cb * 64 + 32 * cbk + 4 * hh;
#pragma unroll
            for (int g = 0; g < 4; ++g) { u32x2 wv; wv.x = pk2(acc[4 * g], acc[4 * g + 1]); wv.y = pk2(acc[4 * g + 2], acc[4 * g + 3]); *(GAS u32x2*)(drow + 8 * g) = wv; }
        }
    }
#undef FFT_LOAD
    __syncthreads();
}
__device__ __forceinline__ void phase_ctx_dft(const Ctx& C0) {
    const Ctx C = opaque(C0);
    unsigned char* const ws = WS_;
    const bf16_t* const FAB = (const bf16_t*)(ws + WS_FAB); const bf16_t* const G3 = (const bf16_t*)(ws + WS_G3); bf16_t* const FN = (bf16_t*)(ws + WS_FAB);
    const int lane = C.lane, w = C.wave, r32 = lane & 31, hh = lane >> 5, qq = (lane & 15) >> 2, pp = lane & 3, blk = (lane >> 4) & 1, mrow = 32 * w + r32;
    LAS unsigned char* const X = C.lds;
    for (int unit = C.vcu; unit < 16; unit += C.G) {
        const int b = unit >> 3, cb = unit & 7;
        f32x16 acc0, acc1;
#pragma unroll
        for (int i = 0; i < 16; ++i) { acc0[i] = 0.f; acc1[i] = 0.f; }
#pragma unroll 1
        for (int h = 0; h < 2; ++h) {
            bf16x8 gf[16];
#pragma unroll
            for (int s = 0; s < 16; ++s) gf[s] = *(const GAS bf16x8*)(G3 + (size_t)mrow * 512 + h * 256 + 16 * s + 8 * hh);
            __syncthreads();
#pragma unroll
            for (int i = 0; i < 4; ++i) { const int idx = C.tid + NTHREADS * i, k = idx >> 3, ch = idx & 7;
                *(LAS u32x4*)(X + k * FT_S + ch * 16) = *(const GAS u32x4*)(FAB + (size_t)(M_LAT + b * CTXL + k) * 1024 + h * 512 + cb * 64 + ch * 8); }
            __syncthreads();
#pragma unroll
            for (int s = 0; s < 16; ++s) {
                const LAS unsigned char* xa = X + (16 * s + 8 * hh + qq) * FT_S + (16 * blk + 4 * pp) * 2;
                const s16x4 lo0 = __builtin_amdgcn_ds_read_tr16_b64_v4i16((LAS s16x4*)xa), hi0 = __builtin_amdgcn_ds_read_tr16_b64_v4i16((LAS s16x4*)(xa + 4 * FT_S));
                const s16x4 lo1 = __builtin_amdgcn_ds_read_tr16_b64_v4i16((LAS s16x4*)(xa + 64)), hi1 = __builtin_amdgcn_ds_read_tr16_b64_v4i16((LAS s16x4*)(xa + 64 + 4 * FT_S));
                acc0 = __builtin_amdgcn_mfma_f32_32x32x16_bf16(__builtin_shufflevector(lo0, hi0, 0, 1, 2, 3, 4, 5, 6, 7), gf[s], acc0, 0, 0, 0);
                acc1 = __builtin_amdgcn_mfma_f32_32x32x16_bf16(__builtin_shufflevector(lo1, hi1, 0, 1, 2, 3, 4, 5, 6, 7), gf[s], acc1, 0, 0, 0);
            }
        }
        bf16_t* const drow = FN + (size_t)(M_LAT + b * CTXL + mrow) * 512 + cb * 64 + 4 * hh;
#pragma unroll
        for (int g = 0; g < 4; ++g) { u32x2 wv; wv.x = pk2(acc0[4 * g], acc0[4 * g + 1]); wv.y = pk2(acc0[4 * g + 2], acc0[4 * g + 3]); *(GAS u32x2*)(drow + 8 * g) = wv;
            wv.x = pk2(acc1[4 * g], acc1[4 * g + 1]); wv.y = pk2(acc1[4 * g + 2], acc1[4 * g + 3]); *(GAS u32x2*)(drow + 32 + 8 * g) = wv; }
    }
    __syncthreads();
}
__device__ __forceinline__ void unpack8(const u32x4 w, float (&f)[8]) { f[0] = bflo(w.x); f[1] = bfhi(w.x); f[2] = bflo(w.y); f[3] = bfhi(w.y); f[4] = bflo(w.z); f[5] = bfhi(w.z); f[6] = bflo(w.w); f[7] = bfhi(w.w); }
__device__ __forceinline__ void phase_conv(const Ctx& C0, int l, int nrows) {
    const Ctx C = opaque(C0);
    const bf16_t* CIN = (const bf16_t*)(WS_ + WS_CIN); bf16_t* CO = (bf16_t*)(WS_ + WS_COUT); const float* wc = IN_(12) + l * 3 * 512;
    for (int it = C.vcu * NTHREADS + C.tid; it < nrows * 64; it += C.G * NTHREADS) {
        const int row = it >> 6, c0 = (it & 63) * 8; const bool lat = row < M_LAT;
        const int s = lat ? (row & (SEQ - 1)) : ((row - M_LAT) & (CTXL - 1)), last = lat ? SEQ - 1 : CTXL - 1;
        const bf16_t* p = CIN + (size_t)row * 1536 + c0;
        float xm[8], cm[8], x0[8], cc0[8], xp[8], cp[8], bb[8];
        const u32x4 z = (u32x4){0u, 0u, 0u, 0u};
        unpack8(s > 0 ? *(const GAS u32x4*)(p - 1536) : z, xm); unpack8(s > 0 ? *(const GAS u32x4*)(p - 1536 + 1024) : z, cm);
        unpack8(*(const GAS u32x4*)p, x0); unpack8(*(const GAS u32x4*)(p + 1024), cc0); unpack8(*(const GAS u32x4*)(p + 512), bb);
        unpack8(s < last ? *(const GAS u32x4*)(p + 1536) : z, xp); unpack8(s < last ? *(const GAS u32x4*)(p + 1536 + 1024) : z, cp);
        float y[8];
#pragma unroll
        for (int j = 0; j < 8; ++j) y[j] = bb[j] * (xm[j] * cm[j] * wc[c0 + j] + x0[j] * cc0[j] * wc[512 + c0 + j] + xp[j] * cp[j] * wc[1024 + c0 + j]);
        u32x4 o; o.x = pk2(y[0], y[1]); o.y = pk2(y[2], y[3]); o.z = pk2(y[4], y[5]); o.w = pk2(y[6], y[7]);
        *(GAS u32x4*)(CO + (size_t)row * 512 + c0) = o;
    }
}
__device__ __forceinline__ void phase_moe_gather(const Ctx& C0, int chunk, int ntiles) {
    const Ctx C = opaque(C0);
    const unsigned char* HN = WS_ + WS_HN; unsigned char* H2G = WS_ + WS_H2G; const int* EL = (const int*)(WS_ + WS_ELIST);
    const LAS int* tbl = (const LAS int*)(C.lds + MISC_OFF) + 16;
    const int gw = C.vcu * NWAVES + C.wave, NGW = C.G * NWAVES;
    for (int rl = gw; rl < CHUNK_ROWS; rl += NGW) {
        const int R = chunk * CHUNK_ROWS + rl, t = R >> 8; if (t >= ntiles) break;
        int e = 0;
#pragma unroll
        for (int k = 1; k < 8; ++k) e += (t >= tbl[k]) ? 1 : 0;
        const int pos = R - tbl[e] * 256, ce = tbl[8 + e];
        u32x4 v0 = (u32x4){0u, 0u, 0u, 0u};
        if (pos < ce) { const int tok = EL[e * M_LAT + pos]; v0 = *(const GAS u32x4*)(HN + (size_t)tok * D + C.lane * 16); }
        *(GAS u32x4*)(H2G + (size_t)rl * D + C.lane * 16) = v0;
    }
}

#ifndef REP_PRO
#define REP_PRO 1
#endif
#ifndef REP_GEMM
#define REP_GEMM 1
#endif
#ifndef REP_ATT
#define REP_ATT 1
#endif
#ifndef REP_F1
#define REP_F1 1
#endif
#ifndef REP_F2
#define REP_F2 1
#endif
#ifndef REP_CV
#define REP_CV 1
#endif
#ifndef REP_CD
#define REP_CD 1
#endif
#ifndef REP_AUX
#define REP_AUX 1
#endif
#define REPEAT(N) for (int rep_ = 0; rep_ < (N); ++rep_)
#ifndef STAGGER_TICKS
#define STAGGER_TICKS 0
#endif
#define STAG(bid) ((((bid) >> 3) & 1) ? STAGGER_TICKS : 0)
__global__ void __launch_bounds__(NTHREADS, 2) dit_fwd(Params P) {
    extern __shared__ __attribute__((aligned(16))) unsigned char lds_raw[];
    Ctx C;
    C.lds = (LAS unsigned char*)lds_raw;
    C.wave = __builtin_amdgcn_readfirstlane((int)threadIdx.x >> 6); C.lane = 0; C.tid = 0;
    C.G = gridDim.x; { const int bx = blockIdx.x; C.vcu = (C.G % 8 == 0) ? (bx % 8) * (C.G / 8) + bx / 8 : bx; }
    volatile LAS unsigned* MISC = (volatile LAS unsigned*)(C.lds + MISC_OFF);
    if (threadIdx.x < 32) MISC[threadIdx.x] = 0u;
    __syncthreads();
    (void)xcd_barrier_post((unsigned*)(WS_ + WS_CTL) + CW_BAR, MISC + 8);
#define GRID_BAR() do { XcdBarrier b_; b_.bar = (unsigned*)(WS_ + WS_CTL) + CW_BAR; b_.x = xb_xcc_id(); b_.st = (volatile LAS unsigned*)(C.lds + MISC_OFF) + 8; xcd_barrier(b_); } while (0)
    LAS unsigned char* ring = C.lds;
    const int bid = (int)blockIdx.x;

    REPEAT(REP_PRO) p0_prologue(C);
    GRID_BAR();
    REPEAT(REP_AUX) phase_norm<0>(C, 0);
    GRID_BAR();

    for (int l = 0; l < 2; ++l) {
        const int nM = (l == 0) ? MT / 256 : M_LAT / 256;
        REPEAT(REP_GEMM) {
            unsigned char* ws = WS_;
            pg8::Gemm g{(const bf16_t*)(ws + WS_HN), (const bf16_t*)(ws + WS_WIN + l * WIN_BYTES), MT, ZN, D};
            pg8::RectOrder S; if (l == 0) S.init(MT / 256, ZN / 256, C.G, bid); else S.init(M_LAT / 256, ZN / 256, C.G, bid, 0, 2, M_LAT / 256, 2);
            pg8::EpiIn E{ws, WS_Q, WS_KV, WS_FAB, WS_CIN, WS_GT, WS_ROPE, QSCALE};
            pg8::gemm_phase<pg8::EpiIn, pg8::RectOrder, true, true>(ring, g, S, E, C.wave, STAG(bid));
        }
        GRID_BAR();
        REPEAT(REP_ATT) phase_attention(C, l, l == 0);
        REPEAT(REP_F1) phase_fft<1>(C);
        REPEAT(REP_CV) phase_conv(C, l, nM * 256);
        GRID_BAR();
        REPEAT(REP_F2) phase_fft<2>(C);
        if (l == 0) REPEAT(REP_CD) phase_ctx_dft(C);
        GRID_BAR();
        REPEAT(REP_GEMM) {
            unsigned char* ws = WS_;
            pg8::RectOrder S; S.init(nM, 4, C.G, bid);
            const bf16_t* WY = (const bf16_t*)(ws + WS_WY) + (size_t)l * 3 * 1024 * 512; bf16_t* HN = (bf16_t*)(ws + WS_HN);
            { pg8::Gemm g{(const bf16_t*)(ws + WS_ATT), WY, MT, D, 512}; pg8::EpiMerge<true> E{HN, (const bf16_t*)(ws + WS_GT), 0};
              pg8::gemm_phase<pg8::EpiMerge<true>, pg8::RectOrder, true, true>(ring, g, S, E, C.wave); }
            { pg8::Gemm g{(const bf16_t*)(ws + WS_FAB), WY + (size_t)1024 * 512, MT, D, 512}; pg8::EpiMerge<false> E{HN, (const bf16_t*)(ws + WS_GT), 1024};
              pg8::gemm_phase<pg8::EpiMerge<false>, pg8::RectOrder, true, true>(ring, g, S, E, C.wave); }
            { pg8::Gemm g{(const bf16_t*)(ws + WS_COUT), WY + (size_t)2 * 1024 * 512, MT, D, 512}; pg8::EpiMerge<false> E{HN, (const bf16_t*)(ws + WS_GT), 2048};
              pg8::gemm_phase<pg8::EpiMerge<false>, pg8::RectOrder, true, true>(ring, g, S, E, C.wave); }
        }
        GRID_BAR();
        REPEAT(REP_GEMM) {
            unsigned char* ws = WS_;
            pg8::Gemm g{(const bf16_t*)(ws + WS_HN), (const bf16_t*)(ws + WS_WO) + (size_t)l * D * D, MT, D, D}; pg8::RectOrder S; S.init(nM, 4, C.G, bid);
            pg8::EpiPlain E{(bf16_t*)(ws + WS_MIX), D, 4, 0, 1.0f};
            pg8::gemm_phase<pg8::EpiPlain, pg8::RectOrder, true, true>(ring, g, S, E, C.wave);
        }
        GRID_BAR();
        if (l == 1) REPEAT(REP_AUX) phase_expert_convert(C);
        if (l == 0) phase_norm<1>(C, 0); else phase_norm<4>(C, 1);
        GRID_BAR();
        if (l == 0) {
            REPEAT(REP_GEMM) { unsigned char* ws = WS_;
              pg8::Gemm g{(const bf16_t*)(ws + WS_HN), (const bf16_t*)(ws + WS_WFF_UP), MT, 2 * DFF, D}; pg8::RectOrder S; S.init(nM, 2 * DFF / 256, C.G, bid);
              pg8::EpiSwiglu<false> E{(void*)(ws + WS_HID0), DFF, 2 * DFF / 256, 1.0f};
              pg8::gemm_phase<pg8::EpiSwiglu<false>, pg8::RectOrder, true, true>(ring, g, S, E, C.wave, STAG(bid)); }
            GRID_BAR();
            REPEAT(REP_GEMM) { unsigned char* ws = WS_;
              pg8::Gemm g{(const bf16_t*)(ws + WS_HID0), (const bf16_t*)(ws + WS_WFF_DN), MT, D, DFF}; pg8::RectOrder S; S.init(nM, 4, C.G, bid);
              pg8::EpiPlain E{(bf16_t*)(ws + WS_F0), D, 4, 0, 1.0f};
              pg8::gemm_phase<pg8::EpiPlain, pg8::RectOrder, true, true>(ring, g, S, E, C.wave); }
            GRID_BAR();
        } else {
            if (threadIdx.x == 0) { const unsigned* ctl = (const unsigned*)(WS_ + WS_CTL); unsigned tb = 0u;
                for (int e = 0; e < 8; ++e) { const unsigned c = __hip_atomic_load(ctl + CW_CNT + 64 * e, __ATOMIC_RELAXED, __HIP_MEMORY_SCOPE_AGENT); MISC[16 + e] = tb; MISC[24 + e] = c; tb += (c + 255u) >> 8; } }
            __syncthreads();
            const int T = __builtin_amdgcn_readfirstlane((int)(MISC[23] + ((MISC[31] + 255u) >> 8))), nchunks = (T + CHUNK_TILES - 1) / CHUNK_TILES;
            const LAS int* tbl = (const LAS int*)(C.lds + MISC_OFF) + 16;
            for (int ch = 0; ch < nchunks; ++ch) {
                const int tc = (T - ch * CHUNK_TILES) < CHUNK_TILES ? (T - ch * CHUNK_TILES) : CHUNK_TILES;
                REPEAT(REP_AUX) phase_moe_gather(C, ch, T);
                GRID_BAR();
                REPEAT(REP_GEMM) { unsigned char* ws = WS_;
                  pg8::Gemm g{(const bf16_t*)(ws + WS_H2G), (const bf16_t*)(ws + WS_EXUP), CHUNK_ROWS, 8 * 7168, D};
                  pg8::MoeOrder S{tc, 28, ch * CHUNK_TILES, C.G, bid, tbl};
                  pg8::EpiSwiglu<true> E{(void*)(ws + WS_HIDX), DEXP, 28, 1.0f / WSCALE8};
                  pg8::gemm_phase<pg8::EpiSwiglu<true>, pg8::MoeOrder, true, true, true>(ring, g, S, E, C.wave, STAG(bid)); }
                GRID_BAR();
                REPEAT(REP_GEMM) { unsigned char* ws = WS_;
                  pg8::Gemm g{(const bf16_t*)(ws + WS_HIDX), (const bf16_t*)(ws + WS_EXDN), CHUNK_ROWS, 8 * 1024, DEXP};
                  pg8::MoeOrder S{tc, 4, ch * CHUNK_TILES, C.G, bid, tbl};
                  pg8::EpiPlain E{(bf16_t*)(ws + WS_YEXP), D, 4, ch * CHUNK_ROWS, 1.0f / WSCALE8};
                  pg8::gemm_phase<pg8::EpiPlain, pg8::MoeOrder, true, true, true>(ring, g, S, E, C.wave); }
                GRID_BAR();
            }
        }
        if (l == 0) phase_norm<2>(C, 0); else phase_norm<3>(C, 1);
        if (l == 0) GRID_BAR();
    }
#undef GRID_BAR
}

extern "C" void kernel_launch(void* const* d_in, const int* in_sizes, int n_in, void* d_out, int out_size, void* d_ws, size_t ws_size, hipStream_t stream) {
    static int grid = 0;
    if (grid == 0) {
        if (n_in != 25 || in_sizes[0] != M_LAT * D || out_size != M_LAT * D || ws_size < WS_NEED) {
            fprintf(stderr, "kernel_launch: built for 25 inputs, x/out of %d floats, >= %zu bytes of workspace; got n_in %d, in0 %d, out %d, ws %zu; nothing launched\n", M_LAT * D, (size_t)WS_NEED, n_in, n_in > 0 ? in_sizes[0] : -1, out_size, ws_size);
            grid = -1; return; }
        int dev = 0, cus = 0, per_cu = 0;
        if (hipGetDevice(&dev) != hipSuccess || hipDeviceGetAttribute(&cus, hipDeviceAttributeMultiprocessorCount, dev) != hipSuccess) { fprintf(stderr, "kernel_launch: device query failed\n"); grid = -1; return; }
        if (hipFuncSetAttribute((const void*)dit_fwd, hipFuncAttributeMaxDynamicSharedMemorySize, LDS_BYTES) != hipSuccess) { fprintf(stderr, "kernel_launch: hipFuncSetAttribute failed\n"); grid = -1; return; }
        if (hipOccupancyMaxActiveBlocksPerMultiprocessor(&per_cu, (const void*)dit_fwd, NTHREADS, LDS_BYTES) != hipSuccess || per_cu < 1) { fprintf(stderr, "kernel_launch: occupancy query says %d workgroups per CU; nothing launched\n", per_cu); (void)hipGetLastError(); grid = -1; return; }
        (void)hipGetLastError();
        grid = cus;
        if (grid < 192 || grid > 304) { fprintf(stderr, "kernel_launch: unexpected CU count %d\n", cus); grid = -1; return; }
    }
    if (grid < 0) return;
    if (hipMemsetAsync((char*)d_ws + WS_CTL, 0, CTL_BYTES, stream) != hipSuccess) { fprintf(stderr, "kernel_launch: memset failed\n"); return; }
    Params p{};
    for (int i = 0; i < 25; ++i) p.in[i] = (const float*)d_in[i];
    p.out = (float*)d_out; p.ws = (unsigned char*)d_ws;
    hipLaunchKernelGGL(dit_fwd, dim3(grid), dim3(NTHREADS), LDS_BYTES, stream, p);
    const hipError_t le = hipPeekAtLastError();
    if (le != hipSuccess) fprintf(stderr, "kernel_launch: launch failed: %s\n", hipGetErrorName(le));
}
```

```cpp
#include <hip/hip_runtime.h>
#include <cstdio>
#include <cstdint>
#include <cmath>
namespace pg8 {
#define PG8_LAS __attribute__((address_space(3)))
typedef unsigned short bf16_t;
typedef short bf16x8 __attribute__((ext_vector_type(8)));
typedef float f32x4 __attribute__((ext_vector_type(4)));
typedef unsigned u32x4 __attribute__((ext_vector_type(4)));
constexpr int BM = 256, BK = 64, HALF = 128, HTB = HALF * BK * 2  , STAGE_BYTES = 8 * HTB, NXCD = 8, WGM = 8;

__host__ __device__ __forceinline__ int lds_byte(int r, int c) { const int st = (r >> 4) * 2 + (c >> 5), rr = r & 15, cc = c & 31, ob = rr * 64 + cc * 2; return st * 1024 + (ob ^ (((ob >> 9) & 1) << 5)); }
__host__ __device__ __forceinline__ void stage_rc(int b, int& R, int& C) { const int st = b / 1024, sb = b % 1024, swz = sb ^ (((sb >> 9) & 1) << 5); R = (st >> 1) * 16 + swz / 64; C = (st & 1) * 32 + (swz % 64) / 2; }
__host__ __device__ __forceinline__ int perm32(int rho) { const int n = rho >> 4, i = rho & 15; return 8 * (i >> 2) + 4 * n + (i & 3); }

struct Unit { int pm, pn; };
struct Gemm { const bf16_t* A; const bf16_t* Bt; int M, N, K; int ld = 0; long A1off = 0, A2off = 0, Bseg = 0; const float* rs = nullptr; const float* cs = nullptr; };

struct StaticOrder {
    int nM, nN, nwg, G, c;
    __host__ __device__ void init(int M, int N, int G_, int c_) { nM = M / BM; nN = N / BM; nwg = nM * nN; G = G_; c = c_; }
    __host__ __device__ bool next(int i, Unit& u) const {
        const long L = (long)i * G + c; if (L >= nwg) return false;
        int wgid = (int)L; { const int q = nwg / NXCD, r = nwg % NXCD, xcd = wgid % NXCD, off = wgid / NXCD; wgid = (xcd < r ? xcd * (q + 1) : r * (q + 1) + (xcd - r) * q) + off; }
        const int nig = WGM * nN, gid = wgid / nig, fm = gid * WGM, gsz = (nM - fm) < WGM ? (nM - fm) : WGM;
        u.pm = fm + ((wgid % nig) % gsz); u.pn = (wgid % nig) / gsz; return true;
    }
    __device__ __forceinline__ void a_ready(const Unit&) const {}
    __device__ __forceinline__ void done(const Unit&) const {}
};

__device__ __forceinline__ unsigned cvt_pk_bf16(float lo, float hi) { unsigned r; asm volatile("v_cvt_pk_bf16_f32 %0, %1, %2" : "=v"(r) : "v"(lo), "v"(hi)); return r; }
struct RectOrder {
    int nM, nN, nwg, G, c, pm0, ne, epm0, epn;
    __device__ __forceinline__ void init(int nM_, int nN_, int G_, int c_, int pm0_ = 0, int ne_ = 0, int epm0_ = 0, int epn_ = 0) { nM = nM_; nN = nN_; nwg = nM * nN; G = G_; c = c_; pm0 = pm0_; ne = ne_; epm0 = epm0_; epn = epn_; }
    __device__ __forceinline__ bool next(int i, Unit& u) const {
        const long L = (long)i * G + c;
        if (L >= nwg) { const long x = L - nwg; if (x >= ne) return false; u.pm = epm0 + (int)x; u.pn = epn; return true; }
        int wgid = (int)L; { const int q = nwg / NXCD, r = nwg % NXCD, xcd = wgid % NXCD, off = wgid / NXCD; wgid = (xcd < r ? xcd * (q + 1) : r * (q + 1) + (xcd - r) * q) + off; }
        const int nig = WGM * nN, gid = wgid / nig, fm = gid * WGM, gsz = (nM - fm) < WGM ? (nM - fm) : WGM;
        u.pm = pm0 + fm + ((wgid % nig) % gsz); u.pn = (wgid % nig) / gsz; return true;
    }
    __device__ __forceinline__ void a_ready(const Unit&) const {}
    __device__ __forceinline__ void done(const Unit&) const {}
};
struct MoeOrder {
    int tc, nN, tile0, G, c; const PG8_LAS int* tbl;
    __device__ __forceinline__ bool next(int i, Unit& u) const {
        const int L = i * G + c; if (L >= tc * nN) return false;
        const int j = L / tc, pml = L - j * tc, t = tile0 + pml;
        int e = 0;
#pragma unroll
        for (int k = 1; k < 8; ++k) e += (t >= __builtin_amdgcn_readfirstlane(tbl[k])) ? 1 : 0;
        u.pm = __builtin_amdgcn_readfirstlane(pml); u.pn = __builtin_amdgcn_readfirstlane(e * nN + j); return true;
    }
    __device__ __forceinline__ void a_ready(const Unit&) const {}
    __device__ __forceinline__ void done(const Unit&) const {}
};

__device__ __forceinline__ float bflo(unsigned u) { return __uint_as_float(u << 16); }
__device__ __forceinline__ float bfhi(unsigned u) { return __uint_as_float(u & 0xffff0000u); }
__device__ __forceinline__ float sigm(float x) { return __builtin_amdgcn_rcpf(1.0f + __builtin_amdgcn_exp2f(-1.4426950408889634f * x)); }
__device__ __forceinline__ u32x4 pack8(const f32x4 a, const f32x4 b) { u32x4 w; w.x = cvt_pk_bf16(a[0], a[1]); w.y = cvt_pk_bf16(a[2], a[3]); w.z = cvt_pk_bf16(b[0], b[1]); w.w = cvt_pk_bf16(b[2], b[3]); return w; }

struct EpiPlain {
    static constexpr bool PERM = true, AFTER_DRAIN = false, IDEMPOTENT = true;
    bf16_t* O; int ld, nmod, row_off; float scale;
    __device__ __forceinline__ void operator()(const f32x4 (&acc)[2][2][4][2], const Unit& u, int wr, int wc, int fr, int fq) const {
        const int row0 = row_off + u.pm * BM + wr * 64 + fr, col0 = (u.pn % nmod) * BM + wc * 32 + 8 * fq;
#pragma unroll
        for (int ai = 0; ai < 2; ++ai)
#pragma unroll
            for (int m = 0; m < 4; ++m) { bf16_t* rowp = O + (size_t)(row0 + ai * HALF + m * 16) * ld + col0;
#pragma unroll
                for (int bj = 0; bj < 2; ++bj) *(u32x4*)(rowp + bj * HALF) = pack8(acc[ai][bj][m][0] * scale, acc[ai][bj][m][1] * scale); }
    }
};
template <bool FIRST> struct EpiMerge {
    static constexpr bool PERM = true, AFTER_DRAIN = false, IDEMPOTENT = FIRST;
    bf16_t* MG; const bf16_t* GT; int gcol0;
    __device__ __forceinline__ void operator()(const f32x4 (&acc)[2][2][4][2], const Unit& u, int wr, int wc, int fr, int fq) const {
        const int row0 = u.pm * BM + wr * 64 + fr, col0 = u.pn * BM + wc * 32 + 8 * fq;
#pragma unroll
        for (int ai = 0; ai < 2; ++ai)
#pragma unroll
            for (int m = 0; m < 4; ++m) { const size_t row = (size_t)(row0 + ai * HALF + m * 16);
#pragma unroll
                for (int bj = 0; bj < 2; ++bj) {
                    const u32x4 g = *(const u32x4*)(GT + row * 3072 + gcol0 + col0 + bj * HALF);
                    f32x4 v0 = acc[ai][bj][m][0], v1 = acc[ai][bj][m][1];
                    v0[0] *= bflo(g.x); v0[1] *= bfhi(g.x); v0[2] *= bflo(g.y); v0[3] *= bfhi(g.y); v1[0] *= bflo(g.z); v1[1] *= bfhi(g.z); v1[2] *= bflo(g.w); v1[3] *= bfhi(g.w);
                    bf16_t* dst = MG + row * 1024 + col0 + bj * HALF;
                    if (!FIRST) { const u32x4 o = *(const u32x4*)dst;
                        v0[0] += bflo(o.x); v0[1] += bfhi(o.x); v0[2] += bflo(o.y); v0[3] += bfhi(o.y); v1[0] += bflo(o.z); v1[1] += bfhi(o.z); v1[2] += bflo(o.w); v1[3] += bfhi(o.w); }
                    *(u32x4*)dst = pack8(v0, v1); } }
    }
};
struct EpiHorner {
    static constexpr bool PERM = true, AFTER_DRAIN = false, IDEMPOTENT = true;
    bf16_t* MG; const bf16_t* GT;
    __device__ __forceinline__ void mid(f32x4 (&acc)[2][2][4][2], const Unit& u, int s, int wr, int wc, int fr, int fq) const {
        const int row0 = u.pm * BM + wr * 64 + fr, col0 = u.pn * BM + wc * 32 + 8 * fq;
#pragma unroll
        for (int ai = 0; ai < 2; ++ai)
#pragma unroll
            for (int m = 0; m < 4; ++m) { const bf16_t* gp = GT + (size_t)(row0 + ai * HALF + m * 16) * 3072 + (s - 1) * 1024 + col0;
#pragma unroll
                for (int bj = 0; bj < 2; ++bj) { const u32x4 a = *(const u32x4*)(gp + bj * HALF), b = *(const u32x4*)(gp + 1024 + bj * HALF);
                    f32x4& v0 = acc[ai][bj][m][0]; f32x4& v1 = acc[ai][bj][m][1];
                    v0[0] *= bflo(a.x) * __builtin_amdgcn_rcpf(bflo(b.x)); v0[1] *= bfhi(a.x) * __builtin_amdgcn_rcpf(bfhi(b.x)); v0[2] *= bflo(a.y) * __builtin_amdgcn_rcpf(bflo(b.y)); v0[3] *= bfhi(a.y) * __builtin_amdgcn_rcpf(bfhi(b.y));
                    v1[0] *= bflo(a.z) * __builtin_amdgcn_rcpf(bflo(b.z)); v1[1] *= bfhi(a.z) * __builtin_amdgcn_rcpf(bfhi(b.z)); v1[2] *= bflo(a.w) * __builtin_amdgcn_rcpf(bflo(b.w)); v1[3] *= bfhi(a.w) * __builtin_amdgcn_rcpf(bfhi(b.w)); } }
    }
    __device__ __forceinline__ void operator()(const f32x4 (&acc)[2][2][4][2], const Unit& u, int wr, int wc, int fr, int fq) const {
        const int row0 = u.pm * BM + wr * 64 + fr, col0 = u.pn * BM + wc * 32 + 8 * fq;
#pragma unroll
        for (int ai = 0; ai < 2; ++ai)
#pragma unroll
            for (int m = 0; m < 4; ++m) { const size_t row = (size_t)(row0 + ai * HALF + m * 16);
#pragma unroll
                for (int bj = 0; bj < 2; ++bj) { const u32x4 g = *(const u32x4*)(GT + row * 3072 + 2048 + col0 + bj * HALF);
                    f32x4 v0 = acc[ai][bj][m][0], v1 = acc[ai][bj][m][1];
                    v0[0] *= bflo(g.x); v0[1] *= bfhi(g.x); v0[2] *= bflo(g.y); v0[3] *= bfhi(g.y); v1[0] *= bflo(g.z); v1[1] *= bfhi(g.z); v1[2] *= bflo(g.w); v1[3] *= bfhi(g.w);
                    *(u32x4*)(MG + row * 1024 + col0 + bj * HALF) = pack8(v0, v1); } }
    }
};
__device__ __forceinline__ unsigned pack4_fp8(float a, float b, float c, float d) { int p = 0; p = __builtin_amdgcn_cvt_pk_fp8_f32(a, b, p, false); p = __builtin_amdgcn_cvt_pk_fp8_f32(c, d, p, true); return (unsigned)p; }
template <bool F8> struct EpiSwiglu {
    static constexpr bool PERM = true, AFTER_DRAIN = false, IDEMPOTENT = true;
    void* H; int ld, nmod; float scale;
    __device__ __forceinline__ void operator()(const f32x4 (&acc)[2][2][4][2], const Unit& u, int wr, int wc, int fr, int fq) const {
        const int row0 = u.pm * BM + wr * 64 + fr, col0 = (u.pn % nmod) * HALF + wc * 32 + 8 * fq;
#pragma unroll
        for (int ai = 0; ai < 2; ++ai)
#pragma unroll
            for (int m = 0; m < 4; ++m) {
                f32x4 h0, h1;
#pragma unroll
                for (int j = 0; j < 4; ++j) { const float g0 = acc[ai][0][m][0][j] * scale, g1 = acc[ai][0][m][1][j] * scale;
                    h0[j] = g0 * sigm(g0) * (acc[ai][1][m][0][j] * scale); h1[j] = g1 * sigm(g1) * (acc[ai][1][m][1][j] * scale); }
                const size_t off = (size_t)(row0 + ai * HALF + m * 16) * ld + col0;
                if constexpr (F8) { typedef unsigned u32x2_ __attribute__((ext_vector_type(2))); u32x2_ w; w.x = pack4_fp8(h0[0], h0[1], h0[2], h0[3]); w.y = pack4_fp8(h1[0], h1[1], h1[2], h1[3]); *(u32x2_*)((unsigned char*)H + off) = w; }
                else *(u32x4*)((bf16_t*)H + off) = pack8(h0, h1); }
    }
};
struct EpiIn {
    static constexpr bool PERM = true, AFTER_DRAIN = false, IDEMPOTENT = true;
    unsigned char* ws; size_t oQ, oKV, oFAB, oCIN, oGT, oROPE; float qscale;
    __device__ __forceinline__ void operator()(const f32x4 (&acc)[2][2][4][2], const Unit& u, int wr, int wc, int fr, int fq) const {
        const int pn = u.pn, lc0 = wc * 32 + 8 * fq, row0 = u.pm * BM + wr * 64 + fr;
        const bool ctxrow = u.pm >= 128;
        bf16_t* const Q = (bf16_t*)(ws + oQ); bf16_t* const KV = (bf16_t*)(ws + oKV); bf16_t* const FAB = (bf16_t*)(ws + oFAB); bf16_t* const CIN = (bf16_t*)(ws + oCIN); bf16_t* const GT = (bf16_t*)(ws + oGT);
        const float* const rope = (const float*)(ws + oROPE);
#pragma unroll
        for (int bj = 0; bj < 2; ++bj) {
            const int cc = bj * HALF + lc0;
            int mode, ld, dcol; bf16_t* dst;
            if (pn < 2) { mode = 2; dst = Q; ld = 512; dcol = pn * 256 + cc; }
            else if (pn == 2) { dst = KV; ld = 256; dcol = cc; mode = (bj == 0) ? 3 : 0; }
            else if (pn < 7) { mode = 0; dst = FAB; ld = 1024; dcol = (pn - 3) * 256 + cc; }
            else if (pn < 13) { mode = 0; dst = CIN; ld = 1536; dcol = (pn - 7) * 256 + cc; }
            else { mode = 1; dst = GT; ld = 3072; dcol = (pn - 13) * 256 + cc; }
            if (mode == 0) {
#pragma unroll
                for (int ai = 0; ai < 2; ++ai)
#pragma unroll
                    for (int m = 0; m < 4; ++m) *(u32x4*)(dst + (size_t)(row0 + ai * HALF + m * 16) * ld + dcol) = pack8(acc[ai][bj][m][0], acc[ai][bj][m][1]);
            } else if (mode == 1) {
#pragma unroll
                for (int ai = 0; ai < 2; ++ai)
#pragma unroll
                    for (int m = 0; m < 4; ++m) { f32x4 v0 = acc[ai][bj][m][0], v1 = acc[ai][bj][m][1];
#pragma unroll
                        for (int j = 0; j < 4; ++j) { v0[j] = fmaxf(sigm(v0[j]), 9.5367431640625e-07f); v1[j] = fmaxf(sigm(v1[j]), 9.5367431640625e-07f); }
                        *(u32x4*)(dst + (size_t)(row0 + ai * HALF + m * 16) * ld + dcol) = pack8(v0, v1); }
            } else {
                const float qs = (mode == 2) ? qscale : 1.0f;
                const int i0 = (dcol & 63) >> 1;
#pragma unroll
                for (int ai = 0; ai < 2; ++ai)
#pragma unroll
                    for (int m = 0; m < 4; ++m) { const int row = row0 + ai * HALF + m * 16; f32x4 v0 = acc[ai][bj][m][0], v1 = acc[ai][bj][m][1];
                        if (!ctxrow) { const int s = row & 16383, pos = (i0 < 16) ? (s >> 6) : (s & 63);
                            const float* t = rope + (size_t)(pos * 16 + (i0 & 15)) * 2; const f32x4 t0 = *(const f32x4*)t, t1 = *(const f32x4*)(t + 4);
                            f32x4 r0, r1;
                            r0[0] = v0[0] * t0[0] - v0[1] * t0[1]; r0[1] = v0[0] * t0[1] + v0[1] * t0[0]; r0[2] = v0[2] * t0[2] - v0[3] * t0[3]; r0[3] = v0[2] * t0[3] + v0[3] * t0[2];
                            r1[0] = v1[0] * t1[0] - v1[1] * t1[1]; r1[1] = v1[0] * t1[1] + v1[1] * t1[0]; r1[2] = v1[2] * t1[2] - v1[3] * t1[3]; r1[3] = v1[2] * t1[3] + v1[3] * t1[2];
                            v0 = r0; v1 = r1; }
                        v0 = v0 * qs; v1 = v1 * qs;
                        *(u32x4*)(dst + (size_t)(row0 + ai * HALF + m * 16) * ld + dcol) = pack8(v0, v1); }
            }
        }
    }
};

template <class Epi, class Sched, bool ALIGN_EPI = false, bool SP2 = false, int DT = 0, bool SEG = false>
__device__ __forceinline__ void gemm_phase(PG8_LAS unsigned char* lds, const Gemm g, const Sched& S, const Epi& E, int wave_id  , int stagger_ticks = 0) {
    unsigned z_ = 0u; asm volatile("" : "+v"(z_)); int wid_ = wave_id; asm volatile("" : "+s"(wid_));
    const int lane_ = (int)__builtin_amdgcn_mbcnt_hi(~0u, __builtin_amdgcn_mbcnt_lo(~0u, z_));
    const int wid = wid_, lane = lane_, tid = wid * 64 + lane, wr = wid >> 2, wc = wid & 3, fr = lane & 15, fq = lane >> 4;
    constexpr bool FP8 = (DT == 1), I8 = (DT == 2);
    const int K = g.K, ldk = g.ld ? g.ld : K, pitch = DT ? ldk : 2 * ldk  , nt = (DT ? K : 2 * K) / 128;
#define PG8_PA(base, tt) (SEG ? (base) + ((tt) < 8 ? 0L : (tt) < 16 ? g.A1off : g.A2off) + (size_t)((tt) & 7) * kstep : (base) + (size_t)(tt) * kstep)
#define PG8_PB(base, tt) (SEG ? (base) + (size_t)((tt) >> 3) * g.Bseg + (size_t)((tt) & 7) * kstep : (base) + (size_t)(tt) * kstep)
    unsigned voffA, voffB;
    { int R, C; stage_rc(tid * 16, R, C); const int Rb = Epi::PERM ? ((R & ~31) + perm32(R & 31)) : R;
        voffA = (unsigned)(R * pitch + C * 2); voffB = (unsigned)(Rb * pitch + C * 2); }
    const size_t pstep = (size_t)64 * pitch;
    const size_t kstep = (size_t)(BK * 2);
    const size_t hstep = (size_t)HALF * pitch;
    const size_t tstep = 2 * hstep;
    const unsigned ldsw = (unsigned)wid * 1024u;
    const int aoff = lds_byte(wr * 64 + fr, fq * 8), boff = lds_byte(wc * 32 + fr, fq * 8);
#define PG8_SA(b, h) (((b) * 2 + (h)) * HTB)
#define PG8_SB(b, h) ((4 + (b) * 2 + (h)) * HTB)
#define PG8_STAGE(bufoff, gbase, voff) do { _Pragma("unroll") for (int _i = 0; _i < 2; ++_i) \
        __builtin_amdgcn_global_load_lds((const unsigned*)((const char*)(gbase) + _i * pstep + (voff)), (PG8_LAS unsigned*)(lds + (bufoff) + ldsw + _i * 8192), 16, 0, 0); } while (0)
#define PG8_LDA(dst, b, h) do { _Pragma("unroll") for (int m = 0; m < 4; ++m) _Pragma("unroll") for (int k = 0; k < 2; ++k) dst[m][k] = *(const PG8_LAS bf16x8*)(lds + PG8_SA(b, h) + aoff + m * 2048 + k * 1024); } while (0)
#define PG8_LDB(dst, b, h) do { _Pragma("unroll") for (int n = 0; n < 2; ++n) _Pragma("unroll") for (int k = 0; k < 2; ++k) dst[n][k] = *(const PG8_LAS bf16x8*)(lds + PG8_SB(b, h) + boff + n * 2048 + k * 1024); } while (0)
#define PG8_MMA(ai, bj, At, Bt) do { __builtin_amdgcn_s_setprio(1); _Pragma("unroll") for (int m = 0; m < 4; ++m) _Pragma("unroll") for (int n = 0; n < 2; ++n) { \
        if constexpr (FP8) { typedef int i32x4_ __attribute__((ext_vector_type(4))); \
            acc[ai][bj][m][n] = __builtin_amdgcn_mfma_scale_f32_16x16x128_f8f6f4(__builtin_shufflevector(__builtin_bit_cast(i32x4_, Bt[n][0]), __builtin_bit_cast(i32x4_, Bt[n][1]), 0, 1, 2, 3, 4, 5, 6, 7), \
                __builtin_shufflevector(__builtin_bit_cast(i32x4_, At[m][0]), __builtin_bit_cast(i32x4_, At[m][1]), 0, 1, 2, 3, 4, 5, 6, 7), acc[ai][bj][m][n], 0, 0, 0, 0, 0, 0); } \
        else if constexpr (I8) { typedef int i32x4_ __attribute__((ext_vector_type(4))); _Pragma("unroll") for (int k = 0; k < 2; ++k) \
            acc[ai][bj][m][n] = __builtin_bit_cast(f32x4, __builtin_amdgcn_mfma_i32_16x16x64_i8(__builtin_bit_cast(i32x4_, Bt[n][k]), __builtin_bit_cast(i32x4_, At[m][k]), __builtin_bit_cast(i32x4_, acc[ai][bj][m][n]), 0, 0, 0)); } \
        else { _Pragma("unroll") for (int k = 0; k < 2; ++k) acc[ai][bj][m][n] = __builtin_amdgcn_mfma_f32_16x16x32_bf16(Bt[n][k], At[m][k], acc[ai][bj][m][n], 0, 0, 0); } } \
        __builtin_amdgcn_s_setprio(0); } while (0)
#define PG8_WAIT_V(n) asm volatile("s_waitcnt vmcnt(" #n ")" ::: "memory")
#define PG8_WAIT_L(n) asm volatile("s_waitcnt lgkmcnt(" #n ")" ::: "memory")
#define PG8_BAR __builtin_amdgcn_s_barrier()
#define PG8_SCHED __builtin_amdgcn_sched_barrier(0)
    Unit cur, nxt; int ui = 0;
    if (!S.next(0, cur)) return;
    if (stagger_ticks > 0) { const unsigned long long t0_ = __builtin_amdgcn_s_memrealtime(); while (__builtin_amdgcn_s_memrealtime() - t0_ < (unsigned long long)stagger_ticks) __builtin_amdgcn_s_sleep(4); }
    f32x4 acc[2][2][4][2];
#pragma unroll
    for (int a = 0; a < 2; ++a)
#pragma unroll
        for (int b = 0; b < 2; ++b)
#pragma unroll
            for (int m = 0; m < 4; ++m)
#pragma unroll
                for (int n = 0; n < 2; ++n) acc[a][b][m][n] = (f32x4){0.f, 0.f, 0.f, 0.f};
    bf16x8 At[4][2], B0[2][2], B1[2][2];
    const char* cA = (const char*)g.A + (size_t)cur.pm * tstep; const char* cB = (const char*)g.Bt + (size_t)cur.pn * tstep;
    S.a_ready(cur);
    if constexpr (SP2) {
        PG8_STAGE(PG8_SB(0, 0), cB, voffB); PG8_STAGE(PG8_SB(0, 1), cB + hstep, voffB); PG8_STAGE(PG8_SA(0, 0), cA, voffA); PG8_STAGE(PG8_SA(0, 1), cA + hstep, voffA);
        if (wr == 1) PG8_BAR;
        PG8_WAIT_V(2); PG8_BAR;
        PG8_STAGE(PG8_SB(1, 0), cB + kstep, voffB); PG8_STAGE(PG8_SA(1, 0), cA + kstep, voffA); PG8_STAGE(PG8_SB(1, 1), cB + hstep + kstep, voffB);
        PG8_WAIT_V(6); PG8_BAR;
    } else {
        PG8_STAGE(PG8_SB(0, 0), cB, voffB); PG8_STAGE(PG8_SA(0, 0), cA, voffA); PG8_STAGE(PG8_SB(0, 1), cB + hstep, voffB); PG8_STAGE(PG8_SA(0, 1), cA + hstep, voffA);
        if (wr == 1) PG8_BAR;
        PG8_WAIT_V(4); PG8_BAR;
        PG8_STAGE(PG8_SB(1, 0), cB + kstep, voffB); PG8_STAGE(PG8_SA(1, 0), cA + kstep, voffA); PG8_STAGE(PG8_SB(1, 1), cB + hstep + kstep, voffB);
        PG8_WAIT_V(6); PG8_BAR;
    }
    for (;;) {
        const bool has_next = S.next(ui + 1, nxt);
        const char* nA = has_next ? (const char*)g.A + (size_t)nxt.pm * tstep : cA; const char* nB = has_next ? (const char*)g.Bt + (size_t)nxt.pn * tstep : cB;
#pragma unroll 1
        for (int t = 0; t < nt; t += 2) {
            const bool last = (t == nt - 2);
            if constexpr (SEG) { if (t == 8 || t == 16) { unsigned zm_ = 0u; asm volatile("" : "+v"(zm_)); const int lm_ = (int)__builtin_amdgcn_mbcnt_hi(~0u, __builtin_amdgcn_mbcnt_lo(~0u, zm_)); E.mid(acc, cur, t >> 3, wr, wc, lm_ & 15, lm_ >> 4); } }
            const char* a1 = PG8_PA(cA, t + 1);
            const char* a2 = last ? nA : PG8_PA(cA, t + 2); const char* b2 = last ? nB : PG8_PB(cB, t + 2);
            const char* a3 = a2 + kstep; const char* b3 = b2 + kstep;
            if (last && has_next) S.a_ready(nxt);
            if constexpr (SP2) {
            PG8_LDB(B0, 0, 0); PG8_LDB(B1, 0, 1); PG8_SCHED; PG8_LDA(At, 0, 0); PG8_STAGE(PG8_SA(1, 1), a1 + hstep, voffA);
            PG8_WAIT_V(8); PG8_WAIT_L(0); PG8_BAR; PG8_MMA(0, 0, At, B0); PG8_MMA(0, 1, At, B1); PG8_BAR; PG8_SCHED;
            PG8_LDA(At, 0, 1); PG8_STAGE(PG8_SB(0, 0), b2, voffB); PG8_STAGE(PG8_SB(0, 1), b2 + hstep, voffB); PG8_STAGE(PG8_SA(0, 0), a2, voffA);
            PG8_WAIT_V(8); PG8_WAIT_L(0); PG8_BAR; PG8_MMA(1, 0, At, B0); PG8_MMA(1, 1, At, B1); PG8_BAR; PG8_SCHED;
            PG8_LDB(B0, 1, 0); PG8_LDB(B1, 1, 1); PG8_SCHED; PG8_LDA(At, 1, 0); PG8_STAGE(PG8_SA(0, 1), a2 + hstep, voffA);
            PG8_WAIT_V(8); PG8_WAIT_L(0); PG8_BAR; PG8_MMA(0, 0, At, B0); PG8_MMA(0, 1, At, B1); PG8_BAR; PG8_SCHED;
            PG8_LDA(At, 1, 1); PG8_STAGE(PG8_SB(1, 0), b3, voffB); PG8_STAGE(PG8_SB(1, 1), b3 + hstep, voffB); PG8_STAGE(PG8_SA(1, 0), a3, voffA);
            PG8_WAIT_V(8); PG8_WAIT_L(0); PG8_BAR; PG8_MMA(1, 0, At, B0); PG8_MMA(1, 1, At, B1); PG8_BAR; PG8_SCHED;
            } else {
            PG8_LDB(B0, 0, 0); PG8_SCHED; PG8_LDA(At, 0, 0); PG8_STAGE(PG8_SA(1, 1), a1 + hstep, voffA);
            PG8_WAIT_L(8); PG8_BAR; PG8_WAIT_L(0); PG8_MMA(0, 0, At, B0); PG8_BAR; PG8_SCHED;
            PG8_LDB(B1, 0, 1); PG8_STAGE(PG8_SB(0, 0), b2, voffB);
            PG8_BAR; PG8_WAIT_L(0); PG8_MMA(0, 1, At, B1); PG8_BAR;
            PG8_LDA(At, 0, 1); PG8_STAGE(PG8_SA(0, 0), a2, voffA);
            PG8_BAR; PG8_WAIT_L(0); PG8_MMA(1, 0, At, B0); PG8_BAR; PG8_SCHED;
            PG8_STAGE(PG8_SB(0, 1), b2 + hstep, voffB);
            PG8_WAIT_V(6); PG8_BAR; PG8_MMA(1, 1, At, B1); PG8_BAR;
            PG8_LDB(B0, 1, 0); PG8_SCHED; PG8_LDA(At, 1, 0); PG8_STAGE(PG8_SA(0, 1), a2 + hstep, voffA);
            PG8_WAIT_L(8); PG8_BAR; PG8_WAIT_L(0); PG8_MMA(0, 0, At, B0); PG8_BAR; PG8_SCHED;
            PG8_LDB(B1, 1, 1); PG8_STAGE(PG8_SB(1, 0), b3, voffB);
            PG8_BAR; PG8_WAIT_L(0); PG8_MMA(0, 1, At, B1); PG8_BAR;
            PG8_LDA(At, 1, 1); PG8_STAGE(PG8_SA(1, 0), a3, voffA);
            PG8_BAR; PG8_WAIT_L(0); PG8_MMA(1, 0, At, B0); PG8_BAR; PG8_SCHED;
            PG8_STAGE(PG8_SB(1, 1), b3 + hstep, voffB);
            PG8_WAIT_V(6); PG8_BAR; PG8_MMA(1, 1, At, B1); PG8_BAR;
            }
        }
        if constexpr (ALIGN_EPI) { if (wr == 0) PG8_BAR; }
        if constexpr (!Epi::AFTER_DRAIN) { unsigned ze_ = 0u; asm volatile("" : "+v"(ze_)); const int le_ = (int)__builtin_amdgcn_mbcnt_hi(~0u, __builtin_amdgcn_mbcnt_lo(~0u, ze_));
            if constexpr (I8) {
                typedef int i32x4_ __attribute__((ext_vector_type(4)));
                const int fr_ = le_ & 15, fq_ = le_ >> 4; const float* rsp = g.rs + (size_t)cur.pm * BM + wr * 64 + fr_; const float* csp = g.cs + (size_t)cur.pn * BM + wc * 32 + 8 * fq_;
                f32x4 cv[2][2];
                _Pragma("unroll") for (int bj = 0; bj < 2; ++bj) _Pragma("unroll") for (int n = 0; n < 2; ++n) cv[bj][n] = *(const f32x4*)(csp + bj * HALF + 4 * n);
                _Pragma("unroll") for (int ai = 0; ai < 2; ++ai) _Pragma("unroll") for (int m = 0; m < 4; ++m) { const float rv = rsp[ai * HALF + m * 16];
                    _Pragma("unroll") for (int bj = 0; bj < 2; ++bj) _Pragma("unroll") for (int n = 0; n < 2; ++n)
                        acc[ai][bj][m][n] = __builtin_convertvector(__builtin_bit_cast(i32x4_, acc[ai][bj][m][n]), f32x4) * (cv[bj][n] * rv); }
            }
            E(acc, cur, wr, wc, le_ & 15, le_ >> 4);
#if defined(REP_EPI)
            if constexpr (Epi::IDEMPOTENT) { for (int r_ = 1; r_ < REP_EPI; ++r_) { asm volatile("" ::: "memory"); E(acc, cur, wr, wc, le_ & 15, le_ >> 4); } }
#endif
            S.done(cur); }
        if (!has_next) break;
#pragma unroll
        for (int a = 0; a < 2; ++a)
#pragma unroll
            for (int b = 0; b < 2; ++b)
#pragma unroll
                for (int m = 0; m < 4; ++m)
#pragma unroll
                    for (int n = 0; n < 2; ++n) acc[a][b][m][n] = (f32x4){0.f, 0.f, 0.f, 0.f};
        cur = nxt; cA = nA; cB = nB; ++ui;
        if constexpr (ALIGN_EPI) { if (wr == 1) PG8_BAR; }
    }
    PG8_WAIT_V(0);
    if constexpr (!ALIGN_EPI) { if (wr == 0) PG8_BAR; }
    PG8_BAR;
    if constexpr (Epi::AFTER_DRAIN) { E.fused(acc, cur, wr, wc, fr, fq, lds, wid, lane); S.done(cur); }
#undef PG8_PA
#undef PG8_PB
#undef PG8_SA
#undef PG8_SB
#undef PG8_STAGE
#undef PG8_LDA
#undef PG8_LDB
#undef PG8_MMA
#undef PG8_WAIT_V
#undef PG8_WAIT_L
#undef PG8_BAR
#undef PG8_SCHED
}
}
#define GAS __attribute__((address_space(1)))
#define LAS __attribute__((address_space(3)))
typedef pg8::bf16_t bf16_t;
typedef pg8::bf16x8 bf16x8;
typedef pg8::f32x4 f32x4;
typedef pg8::u32x4 u32x4;
typedef float f32x16 __attribute__((ext_vector_type(16)));
typedef float f32x2 __attribute__((ext_vector_type(2)));
typedef short s16x4 __attribute__((ext_vector_type(4)));
typedef unsigned u32x2 __attribute__((ext_vector_type(2)));
typedef GAS unsigned gu32;

typedef const __attribute__((address_space(4))) unsigned char* kptr_t;
__device__ __forceinline__ kptr_t kbase() { kptr_t p = (kptr_t)__builtin_amdgcn_kernarg_segment_ptr(); asm volatile("" : "+s"(p)); return p; }
#define IN_(i) (*(const float* const __attribute__((address_space(4)))*)(kbase() + 8 * (i)))
#define OUT_ (*(float* const __attribute__((address_space(4)))*)(kbase() + 200))
#define WS_ (*(unsigned char* const __attribute__((address_space(4)))*)(kbase() + 208))
constexpr int NWAVES = 8, NTHREADS = 512;
constexpr int D = 1024, SEQ = 16384, M_LAT = 32768, CTXL = 256, M_CTX = 512, MT = M_LAT + M_CTX;
constexpr int ZN = 6400, DFF = 2816, DEXP = 3584, NEXP = 8, NMOD = 6144;
constexpr float EPS = 1e-6f, LOG2E = 1.4426950408889634f, QSCALE = 0.125f * LOG2E;
constexpr int CHUNK_TILES = 128, CHUNK_MAX = 136, CHUNK_ROWS = CHUNK_MAX * 256;
constexpr float WSCALE8 = 64.0f;

constexpr size_t MiB = 1u << 20;
constexpr size_t WS_CTL = 0, CTL_BYTES = 1 * MiB;
constexpr size_t WS_MODV = 6 * MiB + 768 * 1024;
constexpr size_t WS_MODF = 1 * MiB;
constexpr size_t WS_CS = 1 * MiB + 152 * 1024;
constexpr size_t WS_RS = 1 * MiB + 864 * 1024;
constexpr size_t WS_ROPE = 1 * MiB + 256 * 1024;
constexpr size_t WS_G1 = 1 * MiB + 512 * 1024;
constexpr size_t WS_G2 = 1 * MiB + 768 * 1024;
constexpr size_t WS_HCTX = 2 * MiB;
constexpr size_t WS_ASG = 4 * MiB;
constexpr size_t WS_ELIST = 5 * MiB;
constexpr size_t WS_TW = 6 * MiB;
constexpr size_t WS_G3 = 6 * MiB + 512 * 1024;
constexpr size_t WS_WIN = 8 * MiB, WIN_BYTES = (size_t)ZN * D;
constexpr size_t WS_WY = 33 * MiB;
constexpr size_t WS_WO = 39 * MiB;
constexpr size_t WS_WFF_UP = 43 * MiB;
constexpr size_t WS_WFF_DN = 54 * MiB;
constexpr size_t WS_HN = 60 * MiB;
constexpr size_t WS_Q = 125 * MiB;
constexpr size_t WS_KV = WS_Q + (size_t)MT * 512 * 2;
constexpr size_t WS_FAB = 174 * MiB;
constexpr size_t WS_CIN = 239 * MiB;
constexpr size_t WS_GT = WS_CIN + (size_t)MT * 1536 * 2;
constexpr size_t WS_COUT = 532 * MiB;
constexpr size_t WS_MIX = WS_GT;
constexpr size_t WS_HID0 = 125 * MiB;
constexpr size_t WS_F0 = 402 * MiB;
constexpr size_t WS_EXUP = 125 * MiB;
constexpr size_t WS_EXDN = 181 * MiB;
constexpr size_t WS_H2G = 209 * MiB;
constexpr size_t WS_HIDX = 244 * MiB;
constexpr size_t WS_YEXP = 437 * MiB;
constexpr size_t WS_ATT = 570 * MiB;
constexpr size_t WS_NEED = 603 * MiB;
static_assert(WS_KV + (size_t)MT * 256 * 2 <= WS_FAB && WS_FAB + (size_t)MT * 1024 * 2 <= WS_CIN && WS_GT + (size_t)MT * 3072 * 2 <= WS_COUT && WS_COUT + (size_t)MT * 512 * 2 <= WS_ATT && WS_ATT + (size_t)MT * 512 * 2 <= WS_NEED, "ws map (mixer)");
static_assert(WS_HN + (size_t)MT * 1024 * 2 <= WS_Q && WS_WFF_DN + (size_t)1024 * DFF * 2 <= WS_HN && WS_WFF_UP + (size_t)2 * DFF * 1024 * 2 <= WS_WFF_DN, "ws map (weights)");
static_assert(WS_HID0 + (size_t)MT * DFF * 2 <= WS_MIX && WS_MIX + (size_t)MT * 1024 * 2 <= WS_F0 && WS_EXUP + (size_t)8 * 7168 * 1024 <= WS_EXDN && WS_EXDN + (size_t)8 * 1024 * DEXP <= WS_H2G && WS_EXDN + (size_t)8 * 1024 * DEXP <= WS_MIX, "ws map (ffn)");
static_assert(WS_H2G + (size_t)CHUNK_ROWS * 1024 <= WS_HIDX && WS_HIDX + (size_t)CHUNK_ROWS * DEXP <= WS_YEXP && WS_YEXP + (size_t)264 * 256 * 1024 * 2 <= WS_ATT, "ws map (moe)");
constexpr int CW_BAR = 4096;
constexpr int CW_CNT = 8192;
constexpr int CW_COLMAX = 16384;
constexpr int CW_FOLDMAX = CW_COLMAX + 2 * 6400 + 5632;

constexpr int RING_BYTES = 131072;
constexpr int MISC_OFF = RING_BYTES + 320;
constexpr int LDSX_OFF = RING_BYTES + 1024;
constexpr int LDS_BYTES = 147456;

#define LDS_WAIT() asm volatile("s_waitcnt lgkmcnt(0)" ::: "memory")
#define VM_WAIT() asm volatile("s_waitcnt vmcnt(0)" ::: "memory")

#define XB_TMO      128
#define XB_XCNT(j)  (256  + 64 * (j))
#define XB_XSUB(j)  (1280 + 64 * (j))
#define XB_XGEN(j)  (2304 + 64 * (j))
#define XB_TOP      3328
#define XB_TOPGEN   3392
#define XCD_BAR_WORDS 3456
#define XB_SPIN_CAP (1u << 22)

__device__ __forceinline__ unsigned xb_ld(unsigned* p)              { return __hip_atomic_load(p, __ATOMIC_RELAXED, __HIP_MEMORY_SCOPE_AGENT); }
__device__ __forceinline__ unsigned xb_add(unsigned* p, unsigned v) { return __hip_atomic_fetch_add(p, v, __ATOMIC_RELAXED, __HIP_MEMORY_SCOPE_AGENT); }
__device__ __forceinline__ unsigned xb_xcc_id() { return (unsigned)__builtin_amdgcn_s_getreg((3 << 11) | 20) & 0xFu; }
#define XB_SPIN(cond, bar) do { unsigned _sp = 0; while (cond) { __builtin_amdgcn_s_sleep(1); \
    if ((++_sp & 255u) == 0u) { if (xb_ld(&(bar)[XB_TMO])) break; if (_sp > XB_SPIN_CAP) { atomicAdd(&(bar)[XB_TMO], 1u); break; } } } } while (0)

struct XcdBarrier {
    unsigned* bar; unsigned x;
    volatile LAS unsigned* st;
};

__device__ __forceinline__ XcdBarrier xcd_barrier_post(unsigned* bar, volatile LAS unsigned* st) {
    XcdBarrier b; b.bar = bar; b.x = xb_xcc_id(); b.st = st;
    if (threadIdx.x == 0) (void)xb_add(&bar[XB_XCNT(b.x)], 1u);
    return b;
}
__device__ __forceinline__ void xcd_barrier_complete(unsigned* bar, unsigned x, unsigned& nloc, unsigned& nx) {
    const unsigned G = gridDim.x * gridDim.y * gridDim.z;
    unsigned sum, cnt, mine, sp = 0u;
    for (;;) {
        sum = 0u; cnt = 0u; mine = 0u;
#pragma unroll
        for (unsigned j = 0; j < 16; ++j) { const unsigned c = xb_ld(&bar[XB_XCNT(j)]); sum += c; cnt += (c > 0u) ? 1u : 0u; mine = (j == x) ? c : mine; }
        if (sum == G) break;
        __builtin_amdgcn_s_sleep(1);
        if ((++sp & 255u) == 0u) { if (xb_ld(&bar[XB_TMO])) break; if (sp > XB_SPIN_CAP) { atomicAdd(&bar[XB_TMO], 1u); break; } }
    }
    nloc = mine > 0u ? mine : 1u; nx = cnt > 0u ? cnt : 1u;
}

__device__ __forceinline__ void xcd_barrier(const XcdBarrier& b) {
    asm volatile("s_waitcnt vmcnt(0)" ::: "memory");
    __syncthreads();
    if (threadIdx.x == 0) {
        unsigned* bar = b.bar;
        __builtin_amdgcn_s_waitcnt(0);
        unsigned nloc = b.st[0], nx = b.st[1];
        if (nloc == 0u) { xcd_barrier_complete(bar, b.x, nloc, nx); b.st[0] = nloc; b.st[1] = nx; }
        const unsigned old = xb_add(&bar[XB_XSUB(b.x)], 1u);
        const unsigned gen = old / nloc;
        if (old + 1u == (gen + 1u) * nloc) {
            __builtin_amdgcn_fence(__ATOMIC_RELEASE, "agent");
            asm volatile("s_waitcnt vmcnt(0)" ::: "memory");
            const unsigned og = xb_add(&bar[XB_TOP], 1u);
            const unsigned tg = og / nx;
            if (og + 1u == (tg + 1u) * nx) xb_add(&bar[XB_TOPGEN], 1u);
            else XB_SPIN(xb_ld(&bar[XB_TOPGEN]) == tg, bar);
            __builtin_amdgcn_fence(__ATOMIC_ACQUIRE, "agent");
            xb_add(&bar[XB_XGEN(b.x)], 1u);
            asm volatile("s_waitcnt vmcnt(0)" ::: "memory");
        } else {
            XB_SPIN(xb_ld(&bar[XB_XGEN(b.x)]) == gen, bar);
            __builtin_amdgcn_fence(__ATOMIC_ACQUIRE, "agent");
            asm volatile("s_waitcnt vmcnt(0)" ::: "memory");
        }
    }
    __syncthreads();
}

struct Params { const float* in[25]; float* out; unsigned char* ws; };
struct Ctx {
    LAS unsigned char* lds;
    int tid, lane, wave, vcu, G;
};
__device__ __forceinline__ Ctx opaque(const Ctx& c) { Ctx o = c; asm volatile("" : "+s"(o.wave), "+s"(o.vcu), "+s"(o.G));
    unsigned z = 0u; asm volatile("" : "+v"(z)); o.lane = (int)__builtin_amdgcn_mbcnt_hi(~0u, __builtin_amdgcn_mbcnt_lo(~0u, z)); o.tid = o.wave * 64 + o.lane; return o; }
template <int O> __device__ __forceinline__ float lane_xor(float v) { return __int_as_float(__builtin_amdgcn_ds_swizzle(__float_as_int(v), (O << 10) | 0x1f)); }
__device__ __forceinline__ float half_sum(float v) { const auto r = __builtin_amdgcn_permlane32_swap(__float_as_uint(v), __float_as_uint(v), false, false); return __uint_as_float(r[0]) + __uint_as_float(r[1]); }
__device__ __forceinline__ float half_max(float v) { const auto r = __builtin_amdgcn_permlane32_swap(__float_as_uint(v), __float_as_uint(v), false, false); return fmaxf(__uint_as_float(r[0]), __uint_as_float(r[1])); }
__device__ __forceinline__ float wave_max(float v) {
    v = fmaxf(v, lane_xor<1>(v)); v = fmaxf(v, lane_xor<2>(v)); v = fmaxf(v, lane_xor<4>(v)); v = fmaxf(v, lane_xor<8>(v)); v = fmaxf(v, lane_xor<16>(v));
    return half_max(v);
}
__device__ __forceinline__ unsigned pack4_i8(float a, float b, float c, float d) {
    const int qa = __float2int_rn(a), qb = __float2int_rn(b), qc = __float2int_rn(c), qd = __float2int_rn(d);
    return (unsigned)(qa & 255) | ((unsigned)(qb & 255) << 8) | ((unsigned)(qc & 255) << 16) | ((unsigned)qd << 24);
}
__device__ __forceinline__ float wave_sum(float v) {
    v += lane_xor<1>(v); v += lane_xor<2>(v); v += lane_xor<4>(v); v += lane_xor<8>(v); v += lane_xor<16>(v);
    return half_sum(v);
}
__device__ __forceinline__ unsigned pk2(float lo, float hi) { return pg8::cvt_pk_bf16(lo, hi); }
__device__ __forceinline__ float bflo(unsigned u) { return __uint_as_float(u << 16); }
__device__ __forceinline__ float bfhi(unsigned u) { return __uint_as_float(u & 0xffff0000u); }

__device__ __forceinline__ void tr_item(const float* W, int ldw, int k0, int n0, bf16_t* WT, int ldt, int drow0, LAS float* scr, int lane) {
#pragma unroll 8
    for (int i = 0; i < 32; ++i) { const int kk = 2 * i + (lane >> 5); scr[kk * 33 + (lane & 31)] = W[(size_t)(k0 + kk) * ldw + n0 + (lane & 31)]; }
    LDS_WAIT(); asm volatile("" ::: "memory");
    const int c = lane & 7;
#pragma unroll
    for (int j = 0; j < 4; ++j) { const int n = (lane >> 3) + 8 * j; const LAS float* s = scr + (8 * c) * 33 + n;
        u32x4 o; o.x = pk2(s[0 * 33], s[1 * 33]); o.y = pk2(s[2 * 33], s[3 * 33]); o.z = pk2(s[4 * 33], s[5 * 33]); o.w = pk2(s[6 * 33], s[7 * 33]);
        *(GAS u32x4*)(WT + (size_t)(drow0 + n) * ldt + k0 + 8 * c) = o; }
    LDS_WAIT(); asm volatile("" ::: "memory");
}
__device__ __forceinline__ void tr_item8(const float* W, int ldw, int k0, int n0, unsigned char* WT, int ldt, int drow0, float scale, LAS float* scr, int lane) {
#pragma unroll 8
    for (int i = 0; i < 32; ++i) { const int kk = 2 * i + (lane >> 5); scr[kk * 33 + (lane & 31)] = W[(size_t)(k0 + kk) * ldw + n0 + (lane & 31)]; }
    LDS_WAIT(); asm volatile("" ::: "memory");
    const int c = lane & 7;
#pragma unroll
    for (int j = 0; j < 4; ++j) { const int n = (lane >> 3) + 8 * j; const LAS float* s = scr + (8 * c) * 33 + n;
        u32x2 o; o.x = pg8::pack4_fp8(s[0 * 33] * scale, s[1 * 33] * scale, s[2 * 33] * scale, s[3 * 33] * scale); o.y = pg8::pack4_fp8(s[4 * 33] * scale, s[5 * 33] * scale, s[6 * 33] * scale, s[7 * 33] * scale);
        *(GAS u32x2*)(WT + (size_t)(drow0 + n) * ldt + k0 + 8 * c) = o; }
    LDS_WAIT(); asm volatile("" ::: "memory");
}
__device__ __forceinline__ void amax_item(const float* W, int ldw, int k0, int n0, unsigned* cmax, int drow0, int lane) {
    float m = 0.f;
#pragma unroll 8
    for (int i = 0; i < 32; ++i) { const int kk = 2 * i + (lane >> 5); m = fmaxf(m, fabsf(W[(size_t)(k0 + kk) * ldw + n0 + (lane & 31)])); }
    m = half_max(m);
    if (lane < 32) atomicMax(cmax + drow0 + lane, __float_as_uint(m));
}
__device__ __forceinline__ void tr_item_i8(const float* W, int ldw, int k0, int n0, unsigned char* WT, int ldt, int drow0, const unsigned* cmax, float* cs, LAS float* scr, int lane) {
#pragma unroll 8
    for (int i = 0; i < 32; ++i) { const int kk = 2 * i + (lane >> 5); scr[kk * 33 + (lane & 31)] = W[(size_t)(k0 + kk) * ldw + n0 + (lane & 31)]; }
    LDS_WAIT(); asm volatile("" ::: "memory");
    const int c = lane & 7;
#pragma unroll
    for (int j = 0; j < 4; ++j) { const int n = (lane >> 3) + 8 * j; const LAS float* s = scr + (8 * c) * 33 + n;
        const float inv = 127.0f / fmaxf(__uint_as_float(cmax[drow0 + n]), 1e-30f);
        u32x2 o; o.x = pack4_i8(s[0 * 33] * inv, s[1 * 33] * inv, s[2 * 33] * inv, s[3 * 33] * inv); o.y = pack4_i8(s[4 * 33] * inv, s[5 * 33] * inv, s[6 * 33] * inv, s[7 * 33] * inv);
        *(GAS u32x2*)(WT + (size_t)(drow0 + n) * ldt + k0 + 8 * c) = o; }
    if (k0 == 0 && lane < 32) cs[drow0 + lane] = __uint_as_float(cmax[drow0 + lane]) * (1.0f / 127.0f);
    LDS_WAIT(); asm volatile("" ::: "memory");
}
__device__ __forceinline__ int gu_row(int n0, int up) { return (n0 >> 7) * 256 + up * 128 + (n0 & 127); }

__device__ __forceinline__ void p0_convert_item(int it, int pass, LAS float* scr, int lane) {
    unsigned char* ws = WS_;
    unsigned* const cmax = (unsigned*)(ws + WS_CTL) + CW_COLMAX; float* const cs = (float*)(ws + WS_CS);
    if (it < 5376) { const int l = it / 2688, r = it % 2688, kb = r / 168, j = r % 168; const int n0 = j < 24 ? 32 * j : 1280 + 32 * (j - 24), drow = n0 < 768 ? n0 : n0 + 512;
        const float* W = IN_(10) + (size_t)l * D * 5888;
        if (pass == 0) amax_item(W, 5888, 64 * kb, n0, cmax + l * ZN, drow, lane);
        else tr_item_i8(W, 5888, 64 * kb, n0, ws + WS_WIN + l * WIN_BYTES, D, drow, cmax + l * ZN, cs + l * ZN, scr, lane);
        return; }
    it -= 5376;
    if (it < 2816) { const int up = it / 1408, r = it % 1408, kb = r / 88, nb = r % 88;
        if (pass == 0) amax_item(IN_(17 + up), DFF, 64 * kb, 32 * nb, cmax + 2 * ZN, gu_row(32 * nb, up), lane);
        else tr_item_i8(IN_(17 + up), DFF, 64 * kb, 32 * nb, ws + WS_WFF_UP, D, gu_row(32 * nb, up), cmax + 2 * ZN, cs + 2 * ZN, scr, lane);
        return; }
    it -= 2816;
    if (pass != 0) return;
    if (it < 1536) { const int mi = it / 256, r = it % 256, l = mi / 3, i = mi % 3, kb = r / 32, nb = r % 32;
        tr_item(IN_(13 + i) + (size_t)l * 512 * 1024, 1024, 64 * kb, 32 * nb, (bf16_t*)(ws + WS_WY) + (size_t)(l * 3 + i) * 1024 * 512, 512, 32 * nb, scr, lane); return; }
    it -= 1536;
    if (it < 1024) { const int l = it / 512, r = it % 512, kb = r / 32, nb = r % 32;
        tr_item(IN_(16) + (size_t)l * D * D, D, 64 * kb, 32 * nb, (bf16_t*)(ws + WS_WO) + (size_t)l * D * D, D, 32 * nb, scr, lane); return; }
    it -= 1024;
    { const int kb = it / 32, nb = it % 32; tr_item(IN_(19), D, 64 * kb, 32 * nb, (bf16_t*)(ws + WS_WFF_DN), DFF, 32 * nb, scr, lane); }
}
constexpr int P0_I8_ITEMS = 5376 + 2816;
constexpr int P0_ITEMS = 5376 + 1536 + 1024 + 2816 + 1408;
__device__ __forceinline__ void expert_convert_item(int it, LAS float* scr, int lane) {
    unsigned char* ws = WS_;
    const int e = it / 5376, r0 = it % 5376, which = r0 / 1792, r = r0 % 1792;
    if (which < 2) { const int kb = r / 112, nb = r % 112;
        tr_item8(IN_(22 + which) + (size_t)e * D * DEXP, DEXP, 64 * kb, 32 * nb, ws + WS_EXUP + (size_t)e * 7168 * D, D, gu_row(32 * nb, which), WSCALE8, scr, lane); }
    else { const int kb = r / 32, nb = r % 32;
        tr_item8(IN_(24) + (size_t)e * DEXP * D, D, 64 * kb, 32 * nb, ws + WS_EXDN + (size_t)e * D * DEXP, DEXP, 32 * nb, WSCALE8, scr, lane); }
}
constexpr int EXP_ITEMS = 8 * 5376;
__device__ __forceinline__ void phase_expert_convert(const Ctx& C0) {
    const Ctx C = opaque(C0);
    LAS float* scr = (LAS float*)(C.lds + C.wave * 16384);
    for (int it = C.vcu * NWAVES + C.wave; it < EXP_ITEMS; it += C.G * NWAVES) expert_convert_item(it, scr, C.lane);
}

__device__ __forceinline__ void p0_prologue(const Ctx& C0, int pass) {
    const Ctx C = opaque(C0);
    unsigned char* ws = WS_;
    LAS float* sil = (LAS float*)(C.lds + LDSX_OFF);
    LAS float* tab = (LAS float*)(C.lds + LDSX_OFF + 12288);
    for (int i = C.tid; i < 3072; i += NTHREADS) { const float v = i < 2048 ? IN_(1)[i] : IN_(3)[i - 2048]; sil[i] = v / (1.0f + __expf(-v)); }
    if (C.tid < 128) { float s, c; sincospif((float)C.tid / 64.0f, &s, &c); tab[2 * C.tid] = c; tab[2 * C.tid + 1] = s; }
    __syncthreads();
    if (pass == 0) {
    { const int gw0 = C.vcu * NWAVES + C.wave, NGW0 = C.G * NWAVES;
      for (int t = gw0; t < 8 * 2 * 96; t += NGW0) {
        const int kc = t / 192, l = (t % 192) / 96, col = (t % 96) * 64 + C.lane; const float* w = IN_(4) + (size_t)l * D * NMOD + (size_t)(kc * 128) * NMOD + col;
        float a0 = 0.f, a1 = 0.f, a2 = 0.f;
        for (int k = 0; k < 128; k += 16) { float wv[16];
#pragma unroll
            for (int j = 0; j < 16; ++j) wv[j] = w[(size_t)(k + j) * NMOD];
#pragma unroll
            for (int j = 0; j < 16; ++j) { const int kk = kc * 128 + k + j; a0 += sil[kk] * wv[j]; a1 += sil[1024 + kk] * wv[j]; a2 += sil[2048 + kk] * wv[j]; } }
        float* mv = (float*)(ws + WS_MODV) + (size_t)((kc * 2 + l) * 3) * NMOD + col;
        mv[0] = a0; mv[NMOD] = a1; mv[2 * NMOD] = a2;
      } }
    for (int idx = C.vcu * NTHREADS + C.tid; idx < 4096 + 65536 + 32768 + 16384 + 131072; idx += C.G * NTHREADS) {
        if (idx < 4096) { const int pos = idx >> 4, f = idx & 15; const float inv = 1.0f / powf(10000.0f, (float)(2 * f) / 32.0f), ang = (float)pos * inv;
            float* t = (float*)(ws + WS_ROPE) + 2 * idx; t[0] = cosf(ang); t[1] = sinf(ang); }
        else if (idx < 4096 + 65536) { const int i = idx - 4096, m = i >> 8, k = i & 255, k1 = m >> 1, part = m & 1, n1 = k & 127, isb = k >> 7; const int p = (k1 * n1) & 127;
            float s, c; sincospif((float)p / 64.0f, &s, &c); const float v = part == 0 ? (isb ? -s : c) : (isb ? -c : -s);
            ((bf16_t*)(ws + WS_G1))[i] = (bf16_t)pk2(v * 0.08838834764831845f, 0.f); }
        else if (idx >= 4096 + 65536 + 32768 + 16384) { const int i = idx - (4096 + 65536 + 32768 + 16384), k = i >> 9, kk = i & 511, n = kk & 255; float s, c; sincospif((float)((k * n) & 255) / 128.0f, &s, &c);
            ((bf16_t*)(ws + WS_G3))[i] = (bf16_t)pk2((kk < 256 ? c : -s) * 0.0625f, 0.f); }
        else if (idx >= 4096 + 65536 + 32768) { const int i = idx - (4096 + 65536 + 32768), n2 = i >> 7, k1 = i & 127; float s, c; sincospif((float)(k1 * n2) * (1.0f / 8192.0f), &s, &c);
            float* t = (float*)(ws + WS_TW) + 2 * i; t[0] = c; t[1] = s; }
        else { const int i = idx - 4096 - 65536, k2 = i >> 8, k = i & 255, n2 = k & 127, isi = k >> 7; const int p = (k2 * n2) & 127;
            float s, c; sincospif((float)p / 64.0f, &s, &c); ((bf16_t*)(ws + WS_G2))[i] = (bf16_t)pk2((isi ? s : c) * 0.08838834764831845f, 0.f); }
    }
    }
    LAS float* scr = (LAS float*)(C.lds + C.wave * 16384);
    const int gw = C.vcu * NWAVES + C.wave, NGW = C.G * NWAVES;
    for (int it = gw; it < (pass == 0 ? P0_ITEMS : P0_I8_ITEMS); it += NGW) p0_convert_item(it, pass, scr, C.lane);
    LAS float* wf = scr + 2304;
    for (int t = gw; t < 2 * 1024 * 4; t += NGW) {
        const int l = t >> 12, k = (t >> 2) & 1023, g = t & 3; const float* src = IN_(10) + (size_t)l * D * 5888 + (size_t)k * 5888 + 768 + g * 128;
        wf[C.lane] = src[C.lane]; wf[C.lane + 64] = src[C.lane + 64];
        LDS_WAIT(); asm volatile("" ::: "memory");
        float aA0 = 0.f, aB0 = 0.f, aA1 = 0.f, aB1 = 0.f; const int j0 = C.lane, j1 = C.lane + 64;
#pragma unroll 4
        for (int c = 0; c < 128; ++c) { const float w = wf[c]; const int i0 = (c * j0) & 127, i1 = (c * j1) & 127;
            aA0 += w * tab[2 * i0]; aB0 += w * tab[2 * i0 + 1]; aA1 += w * tab[2 * i1]; aB1 += w * tab[2 * i1 + 1]; }
        const float sc = 0.08838834764831845f; unsigned* const fmx = (unsigned*)(ws + WS_CTL) + CW_FOLDMAX + l;
        if (pass == 0) { const float m = wave_max(fmaxf(fmaxf(fabsf(aA0), fabsf(aA1)), fmaxf(fabsf(aB0), fabsf(aB1))) * sc); if (C.lane == 0) atomicMax(fmx, __float_as_uint(m)); }
        else {
            const float amax = fmaxf(__uint_as_float(*fmx), 1e-30f), inv = sc * 127.0f / amax; unsigned char* wt = ws + WS_WIN + l * WIN_BYTES;
            wt[(size_t)(768 + g * 128 + j0) * D + k] = (unsigned char)__float2int_rn(aA0 * inv); wt[(size_t)(768 + g * 128 + j1) * D + k] = (unsigned char)__float2int_rn(aA1 * inv);
            wt[(size_t)(1280 + g * 128 + j0) * D + k] = (unsigned char)__float2int_rn(aB0 * inv); wt[(size_t)(1280 + g * 128 + j1) * D + k] = (unsigned char)__float2int_rn(aB1 * inv);
            if (k == 0) { float* cs = (float*)(ws + WS_CS) + l * ZN; const float f = amax * (1.0f / 127.0f); cs[768 + g * 128 + j0] = f; cs[768 + g * 128 + j1] = f; cs[1280 + g * 128 + j0] = f; cs[1280 + g * 128 + j1] = f; } }
        LDS_WAIT(); asm volatile("" ::: "memory");
    }
}

__device__ __forceinline__ void norm_row(const float* xin, float* xout, bool has_br, const f32x4 (&br)[4], const float* gpost, const float* ga,
                                         const float* gpre, const float* sc, const float* sh, bf16_t* hn, int lane, f32x4 (&h2f)[4], bool hn_fp8 = false) {
    f32x4 x[4];
#pragma unroll
    for (int j = 0; j < 4; ++j) x[j] = *(const GAS f32x4*)(xin + 4 * lane + 256 * j);
    if (has_br) {
        float ss = 0.f;
#pragma unroll
        for (int j = 0; j < 4; ++j) ss += (br[j][0] * br[j][0] + br[j][1] * br[j][1]) + (br[j][2] * br[j][2] + br[j][3] * br[j][3]);
        const float rstd = 1.0f / sqrtf(wave_sum(ss) * (1.0f / D) + EPS);
#pragma unroll
        for (int j = 0; j < 4; ++j) { const f32x4 gp = *(const GAS f32x4*)(gpost + 4 * lane + 256 * j), gg = *(const GAS f32x4*)(ga + 4 * lane + 256 * j); x[j] = x[j] + gg * (br[j] * rstd * gp); }
    }
    if (xout) {
#pragma unroll
        for (int j = 0; j < 4; ++j) *(GAS f32x4*)(xout + 4 * lane + 256 * j) = x[j];
    }
    if (hn) {
        float ss = 0.f;
#pragma unroll
        for (int j = 0; j < 4; ++j) ss += (x[j][0] * x[j][0] + x[j][1] * x[j][1]) + (x[j][2] * x[j][2] + x[j][3] * x[j][3]);
        const float rstd = 1.0f / sqrtf(wave_sum(ss) * (1.0f / D) + EPS);
#pragma unroll
        for (int j = 0; j < 4; ++j) { const f32x4 gp = *(const GAS f32x4*)(gpre + 4 * lane + 256 * j), s1 = *(const GAS f32x4*)(sc + 4 * lane + 256 * j), s0 = *(const GAS f32x4*)(sh + 4 * lane + 256 * j);
            const f32x4 h = (x[j] * rstd * gp) * (s1 + 1.0f) + s0; h2f[j] = h;
            if (hn_fp8) *(GAS unsigned*)((unsigned char*)hn + 4 * lane + 256 * j) = pg8::pack4_fp8(h[0], h[1], h[2], h[3]);
            else { u32x2 w; w.x = pk2(h[0], h[1]); w.y = pk2(h[2], h[3]); *(GAS u32x2*)(hn + 4 * lane + 256 * j) = w; } }
    }
}
__device__ __forceinline__ void load_br(const bf16_t* p, int lane, f32x4 (&br)[4]) {
#pragma unroll
    for (int j = 0; j < 4; ++j) { const u32x2 w = *(const GAS u32x2*)(p + 4 * lane + 256 * j); br[j] = (f32x4){bflo(w.x), bfhi(w.x), bflo(w.y), bfhi(w.y)}; }
}
__device__ __forceinline__ int mod_set(int row) { return row >= M_LAT ? 2 : (row >> 14); }

template <bool PARTS> __device__ __forceinline__ f32x4 modv4(const float* modp, const float* modf, const float* bmod, int l, int set, int off) {
    if constexpr (!PARTS) return *(const GAS f32x4*)(modf + (size_t)(l * 3 + set) * NMOD + off);
    else { f32x4 s = *(const GAS f32x4*)(bmod + l * NMOD + off); const float* p = modp + (size_t)(l * 3 + set) * NMOD + off; f32x4 v[8];
#pragma unroll
        for (int kc = 0; kc < 8; ++kc) v[kc] = *(const GAS f32x4*)(p + (size_t)kc * 6 * NMOD);
#pragma unroll
        for (int kc = 0; kc < 8; ++kc) s = s + v[kc];
        return s; }
}
template <int MODE> __device__ __forceinline__ void phase_norm(const Ctx& C0, int l) {
    constexpr int NR = (MODE == 3) ? 2 : 4;
    const Ctx C = opaque(C0);
    const int gw = C.vcu * NWAVES + C.wave, NGW = C.G * NWAVES, lane = C.lane;
    unsigned char* const ws = WS_;
    const float* const modv = (const float*)(ws + WS_MODV); const float* const bmod = IN_(5);
    const float* const modf = (const float*)(ws + WS_MODF);
    if (MODE == 0) {
        float* mf = (float*)(ws + WS_MODF);
        for (int i = C.vcu * NTHREADS + C.tid; i < 2 * 3 * NMOD; i += C.G * NTHREADS) { const int li = i / (3 * NMOD), c = i % NMOD; float s = bmod[li * NMOD + c]; float v[8];
#pragma unroll
            for (int kc = 0; kc < 8; ++kc) v[kc] = modv[(size_t)kc * 6 * NMOD + i];
#pragma unroll
            for (int kc = 0; kc < 8; ++kc) s += v[kc];
            mf[i] = s; }
    }
    constexpr bool moe = (MODE == 4), comb = (MODE == 3), mid = (MODE == 1 || MODE == 4);
    const bool has_hn = (MODE != 3);
    const int nsets = (MODE == 0 || l == 0) ? 3 : 2;
    const float* const xsrc_lat = (MODE == 0 || MODE == 1) ? IN_(0) : (const float*)OUT_;
    float* const xdst_lat = OUT_;
    const float* const xsrc_ctx = (MODE == 2) ? (const float*)(ws + WS_HCTX) : IN_(2);
    float* const xdst_ctx = (float*)(ws + WS_HCTX);
    const bf16_t* const brbuf = mid ? (const bf16_t*)(ws + WS_MIX) : (const bf16_t*)(ws + WS_F0);
    const float* const gpost = mid ? IN_(7) + l * D : IN_(9) + l * D;
    const float* const gpre = (MODE == 0) ? IN_(6) : mid ? IN_(8) + l * D : IN_(6) + D;
    const int ga_off = mid ? 2048 : 5120, hl = (MODE == 2 || MODE == 3) ? 1 : l, sc_off = mid ? 4096 : 1024, sh_off = mid ? 3072 : 0;
    bf16_t* const HN = (bf16_t*)(ws + WS_HN); float* const RS = (float*)(ws + WS_RS);
    LAS unsigned* const lcnt = (LAS unsigned*)(C.lds + LDSX_OFF);
    LAS unsigned* const stage = (LAS unsigned*)(C.lds + LDSX_OFF + 256);
    LAS float* const wrl = (LAS float*)C.lds;
    const LAS int* const tbl = (const LAS int*)(C.lds + MISC_OFF) + 16;
    if (moe) { if (C.tid < 16) lcnt[C.tid] = 0u; const float* wsrc = IN_(20);
        __syncthreads();
        for (int i = C.tid; i < 2048; i += NTHREADS) *(LAS f32x4*)(wrl + 4 * i) = *(const GAS f32x4*)(wsrc + 4 * i);
        __syncthreads(); }
    const float* const brt = IN_(21);
    const unsigned* const asg = (const unsigned*)(ws + WS_ASG); const bf16_t* const Y = (const bf16_t*)(ws + WS_YEXP);
    int it = 0;
    for (int set = 0; set < nsets; ++set) {
        f32x4 vA[4], vB[4], vS[4];
#pragma unroll
        for (int j = 0; j < 4; ++j) { const int c = 4 * lane + 256 * j;
            if (MODE != 0) vA[j] = modv4<MODE == 0>(modv, modf, bmod, l, set, ga_off + c) * *(const GAS f32x4*)(gpost + c); else vA[j] = (f32x4){0.f, 0.f, 0.f, 0.f};
            if (has_hn) { vB[j] = *(const GAS f32x4*)(gpre + c) * (modv4<MODE == 0>(modv, modf, bmod, hl, set, sc_off + c) + 1.0f); vS[j] = modv4<MODE == 0>(modv, modf, bmod, hl, set, sh_off + c); }
            else { vB[j] = (f32x4){0.f, 0.f, 0.f, 0.f}; vS[j] = vB[j]; } }
        const int base = set < 2 ? set * SEQ : M_LAT, n = set < 2 ? SEQ : M_CTX;
        const float* const xs = set < 2 ? xsrc_lat + (size_t)base * D : xsrc_ctx; float* const xd = set < 2 ? xdst_lat + (size_t)base * D : xdst_ctx;
        for (int i0 = gw; i0 < n; i0 += NGW * NR) {
            f32x4 x[NR][4]; u32x2 bw[NR][4], bw2[NR][4]; float cw0[NR], cw1[NR];
#pragma unroll
            for (int k = 0; k < NR; ++k) { const int ri = i0 + NGW * k; if (ri < n) {
#pragma unroll
                for (int j = 0; j < 4; ++j) x[k][j] = __builtin_nontemporal_load((const GAS f32x4*)(xs + (size_t)ri * D + 4 * lane + 256 * j));
                if (MODE != 0) {
                    if (comb) { const unsigned* a = asg + (size_t)(base + ri) * 8; const int e0 = (int)a[0], e1 = (int)a[3]; cw0[k] = __uint_as_float(a[2]); cw1[k] = __uint_as_float(a[5]);
                        const bf16_t* y0 = Y + ((size_t)tbl[e0] * 256 + a[1]) * D, * y1 = Y + ((size_t)tbl[e1] * 256 + a[4]) * D;
#pragma unroll
                        for (int j = 0; j < 4; ++j) { bw[k][j] = *(const GAS u32x2*)(y0 + 4 * lane + 256 * j); bw2[k][j] = *(const GAS u32x2*)(y1 + 4 * lane + 256 * j); } }
                    else {
#pragma unroll
                        for (int j = 0; j < 4; ++j) bw[k][j] = __builtin_nontemporal_load((const GAS u32x2*)(brbuf + (size_t)(base + ri) * D + 4 * lane + 256 * j)); } } }
              else {
#pragma unroll
                for (int j = 0; j < 4; ++j) { x[k][j] = (f32x4){0.f, 0.f, 0.f, 0.f}; bw[k][j] = (u32x2){0u, 0u}; bw2[k][j] = (u32x2){0u, 0u}; } cw0[k] = 0.f; cw1[k] = 0.f; } }
            if (MODE != 0) {
                float ss[NR]; f32x4 br[NR][4];
#pragma unroll
                for (int k = 0; k < NR; ++k) { ss[k] = 0.f;
#pragma unroll
                    for (int j = 0; j < 4; ++j) { f32x4 b = (f32x4){bflo(bw[k][j].x), bfhi(bw[k][j].x), bflo(bw[k][j].y), bfhi(bw[k][j].y)};
                        if (comb) { const f32x4 b2 = (f32x4){bflo(bw2[k][j].x), bfhi(bw2[k][j].x), bflo(bw2[k][j].y), bfhi(bw2[k][j].y)}; b = b * cw0[k] + b2 * cw1[k]; }
                        br[k][j] = b; ss[k] += (b[0] * b[0] + b[1] * b[1]) + (b[2] * b[2] + b[3] * b[3]); } }
#pragma unroll
                for (int k = 0; k < NR; ++k) ss[k] = wave_sum(ss[k]);
#pragma unroll
                for (int k = 0; k < NR; ++k) { const float rstd = 1.0f / sqrtf(ss[k] * (1.0f / D) + EPS);
#pragma unroll
                    for (int j = 0; j < 4; ++j) x[k][j] = x[k][j] + vA[j] * (br[k][j] * rstd); }
#pragma unroll
                for (int k = 0; k < NR; ++k) { const int ri = i0 + NGW * k; if (ri < n) {
#pragma unroll
                    for (int j = 0; j < 4; ++j) __builtin_nontemporal_store(x[k][j], (GAS f32x4*)(xd + (size_t)ri * D + 4 * lane + 256 * j)); } }
            }
            if (has_hn) {
                float s2[NR];
#pragma unroll
                for (int k = 0; k < NR; ++k) { s2[k] = 0.f;
#pragma unroll
                    for (int j = 0; j < 4; ++j) s2[k] += (x[k][j][0] * x[k][j][0] + x[k][j][1] * x[k][j][1]) + (x[k][j][2] * x[k][j][2] + x[k][j][3] * x[k][j][3]); }
#pragma unroll
                for (int k = 0; k < NR; ++k) s2[k] = wave_sum(s2[k]);
                float am[NR];
#pragma unroll
                for (int k = 0; k < NR; ++k) { const float rstd = 1.0f / sqrtf(s2[k] * (1.0f / D) + EPS); am[k] = 0.f;
#pragma unroll
                    for (int j = 0; j < 4; ++j) { x[k][j] = (x[k][j] * rstd) * vB[j] + vS[j];
                        am[k] = fmaxf(fmaxf(am[k], fmaxf(fabsf(x[k][j][0]), fabsf(x[k][j][1]))), fmaxf(fabsf(x[k][j][2]), fabsf(x[k][j][3]))); } }
                if (!moe) {
#pragma unroll
                    for (int k = 0; k < NR; ++k) am[k] = fmaxf(wave_max(am[k]), 1e-20f);
                }
#pragma unroll
                for (int k = 0; k < NR; ++k) { const int ri = i0 + NGW * k;
                    if (ri < n) {
                        if (moe) {
#pragma unroll
                            for (int j = 0; j < 4; ++j) *(GAS unsigned*)((unsigned char*)HN + (size_t)(base + ri) * D + 4 * lane + 256 * j) = pg8::pack4_fp8(x[k][j][0], x[k][j][1], x[k][j][2], x[k][j][3]); }
                        else {
                            const float inv = 127.0f / am[k];
#pragma unroll
                            for (int j = 0; j < 4; ++j) *(GAS unsigned*)((unsigned char*)HN + (size_t)(base + ri) * D + 4 * lane + 256 * j) = pack4_i8(x[k][j][0] * inv, x[k][j][1] * inv, x[k][j][2] * inv, x[k][j][3] * inv);
                            if (lane == 0) RS[base + ri] = am[k] * (1.0f / 127.0f); } } }
                if (moe) {
#pragma unroll
                    for (int k = 0; k < NR; ++k) { const int ri = i0 + NGW * k; if (ri < n) {
                        float lg[8];
#pragma unroll
                        for (int e = 0; e < 8; ++e) lg[e] = 0.f;
#pragma unroll
                        for (int j = 0; j < 4; ++j)
#pragma unroll
                            for (int q = 0; q < 4; ++q) { const LAS float* wr = wrl + (4 * lane + 256 * j + q) * 8; const f32x4 w0 = *(const LAS f32x4*)wr, w1 = *(const LAS f32x4*)(wr + 4); const float h = x[k][j][q];
                                lg[0] += h * w0[0]; lg[1] += h * w0[1]; lg[2] += h * w0[2]; lg[3] += h * w0[3]; lg[4] += h * w1[0]; lg[5] += h * w1[1]; lg[6] += h * w1[2]; lg[7] += h * w1[3]; }
                        float w4[4];
#pragma unroll
                        for (int j = 0; j < 4; ++j) { const auto r = __builtin_amdgcn_permlane32_swap(__float_as_uint(lg[j]), __float_as_uint(lg[4 + j]), false, false); w4[j] = __uint_as_float(r[0]) + __uint_as_float(r[1]); }
                        const bool b4 = (lane & 16) != 0, b3 = (lane & 8) != 0;
                        float w2[2];
#pragma unroll
                        for (int j = 0; j < 2; ++j) { const float keep = b4 ? w4[2 + j] : w4[j], send = b4 ? w4[j] : w4[2 + j]; w2[j] = keep + lane_xor<16>(send); }
                        float w1v; { const float keep = b3 ? w2[1] : w2[0], send = b3 ? w2[0] : w2[1]; w1v = keep + lane_xor<8>(send); }
                        w1v += lane_xor<4>(w1v); w1v += lane_xor<2>(w1v); w1v += lane_xor<1>(w1v);
                        float lgt[8];
#pragma unroll
                        for (int e = 0; e < 8; ++e) lgt[e] = __int_as_float(__builtin_amdgcn_readlane(__float_as_int(w1v), 8 * e)) + brt[e];
                        int e0 = 0; float v0 = lgt[0];
#pragma unroll
                        for (int e = 1; e < 8; ++e) if (lgt[e] > v0) { v0 = lgt[e]; e0 = e; }
                        int e1 = -1; float v1 = -INFINITY;
#pragma unroll
                        for (int e = 0; e < 8; ++e) if (e != e0 && lgt[e] > v1) { v1 = lgt[e]; e1 = e; }
                        const float pw1 = 1.0f / (1.0f + __expf(v0 - v1)), pw0 = 1.0f - pw1;
                        if (lane == 0) { const unsigned p0 = atomicAdd((unsigned*)&lcnt[e0], 1u), p1 = atomicAdd((unsigned*)&lcnt[e1], 1u);
                            LAS unsigned* st = stage + (C.wave * 24 + it) * 6; st[0] = (unsigned)e0; st[1] = p0; st[2] = __float_as_uint(pw0); st[3] = (unsigned)e1; st[4] = p1; st[5] = __float_as_uint(pw1); }
                        ++it; } }
                }
            }
        }
    }
    if (moe) {
        __syncthreads();
        if (C.tid < 8) lcnt[8 + C.tid] = __hip_atomic_fetch_add((unsigned*)(ws + WS_CTL) + CW_CNT + 64 * C.tid, lcnt[C.tid], __ATOMIC_RELAXED, __HIP_MEMORY_SCOPE_AGENT);
        __syncthreads();
        if (lane == 0) { int i2 = 0; int* elist = (int*)(ws + WS_ELIST); unsigned* asgw = (unsigned*)(ws + WS_ASG);
            for (int set = 0; set < 2; ++set)
                for (int i0 = gw; i0 < SEQ; i0 += NGW * NR)
                    for (int k = 0; k < NR; ++k) { const int ri = i0 + NGW * k; if (ri < SEQ) { const int row = set * SEQ + ri; const LAS unsigned* st = stage + (C.wave * 24 + i2) * 6; ++i2;
                        const unsigned e0 = st[0], p0 = st[1] + lcnt[8 + e0], e1 = st[3], p1 = st[4] + lcnt[8 + e1];
                        elist[e0 * M_LAT + p0] = row; elist[e1 * M_LAT + p1] = row;
                        unsigned* a = asgw + (size_t)row * 8; a[0] = e0; a[1] = p0; a[2] = st[2]; a[3] = e1; a[4] = p1; a[5] = st[5]; } } }
    }
}

constexpr int AT_S = 144;
__device__ __forceinline__ int crow(int r, int h) { return (r & 3) + 8 * (r >> 2) + 4 * h; }
__device__ __forceinline__ void phase_attention(const Ctx& C0, int l, bool with_ctx_q) {
    const Ctx C = opaque(C0);
    const bf16_t* Q = (const bf16_t*)(WS_ + WS_Q); const bf16_t* KV = (const bf16_t*)(WS_ + WS_KV); bf16_t* AO = (bf16_t*)(WS_ + WS_ATT);
    int lane_ = C.lane; asm volatile("" : "+v"(lane_)); const int lane = lane_, w = C.wave, r32 = lane & 31, hh = lane >> 5, qq = (lane & 15) >> 2, pp = lane & 3, blk = (lane >> 4) & 1;
    const int nunits = 1024 + (with_ctx_q ? 16 : 0); const float* sinks = IN_(11) + l * 8;
    for (int unit = C.vcu; unit < nunits; unit += C.G) {
        int b, head, hkv, qrowbase, q0, lo, nloc;
        if (unit < 1024) { const int g = unit & 3, qb = (unit >> 2) & 63; hkv = (unit >> 8) & 1; b = unit >> 9; head = hkv * 4 + g; q0 = qb * 256; qrowbase = b * SEQ + q0;
            lo = q0 - 128 < 0 ? 0 : q0 - 128; const int hi = q0 + 384 > SEQ ? SEQ : q0 + 384; nloc = (hi - lo) >> 6; }
        else { const int x = unit - 1024; b = x >> 3; head = x & 7; hkv = head >> 2; q0 = 0; lo = 0; nloc = 0; qrowbase = M_LAT + b * CTXL; }
        const int ntiles = nloc + 4, qw = q0 + 32 * w;
        bf16x8 qf[4];
        { const bf16_t* qp = Q + (size_t)(qrowbase + 32 * w + r32) * 512 + head * 64 + 8 * hh;
#pragma unroll
          for (int s = 0; s < 4; ++s) qf[s] = *(const GAS bf16x8*)(qp + 16 * s); }
        float m_run = sinks[head] * LOG2E, l_run = hh == 0 ? 1.0f : 0.0f;
        f32x16 o0, o1;
#pragma unroll
        for (int i = 0; i < 16; ++i) { o0[i] = 0.f; o1[i] = 0.f; }
        const int lrow = C.tid >> 3, lch = C.tid & 7;
        u32x4 kx, vx;
        { const int krow0 = nloc > 0 ? b * SEQ + lo : M_LAT + b * CTXL; const bf16_t* src = KV + (size_t)(krow0 + lrow) * 256 + hkv * 64 + lch * 8;
          kx = *(const GAS u32x4*)src; vx = *(const GAS u32x4*)(src + 128); }
        for (int t = 0; t < ntiles; ++t) {
            const bool local = t < nloc; const int kpos = lo + 64 * t;
            LAS unsigned char* Kt = C.lds + (t & 1) * (128 * AT_S); LAS unsigned char* Vt = Kt + 64 * AT_S;
            *(LAS u32x4*)(Kt + lrow * AT_S + lch * 16) = kx; *(LAS u32x4*)(Vt + lrow * AT_S + lch * 16) = vx;
            __syncthreads();
            if (t + 1 < ntiles) { const int t1 = t + 1; const int krow1 = t1 < nloc ? b * SEQ + lo + 64 * t1 : M_LAT + b * CTXL + 64 * (t1 - nloc);
                const bf16_t* src = KV + (size_t)(krow1 + lrow) * 256 + hkv * 64 + lch * 8; kx = *(const GAS u32x4*)src; vx = *(const GAS u32x4*)(src + 128); }
            const bool relevant = !local || (kpos + 63 >= qw - 128 && kpos <= qw + 31 + 128);
            if (relevant) {
                f32x16 p0, p1;
#pragma unroll
                for (int i = 0; i < 16; ++i) { p0[i] = 0.f; p1[i] = 0.f; }
#pragma unroll
                for (int s = 0; s < 4; ++s) {
                    const bf16x8 k0 = *(const LAS bf16x8*)(Kt + r32 * AT_S + (16 * s + 8 * hh) * 2), k1 = *(const LAS bf16x8*)(Kt + (32 + r32) * AT_S + (16 * s + 8 * hh) * 2);
                    p0 = __builtin_amdgcn_mfma_f32_32x32x16_bf16(k0, qf[s], p0, 0, 0, 0); p1 = __builtin_amdgcn_mfma_f32_32x32x16_bf16(k1, qf[s], p1, 0, 0, 0);
                }
                if (local) { const int qpos = qw + r32;
#pragma unroll
                    for (int i = 0; i < 16; ++i) { const int d0 = kpos + crow(i, hh) - qpos, d1 = d0 + 32;
                        if (d0 > 128 || d0 < -128) p0[i] = -INFINITY; if (d1 > 128 || d1 < -128) p1[i] = -INFINITY; } }
                float mt = fmaxf(p0[0], p1[0]);
#pragma unroll
                for (int i = 1; i < 16; ++i) mt = fmaxf(mt, fmaxf(p0[i], p1[i]));
                mt = half_max(mt);
                const float mn = fmaxf(m_run, mt), alpha = __builtin_amdgcn_exp2f(m_run - mn); m_run = mn;
                float ls = 0.f;
#pragma unroll
                for (int i = 0; i < 16; ++i) { p0[i] = __builtin_amdgcn_exp2f(p0[i] - mn); p1[i] = __builtin_amdgcn_exp2f(p1[i] - mn); ls += p0[i] + p1[i]; }
                l_run = l_run * alpha + ls;
#pragma unroll
                for (int i = 0; i < 16; ++i) { o0[i] *= alpha; o1[i] *= alpha; }
#pragma unroll
                for (int kb = 0; kb < 2; ++kb)
#pragma unroll
                    for (int s2 = 0; s2 < 2; ++s2) {
                        u32x4 pw;
                        if (kb == 0) { pw.x = pk2(p0[8 * s2 + 0], p0[8 * s2 + 1]); pw.y = pk2(p0[8 * s2 + 2], p0[8 * s2 + 3]); pw.z = pk2(p0[8 * s2 + 4], p0[8 * s2 + 5]); pw.w = pk2(p0[8 * s2 + 6], p0[8 * s2 + 7]); }
                        else { pw.x = pk2(p1[8 * s2 + 0], p1[8 * s2 + 1]); pw.y = pk2(p1[8 * s2 + 2], p1[8 * s2 + 3]); pw.z = pk2(p1[8 * s2 + 4], p1[8 * s2 + 5]); pw.w = pk2(p1[8 * s2 + 6], p1[8 * s2 + 7]); }
                        const bf16x8 pb = __builtin_bit_cast(bf16x8, pw);
                        const int kbase = 32 * kb + 16 * s2 + 4 * hh + qq;
#pragma unroll
                        for (int c = 0; c < 2; ++c) {
                            const LAS unsigned char* va = Vt + kbase * AT_S + (32 * c + 16 * blk + 4 * pp) * 2;
                            const s16x4 vlo = __builtin_amdgcn_ds_read_tr16_b64_v4i16((LAS s16x4*)va), vhi = __builtin_amdgcn_ds_read_tr16_b64_v4i16((LAS s16x4*)(va + 8 * AT_S));
                            const bf16x8 vf = __builtin_shufflevector(vlo, vhi, 0, 1, 2, 3, 4, 5, 6, 7);
                            if (c == 0) o0 = __builtin_amdgcn_mfma_f32_32x32x16_bf16(vf, pb, o0, 0, 0, 0); else o1 = __builtin_amdgcn_mfma_f32_32x32x16_bf16(vf, pb, o1, 0, 0, 0);
                        }
                    }
            }
        }
        const float linv = 1.0f / half_sum(l_run);
        bf16_t* op = AO + (size_t)(qrowbase + 32 * w + r32) * 512 + head * 64 + 4 * hh;
#pragma unroll
        for (int g = 0; g < 4; ++g) {
            u32x2 a, c2; a.x = pk2(o0[4 * g] * linv, o0[4 * g + 1] * linv); a.y = pk2(o0[4 * g + 2] * linv, o0[4 * g + 3] * linv);
            c2.x = pk2(o1[4 * g] * linv, o1[4 * g + 1] * linv); c2.y = pk2(o1[4 * g + 2] * linv, o1[4 * g + 3] * linv);
            *(GAS u32x2*)(op + 8 * g) = a; *(GAS u32x2*)(op + 32 + 8 * g) = c2; }
        __syncthreads();
    }
}

constexpr int FT_S = 144, FT_TILE = 256 * FT_S;
__device__ __forceinline__ float quad_swap1(float v) { return __int_as_float(__builtin_amdgcn_mov_dpp(__float_as_int(v), 0xB1, 0xF, 0xF, true)); }
template <int STAGE> __device__ __forceinline__ void phase_fft(const Ctx& C0) {
    const Ctx C = opaque(C0);
    unsigned char* const ws = WS_;
    const bf16_t* const SRC = (const bf16_t*)(ws + (STAGE == 1 ? WS_FAB : WS_HN)); const bf16_t* const GM = (const bf16_t*)(ws + (STAGE == 1 ? WS_G1 : WS_G2)); const float* const TW = (const float*)(ws + WS_TW);
    bf16_t* const DST = (bf16_t*)(ws + (STAGE == 1 ? WS_HN : WS_FAB));
    const int lane = C.lane, w = C.wave, r32 = lane & 31, hh = lane >> 5, qq = (lane & 15) >> 2, pp = lane & 3, blk = (lane >> 4) & 1;
    const int mrow = STAGE == 1 ? 32 * w + r32 : 32 * (w & 3) + r32;
    bf16x8 gf[16];
#pragma unroll
    for (int s = 0; s < 16; ++s) gf[s] = *(const GAS bf16x8*)(GM + (size_t)mrow * 256 + 16 * s + 8 * hh);
    u32x4 pf[4];
#define FFT_LOAD(unit_) do { const int b_ = (unit_) >> 10, q_ = ((unit_) >> 3) & 127, cb_ = (unit_) & 7; _Pragma("unroll") for (int i = 0; i < 4; ++i) { const int idx = C.tid + NTHREADS * i, k = idx >> 3, ch = idx & 7; \
        const int srow = b_ * SEQ + (STAGE == 1 ? 128 * (k & 127) + q_ : 128 * q_ + (k & 127)); pf[i] = *(const GAS u32x4*)(SRC + (size_t)srow * 1024 + (k >> 7) * 512 + cb_ * 64 + ch * 8); } } while (0)
    for (int unit = C.vcu; unit < 2048; unit += C.G) {
        const int b = unit >> 10, q = (unit >> 3) & 127, cb = unit & 7;
        LAS unsigned char* X = C.lds;
        __syncthreads();
        FFT_LOAD(unit);
#pragma unroll
        for (int i = 0; i < 4; ++i) { const int idx = C.tid + NTHREADS * i, k = idx >> 3, ch = idx & 7; *(LAS u32x4*)(X + k * FT_S + ch * 16) = pf[i]; }
        __syncthreads();
        if (STAGE == 1) {
            const int k1 = mrow >> 1, part = mrow & 1; const f32x2 tw = *(const GAS f32x2*)(TW + 2 * (q * 128 + k1)); const float tc = tw.x, ts = part ? -tw.y : tw.y;
            bf16_t* const drow = DST + (size_t)(b * SEQ + 128 * k1 + q) * 1024 + part * 512 + cb * 64 + 4 * hh;
#pragma unroll
            for (int cbk = 0; cbk < 2; ++cbk) {
                f32x16 acc;
#pragma unroll
                for (int i = 0; i < 16; ++i) acc[i] = 0.f;
#pragma unroll
                for (int s = 0; s < 16; ++s) {
                    const LAS unsigned char* xa = X + (16 * s + 8 * hh + qq) * FT_S + (32 * cbk + 16 * blk + 4 * pp) * 2;
                    const s16x4 lo = __builtin_amdgcn_ds_read_tr16_b64_v4i16((LAS s16x4*)xa), hi = __builtin_amdgcn_ds_read_tr16_b64_v4i16((LAS s16x4*)(xa + 4 * FT_S));
                    acc = __builtin_amdgcn_mfma_f32_32x32x16_bf16(__builtin_shufflevector(lo, hi, 0, 1, 2, 3, 4, 5, 6, 7), gf[s], acc, 0, 0, 0);
                }
#pragma unroll
                for (int g = 0; g < 4; ++g) { float o[4];
#pragma unroll
                    for (int j = 0; j < 4; ++j) { const float own = acc[4 * g + j]; o[j] = own * tc + lane_xor<1>(own) * ts; }
                    u32x2 wv; wv.x = pk2(o[0], o[1]); wv.y = pk2(o[2], o[3]); *(GAS u32x2*)(drow + 32 * cbk + 8 * g) = wv; }
            }
        } else {
            const int cbk = w >> 2;
            f32x16 acc;
#pragma unroll
            for (int i = 0; i < 16; ++i) acc[i] = 0.f;
#pragma unroll
            for (int s = 0; s < 16; ++s) {
                const LAS unsigned char* xa = X + (16 * s + 8 * hh + qq) * FT_S + (32 * cbk + 16 * blk + 4 * pp) * 2;
                const s16x4 lo = __builtin_amdgcn_ds_read_tr16_b64_v4i16((LAS s16x4*)xa), hi = __builtin_amdgcn_ds_read_tr16_b64_v4i16((LAS s16x4*)(xa + 4 * FT_S));
                acc = __builtin_amdgcn_mfma_f32_32x32x16_bf16(__builtin_shufflevector(lo, hi, 0, 1, 2, 3, 4, 5, 6, 7), gf[s], acc, 0, 0, 0);
            }
            bf16_t* const drow = DST + (size_t)(b * SEQ + q + 128 * mrow) * 512 + cb * 64 + 32 * cbk + 4 * hh;
#pragma unroll
            for (int g = 0; g < 4; ++g) { u32x2 wv; wv.x = pk2(acc[4 * g], acc[4 * g + 1]); wv.y = pk2(acc[4 * g + 2], acc[4 * g + 3]); *(GAS u32x2*)(drow + 8 * g) = wv; }
        }
    }
#undef FFT_LOAD
    __syncthreads();
}
__device__ __forceinline__ void phase_ctx_dft(const Ctx& C0) {
    const Ctx C = opaque(C0);
    unsigned char* const ws = WS_;
    const bf16_t* const FAB = (const bf16_t*)(ws + WS_FAB); const bf16_t* const G3 = (const bf16_t*)(ws + WS_G3); bf16_t* const FN = (bf16_t*)(ws + WS_FAB);
    const int lane = C.lane, w = C.wave, r32 = lane & 31, hh = lane >> 5, qq = (lane & 15) >> 2, pp = lane & 3, blk = (lane >> 4) & 1, mrow = 32 * w + r32;
    LAS unsigned char* const X = C.lds;
    for (int unit = C.vcu; unit < 16; unit += C.G) {
        const int b = unit >> 3, cb = unit & 7;
        f32x16 acc0, acc1;
#pragma unroll
        for (int i = 0; i < 16; ++i) { acc0[i] = 0.f; acc1[i] = 0.f; }
#pragma unroll 1
        for (int h = 0; h < 2; ++h) {
            bf16x8 gf[16];
#pragma unroll
            for (int s = 0; s < 16; ++s) gf[s] = *(const GAS bf16x8*)(G3 + (size_t)mrow * 512 + h * 256 + 16 * s + 8 * hh);
            __syncthreads();
#pragma unroll
            for (int i = 0; i < 4; ++i) { const int idx = C.tid + NTHREADS * i, k = idx >> 3, ch = idx & 7;
                *(LAS u32x4*)(X + k * FT_S + ch * 16) = *(const GAS u32x4*)(FAB + (size_t)(M_LAT + b * CTXL + k) * 1024 + h * 512 + cb * 64 + ch * 8); }
            __syncthreads();
#pragma unroll
            for (int s = 0; s < 16; ++s) {
                const LAS unsigned char* xa = X + (16 * s + 8 * hh + qq) * FT_S + (16 * blk + 4 * pp) * 2;
                const s16x4 lo0 = __builtin_amdgcn_ds_read_tr16_b64_v4i16((LAS s16x4*)xa), hi0 = __builtin_amdgcn_ds_read_tr16_b64_v4i16((LAS s16x4*)(xa + 4 * FT_S));
                const s16x4 lo1 = __builtin_amdgcn_ds_read_tr16_b64_v4i16((LAS s16x4*)(xa + 64)), hi1 = __builtin_amdgcn_ds_read_tr16_b64_v4i16((LAS s16x4*)(xa + 64 + 4 * FT_S));
                acc0 = __builtin_amdgcn_mfma_f32_32x32x16_bf16(__builtin_shufflevector(lo0, hi0, 0, 1, 2, 3, 4, 5, 6, 7), gf[s], acc0, 0, 0, 0);
                acc1 = __builtin_amdgcn_mfma_f32_32x32x16_bf16(__builtin_shufflevector(lo1, hi1, 0, 1, 2, 3, 4, 5, 6, 7), gf[s], acc1, 0, 0, 0);
            }
        }
        bf16_t* const drow = FN + (size_t)(M_LAT + b * CTXL + mrow) * 512 + cb * 64 + 4 * hh;
#pragma unroll
        for (int g = 0; g < 4; ++g) { u32x2 wv; wv.x = pk2(acc0[4 * g], acc0[4 * g + 1]); wv.y = pk2(acc0[4 * g + 2], acc0[4 * g + 3]); *(GAS u32x2*)(drow + 8 * g) = wv;
            wv.x = pk2(acc1[4 * g], acc1[4 * g + 1]); wv.y = pk2(acc1[4 * g + 2], acc1[4 * g + 3]); *(GAS u32x2*)(drow + 32 + 8 * g) = wv; }
    }
    __syncthreads();
}
__device__ __forceinline__ void unpack8(const u32x4 w, float (&f)[8]) { f[0] = bflo(w.x); f[1] = bfhi(w.x); f[2] = bflo(w.y); f[3] = bfhi(w.y); f[4] = bflo(w.z); f[5] = bfhi(w.z); f[6] = bflo(w.w); f[7] = bfhi(w.w); }
__device__ __forceinline__ void phase_conv(const Ctx& C0, int l, int nrows) {
    const Ctx C = opaque(C0);
    const bf16_t* CIN = (const bf16_t*)(WS_ + WS_CIN); bf16_t* CO = (bf16_t*)(WS_ + WS_COUT); const float* wc = IN_(12) + l * 3 * 512;
    for (int it = C.vcu * NTHREADS + C.tid; it < nrows * 64; it += C.G * NTHREADS) {
        const int row = it >> 6, c0 = (it & 63) * 8; const bool lat = row < M_LAT;
        const int s = lat ? (row & (SEQ - 1)) : ((row - M_LAT) & (CTXL - 1)), last = lat ? SEQ - 1 : CTXL - 1;
        const bf16_t* p = CIN + (size_t)row * 1536 + c0;
        float xm[8], cm[8], x0[8], cc0[8], xp[8], cp[8], bb[8];
        const u32x4 z = (u32x4){0u, 0u, 0u, 0u};
        unpack8(s > 0 ? *(const GAS u32x4*)(p - 1536) : z, xm); unpack8(s > 0 ? *(const GAS u32x4*)(p - 1536 + 1024) : z, cm);
        unpack8(*(const GAS u32x4*)p, x0); unpack8(*(const GAS u32x4*)(p + 1024), cc0); unpack8(*(const GAS u32x4*)(p + 512), bb);
        unpack8(s < last ? *(const GAS u32x4*)(p + 1536) : z, xp); unpack8(s < last ? *(const GAS u32x4*)(p + 1536 + 1024) : z, cp);
        float y[8];
#pragma unroll
        for (int j = 0; j < 8; ++j) y[j] = bb[j] * (xm[j] * cm[j] * wc[c0 + j] + x0[j] * cc0[j] * wc[512 + c0 + j] + xp[j] * cp[j] * wc[1024 + c0 + j]);
        u32x4 o; o.x = pk2(y[0], y[1]); o.y = pk2(y[2], y[3]); o.z = pk2(y[4], y[5]); o.w = pk2(y[6], y[7]);
        *(GAS u32x4*)(CO + (size_t)row * 512 + c0) = o;
    }
}
__device__ __forceinline__ void phase_moe_gather(const Ctx& C0, int chunk, int ntiles) {
    const Ctx C = opaque(C0);
    const unsigned char* HN = WS_ + WS_HN; unsigned char* H2G = WS_ + WS_H2G; const int* EL = (const int*)(WS_ + WS_ELIST);
    const LAS int* tbl = (const LAS int*)(C.lds + MISC_OFF) + 16;
    const int gw = C.vcu * NWAVES + C.wave, NGW = C.G * NWAVES;
    for (int rl = gw; rl < CHUNK_ROWS; rl += NGW) {
        const int R = chunk * CHUNK_TILES * 256 + rl, t = R >> 8; if (t >= ntiles) break;
        int e = 0;
#pragma unroll
        for (int k = 1; k < 8; ++k) e += (t >= tbl[k]) ? 1 : 0;
        const int pos = R - tbl[e] * 256, ce = tbl[8 + e];
        u32x4 v0 = (u32x4){0u, 0u, 0u, 0u};
        if (pos < ce) { const int tok = EL[e * M_LAT + pos]; v0 = *(const GAS u32x4*)(HN + (size_t)tok * D + C.lane * 16); }
        *(GAS u32x4*)(H2G + (size_t)rl * D + C.lane * 16) = v0;
    }
}

#ifndef REP_PRO
#define REP_PRO 1
#endif
#ifndef REP_GEMM
#define REP_GEMM 1
#endif
#ifndef REP_ATT
#define REP_ATT 1
#endif
#ifndef REP_F1
#define REP_F1 1
#endif
#ifndef REP_F2
#define REP_F2 1
#endif
#ifndef REP_CV
#define REP_CV 1
#endif
#ifndef REP_CD
#define REP_CD 1
#endif
#ifndef REP_AUX
#define REP_AUX 1
#endif
#define REPEAT(N) for (int rep_ = 0; rep_ < (N); ++rep_)
#ifndef STAGGER_TICKS
#define STAGGER_TICKS 0
#endif
#define STAG(bid) ((((bid) >> 3) & 1) ? STAGGER_TICKS : 0)
__global__ void __launch_bounds__(NTHREADS, 2) dit_fwd(Params P) {
    extern __shared__ __attribute__((aligned(16))) unsigned char lds_raw[];
    Ctx C;
    C.lds = (LAS unsigned char*)lds_raw;
    C.wave = __builtin_amdgcn_readfirstlane((int)threadIdx.x >> 6); C.lane = 0; C.tid = 0;
    C.G = gridDim.x; { const int bx = blockIdx.x; C.vcu = (C.G % 8 == 0) ? (bx % 8) * (C.G / 8) + bx / 8 : bx; }
    volatile LAS unsigned* MISC = (volatile LAS unsigned*)(C.lds + MISC_OFF);
    if (threadIdx.x < 32) MISC[threadIdx.x] = 0u;
    __syncthreads();
    (void)xcd_barrier_post((unsigned*)(WS_ + WS_CTL) + CW_BAR, MISC + 8);
#define GRID_BAR() do { XcdBarrier b_; b_.bar = (unsigned*)(WS_ + WS_CTL) + CW_BAR; b_.x = xb_xcc_id(); b_.st = (volatile LAS unsigned*)(C.lds + MISC_OFF) + 8; xcd_barrier(b_); } while (0)
    LAS unsigned char* ring = C.lds;
    const int bid = (int)blockIdx.x;

    REPEAT(REP_PRO) p0_prologue(C, 0);
    GRID_BAR();
    p0_prologue(C, 1);
    GRID_BAR();
    REPEAT(REP_AUX) phase_norm<0>(C, 0);
    GRID_BAR();

    for (int l = 0; l < 2; ++l) {
        const int nM = (l == 0) ? MT / 256 : M_LAT / 256;
        REPEAT(REP_GEMM) {
            unsigned char* ws = WS_;
            pg8::Gemm g{(const bf16_t*)(ws + WS_HN), (const bf16_t*)(ws + WS_WIN + l * WIN_BYTES), MT, ZN, D, 0, 0, 0, 0, (const float*)(ws + WS_RS), (const float*)(ws + WS_CS) + l * ZN};
            pg8::RectOrder S; if (l == 0) S.init(MT / 256, ZN / 256, C.G, bid); else S.init(M_LAT / 256, ZN / 256, C.G, bid, 0, 2, M_LAT / 256, 2);
            pg8::EpiIn E{ws, WS_Q, WS_KV, WS_FAB, WS_CIN, WS_GT, WS_ROPE, QSCALE};
            pg8::gemm_phase<pg8::EpiIn, pg8::RectOrder, true, true, 2>(ring, g, S, E, C.wave, STAG(bid));
        }
        GRID_BAR();
        REPEAT(REP_ATT) phase_attention(C, l, l == 0);
        REPEAT(REP_F1) phase_fft<1>(C);
        REPEAT(REP_CV) phase_conv(C, l, nM * 256);
        GRID_BAR();
        REPEAT(REP_F2) phase_fft<2>(C);
        if (l == 0) REPEAT(REP_CD) phase_ctx_dft(C);
        GRID_BAR();
        REPEAT(REP_GEMM) {
            unsigned char* ws = WS_;
            pg8::RectOrder S; S.init(nM, 4, C.G, bid);
            const bf16_t* WY = (const bf16_t*)(ws + WS_WY) + (size_t)l * 3 * 1024 * 512; bf16_t* HN = (bf16_t*)(ws + WS_HN);
            { pg8::Gemm g{(const bf16_t*)(ws + WS_ATT), WY, MT, D, 512}; pg8::EpiMerge<true> E{HN, (const bf16_t*)(ws + WS_GT), 0};
              pg8::gemm_phase<pg8::EpiMerge<true>, pg8::RectOrder, true, true>(ring, g, S, E, C.wave); }
            { pg8::Gemm g{(const bf16_t*)(ws + WS_FAB), WY + (size_t)1024 * 512, MT, D, 512}; pg8::EpiMerge<false> E{HN, (const bf16_t*)(ws + WS_GT), 1024};
              pg8::gemm_phase<pg8::EpiMerge<false>, pg8::RectOrder, true, true>(ring, g, S, E, C.wave); }
            { pg8::Gemm g{(const bf16_t*)(ws + WS_COUT), WY + (size_t)2 * 1024 * 512, MT, D, 512}; pg8::EpiMerge<false> E{HN, (const bf16_t*)(ws + WS_GT), 2048};
              pg8::gemm_phase<pg8::EpiMerge<false>, pg8::RectOrder, true, true>(ring, g, S, E, C.wave); }
        }
        GRID_BAR();
        REPEAT(REP_GEMM) {
            unsigned char* ws = WS_;
            pg8::Gemm g{(const bf16_t*)(ws + WS_HN), (const bf16_t*)(ws + WS_WO) + (size_t)l * D * D, MT, D, D}; pg8::RectOrder S; S.init(nM, 4, C.G, bid);
            pg8::EpiPlain E{(bf16_t*)(ws + WS_MIX), D, 4, 0, 1.0f};
            pg8::gemm_phase<pg8::EpiPlain, pg8::RectOrder, true, true>(ring, g, S, E, C.wave);
        }
        GRID_BAR();
        if (l == 1) REPEAT(REP_AUX) phase_expert_convert(C);
        if (l == 0) phase_norm<1>(C, 0); else phase_norm<4>(C, 1);
        GRID_BAR();
        if (l == 0) {
            REPEAT(REP_GEMM) { unsigned char* ws = WS_;
              pg8::Gemm g{(const bf16_t*)(ws + WS_HN), (const bf16_t*)(ws + WS_WFF_UP), MT, 2 * DFF, D, 0, 0, 0, 0, (const float*)(ws + WS_RS), (const float*)(ws + WS_CS) + 2 * ZN}; pg8::RectOrder S; S.init(nM, 2 * DFF / 256, C.G, bid);
              pg8::EpiSwiglu<false> E{(void*)(ws + WS_HID0), DFF, 2 * DFF / 256, 1.0f};
              pg8::gemm_phase<pg8::EpiSwiglu<false>, pg8::RectOrder, true, true, 2>(ring, g, S, E, C.wave, STAG(bid)); }
            GRID_BAR();
            REPEAT(REP_GEMM) { unsigned char* ws = WS_;
              pg8::Gemm g{(const bf16_t*)(ws + WS_HID0), (const bf16_t*)(ws + WS_WFF_DN), MT, D, DFF}; pg8::RectOrder S; S.init(nM, 4, C.G, bid);
              pg8::EpiPlain E{(bf16_t*)(ws + WS_F0), D, 4, 0, 1.0f};
              pg8::gemm_phase<pg8::EpiPlain, pg8::RectOrder, true, true>(ring, g, S, E, C.wave); }
            GRID_BAR();
        } else {
            if (threadIdx.x == 0) { const unsigned* ctl = (const unsigned*)(WS_ + WS_CTL); unsigned tb = 0u;
                for (int e = 0; e < 8; ++e) { const unsigned c = __hip_atomic_load(ctl + CW_CNT + 64 * e, __ATOMIC_RELAXED, __HIP_MEMORY_SCOPE_AGENT); MISC[16 + e] = tb; MISC[24 + e] = c; tb += (c + 255u) >> 8; } }
            __syncthreads();
            const int T = __builtin_amdgcn_readfirstlane((int)(MISC[23] + ((MISC[31] + 255u) >> 8))), nchunks = T > CHUNK_TILES ? 2 : 1;
            const LAS int* tbl = (const LAS int*)(C.lds + MISC_OFF) + 16;
            for (int ch = 0; ch < nchunks; ++ch) {
                const int tc = ch == 0 ? (T < CHUNK_TILES ? T : CHUNK_TILES) : T - CHUNK_TILES;
                REPEAT(REP_AUX) phase_moe_gather(C, ch, T);
                GRID_BAR();
                REPEAT(REP_GEMM) { unsigned char* ws = WS_;
                  pg8::Gemm g{(const bf16_t*)(ws + WS_H2G), (const bf16_t*)(ws + WS_EXUP), CHUNK_ROWS, 8 * 7168, D};
                  pg8::MoeOrder S{tc, 28, ch * CHUNK_TILES, C.G, bid, tbl};
                  pg8::EpiSwiglu<true> E{(void*)(ws + WS_HIDX), DEXP, 28, 1.0f / WSCALE8};
                  pg8::gemm_phase<pg8::EpiSwiglu<true>, pg8::MoeOrder, true, true, true>(ring, g, S, E, C.wave, STAG(bid)); }
                GRID_BAR();
                REPEAT(REP_GEMM) { unsigned char* ws = WS_;
                  pg8::Gemm g{(const bf16_t*)(ws + WS_HIDX), (const bf16_t*)(ws + WS_EXDN), CHUNK_ROWS, 8 * 1024, DEXP};
                  pg8::MoeOrder S{tc, 4, ch * CHUNK_TILES, C.G, bid, tbl};
                  pg8::EpiPlain E{(bf16_t*)(ws + WS_YEXP), D, 4, ch * CHUNK_TILES * 256, 1.0f / WSCALE8};
                  pg8::gemm_phase<pg8::EpiPlain, pg8::MoeOrder, true, true, true>(ring, g, S, E, C.wave); }
                GRID_BAR();
            }
        }
        if (l == 0) phase_norm<2>(C, 0); else phase_norm<3>(C, 1);
        if (l == 0) GRID_BAR();
    }
#undef GRID_BAR
}

extern "C" void kernel_launch(void* const* d_in, const int* in_sizes, int n_in, void* d_out, int out_size, void* d_ws, size_t ws_size, hipStream_t stream) {
    static int grid = 0;
    if (grid == 0) {
        if (n_in != 25 || in_sizes[0] != M_LAT * D || out_size != M_LAT * D || ws_size < WS_NEED) {
            fprintf(stderr, "kernel_launch: built for 25 inputs, x/out of %d floats, >= %zu bytes of workspace; got n_in %d, in0 %d, out %d, ws %zu; nothing launched\n", M_LAT * D, (size_t)WS_NEED, n_in, n_in > 0 ? in_sizes[0] : -1, out_size, ws_size);
            grid = -1; return; }
        int dev = 0, cus = 0, per_cu = 0;
        if (hipGetDevice(&dev) != hipSuccess || hipDeviceGetAttribute(&cus, hipDeviceAttributeMultiprocessorCount, dev) != hipSuccess) { fprintf(stderr, "kernel_launch: device query failed\n"); grid = -1; return; }
        if (hipFuncSetAttribute((const void*)dit_fwd, hipFuncAttributeMaxDynamicSharedMemorySize, LDS_BYTES) != hipSuccess) { fprintf(stderr, "kernel_launch: hipFuncSetAttribute failed\n"); grid = -1; return; }
        if (hipOccupancyMaxActiveBlocksPerMultiprocessor(&per_cu, (const void*)dit_fwd, NTHREADS, LDS_BYTES) != hipSuccess || per_cu < 1) { fprintf(stderr, "kernel_launch: occupancy query says %d workgroups per CU; nothing launched\n", per_cu); (void)hipGetLastError(); grid = -1; return; }
        (void)hipGetLastError();
        grid = cus;
        if (grid < 192 || grid > 304) { fprintf(stderr, "kernel_launch: unexpected CU count %d\n", cus); grid = -1; return; }
    }
    if (grid < 0) return;
    if (hipMemsetAsync((char*)d_ws + WS_CTL, 0, CTL_BYTES, stream) != hipSuccess) { fprintf(stderr, "kernel_launch: memset failed\n"); return; }
    Params p{};
    for (int i = 0; i < 25; ++i) p.in[i] = (const float*)d_in[i];
    p.out = (float*)d_out; p.ws = (unsigned char*)d_ws;
    hipLaunchKernelGGL(dit_fwd, dim3(grid), dim3(NTHREADS), LDS_BYTES, stream, p);
    const hipError_t le = hipPeekAtLastError();
    if (le != hipSuccess) fprintf(stderr, "kernel_launch: launch failed: %s\n", hipGetErrorName(le));
}
```

```cpp
#include <hip/hip_runtime.h>
#include <cstdio>
#include <cstdint>
#include <cmath>
namespace pg8 {
#define PG8_LAS __attribute__((address_space(3)))
typedef unsigned short bf16_t;
typedef short bf16x8 __attribute__((ext_vector_type(8)));
typedef float f32x4 __attribute__((ext_vector_type(4)));
typedef unsigned u32x4 __attribute__((ext_vector_type(4)));
constexpr int BM = 256, BK = 64, HALF = 128, HTB = HALF * BK * 2  , STAGE_BYTES = 8 * HTB, NXCD = 8, WGM = 8;

__host__ __device__ __forceinline__ int lds_byte(int r, int c) { const int st = (r >> 4) * 2 + (c >> 5), rr = r & 15, cc = c & 31, ob = rr * 64 + cc * 2; return st * 1024 + (ob ^ (((ob >> 9) & 1) << 5)); }
__host__ __device__ __forceinline__ void stage_rc(int b, int& R, int& C) { const int st = b / 1024, sb = b % 1024, swz = sb ^ (((sb >> 9) & 1) << 5); R = (st >> 1) * 16 + swz / 64; C = (st & 1) * 32 + (swz % 64) / 2; }
__host__ __device__ __forceinline__ int perm32(int rho) { const int n = rho >> 4, i = rho & 15; return 8 * (i >> 2) + 4 * n + (i & 3); }

struct Unit { int pm, pn; };
struct Gemm { const bf16_t* A; const bf16_t* Bt; int M, N, K; int ld = 0; long A1off = 0, A2off = 0, Bseg = 0; const float* rs = nullptr; const float* cs = nullptr; };

struct StaticOrder {
    int nM, nN, nwg, G, c;
    __host__ __device__ void init(int M, int N, int G_, int c_) { nM = M / BM; nN = N / BM; nwg = nM * nN; G = G_; c = c_; }
    __host__ __device__ bool next(int i, Unit& u) const {
        const long L = (long)i * G + c; if (L >= nwg) return false;
        int wgid = (int)L; { const int q = nwg / NXCD, r = nwg % NXCD, xcd = wgid % NXCD, off = wgid / NXCD; wgid = (xcd < r ? xcd * (q + 1) : r * (q + 1) + (xcd - r) * q) + off; }
        const int nig = WGM * nN, gid = wgid / nig, fm = gid * WGM, gsz = (nM - fm) < WGM ? (nM - fm) : WGM;
        u.pm = fm + ((wgid % nig) % gsz); u.pn = (wgid % nig) / gsz; return true;
    }
    __device__ __forceinline__ void a_ready(const Unit&) const {}
    __device__ __forceinline__ void done(const Unit&) const {}
};

__device__ __forceinline__ unsigned cvt_pk_bf16(float lo, float hi) { unsigned r; asm volatile("v_cvt_pk_bf16_f32 %0, %1, %2" : "=v"(r) : "v"(lo), "v"(hi)); return r; }
struct RectOrder {
    int nM, nN, nwg, G, c, pm0, ne, epm0, epn;
    __device__ __forceinline__ void init(int nM_, int nN_, int G_, int c_, int pm0_ = 0, int ne_ = 0, int epm0_ = 0, int epn_ = 0) { nM = nM_; nN = nN_; nwg = nM * nN; G = G_; c = c_; pm0 = pm0_; ne = ne_; epm0 = epm0_; epn = epn_; }
    __device__ __forceinline__ bool next(int i, Unit& u) const {
        const long L = (long)i * G + c;
        if (L >= nwg) { const long x = L - nwg; if (x >= ne) return false; u.pm = epm0 + (int)x; u.pn = epn; return true; }
        int wgid = (int)L; { const int q = nwg / NXCD, r = nwg % NXCD, xcd = wgid % NXCD, off = wgid / NXCD; wgid = (xcd < r ? xcd * (q + 1) : r * (q + 1) + (xcd - r) * q) + off; }
        const int nig = WGM * nN, gid = wgid / nig, fm = gid * WGM, gsz = (nM - fm) < WGM ? (nM - fm) : WGM;
        u.pm = pm0 + fm + ((wgid % nig) % gsz); u.pn = (wgid % nig) / gsz; return true;
    }
    __device__ __forceinline__ void a_ready(const Unit&) const {}
    __device__ __forceinline__ void done(const Unit&) const {}
};
struct MoeOrder {
    int tc, nN, tile0, G, c; const PG8_LAS int* tbl;
    __device__ __forceinline__ bool next(int i, Unit& u) const {
        const int L = i * G + c; if (L >= tc * nN) return false;
        const int j = L / tc, pml = L - j * tc, t = tile0 + pml;
        int e = 0;
#pragma unroll
        for (int k = 1; k < 8; ++k) e += (t >= __builtin_amdgcn_readfirstlane(tbl[k])) ? 1 : 0;
        u.pm = __builtin_amdgcn_readfirstlane(pml); u.pn = __builtin_amdgcn_readfirstlane(e * nN + j); return true;
    }
    __device__ __forceinline__ void a_ready(const Unit&) const {}
    __device__ __forceinline__ void done(const Unit&) const {}
};

__device__ __forceinline__ float bflo(unsigned u) { return __uint_as_float(u << 16); }
__device__ __forceinline__ float bfhi(unsigned u) { return __uint_as_float(u & 0xffff0000u); }
__device__ __forceinline__ float sigm(float x) { return __builtin_amdgcn_rcpf(1.0f + __builtin_amdgcn_exp2f(-1.4426950408889634f * x)); }
__device__ __forceinline__ u32x4 pack8(const f32x4 a, const f32x4 b) { u32x4 w; w.x = cvt_pk_bf16(a[0], a[1]); w.y = cvt_pk_bf16(a[2], a[3]); w.z = cvt_pk_bf16(b[0], b[1]); w.w = cvt_pk_bf16(b[2], b[3]); return w; }

__device__ __forceinline__ unsigned gate4_u8(float a, float b, float c, float d) { return (unsigned)__float2int_rn(a * 255.0f) | ((unsigned)__float2int_rn(b * 255.0f) << 8) | ((unsigned)__float2int_rn(c * 255.0f) << 16) | ((unsigned)__float2int_rn(d * 255.0f) << 24); }
struct EpiPlain {
    static constexpr bool PERM = true, AFTER_DRAIN = false, IDEMPOTENT = true;
    bf16_t* O; int ld, nmod, row_off; float scale;
    __device__ __forceinline__ void operator()(const f32x4 (&acc)[2][2][4][2], const Unit& u, int wr, int wc, int fr, int fq) const {
        const int row0 = row_off + u.pm * BM + wr * 64 + fr, col0 = (u.pn % nmod) * BM + wc * 32 + 8 * fq;
#pragma unroll
        for (int ai = 0; ai < 2; ++ai)
#pragma unroll
            for (int m = 0; m < 4; ++m) { bf16_t* rowp = O + (size_t)(row0 + ai * HALF + m * 16) * ld + col0;
#pragma unroll
                for (int bj = 0; bj < 2; ++bj) *(u32x4*)(rowp + bj * HALF) = pack8(acc[ai][bj][m][0] * scale, acc[ai][bj][m][1] * scale); }
    }
};
template <bool FIRST> struct EpiMerge {
    static constexpr bool PERM = true, AFTER_DRAIN = false, IDEMPOTENT = FIRST;
    bf16_t* MG; const bf16_t* GT; int gcol0;
    __device__ __forceinline__ void operator()(const f32x4 (&acc)[2][2][4][2], const Unit& u, int wr, int wc, int fr, int fq) const {
        const int row0 = u.pm * BM + wr * 64 + fr, col0 = u.pn * BM + wc * 32 + 8 * fq;
#pragma unroll
        for (int ai = 0; ai < 2; ++ai)
#pragma unroll
            for (int m = 0; m < 4; ++m) { const size_t row = (size_t)(row0 + ai * HALF + m * 16);
#pragma unroll
                for (int bj = 0; bj < 2; ++bj) {
                    typedef unsigned u32x2_ __attribute__((ext_vector_type(2))); const u32x2_ g = *(const u32x2_*)((const unsigned char*)GT + row * 3072 + gcol0 + col0 + bj * HALF);
                    f32x4 v0 = acc[ai][bj][m][0], v1 = acc[ai][bj][m][1]; const float q = 1.0f / 255.0f;
                    v0[0] *= (float)(g.x & 255u) * q; v0[1] *= (float)((g.x >> 8) & 255u) * q; v0[2] *= (float)((g.x >> 16) & 255u) * q; v0[3] *= (float)(g.x >> 24) * q;
                    v1[0] *= (float)(g.y & 255u) * q; v1[1] *= (float)((g.y >> 8) & 255u) * q; v1[2] *= (float)((g.y >> 16) & 255u) * q; v1[3] *= (float)(g.y >> 24) * q;
                    bf16_t* dst = MG + row * 1024 + col0 + bj * HALF;
                    if (!FIRST) { const u32x4 o = *(const u32x4*)dst;
                        v0[0] += bflo(o.x); v0[1] += bfhi(o.x); v0[2] += bflo(o.y); v0[3] += bfhi(o.y); v1[0] += bflo(o.z); v1[1] += bfhi(o.z); v1[2] += bflo(o.w); v1[3] += bfhi(o.w); }
                    *(u32x4*)dst = pack8(v0, v1); } }
    }
};
__device__ __forceinline__ float u8f(unsigned w, int i) { return (float)((w >> (8 * i)) & 255u); }
struct EpiHorner {
    static constexpr bool PERM = true, AFTER_DRAIN = false, IDEMPOTENT = true;
    bf16_t* MG; const unsigned char* GT;
    __device__ __forceinline__ void mid(f32x4 (&acc)[2][2][4][2], const Unit& u, int s, int wr, int wc, int fr, int fq) const {
        typedef unsigned u32x2_ __attribute__((ext_vector_type(2)));
        const int row0 = u.pm * BM + wr * 64 + fr, col0 = u.pn * BM + wc * 32 + 8 * fq;
        u32x2_ ga[2][4][2], gb[2][4][2];
#pragma unroll
        for (int ai = 0; ai < 2; ++ai)
#pragma unroll
            for (int m = 0; m < 4; ++m) { const unsigned char* gp = GT + (size_t)(row0 + ai * HALF + m * 16) * 3072 + (s - 1) * 1024 + col0;
#pragma unroll
                for (int bj = 0; bj < 2; ++bj) { ga[ai][m][bj] = *(const u32x2_*)(gp + bj * HALF); gb[ai][m][bj] = *(const u32x2_*)(gp + 1024 + bj * HALF); } }
        asm volatile("" ::: "memory");
#pragma unroll
        for (int ai = 0; ai < 2; ++ai)
#pragma unroll
            for (int m = 0; m < 4; ++m)
#pragma unroll
                for (int bj = 0; bj < 2; ++bj) { const u32x2_ a = ga[ai][m][bj], b = gb[ai][m][bj];
                    f32x4& v0 = acc[ai][bj][m][0]; f32x4& v1 = acc[ai][bj][m][1];
#pragma unroll
                    for (int j = 0; j < 4; ++j) { const float n0 = s == 1 ? u8f(a.x, j) : fmaxf(u8f(a.x, j), 0.5f), n1 = s == 1 ? u8f(a.y, j) : fmaxf(u8f(a.y, j), 0.5f);
                        v0[j] *= n0 * __builtin_amdgcn_rcpf(fmaxf(u8f(b.x, j), 0.5f)); v1[j] *= n1 * __builtin_amdgcn_rcpf(fmaxf(u8f(b.y, j), 0.5f)); } }
    }
    __device__ __forceinline__ void operator()(const f32x4 (&acc)[2][2][4][2], const Unit& u, int wr, int wc, int fr, int fq) const {
        typedef unsigned u32x2_ __attribute__((ext_vector_type(2)));
        const int row0 = u.pm * BM + wr * 64 + fr, col0 = u.pn * BM + wc * 32 + 8 * fq; const float q = 1.0f / 255.0f;
        u32x2_ gg[2][4][2];
#pragma unroll
        for (int ai = 0; ai < 2; ++ai)
#pragma unroll
            for (int m = 0; m < 4; ++m)
#pragma unroll
                for (int bj = 0; bj < 2; ++bj) gg[ai][m][bj] = *(const u32x2_*)(GT + (size_t)(row0 + ai * HALF + m * 16) * 3072 + 2048 + col0 + bj * HALF);
        asm volatile("" ::: "memory");
#pragma unroll
        for (int ai = 0; ai < 2; ++ai)
#pragma unroll
            for (int m = 0; m < 4; ++m) { const size_t row = (size_t)(row0 + ai * HALF + m * 16);
#pragma unroll
                for (int bj = 0; bj < 2; ++bj) { const u32x2_ g = gg[ai][m][bj];
                    f32x4 v0 = acc[ai][bj][m][0], v1 = acc[ai][bj][m][1];
#pragma unroll
                    for (int j = 0; j < 4; ++j) { v0[j] *= fmaxf(u8f(g.x, j), 0.5f) * q; v1[j] *= fmaxf(u8f(g.y, j), 0.5f) * q; }
                    *(u32x4*)(MG + row * 1024 + col0 + bj * HALF) = pack8(v0, v1); } }
    }
};
__device__ __forceinline__ unsigned pack4_fp8(float a, float b, float c, float d) { int p = 0; p = __builtin_amdgcn_cvt_pk_fp8_f32(a, b, p, false); p = __builtin_amdgcn_cvt_pk_fp8_f32(c, d, p, true); return (unsigned)p; }
template <bool F8> struct EpiSwiglu {
    static constexpr bool PERM = true, AFTER_DRAIN = false, IDEMPOTENT = true;
    void* H; int ld, nmod; float scale;
    __device__ __forceinline__ void operator()(const f32x4 (&acc)[2][2][4][2], const Unit& u, int wr, int wc, int fr, int fq) const {
        const int row0 = u.pm * BM + wr * 64 + fr, col0 = (u.pn % nmod) * HALF + wc * 32 + 8 * fq;
#pragma unroll
        for (int ai = 0; ai < 2; ++ai)
#pragma unroll
            for (int m = 0; m < 4; ++m) {
                f32x4 h0, h1;
#pragma unroll
                for (int j = 0; j < 4; ++j) { const float g0 = acc[ai][0][m][0][j] * scale, g1 = acc[ai][0][m][1][j] * scale;
                    h0[j] = g0 * sigm(g0) * (acc[ai][1][m][0][j] * scale); h1[j] = g1 * sigm(g1) * (acc[ai][1][m][1][j] * scale); }
                const size_t off = (size_t)(row0 + ai * HALF + m * 16) * ld + col0;
                if constexpr (F8) { typedef unsigned u32x2_ __attribute__((ext_vector_type(2))); u32x2_ w; w.x = pack4_fp8(h0[0], h0[1], h0[2], h0[3]); w.y = pack4_fp8(h1[0], h1[1], h1[2], h1[3]); *(u32x2_*)((unsigned char*)H + off) = w; }
                else *(u32x4*)((bf16_t*)H + off) = pack8(h0, h1); }
    }
};
struct EpiIn {
    static constexpr bool PERM = true, AFTER_DRAIN = false, IDEMPOTENT = true;
    unsigned char* ws; size_t oQ, oKV, oFAB, oCIN, oGT, oROPE; float qscale;
    __device__ __forceinline__ void operator()(const f32x4 (&acc)[2][2][4][2], const Unit& u, int wr, int wc, int fr, int fq) const {
        const int pn = u.pn, lc0 = wc * 32 + 8 * fq, row0 = u.pm * BM + wr * 64 + fr;
        const bool ctxrow = u.pm >= 128;
        bf16_t* const Q = (bf16_t*)(ws + oQ); bf16_t* const KV = (bf16_t*)(ws + oKV); bf16_t* const FAB = (bf16_t*)(ws + oFAB); bf16_t* const CIN = (bf16_t*)(ws + oCIN); bf16_t* const GT = (bf16_t*)(ws + oGT);
        const float* const rope = (const float*)(ws + oROPE);
#pragma unroll
        for (int bj = 0; bj < 2; ++bj) {
            const int cc = bj * HALF + lc0;
            int mode, ld, dcol; bf16_t* dst;
            if (pn < 2) { mode = 2; dst = Q; ld = 512; dcol = pn * 256 + cc; }
            else if (pn == 2) { dst = KV; ld = 256; dcol = cc; mode = (bj == 0) ? 3 : 0; }
            else if (pn < 7) { mode = 0; dst = FAB; ld = 1024; dcol = (pn - 3) * 256 + cc; }
            else if (pn < 13) { mode = 0; dst = CIN; ld = 1536; dcol = (pn - 7) * 256 + cc; }
            else { mode = 1; dst = GT; ld = 3072; dcol = (pn - 13) * 256 + cc; }
            if (mode == 0) {
#pragma unroll
                for (int ai = 0; ai < 2; ++ai)
#pragma unroll
                    for (int m = 0; m < 4; ++m) *(u32x4*)(dst + (size_t)(row0 + ai * HALF + m * 16) * ld + dcol) = pack8(acc[ai][bj][m][0], acc[ai][bj][m][1]);
            } else if (mode == 1) {
#pragma unroll
                for (int ai = 0; ai < 2; ++ai)
#pragma unroll
                    for (int m = 0; m < 4; ++m) { const f32x4 v0 = acc[ai][bj][m][0], v1 = acc[ai][bj][m][1]; typedef unsigned u32x2_ __attribute__((ext_vector_type(2)));
                        u32x2_ w; w.x = gate4_u8(sigm(v0[0]), sigm(v0[1]), sigm(v0[2]), sigm(v0[3])); w.y = gate4_u8(sigm(v1[0]), sigm(v1[1]), sigm(v1[2]), sigm(v1[3]));
                        *(u32x2_*)((unsigned char*)GT + (size_t)(row0 + ai * HALF + m * 16) * 3072 + dcol) = w; }
            } else {
                const float qs = (mode == 2) ? qscale : 1.0f;
                const int i0 = (dcol & 63) >> 1;
#pragma unroll
                for (int ai = 0; ai < 2; ++ai) {
                    f32x4 t0[4], t1[4];
                    if (!ctxrow) {
#pragma unroll
                        for (int m = 0; m < 4; ++m) { const int s = (row0 + ai * HALF + m * 16) & 16383, pos = (i0 < 16) ? (s >> 6) : (s & 63);
                            const float* t = rope + (size_t)(pos * 16 + (i0 & 15)) * 2; t0[m] = *(const f32x4*)t; t1[m] = *(const f32x4*)(t + 4); }
                        asm volatile("" ::: "memory");
                    }
#pragma unroll
                    for (int m = 0; m < 4; ++m) { f32x4 v0 = acc[ai][bj][m][0], v1 = acc[ai][bj][m][1];
                        if (!ctxrow) { const f32x4 a = t0[m], b = t1[m];
                            f32x4 r0, r1;
                            r0[0] = v0[0] * a[0] - v0[1] * a[1]; r0[1] = v0[0] * a[1] + v0[1] * a[0]; r0[2] = v0[2] * a[2] - v0[3] * a[3]; r0[3] = v0[2] * a[3] + v0[3] * a[2];
                            r1[0] = v1[0] * b[0] - v1[1] * b[1]; r1[1] = v1[0] * b[1] + v1[1] * b[0]; r1[2] = v1[2] * b[2] - v1[3] * b[3]; r1[3] = v1[2] * b[3] + v1[3] * b[2];
                            v0 = r0; v1 = r1; }
                        v0 = v0 * qs; v1 = v1 * qs;
                        *(u32x4*)(dst + (size_t)(row0 + ai * HALF + m * 16) * ld + dcol) = pack8(v0, v1); }
                }
            }
        }
    }
};

template <class Epi, class Sched, bool ALIGN_EPI = false, bool SP2 = false, int DT = 0, bool SEG = false>
__device__ __forceinline__ void gemm_phase(PG8_LAS unsigned char* lds, const Gemm g, const Sched& S, const Epi& E, int wave_id  , int stagger_ticks = 0) {
    unsigned z_ = 0u; asm volatile("" : "+v"(z_)); int wid_ = wave_id; asm volatile("" : "+s"(wid_));
    const int lane_ = (int)__builtin_amdgcn_mbcnt_hi(~0u, __builtin_amdgcn_mbcnt_lo(~0u, z_));
    const int wid = wid_, lane = lane_, tid = wid * 64 + lane, wr = wid >> 2, wc = wid & 3, fr = lane & 15, fq = lane >> 4;
    constexpr bool FP8 = (DT == 1), I8 = (DT == 2);
    const int K = g.K, ldk = g.ld ? g.ld : K, pitch = DT ? ldk : 2 * ldk  , nt = (DT ? K : 2 * K) / 128;
#define PG8_PA(base, tt) (SEG ? (base) + ((tt) < 8 ? 0L : (tt) < 16 ? g.A1off : g.A2off) + (size_t)((tt) & 7) * kstep : (base) + (size_t)(tt) * kstep)
#define PG8_PB(base, tt) (SEG ? (base) + (size_t)((tt) >> 3) * g.Bseg + (size_t)((tt) & 7) * kstep : (base) + (size_t)(tt) * kstep)
    unsigned voffA, voffB;
    { int R, C; stage_rc(tid * 16, R, C); const int Rb = Epi::PERM ? ((R & ~31) + perm32(R & 31)) : R;
        voffA = (unsigned)(R * pitch + C * 2); voffB = (unsigned)(Rb * pitch + C * 2); }
    const size_t pstep = (size_t)64 * pitch;
    const size_t kstep = (size_t)(BK * 2);
    const size_t hstep = (size_t)HALF * pitch;
    const size_t tstep = 2 * hstep;
    const unsigned ldsw = (unsigned)wid * 1024u;
    const int aoff = lds_byte(wr * 64 + fr, fq * 8), boff = lds_byte(wc * 32 + fr, fq * 8);
#define PG8_SA(b, h) (((b) * 2 + (h)) * HTB)
#define PG8_SB(b, h) ((4 + (b) * 2 + (h)) * HTB)
#define PG8_STAGE(bufoff, gbase, voff) do { _Pragma("unroll") for (int _i = 0; _i < 2; ++_i) \
        __builtin_amdgcn_global_load_lds((const unsigned*)((const char*)(gbase) + _i * pstep + (voff)), (PG8_LAS unsigned*)(lds + (bufoff) + ldsw + _i * 8192), 16, 0, 0); } while (0)
#define PG8_LDA(dst, b, h) do { _Pragma("unroll") for (int m = 0; m < 4; ++m) _Pragma("unroll") for (int k = 0; k < 2; ++k) dst[m][k] = *(const PG8_LAS bf16x8*)(lds + PG8_SA(b, h) + aoff + m * 2048 + k * 1024); } while (0)
#define PG8_LDB(dst, b, h) do { _Pragma("unroll") for (int n = 0; n < 2; ++n) _Pragma("unroll") for (int k = 0; k < 2; ++k) dst[n][k] = *(const PG8_LAS bf16x8*)(lds + PG8_SB(b, h) + boff + n * 2048 + k * 1024); } while (0)
#define PG8_MMA(ai, bj, At, Bt) do { __builtin_amdgcn_s_setprio(1); _Pragma("unroll") for (int m = 0; m < 4; ++m) _Pragma("unroll") for (int n = 0; n < 2; ++n) { \
        if constexpr (FP8) { typedef int i32x4_ __attribute__((ext_vector_type(4))); \
            acc[ai][bj][m][n] = __builtin_amdgcn_mfma_scale_f32_16x16x128_f8f6f4(__builtin_shufflevector(__builtin_bit_cast(i32x4_, Bt[n][0]), __builtin_bit_cast(i32x4_, Bt[n][1]), 0, 1, 2, 3, 4, 5, 6, 7), \
                __builtin_shufflevector(__builtin_bit_cast(i32x4_, At[m][0]), __builtin_bit_cast(i32x4_, At[m][1]), 0, 1, 2, 3, 4, 5, 6, 7), acc[ai][bj][m][n], 0, 0, 0, 0, 0, 0); } \
        else if constexpr (I8) { typedef int i32x4_ __attribute__((ext_vector_type(4))); _Pragma("unroll") for (int k = 0; k < 2; ++k) \
            acc[ai][bj][m][n] = __builtin_bit_cast(f32x4, __builtin_amdgcn_mfma_i32_16x16x64_i8(__builtin_bit_cast(i32x4_, Bt[n][k]), __builtin_bit_cast(i32x4_, At[m][k]), __builtin_bit_cast(i32x4_, acc[ai][bj][m][n]), 0, 0, 0)); } \
        else { _Pragma("unroll") for (int k = 0; k < 2; ++k) acc[ai][bj][m][n] = __builtin_amdgcn_mfma_f32_16x16x32_bf16(Bt[n][k], At[m][k], acc[ai][bj][m][n], 0, 0, 0); } } \
        __builtin_amdgcn_s_setprio(0); } while (0)
#define PG8_WAIT_V(n) asm volatile("s_waitcnt vmcnt(" #n ")" ::: "memory")
#define PG8_WAIT_L(n) asm volatile("s_waitcnt lgkmcnt(" #n ")" ::: "memory")
#define PG8_BAR __builtin_amdgcn_s_barrier()
#define PG8_SCHED __builtin_amdgcn_sched_barrier(0)
    Unit cur, nxt; int ui = 0;
    if (!S.next(0, cur)) return;
    if (stagger_ticks > 0) { const unsigned long long t0_ = __builtin_amdgcn_s_memrealtime(); while (__builtin_amdgcn_s_memrealtime() - t0_ < (unsigned long long)stagger_ticks) __builtin_amdgcn_s_sleep(4); }
    f32x4 acc[2][2][4][2];
#pragma unroll
    for (int a = 0; a < 2; ++a)
#pragma unroll
        for (int b = 0; b < 2; ++b)
#pragma unroll
            for (int m = 0; m < 4; ++m)
#pragma unroll
                for (int n = 0; n < 2; ++n) acc[a][b][m][n] = (f32x4){0.f, 0.f, 0.f, 0.f};
    bf16x8 At[4][2], B0[2][2], B1[2][2];
    const char* cA = (const char*)g.A + (size_t)cur.pm * tstep; const char* cB = (const char*)g.Bt + (size_t)cur.pn * tstep;
    S.a_ready(cur);
    if constexpr (SP2) {
        PG8_STAGE(PG8_SB(0, 0), cB, voffB); PG8_STAGE(PG8_SB(0, 1), cB + hstep, voffB); PG8_STAGE(PG8_SA(0, 0), cA, voffA); PG8_STAGE(PG8_SA(0, 1), cA + hstep, voffA);
        if (wr == 1) PG8_BAR;
        PG8_WAIT_V(2); PG8_BAR;
        PG8_STAGE(PG8_SB(1, 0), cB + kstep, voffB); PG8_STAGE(PG8_SA(1, 0), cA + kstep, voffA); PG8_STAGE(PG8_SB(1, 1), cB + hstep + kstep, voffB);
        PG8_WAIT_V(6); PG8_BAR;
    } else {
        PG8_STAGE(PG8_SB(0, 0), cB, voffB); PG8_STAGE(PG8_SA(0, 0), cA, voffA); PG8_STAGE(PG8_SB(0, 1), cB + hstep, voffB); PG8_STAGE(PG8_SA(0, 1), cA + hstep, voffA);
        if (wr == 1) PG8_BAR;
        PG8_WAIT_V(4); PG8_BAR;
        PG8_STAGE(PG8_SB(1, 0), cB + kstep, voffB); PG8_STAGE(PG8_SA(1, 0), cA + kstep, voffA); PG8_STAGE(PG8_SB(1, 1), cB + hstep + kstep, voffB);
        PG8_WAIT_V(6); PG8_BAR;
    }
    for (;;) {
        const bool has_next = S.next(ui + 1, nxt);
        const char* nA = has_next ? (const char*)g.A + (size_t)nxt.pm * tstep : cA; const char* nB = has_next ? (const char*)g.Bt + (size_t)nxt.pn * tstep : cB;
#pragma unroll 1
        for (int t = 0; t < nt; t += 2) {
            const bool last = (t == nt - 2);
            if constexpr (SEG) { if (t == 8 || t == 16) { unsigned zm_ = 0u; asm volatile("" : "+v"(zm_)); const int lm_ = (int)__builtin_amdgcn_mbcnt_hi(~0u, __builtin_amdgcn_mbcnt_lo(~0u, zm_)); E.mid(acc, cur, t >> 3, wr, wc, lm_ & 15, lm_ >> 4); } }
            const char* a1 = PG8_PA(cA, t + 1);
            const char* a2 = last ? nA : PG8_PA(cA, t + 2); const char* b2 = last ? nB : PG8_PB(cB, t + 2);
            const char* a3 = a2 + kstep; const char* b3 = b2 + kstep;
            if (last && has_next) S.a_ready(nxt);
            if constexpr (SP2) {
            PG8_LDB(B0, 0, 0); PG8_LDB(B1, 0, 1); PG8_SCHED; PG8_LDA(At, 0, 0); PG8_STAGE(PG8_SA(1, 1), a1 + hstep, voffA);
            PG8_WAIT_V(8); PG8_WAIT_L(0); PG8_BAR; PG8_MMA(0, 0, At, B0); PG8_MMA(0, 1, At, B1); PG8_BAR; PG8_SCHED;
            PG8_LDA(At, 0, 1); PG8_STAGE(PG8_SB(0, 0), b2, voffB); PG8_STAGE(PG8_SB(0, 1), b2 + hstep, voffB); PG8_STAGE(PG8_SA(0, 0), a2, voffA);
            PG8_WAIT_V(8); PG8_WAIT_L(0); PG8_BAR; PG8_MMA(1, 0, At, B0); PG8_MMA(1, 1, At, B1); PG8_BAR; PG8_SCHED;
            PG8_LDB(B0, 1, 0); PG8_LDB(B1, 1, 1); PG8_SCHED; PG8_LDA(At, 1, 0); PG8_STAGE(PG8_SA(0, 1), a2 + hstep, voffA);
            PG8_WAIT_V(8); PG8_WAIT_L(0); PG8_BAR; PG8_MMA(0, 0, At, B0); PG8_MMA(0, 1, At, B1); PG8_BAR; PG8_SCHED;
            PG8_LDA(At, 1, 1); PG8_STAGE(PG8_SB(1, 0), b3, voffB); PG8_STAGE(PG8_SB(1, 1), b3 + hstep, voffB); PG8_STAGE(PG8_SA(1, 0), a3, voffA);
            PG8_WAIT_V(8); PG8_WAIT_L(0); PG8_BAR; PG8_MMA(1, 0, At, B0); PG8_MMA(1, 1, At, B1); PG8_BAR; PG8_SCHED;
            } else {
            PG8_LDB(B0, 0, 0); PG8_SCHED; PG8_LDA(At, 0, 0); PG8_STAGE(PG8_SA(1, 1), a1 + hstep, voffA);
            PG8_WAIT_L(8); PG8_BAR; PG8_WAIT_L(0); PG8_MMA(0, 0, At, B0); PG8_BAR; PG8_SCHED;
            PG8_LDB(B1, 0, 1); PG8_STAGE(PG8_SB(0, 0), b2, voffB);
            PG8_BAR; PG8_WAIT_L(0); PG8_MMA(0, 1, At, B1); PG8_BAR;
            PG8_LDA(At, 0, 1); PG8_STAGE(PG8_SA(0, 0), a2, voffA);
            PG8_BAR; PG8_WAIT_L(0); PG8_MMA(1, 0, At, B0); PG8_BAR; PG8_SCHED;
            PG8_STAGE(PG8_SB(0, 1), b2 + hstep, voffB);
            PG8_WAIT_V(6); PG8_BAR; PG8_MMA(1, 1, At, B1); PG8_BAR;
            PG8_LDB(B0, 1, 0); PG8_SCHED; PG8_LDA(At, 1, 0); PG8_STAGE(PG8_SA(0, 1), a2 + hstep, voffA);
            PG8_WAIT_L(8); PG8_BAR; PG8_WAIT_L(0); PG8_MMA(0, 0, At, B0); PG8_BAR; PG8_SCHED;
            PG8_LDB(B1, 1, 1); PG8_STAGE(PG8_SB(1, 0), b3, voffB);
            PG8_BAR; PG8_WAIT_L(0); PG8_MMA(0, 1, At, B1); PG8_BAR;
            PG8_LDA(At, 1, 1); PG8_STAGE(PG8_SA(1, 0), a3, voffA);
            PG8_BAR; PG8_WAIT_L(0); PG8_MMA(1, 0, At, B0); PG8_BAR; PG8_SCHED;
            PG8_STAGE(PG8_SB(1, 1), b3 + hstep, voffB);
            PG8_WAIT_V(6); PG8_BAR; PG8_MMA(1, 1, At, B1); PG8_BAR;
            }
        }
        if constexpr (ALIGN_EPI) { if (wr == 0) PG8_BAR; }
        if constexpr (!Epi::AFTER_DRAIN) { unsigned ze_ = 0u; asm volatile("" : "+v"(ze_)); const int le_ = (int)__builtin_amdgcn_mbcnt_hi(~0u, __builtin_amdgcn_mbcnt_lo(~0u, ze_));
            if constexpr (I8) {
                typedef int i32x4_ __attribute__((ext_vector_type(4)));
                const int fr_ = le_ & 15, fq_ = le_ >> 4; const float* rsp = g.rs + (size_t)cur.pm * BM + wr * 64 + fr_; const float* csp = g.cs + (size_t)cur.pn * BM + wc * 32 + 8 * fq_;
                f32x4 cv[2][2];
                _Pragma("unroll") for (int bj = 0; bj < 2; ++bj) _Pragma("unroll") for (int n = 0; n < 2; ++n) cv[bj][n] = *(const f32x4*)(csp + bj * HALF + 4 * n);
                _Pragma("unroll") for (int ai = 0; ai < 2; ++ai) _Pragma("unroll") for (int m = 0; m < 4; ++m) { const float rv = rsp[ai * HALF + m * 16];
                    _Pragma("unroll") for (int bj = 0; bj < 2; ++bj) _Pragma("unroll") for (int n = 0; n < 2; ++n)
                        acc[ai][bj][m][n] = __builtin_convertvector(__builtin_bit_cast(i32x4_, acc[ai][bj][m][n]), f32x4) * (cv[bj][n] * rv); }
            }
            E(acc, cur, wr, wc, le_ & 15, le_ >> 4);
#if defined(REP_EPI)
            if constexpr (Epi::IDEMPOTENT) { for (int r_ = 1; r_ < REP_EPI; ++r_) { asm volatile("" ::: "memory"); E(acc, cur, wr, wc, le_ & 15, le_ >> 4); } }
#endif
            S.done(cur); }
        if (!has_next) break;
#pragma unroll
        for (int a = 0; a < 2; ++a)
#pragma unroll
            for (int b = 0; b < 2; ++b)
#pragma unroll
                for (int m = 0; m < 4; ++m)
#pragma unroll
                    for (int n = 0; n < 2; ++n) acc[a][b][m][n] = (f32x4){0.f, 0.f, 0.f, 0.f};
        cur = nxt; cA = nA; cB = nB; ++ui;
        if constexpr (ALIGN_EPI) { if (wr == 1) PG8_BAR; }
    }
    PG8_WAIT_V(0);
    if constexpr (!ALIGN_EPI) { if (wr == 0) PG8_BAR; }
    PG8_BAR;
    if constexpr (Epi::AFTER_DRAIN) { E.fused(acc, cur, wr, wc, fr, fq, lds, wid, lane); S.done(cur); }
#undef PG8_PA
#undef PG8_PB
#undef PG8_SA
#undef PG8_SB
#undef PG8_STAGE
#undef PG8_LDA
#undef PG8_LDB
#undef PG8_MMA
#undef PG8_WAIT_V
#undef PG8_WAIT_L
#undef PG8_BAR
#undef PG8_SCHED
}
}
#define GAS __attribute__((address_space(1)))
#define LAS __attribute__((address_space(3)))
typedef pg8::bf16_t bf16_t;
typedef pg8::bf16x8 bf16x8;
typedef pg8::f32x4 f32x4;
typedef pg8::u32x4 u32x4;
typedef float f32x16 __attribute__((ext_vector_type(16)));
typedef float f32x2 __attribute__((ext_vector_type(2)));
typedef short s16x4 __attribute__((ext_vector_type(4)));
typedef unsigned u32x2 __attribute__((ext_vector_type(2)));
typedef GAS unsigned gu32;

typedef const __attribute__((address_space(4))) unsigned char* kptr_t;
__device__ __forceinline__ kptr_t kbase() { kptr_t p = (kptr_t)__builtin_amdgcn_kernarg_segment_ptr(); asm volatile("" : "+s"(p)); return p; }
#define IN_(i) (*(const float* const __attribute__((address_space(4)))*)(kbase() + 8 * (i)))
#define OUT_ (*(float* const __attribute__((address_space(4)))*)(kbase() + 200))
#define WS_ (*(unsigned char* const __attribute__((address_space(4)))*)(kbase() + 208))
constexpr int NWAVES = 8, NTHREADS = 512;
constexpr int D = 1024, SEQ = 16384, M_LAT = 32768, CTXL = 256, M_CTX = 512, MT = M_LAT + M_CTX;
constexpr int ZN = 6400, DFF = 2816, DEXP = 3584, NEXP = 8, NMOD = 6144;
constexpr float EPS = 1e-6f, LOG2E = 1.4426950408889634f, QSCALE = 0.125f * LOG2E;
constexpr int CHUNK_TILES = 128, CHUNK_MAX = 136, CHUNK_ROWS = CHUNK_MAX * 256;
constexpr float WSCALE8 = 64.0f;

constexpr size_t MiB = 1u << 20;
constexpr size_t WS_CTL = 0, CTL_BYTES = 1 * MiB;
constexpr size_t WS_MODV = 6 * MiB + 768 * 1024;
constexpr size_t WS_MODF = 1 * MiB;
constexpr size_t WS_CS = 1 * MiB + 152 * 1024;
constexpr size_t WS_RS = 1 * MiB + 864 * 1024;
constexpr size_t WS_ROPE = 1 * MiB + 256 * 1024;
constexpr size_t WS_G1 = 1 * MiB + 512 * 1024;
constexpr size_t WS_G2 = 1 * MiB + 768 * 1024;
constexpr size_t WS_HCTX = 2 * MiB;
constexpr size_t WS_ASG = 4 * MiB;
constexpr size_t WS_ELIST = 5 * MiB;
constexpr size_t WS_TW = 6 * MiB;
constexpr size_t WS_G3 = 6 * MiB + 512 * 1024;
constexpr size_t WS_WIN = 8 * MiB, WIN_BYTES = (size_t)ZN * D;
constexpr size_t WS_WY = 33 * MiB;
constexpr size_t WS_WO = 39 * MiB;
constexpr size_t WS_WFF_UP = 43 * MiB;
constexpr size_t WS_WFF_DN = 54 * MiB;
constexpr size_t WS_HN = 60 * MiB;
constexpr size_t WS_Q = 125 * MiB;
constexpr size_t WS_KV = WS_Q + (size_t)MT * 512 * 2;
constexpr size_t WS_FAB = 174 * MiB;
constexpr size_t WS_CIN = 239 * MiB;
constexpr size_t WS_GT = WS_CIN + (size_t)MT * 1536 * 2;
constexpr size_t WS_COUT = 434 * MiB;
constexpr size_t WS_ATT = WS_COUT + (size_t)MT * 512 * 2;
constexpr size_t WS_MIX = WS_GT;
constexpr size_t WS_HID0 = 125 * MiB;
constexpr size_t WS_F0 = 434 * MiB;
constexpr size_t WS_EXUP = 499 * MiB;
constexpr size_t WS_EXDN = 555 * MiB;
constexpr size_t WS_H2G = 209 * MiB;
constexpr size_t WS_HIDX = 244 * MiB;
constexpr size_t WS_YEXP = 363 * MiB;
constexpr size_t WS_NEED = 583 * MiB;
static_assert(WS_KV + (size_t)MT * 256 * 2 <= WS_FAB && WS_FAB + (size_t)MT * 1024 * 2 <= WS_CIN && WS_GT + (size_t)MT * 3072 <= WS_COUT && WS_ATT + (size_t)MT * 512 * 2 <= WS_EXUP, "ws map (mixer)");
static_assert(WS_HN + (size_t)MT * 1024 * 2 <= WS_Q && WS_WFF_DN + (size_t)1024 * DFF * 2 <= WS_HN && WS_WFF_UP + (size_t)2 * DFF * 1024 * 2 <= WS_WFF_DN, "ws map (weights)");
static_assert(WS_HID0 + (size_t)MT * DFF * 2 <= WS_MIX && WS_MIX + (size_t)MT * 1024 * 2 <= WS_F0 && WS_F0 + (size_t)MT * 1024 * 2 <= WS_EXUP && WS_EXUP + (size_t)8 * 7168 * 1024 <= WS_EXDN && WS_EXDN + (size_t)8 * 1024 * DEXP <= WS_NEED, "ws map (ffn)");
static_assert(WS_H2G + (size_t)CHUNK_ROWS * 1024 <= WS_HIDX && WS_HIDX + (size_t)CHUNK_ROWS * DEXP <= WS_YEXP && WS_YEXP + (size_t)264 * 256 * 1024 * 2 <= WS_EXUP, "ws map (moe)");
constexpr int CW_BAR = 4096;
constexpr int CW_CNT = 8192;
constexpr int CW_COLMAX = 16384;
constexpr int CW_FOLDMAX = CW_COLMAX + 2 * 6400 + 5632;

constexpr int RING_BYTES = 131072;
constexpr int MISC_OFF = RING_BYTES + 320;
constexpr int LDSX_OFF = RING_BYTES + 1024;
constexpr int LDS_BYTES = 147456;

#define LDS_WAIT() asm volatile("s_waitcnt lgkmcnt(0)" ::: "memory")
#define VM_WAIT() asm volatile("s_waitcnt vmcnt(0)" ::: "memory")

#define XB_TMO      128
#define XB_XCNT(j)  (256  + 64 * (j))
#define XB_XSUB(j)  (1280 + 64 * (j))
#define XB_XGEN(j)  (2304 + 64 * (j))
#define XB_TOP      3328
#define XB_TOPGEN   3392
#define XCD_BAR_WORDS 3456
#define XB_SPIN_CAP (1u << 22)

__device__ __forceinline__ unsigned xb_ld(unsigned* p)              { return __hip_atomic_load(p, __ATOMIC_RELAXED, __HIP_MEMORY_SCOPE_AGENT); }
__device__ __forceinline__ unsigned xb_add(unsigned* p, unsigned v) { return __hip_atomic_fetch_add(p, v, __ATOMIC_RELAXED, __HIP_MEMORY_SCOPE_AGENT); }
__device__ __forceinline__ unsigned xb_xcc_id() { return (unsigned)__builtin_amdgcn_s_getreg((3 << 11) | 20) & 0xFu; }
#define XB_SPIN(cond, bar) do { unsigned _sp = 0; while (cond) { __builtin_amdgcn_s_sleep(1); \
    if ((++_sp & 255u) == 0u) { if (xb_ld(&(bar)[XB_TMO])) break; if (_sp > XB_SPIN_CAP) { atomicAdd(&(bar)[XB_TMO], 1u); break; } } } } while (0)

struct XcdBarrier {
    unsigned* bar; unsigned x;
    volatile LAS unsigned* st;
};

__device__ __forceinline__ XcdBarrier xcd_barrier_post(unsigned* bar, volatile LAS unsigned* st) {
    XcdBarrier b; b.bar = bar; b.x = xb_xcc_id(); b.st = st;
    if (threadIdx.x == 0) (void)xb_add(&bar[XB_XCNT(b.x)], 1u);
    return b;
}
__device__ __forceinline__ void xcd_barrier_complete(unsigned* bar, unsigned x, unsigned& nloc, unsigned& nx) {
    const unsigned G = gridDim.x * gridDim.y * gridDim.z;
    unsigned sum, cnt, mine, sp = 0u;
    for (;;) {
        sum = 0u; cnt = 0u; mine = 0u;
#pragma unroll
        for (unsigned j = 0; j < 16; ++j) { const unsigned c = xb_ld(&bar[XB_XCNT(j)]); sum += c; cnt += (c > 0u) ? 1u : 0u; mine = (j == x) ? c : mine; }
        if (sum == G) break;
        __builtin_amdgcn_s_sleep(1);
        if ((++sp & 255u) == 0u) { if (xb_ld(&bar[XB_TMO])) break; if (sp > XB_SPIN_CAP) { atomicAdd(&bar[XB_TMO], 1u); break; } }
    }
    nloc = mine > 0u ? mine : 1u; nx = cnt > 0u ? cnt : 1u;
}

__device__ __forceinline__ void xcd_barrier(const XcdBarrier& b) {
    asm volatile("s_waitcnt vmcnt(0)" ::: "memory");
    __syncthreads();
    if (threadIdx.x == 0) {
        unsigned* bar = b.bar;
        __builtin_amdgcn_s_waitcnt(0);
        unsigned nloc = b.st[0], nx = b.st[1];
        if (nloc == 0u) { xcd_barrier_complete(bar, b.x, nloc, nx); b.st[0] = nloc; b.st[1] = nx; }
        const unsigned old = xb_add(&bar[XB_XSUB(b.x)], 1u);
        const unsigned gen = old / nloc;
        if (old + 1u == (gen + 1u) * nloc) {
            __builtin_amdgcn_fence(__ATOMIC_RELEASE, "agent");
            asm volatile("s_waitcnt vmcnt(0)" ::: "memory");
            const unsigned og = xb_add(&bar[XB_TOP], 1u);
            const unsigned tg = og / nx;
            if (og + 1u == (tg + 1u) * nx) xb_add(&bar[XB_TOPGEN], 1u);
            else XB_SPIN(xb_ld(&bar[XB_TOPGEN]) == tg, bar);
            __builtin_amdgcn_fence(__ATOMIC_ACQUIRE, "agent");
            xb_add(&bar[XB_XGEN(b.x)], 1u);
            asm volatile("s_waitcnt vmcnt(0)" ::: "memory");
        } else {
            XB_SPIN(xb_ld(&bar[XB_XGEN(b.x)]) == gen, bar);
            __builtin_amdgcn_fence(__ATOMIC_ACQUIRE, "agent");
            asm volatile("s_waitcnt vmcnt(0)" ::: "memory");
        }
    }
    __syncthreads();
}

struct Params { const float* in[25]; float* out; unsigned char* ws; };
struct Ctx {
    LAS unsigned char* lds;
    int tid, lane, wave, vcu, G;
};
__device__ __forceinline__ Ctx opaque(const Ctx& c) { Ctx o = c; asm volatile("" : "+s"(o.wave), "+s"(o.vcu), "+s"(o.G));
    unsigned z = 0u; asm volatile("" : "+v"(z)); o.lane = (int)__builtin_amdgcn_mbcnt_hi(~0u, __builtin_amdgcn_mbcnt_lo(~0u, z)); o.tid = o.wave * 64 + o.lane; return o; }
template <int O> __device__ __forceinline__ float lane_xor(float v) { return __int_as_float(__builtin_amdgcn_ds_swizzle(__float_as_int(v), (O << 10) | 0x1f)); }
__device__ __forceinline__ float half_sum(float v) { const auto r = __builtin_amdgcn_permlane32_swap(__float_as_uint(v), __float_as_uint(v), false, false); return __uint_as_float(r[0]) + __uint_as_float(r[1]); }
__device__ __forceinline__ float half_max(float v) { const auto r = __builtin_amdgcn_permlane32_swap(__float_as_uint(v), __float_as_uint(v), false, false); return fmaxf(__uint_as_float(r[0]), __uint_as_float(r[1])); }
__device__ __forceinline__ float wave_max(float v) {
    v = fmaxf(v, lane_xor<1>(v)); v = fmaxf(v, lane_xor<2>(v)); v = fmaxf(v, lane_xor<4>(v)); v = fmaxf(v, lane_xor<8>(v)); v = fmaxf(v, lane_xor<16>(v));
    return half_max(v);
}
__device__ __forceinline__ unsigned pack4_i8(float a, float b, float c, float d) {
    const int qa = __float2int_rn(a), qb = __float2int_rn(b), qc = __float2int_rn(c), qd = __float2int_rn(d);
    return (unsigned)(qa & 255) | ((unsigned)(qb & 255) << 8) | ((unsigned)(qc & 255) << 16) | ((unsigned)qd << 24);
}
__device__ __forceinline__ float wave_sum(float v) {
    v += lane_xor<1>(v); v += lane_xor<2>(v); v += lane_xor<4>(v); v += lane_xor<8>(v); v += lane_xor<16>(v);
    return half_sum(v);
}
__device__ __forceinline__ unsigned pk2(float lo, float hi) { return pg8::cvt_pk_bf16(lo, hi); }
__device__ __forceinline__ float bflo(unsigned u) { return __uint_as_float(u << 16); }
__device__ __forceinline__ float bfhi(unsigned u) { return __uint_as_float(u & 0xffff0000u); }

__device__ __forceinline__ void tr_item(const float* W, int ldw, int k0, int n0, bf16_t* WT, int ldt, int drow0, LAS float* scr, int lane) {
#pragma unroll 8
    for (int i = 0; i < 32; ++i) { const int kk = 2 * i + (lane >> 5); scr[kk * 33 + (lane & 31)] = W[(size_t)(k0 + kk) * ldw + n0 + (lane & 31)]; }
    LDS_WAIT(); asm volatile("" ::: "memory");
    const int c = lane & 7;
#pragma unroll
    for (int j = 0; j < 4; ++j) { const int n = (lane >> 3) + 8 * j; const LAS float* s = scr + (8 * c) * 33 + n;
        u32x4 o; o.x = pk2(s[0 * 33], s[1 * 33]); o.y = pk2(s[2 * 33], s[3 * 33]); o.z = pk2(s[4 * 33], s[5 * 33]); o.w = pk2(s[6 * 33], s[7 * 33]);
        *(GAS u32x4*)(WT + (size_t)(drow0 + n) * ldt + k0 + 8 * c) = o; }
    LDS_WAIT(); asm volatile("" ::: "memory");
}
__device__ __forceinline__ void tr_item8(const float* W, int ldw, int k0, int n0, unsigned char* WT, int ldt, int drow0, float scale, LAS float* scr, int lane) {
#pragma unroll 8
    for (int i = 0; i < 32; ++i) { const int kk = 2 * i + (lane >> 5); scr[kk * 33 + (lane & 31)] = W[(size_t)(k0 + kk) * ldw + n0 + (lane & 31)]; }
    LDS_WAIT(); asm volatile("" ::: "memory");
    const int c = lane & 7;
#pragma unroll
    for (int j = 0; j < 4; ++j) { const int n = (lane >> 3) + 8 * j; const LAS float* s = scr + (8 * c) * 33 + n;
        u32x2 o; o.x = pg8::pack4_fp8(s[0 * 33] * scale, s[1 * 33] * scale, s[2 * 33] * scale, s[3 * 33] * scale); o.y = pg8::pack4_fp8(s[4 * 33] * scale, s[5 * 33] * scale, s[6 * 33] * scale, s[7 * 33] * scale);
        *(GAS u32x2*)(WT + (size_t)(drow0 + n) * ldt + k0 + 8 * c) = o; }
    LDS_WAIT(); asm volatile("" ::: "memory");
}
__device__ __forceinline__ void amax_item(const float* W, int ldw, int k0, int n0, unsigned* cmax, int drow0, int lane) {
    float m = 0.f;
#pragma unroll 8
    for (int i = 0; i < 32; ++i) { const int kk = 2 * i + (lane >> 5); m = fmaxf(m, fabsf(W[(size_t)(k0 + kk) * ldw + n0 + (lane & 31)])); }
    m = half_max(m);
    if (lane < 32) atomicMax(cmax + drow0 + lane, __float_as_uint(m));
}
__device__ __forceinline__ void tr_item_i8(const float* W, int ldw, int k0, int n0, unsigned char* WT, int ldt, int drow0, const unsigned* cmax, float* cs, LAS float* scr, int lane) {
#pragma unroll 8
    for (int i = 0; i < 32; ++i) { const int kk = 2 * i + (lane >> 5); scr[kk * 33 + (lane & 31)] = W[(size_t)(k0 + kk) * ldw + n0 + (lane & 31)]; }
    LDS_WAIT(); asm volatile("" ::: "memory");
    const int c = lane & 7;
#pragma unroll
    for (int j = 0; j < 4; ++j) { const int n = (lane >> 3) + 8 * j; const LAS float* s = scr + (8 * c) * 33 + n;
        const float inv = 127.0f / fmaxf(__uint_as_float(cmax[drow0 + n]), 1e-30f);
        u32x2 o; o.x = pack4_i8(s[0 * 33] * inv, s[1 * 33] * inv, s[2 * 33] * inv, s[3 * 33] * inv); o.y = pack4_i8(s[4 * 33] * inv, s[5 * 33] * inv, s[6 * 33] * inv, s[7 * 33] * inv);
        *(GAS u32x2*)(WT + (size_t)(drow0 + n) * ldt + k0 + 8 * c) = o; }
    if (k0 == 0 && lane < 32) cs[drow0 + lane] = __uint_as_float(cmax[drow0 + lane]) * (1.0f / 127.0f);
    LDS_WAIT(); asm volatile("" ::: "memory");
}
__device__ __forceinline__ int gu_row(int n0, int up) { return (n0 >> 7) * 256 + up * 128 + (n0 & 127); }

__device__ __forceinline__ void p0_convert_item(int it, int pass, LAS float* scr, int lane) {
    unsigned char* ws = WS_;
    unsigned* const cmax = (unsigned*)(ws + WS_CTL) + CW_COLMAX; float* const cs = (float*)(ws + WS_CS);
    if (it < 5376) { const int l = it / 2688, r = it % 2688, kb = r / 168, j = r % 168; const int n0 = j < 24 ? 32 * j : 1280 + 32 * (j - 24), drow = n0 < 768 ? n0 : n0 + 512;
        const float* W = IN_(10) + (size_t)l * D * 5888;
        if (pass == 0) amax_item(W, 5888, 64 * kb, n0, cmax + l * ZN, drow, lane);
        else tr_item_i8(W, 5888, 64 * kb, n0, ws + WS_WIN + l * WIN_BYTES, D, drow, cmax + l * ZN, cs + l * ZN, scr, lane);
        return; }
    it -= 5376;
    if (it < 2816) { const int up = it / 1408, r = it % 1408, kb = r / 88, nb = r % 88;
        if (pass == 0) amax_item(IN_(17 + up), DFF, 64 * kb, 32 * nb, cmax + 2 * ZN, gu_row(32 * nb, up), lane);
        else tr_item_i8(IN_(17 + up), DFF, 64 * kb, 32 * nb, ws + WS_WFF_UP, D, gu_row(32 * nb, up), cmax + 2 * ZN, cs + 2 * ZN, scr, lane);
        return; }
    it -= 2816;
    if (pass != 0) return;
    if (it < 1536) { const int mi = it / 256, r = it % 256, l = mi / 3, i = mi % 3, kb = r / 32, nb = r % 32;
        tr_item(IN_(13 + i) + (size_t)l * 512 * 1024, 1024, 64 * kb, 32 * nb, (bf16_t*)(ws + WS_WY) + (size_t)(l * 3 + i) * 1024 * 512, 512, 32 * nb, scr, lane); return; }
    it -= 1536;
    if (it < 1024) { const int l = it / 512, r = it % 512, kb = r / 32, nb = r % 32;
        tr_item(IN_(16) + (size_t)l * D * D, D, 64 * kb, 32 * nb, (bf16_t*)(ws + WS_WO) + (size_t)l * D * D, D, 32 * nb, scr, lane); return; }
    it -= 1024;
    { const int kb = it / 32, nb = it % 32; tr_item(IN_(19), D, 64 * kb, 32 * nb, (bf16_t*)(ws + WS_WFF_DN), DFF, 32 * nb, scr, lane); }
}
constexpr int P0_I8_ITEMS = 5376 + 2816;
constexpr int P0_ITEMS = 5376 + 1536 + 1024 + 2816 + 1408;
__device__ __forceinline__ void expert_convert_item(int it, LAS float* scr, int lane) {
    unsigned char* ws = WS_;
    const int e = it / 5376, r0 = it % 5376, which = r0 / 1792, r = r0 % 1792;
    if (which < 2) { const int kb = r / 112, nb = r % 112;
        tr_item8(IN_(22 + which) + (size_t)e * D * DEXP, DEXP, 64 * kb, 32 * nb, ws + WS_EXUP + (size_t)e * 7168 * D, D, gu_row(32 * nb, which), WSCALE8, scr, lane); }
    else { const int kb = r / 32, nb = r % 32;
        tr_item8(IN_(24) + (size_t)e * DEXP * D, D, 64 * kb, 32 * nb, ws + WS_EXDN + (size_t)e * D * DEXP, DEXP, 32 * nb, WSCALE8, scr, lane); }
}
constexpr int EXP_ITEMS = 8 * 5376;
__device__ __forceinline__ void expert_convert_fill(const Ctx& C0, int bid, int lo, int hi) {
    if (bid < 8) return;
    const Ctx C = opaque(C0);
    LAS float* scr = (LAS float*)(C.lds + C.wave * 16384);
    for (int it = lo + (bid - 8) * NWAVES + C.wave; it < hi; it += (C.G - 8) * NWAVES) expert_convert_item(it, scr, C.lane);
}
__device__ __forceinline__ void p0_prologue(const Ctx& C0, int pass) {
    const Ctx C = opaque(C0);
    unsigned char* ws = WS_;
    LAS float* sil = (LAS float*)(C.lds + LDSX_OFF);
    LAS float* tab = (LAS float*)(C.lds + LDSX_OFF + 12288);
    for (int i = C.tid; i < 3072; i += NTHREADS) { const float v = i < 2048 ? IN_(1)[i] : IN_(3)[i - 2048]; sil[i] = v / (1.0f + __expf(-v)); }
    if (C.tid < 128) { float s, c; sincospif((float)C.tid / 64.0f, &s, &c); tab[2 * C.tid] = c; tab[2 * C.tid + 1] = s; }
    __syncthreads();
    if (pass == 0) {
    { const int gw0 = C.vcu * NWAVES + C.wave, NGW0 = C.G * NWAVES;
      for (int t = gw0; t < 8 * 2 * 96; t += NGW0) {
        const int kc = t / 192, l = (t % 192) / 96, col = (t % 96) * 64 + C.lane; const float* w = IN_(4) + (size_t)l * D * NMOD + (size_t)(kc * 128) * NMOD + col;
        float a0 = 0.f, a1 = 0.f, a2 = 0.f;
        for (int k = 0; k < 128; k += 16) { float wv[16];
#pragma unroll
            for (int j = 0; j < 16; ++j) wv[j] = w[(size_t)(k + j) * NMOD];
#pragma unroll
            for (int j = 0; j < 16; ++j) { const int kk = kc * 128 + k + j; a0 += sil[kk] * wv[j]; a1 += sil[1024 + kk] * wv[j]; a2 += sil[2048 + kk] * wv[j]; } }
        float* mv = (float*)(ws + WS_MODV) + (size_t)((kc * 2 + l) * 3) * NMOD + col;
        mv[0] = a0; mv[NMOD] = a1; mv[2 * NMOD] = a2;
      } }
    for (int idx = C.vcu * NTHREADS + C.tid; idx < 4096 + 65536 + 32768 + 16384 + 131072; idx += C.G * NTHREADS) {
        if (idx < 4096) { const int pos = idx >> 4, f = idx & 15; const float inv = 1.0f / powf(10000.0f, (float)(2 * f) / 32.0f), ang = (float)pos * inv;
            float* t = (float*)(ws + WS_ROPE) + 2 * idx; t[0] = cosf(ang); t[1] = sinf(ang); }
        else if (idx < 4096 + 65536) { const int i = idx - 4096, m = i >> 8, k = i & 255, k1 = m >> 1, part = m & 1, n1 = k & 127, isb = k >> 7; const int p = (k1 * n1) & 127;
            float s, c; sincospif((float)p / 64.0f, &s, &c); const float v = part == 0 ? (isb ? -s : c) : (isb ? -c : -s);
            ((bf16_t*)(ws + WS_G1))[i] = (bf16_t)pk2(v * 0.08838834764831845f, 0.f); }
        else if (idx >= 4096 + 65536 + 32768 + 16384) { const int i = idx - (4096 + 65536 + 32768 + 16384), k = i >> 9, kk = i & 511, n = kk & 255; float s, c; sincospif((float)((k * n) & 255) / 128.0f, &s, &c);
            ((bf16_t*)(ws + WS_G3))[i] = (bf16_t)pk2((kk < 256 ? c : -s) * 0.0625f, 0.f); }
        else if (idx >= 4096 + 65536 + 32768) { const int i = idx - (4096 + 65536 + 32768), n2 = i >> 7, k1 = i & 127; float s, c; sincospif((float)(k1 * n2) * (1.0f / 8192.0f), &s, &c);
            float* t = (float*)(ws + WS_TW) + 2 * i; t[0] = c; t[1] = s; }
        else { const int i = idx - 4096 - 65536, k2 = i >> 8, k = i & 255, n2 = k & 127, isi = k >> 7; const int p = (k2 * n2) & 127;
            float s, c; sincospif((float)p / 64.0f, &s, &c); ((bf16_t*)(ws + WS_G2))[i] = (bf16_t)pk2((isi ? s : c) * 0.08838834764831845f, 0.f); }
    }
    }
    LAS float* scr = (LAS float*)(C.lds + C.wave * 16384);
    const int gw = C.vcu * NWAVES + C.wave, NGW = C.G * NWAVES;
    for (int it = gw; it < (pass == 0 ? P0_ITEMS : P0_I8_ITEMS); it += NGW) p0_convert_item(it, pass, scr, C.lane);
    bf16_t* const TEMP = (bf16_t*)(ws + WS_HN); const float sc = 0.08838834764831845f;
    if (pass == 0) {
        const int r32 = C.lane & 31, hh = C.lane >> 5;
        for (int t = gw; t < 2 * 4 * 32; t += NGW) {
            const int l = t >> 7, g = (t >> 5) & 3, k0 = (t & 31) * 32; const float* src = IN_(10) + (size_t)l * D * 5888 + (size_t)(k0 + r32) * 5888 + 768 + g * 128 + 8 * hh;
            bf16x8 bfr[8];
#pragma unroll
            for (int s2 = 0; s2 < 8; ++s2) { const f32x4 a = *(const GAS f32x4*)(src + 16 * s2), b = *(const GAS f32x4*)(src + 16 * s2 + 4);
                u32x4 w; w.x = pk2(a[0], a[1]); w.y = pk2(a[2], a[3]); w.z = pk2(b[0], b[1]); w.w = pk2(b[2], b[3]); bfr[s2] = __builtin_bit_cast(bf16x8, w); }
            float mx = 0.f;
#pragma unroll 1
            for (int jb = 0; jb < 8; ++jb) {
                const int part = jb >> 2, j = (32 * jb + r32) & 127;
                f32x16 acc;
#pragma unroll
                for (int i = 0; i < 16; ++i) acc[i] = 0.f;
#pragma unroll
                for (int s2 = 0; s2 < 8; ++s2) { int ib = (16 * s2 + 8 * hh) * j; asm volatile("" : "+v"(ib));
                    u32x4 w;
                    w.x = pk2(tab[2 * ((ib) & 127) + part], tab[2 * ((ib + j) & 127) + part]); w.y = pk2(tab[2 * ((ib + 2 * j) & 127) + part], tab[2 * ((ib + 3 * j) & 127) + part]);
                    w.z = pk2(tab[2 * ((ib + 4 * j) & 127) + part], tab[2 * ((ib + 5 * j) & 127) + part]); w.w = pk2(tab[2 * ((ib + 6 * j) & 127) + part], tab[2 * ((ib + 7 * j) & 127) + part]);
                    acc = __builtin_amdgcn_mfma_f32_32x32x16_bf16(__builtin_bit_cast(bf16x8, w), bfr[s2], acc, 0, 0, 0); }
#pragma unroll
                for (int i = 0; i < 16; ++i) { const float v = acc[i] * sc; mx = fmaxf(mx, fabsf(v)); const int jr = 32 * jb + (i & 3) + 8 * (i >> 2) + 4 * hh;
                    TEMP[((size_t)l * 1024 + (size_t)(jr >> 7) * 512 + g * 128 + (jr & 127)) * D + k0 + r32] = (bf16_t)pk2(v, 0.f); }
            }
            mx = wave_max(mx); if (C.lane == 0) atomicMax((unsigned*)(ws + WS_CTL) + CW_FOLDMAX + l, __float_as_uint(mx));
        }
    } else {
        for (int i = C.vcu * NTHREADS + C.tid; i < 2 * 1024 * 128; i += C.G * NTHREADS) {
            const int l = i >> 17, n = (i >> 7) & 1023, k8 = (i & 127) * 8; const float amax = fmaxf(__uint_as_float(((const unsigned*)(ws + WS_CTL))[CW_FOLDMAX + l]), 1e-30f), inv = 127.0f / amax;
            const u32x4 w = *(const GAS u32x4*)(TEMP + ((size_t)l * 1024 + n) * D + k8);
            u32x2 o; o.x = pack4_i8(bflo(w.x) * inv, bfhi(w.x) * inv, bflo(w.y) * inv, bfhi(w.y) * inv); o.y = pack4_i8(bflo(w.z) * inv, bfhi(w.z) * inv, bflo(w.w) * inv, bfhi(w.w) * inv);
            *(GAS u32x2*)(ws + WS_WIN + l * WIN_BYTES + (size_t)(768 + n) * D + k8) = o;
            if (k8 == 0) ((float*)(ws + WS_CS))[l * ZN + 768 + n] = amax * (1.0f / 127.0f);
        }
    }
}

__device__ __forceinline__ void norm_row(const float* xin, float* xout, bool has_br, const f32x4 (&br)[4], const float* gpost, const float* ga,
                                         const float* gpre, const float* sc, const float* sh, bf16_t* hn, int lane, f32x4 (&h2f)[4], bool hn_fp8 = false) {
    f32x4 x[4];
#pragma unroll
    for (int j = 0; j < 4; ++j) x[j] = *(const GAS f32x4*)(xin + 4 * lane + 256 * j);
    if (has_br) {
        float ss = 0.f;
#pragma unroll
        for (int j = 0; j < 4; ++j) ss += (br[j][0] * br[j][0] + br[j][1] * br[j][1]) + (br[j][2] * br[j][2] + br[j][3] * br[j][3]);
        const float rstd = 1.0f / sqrtf(wave_sum(ss) * (1.0f / D) + EPS);
#pragma unroll
        for (int j = 0; j < 4; ++j) { const f32x4 gp = *(const GAS f32x4*)(gpost + 4 * lane + 256 * j), gg = *(const GAS f32x4*)(ga + 4 * lane + 256 * j); x[j] = x[j] + gg * (br[j] * rstd * gp); }
    }
    if (xout) {
#pragma unroll
        for (int j = 0; j < 4; ++j) *(GAS f32x4*)(xout + 4 * lane + 256 * j) = x[j];
    }
    if (hn) {
        float ss = 0.f;
#pragma unroll
        for (int j = 0; j < 4; ++j) ss += (x[j][0] * x[j][0] + x[j][1] * x[j][1]) + (x[j][2] * x[j][2] + x[j][3] * x[j][3]);
        const float rstd = 1.0f / sqrtf(wave_sum(ss) * (1.0f / D) + EPS);
#pragma unroll
        for (int j = 0; j < 4; ++j) { const f32x4 gp = *(const GAS f32x4*)(gpre + 4 * lane + 256 * j), s1 = *(const GAS f32x4*)(sc + 4 * lane + 256 * j), s0 = *(const GAS f32x4*)(sh + 4 * lane + 256 * j);
            const f32x4 h = (x[j] * rstd * gp) * (s1 + 1.0f) + s0; h2f[j] = h;
            if (hn_fp8) *(GAS unsigned*)((unsigned char*)hn + 4 * lane + 256 * j) = pg8::pack4_fp8(h[0], h[1], h[2], h[3]);
            else { u32x2 w; w.x = pk2(h[0], h[1]); w.y = pk2(h[2], h[3]); *(GAS u32x2*)(hn + 4 * lane + 256 * j) = w; } }
    }
}
__device__ __forceinline__ void load_br(const bf16_t* p, int lane, f32x4 (&br)[4]) {
#pragma unroll
    for (int j = 0; j < 4; ++j) { const u32x2 w = *(const GAS u32x2*)(p + 4 * lane + 256 * j); br[j] = (f32x4){bflo(w.x), bfhi(w.x), bflo(w.y), bfhi(w.y)}; }
}
__device__ __forceinline__ int mod_set(int row) { return row >= M_LAT ? 2 : (row >> 14); }

template <bool PARTS> __device__ __forceinline__ f32x4 modv4(const float* modp, const float* modf, const float* bmod, int l, int set, int off) {
    if constexpr (!PARTS) return *(const GAS f32x4*)(modf + (size_t)(l * 3 + set) * NMOD + off);
    else { f32x4 s = *(const GAS f32x4*)(bmod + l * NMOD + off); const float* p = modp + (size_t)(l * 3 + set) * NMOD + off; f32x4 v[8];
#pragma unroll
        for (int kc = 0; kc < 8; ++kc) v[kc] = *(const GAS f32x4*)(p + (size_t)kc * 6 * NMOD);
#pragma unroll
        for (int kc = 0; kc < 8; ++kc) s = s + v[kc];
        return s; }
}
template <int MODE> __device__ __forceinline__ void phase_norm(const Ctx& C0, int l) {
    constexpr int NR = (MODE == 3) ? 2 : 4;
    const Ctx C = opaque(C0);
    const int gw = C.vcu * NWAVES + C.wave, NGW = C.G * NWAVES, lane = C.lane;
    unsigned char* const ws = WS_;
    const float* const modv = (const float*)(ws + WS_MODV); const float* const bmod = IN_(5);
    const float* const modf = (const float*)(ws + WS_MODF);
    if (MODE == 0) {
        float* mf = (float*)(ws + WS_MODF);
        for (int i = C.vcu * NTHREADS + C.tid; i < 2 * 3 * NMOD; i += C.G * NTHREADS) { const int li = i / (3 * NMOD), c = i % NMOD; float s = bmod[li * NMOD + c]; float v[8];
#pragma unroll
            for (int kc = 0; kc < 8; ++kc) v[kc] = modv[(size_t)kc * 6 * NMOD + i];
#pragma unroll
            for (int kc = 0; kc < 8; ++kc) s += v[kc];
            mf[i] = s; }
    }
    constexpr bool moe = (MODE == 4), comb = (MODE == 3), mid = (MODE == 1 || MODE == 4);
    const bool has_hn = (MODE != 3);
    const int nsets = (MODE == 0 || l == 0) ? 3 : 2;
    const float* const xsrc_lat = (MODE == 0 || MODE == 1) ? IN_(0) : (const float*)OUT_;
    float* const xdst_lat = OUT_;
    const float* const xsrc_ctx = (MODE == 2) ? (const float*)(ws + WS_HCTX) : IN_(2);
    float* const xdst_ctx = (float*)(ws + WS_HCTX);
    const bf16_t* const brbuf = mid ? (const bf16_t*)(ws + WS_MIX) : (const bf16_t*)(ws + WS_F0);
    const float* const gpost = mid ? IN_(7) + l * D : IN_(9) + l * D;
    const float* const gpre = (MODE == 0) ? IN_(6) : mid ? IN_(8) + l * D : IN_(6) + D;
    const int ga_off = mid ? 2048 : 5120, hl = (MODE == 2 || MODE == 3) ? 1 : l, sc_off = mid ? 4096 : 1024, sh_off = mid ? 3072 : 0;
    bf16_t* const HN = (bf16_t*)(ws + WS_HN); float* const RS = (float*)(ws + WS_RS);
    LAS unsigned* const lcnt = (LAS unsigned*)(C.lds + LDSX_OFF);
    LAS unsigned* const stage = (LAS unsigned*)(C.lds + LDSX_OFF + 256);
    LAS float* const wrl = (LAS float*)C.lds;
    const LAS int* const tbl = (const LAS int*)(C.lds + MISC_OFF) + 16;
    if (moe) { if (C.tid < 16) lcnt[C.tid] = 0u; const float* wsrc = IN_(20);
        __syncthreads();
        for (int i = C.tid; i < 2048; i += NTHREADS) *(LAS f32x4*)(wrl + 4 * i) = *(const GAS f32x4*)(wsrc + 4 * i);
        __syncthreads(); }
    const float* const brt = IN_(21);
    const unsigned* const asg = (const unsigned*)(ws + WS_ASG); const bf16_t* const Y = (const bf16_t*)(ws + WS_YEXP);
    int it = 0;
    for (int set = 0; set < nsets; ++set) {
        f32x4 vA[4], vB[4], vS[4];
#pragma unroll
        for (int j = 0; j < 4; ++j) { const int c = 4 * lane + 256 * j;
            if (MODE != 0) vA[j] = modv4<MODE == 0>(modv, modf, bmod, l, set, ga_off + c) * *(const GAS f32x4*)(gpost + c); else vA[j] = (f32x4){0.f, 0.f, 0.f, 0.f};
            if (has_hn) { vB[j] = *(const GAS f32x4*)(gpre + c) * (modv4<MODE == 0>(modv, modf, bmod, hl, set, sc_off + c) + 1.0f); vS[j] = modv4<MODE == 0>(modv, modf, bmod, hl, set, sh_off + c); }
            else { vB[j] = (f32x4){0.f, 0.f, 0.f, 0.f}; vS[j] = vB[j]; } }
        const int base = set < 2 ? set * SEQ : M_LAT, n = set < 2 ? SEQ : M_CTX;
        const float* const xs = set < 2 ? xsrc_lat + (size_t)base * D : xsrc_ctx; float* const xd = set < 2 ? xdst_lat + (size_t)base * D : xdst_ctx;
        for (int i0 = gw; i0 < n; i0 += NGW * NR) {
            f32x4 x[NR][4]; u32x2 bw[NR][4], bw2[NR][4]; float cw0[NR], cw1[NR];
#pragma unroll
            for (int k = 0; k < NR; ++k) { const int ri = i0 + NGW * k; if (ri < n) {
#pragma unroll
                for (int j = 0; j < 4; ++j) x[k][j] = __builtin_nontemporal_load((const GAS f32x4*)(xs + (size_t)ri * D + 4 * lane + 256 * j));
                if (MODE != 0) {
                    if (comb) { const unsigned* a = asg + (size_t)(base + ri) * 8; const int e0 = (int)a[0], e1 = (int)a[3]; cw0[k] = __uint_as_float(a[2]); cw1[k] = __uint_as_float(a[5]);
                        const bf16_t* y0 = Y + ((size_t)tbl[e0] * 256 + a[1]) * D, * y1 = Y + ((size_t)tbl[e1] * 256 + a[4]) * D;
#pragma unroll
                        for (int j = 0; j < 4; ++j) { bw[k][j] = *(const GAS u32x2*)(y0 + 4 * lane + 256 * j); bw2[k][j] = *(const GAS u32x2*)(y1 + 4 * lane + 256 * j); } }
                    else {
#pragma unroll
                        for (int j = 0; j < 4; ++j) bw[k][j] = __builtin_nontemporal_load((const GAS u32x2*)(brbuf + (size_t)(base + ri) * D + 4 * lane + 256 * j)); } } }
              else {
#pragma unroll
                for (int j = 0; j < 4; ++j) { x[k][j] = (f32x4){0.f, 0.f, 0.f, 0.f}; bw[k][j] = (u32x2){0u, 0u}; bw2[k][j] = (u32x2){0u, 0u}; } cw0[k] = 0.f; cw1[k] = 0.f; } }
            if (MODE != 0) {
                float ss[NR]; f32x4 br[NR][4];
#pragma unroll
                for (int k = 0; k < NR; ++k) { ss[k] = 0.f;
#pragma unroll
                    for (int j = 0; j < 4; ++j) { f32x4 b = (f32x4){bflo(bw[k][j].x), bfhi(bw[k][j].x), bflo(bw[k][j].y), bfhi(bw[k][j].y)};
                        if (comb) { const f32x4 b2 = (f32x4){bflo(bw2[k][j].x), bfhi(bw2[k][j].x), bflo(bw2[k][j].y), bfhi(bw2[k][j].y)}; b = b * cw0[k] + b2 * cw1[k]; }
                        br[k][j] = b; ss[k] += (b[0] * b[0] + b[1] * b[1]) + (b[2] * b[2] + b[3] * b[3]); } }
#pragma unroll
                for (int k = 0; k < NR; ++k) ss[k] = wave_sum(ss[k]);
#pragma unroll
                for (int k = 0; k < NR; ++k) { const float rstd = 1.0f / sqrtf(ss[k] * (1.0f / D) + EPS);
#pragma unroll
                    for (int j = 0; j < 4; ++j) x[k][j] = x[k][j] + vA[j] * (br[k][j] * rstd); }
#pragma unroll
                for (int k = 0; k < NR; ++k) { const int ri = i0 + NGW * k; if (ri < n) {
#pragma unroll
                    for (int j = 0; j < 4; ++j) __builtin_nontemporal_store(x[k][j], (GAS f32x4*)(xd + (size_t)ri * D + 4 * lane + 256 * j)); } }
            }
            if (has_hn) {
                float s2[NR];
#pragma unroll
                for (int k = 0; k < NR; ++k) { s2[k] = 0.f;
#pragma unroll
                    for (int j = 0; j < 4; ++j) s2[k] += (x[k][j][0] * x[k][j][0] + x[k][j][1] * x[k][j][1]) + (x[k][j][2] * x[k][j][2] + x[k][j][3] * x[k][j][3]); }
#pragma unroll
                for (int k = 0; k < NR; ++k) s2[k] = wave_sum(s2[k]);
                float am[NR];
#pragma unroll
                for (int k = 0; k < NR; ++k) { const float rstd = 1.0f / sqrtf(s2[k] * (1.0f / D) + EPS); am[k] = 0.f;
#pragma unroll
                    for (int j = 0; j < 4; ++j) { x[k][j] = (x[k][j] * rstd) * vB[j] + vS[j];
                        am[k] = fmaxf(fmaxf(am[k], fmaxf(fabsf(x[k][j][0]), fabsf(x[k][j][1]))), fmaxf(fabsf(x[k][j][2]), fabsf(x[k][j][3]))); } }
                if (!moe) {
#pragma unroll
                    for (int k = 0; k < NR; ++k) am[k] = fmaxf(wave_max(am[k]), 1e-20f);
                }
#pragma unroll
                for (int k = 0; k < NR; ++k) { const int ri = i0 + NGW * k;
                    if (ri < n) {
                        if (moe) {
#pragma unroll
                            for (int j = 0; j < 4; ++j) *(GAS unsigned*)((unsigned char*)HN + (size_t)(base + ri) * D + 4 * lane + 256 * j) = pg8::pack4_fp8(x[k][j][0], x[k][j][1], x[k][j][2], x[k][j][3]); }
                        else {
                            const float inv = 127.0f / am[k];
#pragma unroll
                            for (int j = 0; j < 4; ++j) *(GAS unsigned*)((unsigned char*)HN + (size_t)(base + ri) * D + 4 * lane + 256 * j) = pack4_i8(x[k][j][0] * inv, x[k][j][1] * inv, x[k][j][2] * inv, x[k][j][3] * inv);
                            if (lane == 0) RS[base + ri] = am[k] * (1.0f / 127.0f); } } }
                if (moe) {
#pragma unroll
                    for (int k = 0; k < NR; ++k) { const int ri = i0 + NGW * k; if (ri < n) {
                        float lg[8];
#pragma unroll
                        for (int e = 0; e < 8; ++e) lg[e] = 0.f;
#pragma unroll
                        for (int j = 0; j < 4; ++j)
#pragma unroll
                            for (int q = 0; q < 4; ++q) { const LAS float* wr = wrl + (4 * lane + 256 * j + q) * 8; const f32x4 w0 = *(const LAS f32x4*)wr, w1 = *(const LAS f32x4*)(wr + 4); const float h = x[k][j][q];
                                lg[0] += h * w0[0]; lg[1] += h * w0[1]; lg[2] += h * w0[2]; lg[3] += h * w0[3]; lg[4] += h * w1[0]; lg[5] += h * w1[1]; lg[6] += h * w1[2]; lg[7] += h * w1[3]; }
                        float w4[4];
#pragma unroll
                        for (int j = 0; j < 4; ++j) { const auto r = __builtin_amdgcn_permlane32_swap(__float_as_uint(lg[j]), __float_as_uint(lg[4 + j]), false, false); w4[j] = __uint_as_float(r[0]) + __uint_as_float(r[1]); }
                        const bool b4 = (lane & 16) != 0, b3 = (lane & 8) != 0;
                        float w2[2];
#pragma unroll
                        for (int j = 0; j < 2; ++j) { const float keep = b4 ? w4[2 + j] : w4[j], send = b4 ? w4[j] : w4[2 + j]; w2[j] = keep + lane_xor<16>(send); }
                        float w1v; { const float keep = b3 ? w2[1] : w2[0], send = b3 ? w2[0] : w2[1]; w1v = keep + lane_xor<8>(send); }
                        w1v += lane_xor<4>(w1v); w1v += lane_xor<2>(w1v); w1v += lane_xor<1>(w1v);
                        float lgt[8];
#pragma unroll
                        for (int e = 0; e < 8; ++e) lgt[e] = __int_as_float(__builtin_amdgcn_readlane(__float_as_int(w1v), 8 * e)) + brt[e];
                        int e0 = 0; float v0 = lgt[0];
#pragma unroll
                        for (int e = 1; e < 8; ++e) if (lgt[e] > v0) { v0 = lgt[e]; e0 = e; }
                        int e1 = -1; float v1 = -INFINITY;
#pragma unroll
                        for (int e = 0; e < 8; ++e) if (e != e0 && lgt[e] > v1) { v1 = lgt[e]; e1 = e; }
                        const float pw1 = 1.0f / (1.0f + __expf(v0 - v1)), pw0 = 1.0f - pw1;
                        if (lane == 0) { const unsigned p0 = atomicAdd((unsigned*)&lcnt[e0], 1u), p1 = atomicAdd((unsigned*)&lcnt[e1], 1u);
                            LAS unsigned* st = stage + (C.wave * 24 + it) * 6; st[0] = (unsigned)e0; st[1] = p0; st[2] = __float_as_uint(pw0); st[3] = (unsigned)e1; st[4] = p1; st[5] = __float_as_uint(pw1); }
                        ++it; } }
                }
            }
        }
    }
    if (moe) {
        __syncthreads();
        if (C.tid < 8) lcnt[8 + C.tid] = __hip_atomic_fetch_add((unsigned*)(ws + WS_CTL) + CW_CNT + 64 * C.tid, lcnt[C.tid], __ATOMIC_RELAXED, __HIP_MEMORY_SCOPE_AGENT);
        __syncthreads();
        if (lane == 0) { int i2 = 0; int* elist = (int*)(ws + WS_ELIST); unsigned* asgw = (unsigned*)(ws + WS_ASG);
            for (int set = 0; set < 2; ++set)
                for (int i0 = gw; i0 < SEQ; i0 += NGW * NR)
                    for (int k = 0; k < NR; ++k) { const int ri = i0 + NGW * k; if (ri < SEQ) { const int row = set * SEQ + ri; const LAS unsigned* st = stage + (C.wave * 24 + i2) * 6; ++i2;
                        const unsigned e0 = st[0], p0 = st[1] + lcnt[8 + e0], e1 = st[3], p1 = st[4] + lcnt[8 + e1];
                        elist[e0 * M_LAT + p0] = row; elist[e1 * M_LAT + p1] = row;
                        unsigned* a = asgw + (size_t)row * 8; a[0] = e0; a[1] = p0; a[2] = st[2]; a[3] = e1; a[4] = p1; a[5] = st[5]; } } }
    }
}

constexpr int AT_S = 144;
__device__ __forceinline__ int crow(int r, int h) { return (r & 3) + 8 * (r >> 2) + 4 * h; }
__device__ __forceinline__ void phase_attention(const Ctx& C0, int l, bool with_ctx_q) {
    const Ctx C = opaque(C0);
    const bf16_t* Q = (const bf16_t*)(WS_ + WS_Q); const bf16_t* KV = (const bf16_t*)(WS_ + WS_KV); bf16_t* AO = (bf16_t*)(WS_ + WS_ATT);
    int lane_ = C.lane; asm volatile("" : "+v"(lane_)); const int lane = lane_, w = C.wave, r32 = lane & 31, hh = lane >> 5, qq = (lane & 15) >> 2, pp = lane & 3, blk = (lane >> 4) & 1;
    const int nunits = 1024 + (with_ctx_q ? 16 : 0); const float* sinks = IN_(11) + l * 8;
    for (int unit = C.vcu; unit < nunits; unit += C.G) {
        int b, head, hkv, qrowbase, q0, lo, nloc;
        if (unit < 1024) { const int g = unit & 3, qb = (unit >> 2) & 63; hkv = (unit >> 8) & 1; b = unit >> 9; head = hkv * 4 + g; q0 = qb * 256; qrowbase = b * SEQ + q0;
            lo = q0 - 128 < 0 ? 0 : q0 - 128; const int hi = q0 + 384 > SEQ ? SEQ : q0 + 384; nloc = (hi - lo) >> 6; }
        else { const int x = unit - 1024; b = x >> 3; head = x & 7; hkv = head >> 2; q0 = 0; lo = 0; nloc = 0; qrowbase = M_LAT + b * CTXL; }
        const int ntiles = nloc + 4, qw = q0 + 32 * w;
        bf16x8 qf[4];
        { const bf16_t* qp = Q + (size_t)(qrowbase + 32 * w + r32) * 512 + head * 64 + 8 * hh;
#pragma unroll
          for (int s = 0; s < 4; ++s) qf[s] = *(const GAS bf16x8*)(qp + 16 * s); }
        float m_run = sinks[head] * LOG2E, l_run = hh == 0 ? 1.0f : 0.0f;
        f32x16 o0, o1;
#pragma unroll
        for (int i = 0; i < 16; ++i) { o0[i] = 0.f; o1[i] = 0.f; }
        const int lrow = C.tid >> 3, lch = C.tid & 7;
        u32x4 kx, vx;
        { const int krow0 = nloc > 0 ? b * SEQ + lo : M_LAT + b * CTXL; const bf16_t* src = KV + (size_t)(krow0 + lrow) * 256 + hkv * 64 + lch * 8;
          kx = *(const GAS u32x4*)src; vx = *(const GAS u32x4*)(src + 128); }
        for (int t = 0; t < ntiles; ++t) {
            const bool local = t < nloc; const int kpos = lo + 64 * t;
            LAS unsigned char* Kt = C.lds + (t & 1) * (128 * AT_S); LAS unsigned char* Vt = Kt + 64 * AT_S;
            *(LAS u32x4*)(Kt + lrow * AT_S + lch * 16) = kx; *(LAS u32x4*)(Vt + lrow * AT_S + lch * 16) = vx;
            __syncthreads();
            if (t + 1 < ntiles) { const int t1 = t + 1; const int krow1 = t1 < nloc ? b * SEQ + lo + 64 * t1 : M_LAT + b * CTXL + 64 * (t1 - nloc);
                const bf16_t* src = KV + (size_t)(krow1 + lrow) * 256 + hkv * 64 + lch * 8; kx = *(const GAS u32x4*)src; vx = *(const GAS u32x4*)(src + 128); }
            const bool relevant = !local || (kpos + 63 >= qw - 128 && kpos <= qw + 31 + 128);
            if (relevant) {
                f32x16 p0, p1;
#pragma unroll
                for (int i = 0; i < 16; ++i) { p0[i] = 0.f; p1[i] = 0.f; }
#pragma unroll
                for (int s = 0; s < 4; ++s) {
                    const bf16x8 k0 = *(const LAS bf16x8*)(Kt + r32 * AT_S + (16 * s + 8 * hh) * 2), k1 = *(const LAS bf16x8*)(Kt + (32 + r32) * AT_S + (16 * s + 8 * hh) * 2);
                    p0 = __builtin_amdgcn_mfma_f32_32x32x16_bf16(k0, qf[s], p0, 0, 0, 0); p1 = __builtin_amdgcn_mfma_f32_32x32x16_bf16(k1, qf[s], p1, 0, 0, 0);
                }
                if (local) { const int qpos = qw + r32;
#pragma unroll
                    for (int i = 0; i < 16; ++i) { const int d0 = kpos + crow(i, hh) - qpos, d1 = d0 + 32;
                        if (d0 > 128 || d0 < -128) p0[i] = -INFINITY; if (d1 > 128 || d1 < -128) p1[i] = -INFINITY; } }
                float mt = fmaxf(p0[0], p1[0]);
#pragma unroll
                for (int i = 1; i < 16; ++i) mt = fmaxf(mt, fmaxf(p0[i], p1[i]));
                mt = half_max(mt);
                const float mn = fmaxf(m_run, mt), alpha = __builtin_amdgcn_exp2f(m_run - mn); m_run = mn;
                float ls = 0.f;
#pragma unroll
                for (int i = 0; i < 16; ++i) { p0[i] = __builtin_amdgcn_exp2f(p0[i] - mn); p1[i] = __builtin_amdgcn_exp2f(p1[i] - mn); ls += p0[i] + p1[i]; }
                l_run = l_run * alpha + ls;
#pragma unroll
                for (int i = 0; i < 16; ++i) { o0[i] *= alpha; o1[i] *= alpha; }
#pragma unroll
                for (int kb = 0; kb < 2; ++kb)
#pragma unroll
                    for (int s2 = 0; s2 < 2; ++s2) {
                        u32x4 pw;
                        if (kb == 0) { pw.x = pk2(p0[8 * s2 + 0], p0[8 * s2 + 1]); pw.y = pk2(p0[8 * s2 + 2], p0[8 * s2 + 3]); pw.z = pk2(p0[8 * s2 + 4], p0[8 * s2 + 5]); pw.w = pk2(p0[8 * s2 + 6], p0[8 * s2 + 7]); }
                        else { pw.x = pk2(p1[8 * s2 + 0], p1[8 * s2 + 1]); pw.y = pk2(p1[8 * s2 + 2], p1[8 * s2 + 3]); pw.z = pk2(p1[8 * s2 + 4], p1[8 * s2 + 5]); pw.w = pk2(p1[8 * s2 + 6], p1[8 * s2 + 7]); }
                        const bf16x8 pb = __builtin_bit_cast(bf16x8, pw);
                        const int kbase = 32 * kb + 16 * s2 + 4 * hh + qq;
#pragma unroll
                        for (int c = 0; c < 2; ++c) {
                            const LAS unsigned char* va = Vt + kbase * AT_S + (32 * c + 16 * blk + 4 * pp) * 2;
                            const s16x4 vlo = __builtin_amdgcn_ds_read_tr16_b64_v4i16((LAS s16x4*)va), vhi = __builtin_amdgcn_ds_read_tr16_b64_v4i16((LAS s16x4*)(va + 8 * AT_S));
                            const bf16x8 vf = __builtin_shufflevector(vlo, vhi, 0, 1, 2, 3, 4, 5, 6, 7);
                            if (c == 0) o0 = __builtin_amdgcn_mfma_f32_32x32x16_bf16(vf, pb, o0, 0, 0, 0); else o1 = __builtin_amdgcn_mfma_f32_32x32x16_bf16(vf, pb, o1, 0, 0, 0);
                        }
                    }
            }
        }
        const float linv = 1.0f / half_sum(l_run);
        bf16_t* op = AO + (size_t)(qrowbase + 32 * w + r32) * 512 + head * 64 + 4 * hh;
#pragma unroll
        for (int g = 0; g < 4; ++g) {
            u32x2 a, c2; a.x = pk2(o0[4 * g] * linv, o0[4 * g + 1] * linv); a.y = pk2(o0[4 * g + 2] * linv, o0[4 * g + 3] * linv);
            c2.x = pk2(o1[4 * g] * linv, o1[4 * g + 1] * linv); c2.y = pk2(o1[4 * g + 2] * linv, o1[4 * g + 3] * linv);
            *(GAS u32x2*)(op + 8 * g) = a; *(GAS u32x2*)(op + 32 + 8 * g) = c2; }
        __syncthreads();
    }
}

constexpr int FT_S = 144, FT_TILE = 256 * FT_S;
__device__ __forceinline__ float quad_swap1(float v) { return __int_as_float(__builtin_amdgcn_mov_dpp(__float_as_int(v), 0xB1, 0xF, 0xF, true)); }
template <int STAGE> __device__ __forceinline__ void phase_fft(const Ctx& C0) {
    const Ctx C = opaque(C0);
    unsigned char* const ws = WS_;
    const bf16_t* const SRC = (const bf16_t*)(ws + (STAGE == 1 ? WS_FAB : WS_HN)); const bf16_t* const GM = (const bf16_t*)(ws + (STAGE == 1 ? WS_G1 : WS_G2)); const float* const TW = (const float*)(ws + WS_TW);
    bf16_t* const DST = (bf16_t*)(ws + (STAGE == 1 ? WS_HN : WS_FAB));
    const int lane = C.lane, w = C.wave, r32 = lane & 31, hh = lane >> 5, qq = (lane & 15) >> 2, pp = lane & 3, blk = (lane >> 4) & 1;
    const int mrow = STAGE == 1 ? 32 * w + r32 : 32 * (w & 3) + r32;
    bf16x8 gf[16];
#pragma unroll
    for (int s = 0; s < 16; ++s) gf[s] = *(const GAS bf16x8*)(GM + (size_t)mrow * 256 + 16 * s + 8 * hh);
    u32x4 pf[4];
#define FFT_LOAD(unit_) do { const int b_ = (unit_) >> 10, q_ = ((unit_) >> 3) & 127, cb_ = (unit_) & 7; _Pragma("unroll") for (int i = 0; i < 4; ++i) { const int idx = C.tid + NTHREADS * i, k = idx >> 3, ch = idx & 7; \
        const int srow = b_ * SEQ + (STAGE == 1 ? 128 * (k & 127) + q_ : 128 * q_ + (k & 127)); pf[i] = *(const GAS u32x4*)(SRC + (size_t)srow * 1024 + (k >> 7) * 512 + cb_ * 64 + ch * 8); } } while (0)
    for (int unit = C.vcu; unit < 2048; unit += C.G) {
        const int b = unit >> 10, q = (unit >> 3) & 127, cb = unit & 7;
        LAS unsigned char* X = C.lds;
        __syncthreads();
        FFT_LOAD(unit);
#pragma unroll
        for (int i = 0; i < 4; ++i) { const int idx = C.tid + NTHREADS * i, k = idx >> 3, ch = idx & 7; *(LAS u32x4*)(X + k * FT_S + ch * 16) = pf[i]; }
        __syncthreads();
        if (STAGE == 1) {
            const int k1 = mrow >> 1, part = mrow & 1; const f32x2 tw = *(const GAS f32x2*)(TW + 2 * (q * 128 + k1)); const float tc = tw.x, ts = part ? -tw.y : tw.y;
            bf16_t* const drow = DST + (size_t)(b * SEQ + 128 * k1 + q) * 1024 + part * 512 + cb * 64 + 4 * hh;
#pragma unroll
            for (int cbk = 0; cbk < 2; ++cbk) {
                f32x16 acc;
#pragma unroll
                for (int i = 0; i < 16; ++i) acc[i] = 0.f;
#pragma unroll
                for (int s = 0; s < 16; ++s) {
                    const LAS unsigned char* xa = X + (16 * s + 8 * hh + qq) * FT_S + (32 * cbk + 16 * blk + 4 * pp) * 2;
                    const s16x4 lo = __builtin_amdgcn_ds_read_tr16_b64_v4i16((LAS s16x4*)xa), hi = __builtin_amdgcn_ds_read_tr16_b64_v4i16((LAS s16x4*)(xa + 4 * FT_S));
                    acc = __builtin_amdgcn_mfma_f32_32x32x16_bf16(__builtin_shufflevector(lo, hi, 0, 1, 2, 3, 4, 5, 6, 7), gf[s], acc, 0, 0, 0);
                }
#pragma unroll
                for (int g = 0; g < 4; ++g) { float o[4];
#pragma unroll
                    for (int j = 0; j < 4; ++j) { const float own = acc[4 * g + j]; o[j] = own * tc + lane_xor<1>(own) * ts; }
                    u32x2 wv; wv.x = pk2(o[0], o[1]); wv.y = pk2(o[2], o[3]); *(GAS u32x2*)(drow + 32 * cbk + 8 * g) = wv; }
            }
        } else {
            const int cbk = w >> 2;
            f32x16 acc;
#pragma unroll
            for (int i = 0; i < 16; ++i) acc[i] = 0.f;
#pragma unroll
            for (int s = 0; s < 16; ++s) {
                const LAS unsigned char* xa = X + (16 * s + 8 * hh + qq) * FT_S + (32 * cbk + 16 * blk + 4 * pp) * 2;
                const s16x4 lo = __builtin_amdgcn_ds_read_tr16_b64_v4i16((LAS s16x4*)xa), hi = __builtin_amdgcn_ds_read_tr16_b64_v4i16((LAS s16x4*)(xa + 4 * FT_S));
                acc = __builtin_amdgcn_mfma_f32_32x32x16_bf16(__builtin_shufflevector(lo, hi, 0, 1, 2, 3, 4, 5, 6, 7), gf[s], acc, 0, 0, 0);
            }
            bf16_t* const drow = DST + (size_t)(b * SEQ + q + 128 * mrow) * 512 + cb * 64 + 32 * cbk + 4 * hh;
#pragma unroll
            for (int g = 0; g < 4; ++g) { u32x2 wv; wv.x = pk2(acc[4 * g], acc[4 * g + 1]); wv.y = pk2(acc[4 * g + 2], acc[4 * g + 3]); *(GAS u32x2*)(drow + 8 * g) = wv; }
        }
    }
#undef FFT_LOAD
    __syncthreads();
}
__device__ __forceinline__ void phase_ctx_dft(const Ctx& C0) {
    const Ctx C = opaque(C0);
    unsigned char* const ws = WS_;
    const bf16_t* const FAB = (const bf16_t*)(ws + WS_FAB); const bf16_t* const G3 = (const bf16_t*)(ws + WS_G3); bf16_t* const FN = (bf16_t*)(ws + WS_FAB);
    const int lane = C.lane, w = C.wave, r32 = lane & 31, hh = lane >> 5, qq = (lane & 15) >> 2, pp = lane & 3, blk = (lane >> 4) & 1, mrow = 32 * w + r32;
    LAS unsigned char* const X = C.lds;
    for (int unit = C.vcu; unit < 16; unit += C.G) {
        const int b = unit >> 3, cb = unit & 7;
        f32x16 acc0, acc1;
#pragma unroll
        for (int i = 0; i < 16; ++i) { acc0[i] = 0.f; acc1[i] = 0.f; }
#pragma unroll 1
        for (int h = 0; h < 2; ++h) {
            bf16x8 gf[16];
#pragma unroll
            for (int s = 0; s < 16; ++s) gf[s] = *(const GAS bf16x8*)(G3 + (size_t)mrow * 512 + h * 256 + 16 * s + 8 * hh);
            __syncthreads();
#pragma unroll
            for (int i = 0; i < 4; ++i) { const int idx = C.tid + NTHREADS * i, k = idx >> 3, ch = idx & 7;
                *(LAS u32x4*)(X + k * FT_S + ch * 16) = *(const GAS u32x4*)(FAB + (size_t)(M_LAT + b * CTXL + k) * 1024 + h * 512 + cb * 64 + ch * 8); }
            __syncthreads();
#pragma unroll
            for (int s = 0; s < 16; ++s) {
                const LAS unsigned char* xa = X + (16 * s + 8 * hh + qq) * FT_S + (16 * blk + 4 * pp) * 2;
                const s16x4 lo0 = __builtin_amdgcn_ds_read_tr16_b64_v4i16((LAS s16x4*)xa), hi0 = __builtin_amdgcn_ds_read_tr16_b64_v4i16((LAS s16x4*)(xa + 4 * FT_S));
                const s16x4 lo1 = __builtin_amdgcn_ds_read_tr16_b64_v4i16((LAS s16x4*)(xa + 64)), hi1 = __builtin_amdgcn_ds_read_tr16_b64_v4i16((LAS s16x4*)(xa + 64 + 4 * FT_S));
                acc0 = __builtin_amdgcn_mfma_f32_32x32x16_bf16(__builtin_shufflevector(lo0, hi0, 0, 1, 2, 3, 4, 5, 6, 7), gf[s], acc0, 0, 0, 0);
                acc1 = __builtin_amdgcn_mfma_f32_32x32x16_bf16(__builtin_shufflevector(lo1, hi1, 0, 1, 2, 3, 4, 5, 6, 7), gf[s], acc1, 0, 0, 0);
            }
        }
        bf16_t* const drow = FN + (size_t)(M_LAT + b * CTXL + mrow) * 512 + cb * 64 + 4 * hh;
#pragma unroll
        for (int g = 0; g < 4; ++g) { u32x2 wv; wv.x = pk2(acc0[4 * g], acc0[4 * g + 1]); wv.y = pk2(acc0[4 * g + 2], acc0[4 * g + 3]); *(GAS u32x2*)(drow + 8 * g) = wv;
            wv.x = pk2(acc1[4 * g], acc1[4 * g + 1]); wv.y = pk2(acc1[4 * g + 2], acc1[4 * g + 3]); *(GAS u32x2*)(drow + 32 + 8 * g) = wv; }
    }
    __syncthreads();
}
__device__ __forceinline__ void unpack8(const u32x4 w, float (&f)[8]) { f[0] = bflo(w.x); f[1] = bfhi(w.x); f[2] = bflo(w.y); f[3] = bfhi(w.y); f[4] = bflo(w.z); f[5] = bfhi(w.z); f[6] = bflo(w.w); f[7] = bfhi(w.w); }
__device__ __forceinline__ void phase_conv(const Ctx& C0, int l, int nrows) {
    const Ctx C = opaque(C0);
    const bf16_t* CIN = (const bf16_t*)(WS_ + WS_CIN); bf16_t* CO = (bf16_t*)(WS_ + WS_COUT); const float* wc = IN_(12) + l * 3 * 512;
    for (int it = C.vcu * NTHREADS + C.tid; it < nrows * 64; it += C.G * NTHREADS) {
        const int row = it >> 6, c0 = (it & 63) * 8; const bool lat = row < M_LAT;
        const int s = lat ? (row & (SEQ - 1)) : ((row - M_LAT) & (CTXL - 1)), last = lat ? SEQ - 1 : CTXL - 1;
        const bf16_t* p = CIN + (size_t)row * 1536 + c0;
        float xm[8], cm[8], x0[8], cc0[8], xp[8], cp[8], bb[8];
        const u32x4 z = (u32x4){0u, 0u, 0u, 0u};
        unpack8(s > 0 ? *(const GAS u32x4*)(p - 1536) : z, xm); unpack8(s > 0 ? *(const GAS u32x4*)(p - 1536 + 1024) : z, cm);
        unpack8(*(const GAS u32x4*)p, x0); unpack8(*(const GAS u32x4*)(p + 1024), cc0); unpack8(*(const GAS u32x4*)(p + 512), bb);
        unpack8(s < last ? *(const GAS u32x4*)(p + 1536) : z, xp); unpack8(s < last ? *(const GAS u32x4*)(p + 1536 + 1024) : z, cp);
        float y[8];
#pragma unroll
        for (int j = 0; j < 8; ++j) y[j] = bb[j] * (xm[j] * cm[j] * wc[c0 + j] + x0[j] * cc0[j] * wc[512 + c0 + j] + xp[j] * cp[j] * wc[1024 + c0 + j]);
        u32x4 o; o.x = pk2(y[0], y[1]); o.y = pk2(y[2], y[3]); o.z = pk2(y[4], y[5]); o.w = pk2(y[6], y[7]);
        *(GAS u32x4*)(CO + (size_t)row * 512 + c0) = o;
    }
}
__device__ __forceinline__ void phase_moe_gather(const Ctx& C0, int chunk, int ntiles) {
    const Ctx C = opaque(C0);
    const unsigned char* HN = WS_ + WS_HN; unsigned char* H2G = WS_ + WS_H2G; const int* EL = (const int*)(WS_ + WS_ELIST);
    const LAS int* tbl = (const LAS int*)(C.lds + MISC_OFF) + 16;
    const int gw = C.vcu * NWAVES + C.wave, NGW = C.G * NWAVES;
    for (int rl = gw; rl < CHUNK_ROWS; rl += NGW) {
        const int R = chunk * CHUNK_TILES * 256 + rl, t = R >> 8; if (t >= ntiles) break;
        int e = 0;
#pragma unroll
        for (int k = 1; k < 8; ++k) e += (t >= tbl[k]) ? 1 : 0;
        const int pos = R - tbl[e] * 256, ce = tbl[8 + e];
        u32x4 v0 = (u32x4){0u, 0u, 0u, 0u};
        if (pos < ce) { const int tok = EL[e * M_LAT + pos]; v0 = *(const GAS u32x4*)(HN + (size_t)tok * D + C.lane * 16); }
        *(GAS u32x4*)(H2G + (size_t)rl * D + C.lane * 16) = v0;
    }
}

#ifndef REP_PRO
#define REP_PRO 1
#endif
#ifndef REP_GEMM
#define REP_GEMM 1
#endif
#ifndef REP_ATT
#define REP_ATT 1
#endif
#ifndef REP_F1
#define REP_F1 1
#endif
#ifndef REP_F2
#define REP_F2 1
#endif
#ifndef REP_CV
#define REP_CV 1
#endif
#ifndef REP_CD
#define REP_CD 1
#endif
#ifndef REP_AUX
#define REP_AUX 1
#endif
#ifndef REP_GIN
#define REP_GIN REP_GEMM
#endif
#ifndef REP_GMG
#define REP_GMG REP_GEMM
#endif
#ifndef REP_GO
#define REP_GO REP_GEMM
#endif
#ifndef REP_GUP
#define REP_GUP REP_GEMM
#endif
#ifndef REP_GDN
#define REP_GDN REP_GEMM
#endif
#ifndef REP_GMU
#define REP_GMU REP_GEMM
#endif
#ifndef REP_GMD
#define REP_GMD REP_GEMM
#endif
#define REPEAT(N) for (int rep_ = 0; rep_ < (N); ++rep_)
#ifndef GIN_ALIGN
#define GIN_ALIGN true
#endif
constexpr int FILL1 = 11264, FILL2 = 20480;
#ifndef STAGGER_TICKS
#define STAGGER_TICKS 0
#endif
#define STAG(bid) ((((bid) >> 3) & 1) ? STAGGER_TICKS : 0)
__global__ void __launch_bounds__(NTHREADS, 2) dit_fwd(Params P) {
    extern __shared__ __attribute__((aligned(16))) unsigned char lds_raw[];
    Ctx C;
    C.lds = (LAS unsigned char*)lds_raw;
    C.wave = __builtin_amdgcn_readfirstlane((int)threadIdx.x >> 6); C.lane = 0; C.tid = 0;
    C.G = gridDim.x; { const int bx = blockIdx.x; C.vcu = (C.G % 8 == 0) ? (bx % 8) * (C.G / 8) + bx / 8 : bx; }
    volatile LAS unsigned* MISC = (volatile LAS unsigned*)(C.lds + MISC_OFF);
    if (threadIdx.x < 32) MISC[threadIdx.x] = 0u;
    __syncthreads();
    (void)xcd_barrier_post((unsigned*)(WS_ + WS_CTL) + CW_BAR, MISC + 8);
#define GRID_BAR() do { XcdBarrier b_; b_.bar = (unsigned*)(WS_ + WS_CTL) + CW_BAR; b_.x = xb_xcc_id(); b_.st = (volatile LAS unsigned*)(C.lds + MISC_OFF) + 8; xcd_barrier(b_); } while (0)
    LAS unsigned char* ring = C.lds;
    const int bid = (int)blockIdx.x;

    REPEAT(REP_PRO) p0_prologue(C, 0);
    GRID_BAR();
    p0_prologue(C, 1);
    REPEAT(REP_AUX) phase_norm<0>(C, 0);
    GRID_BAR();

    for (int l = 0; l < 2; ++l) {
        const int nM = (l == 0) ? MT / 256 : M_LAT / 256;
        REPEAT(REP_GIN) {
            unsigned char* ws = WS_;
            pg8::Gemm g{(const bf16_t*)(ws + WS_HN), (const bf16_t*)(ws + WS_WIN + l * WIN_BYTES), MT, ZN, D, 0, 0, 0, 0, (const float*)(ws + WS_RS), (const float*)(ws + WS_CS) + l * ZN};
            pg8::RectOrder S; if (l == 0) S.init(MT / 256, ZN / 256, C.G, bid); else S.init(M_LAT / 256, ZN / 256, C.G, bid, 0, 2, M_LAT / 256, 2);
            pg8::EpiIn E{ws, WS_Q, WS_KV, WS_FAB, WS_CIN, WS_GT, WS_ROPE, QSCALE};
            pg8::gemm_phase<pg8::EpiIn, pg8::RectOrder, GIN_ALIGN, true, 2>(ring, g, S, E, C.wave, STAG(bid));
        }
        GRID_BAR();
        REPEAT(REP_ATT) phase_attention(C, l, l == 0);
        REPEAT(REP_F1) phase_fft<1>(C);
        REPEAT(REP_CV) phase_conv(C, l, nM * 256);
        GRID_BAR();
        REPEAT(REP_F2) phase_fft<2>(C);
        if (l == 0) REPEAT(REP_CD) phase_ctx_dft(C);
        GRID_BAR();
        REPEAT(REP_GMG) {
            unsigned char* ws = WS_;
            pg8::RectOrder S; S.init(nM, 4, C.G, bid);
            pg8::Gemm g{(const bf16_t*)(ws + WS_ATT), (const bf16_t*)(ws + WS_WY) + (size_t)l * 3 * 1024 * 512, MT, D, 1536, 512, (long)WS_FAB - (long)WS_ATT, (long)WS_COUT - (long)WS_ATT, (long)1024 * 512 * 2};
            pg8::EpiHorner E{(bf16_t*)(ws + WS_HN), (const unsigned char*)(ws + WS_GT)};
            pg8::gemm_phase<pg8::EpiHorner, pg8::RectOrder, true, true, 0, true>(ring, g, S, E, C.wave);
        }
        if (l == 0) expert_convert_fill(C, bid, 0, FILL1);
        GRID_BAR();
        REPEAT(REP_GO) {
            unsigned char* ws = WS_;
            pg8::Gemm g{(const bf16_t*)(ws + WS_HN), (const bf16_t*)(ws + WS_WO) + (size_t)l * D * D, MT, D, D}; pg8::RectOrder S; S.init(nM, 4, C.G, bid);
            pg8::EpiPlain E{(bf16_t*)(ws + WS_MIX), D, 4, 0, 1.0f};
            pg8::gemm_phase<pg8::EpiPlain, pg8::RectOrder, true, true>(ring, g, S, E, C.wave);
        }
        if (l == 0) expert_convert_fill(C, bid, FILL1, FILL2);
        GRID_BAR();
        if (l == 0) phase_norm<1>(C, 0); else phase_norm<4>(C, 1);
        GRID_BAR();
        if (l == 0) {
            REPEAT(REP_GUP) { unsigned char* ws = WS_;
              pg8::Gemm g{(const bf16_t*)(ws + WS_HN), (const bf16_t*)(ws + WS_WFF_UP), MT, 2 * DFF, D, 0, 0, 0, 0, (const float*)(ws + WS_RS), (const float*)(ws + WS_CS) + 2 * ZN}; pg8::RectOrder S; S.init(nM, 2 * DFF / 256, C.G, bid);
              pg8::EpiSwiglu<false> E{(void*)(ws + WS_HID0), DFF, 2 * DFF / 256, 1.0f};
              pg8::gemm_phase<pg8::EpiSwiglu<false>, pg8::RectOrder, true, true, 2>(ring, g, S, E, C.wave, STAG(bid)); }
            GRID_BAR();
            REPEAT(REP_GDN) { unsigned char* ws = WS_;
              pg8::Gemm g{(const bf16_t*)(ws + WS_HID0), (const bf16_t*)(ws + WS_WFF_DN), MT, D, DFF}; pg8::RectOrder S; S.init(nM, 4, C.G, bid);
              pg8::EpiPlain E{(bf16_t*)(ws + WS_F0), D, 4, 0, 1.0f};
              pg8::gemm_phase<pg8::EpiPlain, pg8::RectOrder, true, true>(ring, g, S, E, C.wave); }
            expert_convert_fill(C, bid, FILL2, EXP_ITEMS);
            GRID_BAR();
        } else {
            if (threadIdx.x == 0) { const unsigned* ctl = (const unsigned*)(WS_ + WS_CTL); unsigned tb = 0u;
                for (int e = 0; e < 8; ++e) { const unsigned c = __hip_atomic_load(ctl + CW_CNT + 64 * e, __ATOMIC_RELAXED, __HIP_MEMORY_SCOPE_AGENT); MISC[16 + e] = tb; MISC[24 + e] = c; tb += (c + 255u) >> 8; } }
            __syncthreads();
            const int T = __builtin_amdgcn_readfirstlane((int)(MISC[23] + ((MISC[31] + 255u) >> 8))), nchunks = T > CHUNK_TILES ? 2 : 1;
            const LAS int* tbl = (const LAS int*)(C.lds + MISC_OFF) + 16;
            for (int ch = 0; ch < nchunks; ++ch) {
                const int tc = ch == 0 ? (T < CHUNK_TILES ? T : CHUNK_TILES) : T - CHUNK_TILES;
                REPEAT(REP_AUX) phase_moe_gather(C, ch, T);
                GRID_BAR();
                REPEAT(REP_GMU) { unsigned char* ws = WS_;
                  pg8::Gemm g{(const bf16_t*)(ws + WS_H2G), (const bf16_t*)(ws + WS_EXUP), CHUNK_ROWS, 8 * 7168, D};
                  pg8::MoeOrder S{tc, 28, ch * CHUNK_TILES, C.G, bid, tbl};
                  pg8::EpiSwiglu<true> E{(void*)(ws + WS_HIDX), DEXP, 28, 1.0f / WSCALE8};
                  pg8::gemm_phase<pg8::EpiSwiglu<true>, pg8::MoeOrder, true, true, true>(ring, g, S, E, C.wave, STAG(bid)); }
                GRID_BAR();
                REPEAT(REP_GMD) { unsigned char* ws = WS_;
                  pg8::Gemm g{(const bf16_t*)(ws + WS_HIDX), (const bf16_t*)(ws + WS_EXDN), CHUNK_ROWS, 8 * 1024, DEXP};
                  pg8::MoeOrder S{tc, 4, ch * CHUNK_TILES, C.G, bid, tbl};
                  pg8::EpiPlain E{(bf16_t*)(ws + WS_YEXP), D, 4, ch * CHUNK_TILES * 256, 1.0f / WSCALE8};
                  pg8::gemm_phase<pg8::EpiPlain, pg8::MoeOrder, true, true, true>(ring, g, S, E, C.wave); }
                GRID_BAR();
            }
        }
        if (l == 0) phase_norm<2>(C, 0); else phase_norm<3>(C, 1);
        if (l == 0) GRID_BAR();
    }
#undef GRID_BAR
}

extern "C" void kernel_launch(void* const* d_in, const int* in_sizes, int n_in, void* d_out, int out_size, void* d_ws, size_t ws_size, hipStream_t stream) {
    static int grid = 0;
    if (grid == 0) {
        if (n_in != 25 || in_sizes[0] != M_LAT * D || out_size != M_LAT * D || ws_size < WS_NEED) {
            fprintf(stderr, "kernel_launch: built for 25 inputs, x/out of %d floats, >= %zu bytes of workspace; got n_in %d, in0 %d, out %d, ws %zu; nothing launched\n", M_LAT * D, (size_t)WS_NEED, n_in, n_in > 0 ? in_sizes[0] : -1, out_size, ws_size);
            grid = -1; return; }
        int dev = 0, cus = 0, per_cu = 0;
        if (hipGetDevice(&dev) != hipSuccess || hipDeviceGetAttribute(&cus, hipDeviceAttributeMultiprocessorCount, dev) != hipSuccess) { fprintf(stderr, "kernel_launch: device query failed\n"); grid = -1; return; }
        if (hipFuncSetAttribute((const void*)dit_fwd, hipFuncAttributeMaxDynamicSharedMemorySize, LDS_BYTES) != hipSuccess) { fprintf(stderr, "kernel_launch: hipFuncSetAttribute failed\n"); grid = -1; return; }
        if (hipOccupancyMaxActiveBlocksPerMultiprocessor(&per_cu, (const void*)dit_fwd, NTHREADS, LDS_BYTES) != hipSuccess || per_cu < 1) { fprintf(stderr, "kernel_launch: occupancy query says %d workgroups per CU; nothing launched\n", per_cu); (void)hipGetLastError(); grid = -1; return; }
        (void)hipGetLastError();
        grid = cus;
        if (grid < 192 || grid > 304) { fprintf(stderr, "kernel_launch: unexpected CU count %d\n", cus); grid = -1; return; }
    }
    if (grid < 0) return;
    if (hipMemsetAsync((char*)d_ws + WS_CTL, 0, CTL_BYTES, stream) != hipSuccess) { fprintf(stderr, "kernel_launch: memset failed\n"); return; }
    Params p{};
    for (int i = 0; i < 25; ++i) p.in[i] = (const float*)d_in[i];
    p.out = (float*)d_out; p.ws = (unsigned char*)d_ws;
    hipLaunchKernelGGL(dit_fwd, dim3(grid), dim3(NTHREADS), LDS_BYTES, stream, p);
    const hipError_t le = hipPeekAtLastError();
    if (le != hipSuccess) fprintf(stderr, "kernel_launch: launch failed: %s\n", hipGetErrorName(le));
}
```

```cpp
#include <hip/hip_runtime.h>
#include <cstdio>
#include <cstdint>
#include <cmath>
namespace pg8 {
#define PG8_LAS __attribute__((address_space(3)))
typedef unsigned short bf16_t;
typedef short bf16x8 __attribute__((ext_vector_type(8)));
typedef float f32x4 __attribute__((ext_vector_type(4)));
typedef unsigned u32x4 __attribute__((ext_vector_type(4)));
constexpr int BM = 256, BK = 64, HALF = 128, HTB = HALF * BK * 2  , STAGE_BYTES = 8 * HTB, NXCD = 8, WGM = 8;

__host__ __device__ __forceinline__ int lds_byte(int r, int c) { const int st = (r >> 4) * 2 + (c >> 5), rr = r & 15, cc = c & 31, ob = rr * 64 + cc * 2; return st * 1024 + (ob ^ (((ob >> 9) & 1) << 5)); }
__host__ __device__ __forceinline__ void stage_rc(int b, int& R, int& C) { const int st = b / 1024, sb = b % 1024, swz = sb ^ (((sb >> 9) & 1) << 5); R = (st >> 1) * 16 + swz / 64; C = (st & 1) * 32 + (swz % 64) / 2; }
__host__ __device__ __forceinline__ int perm32(int rho) { const int n = rho >> 4, i = rho & 15; return 8 * (i >> 2) + 4 * n + (i & 3); }

struct Unit { int pm, pn; };
struct Gemm { const bf16_t* A; const bf16_t* Bt; int M, N, K; int ld = 0; long A1off = 0, A2off = 0, Bseg = 0; const float* rs = nullptr; const float* cs = nullptr; };

struct StaticOrder {
    int nM, nN, nwg, G, c;
    __host__ __device__ void init(int M, int N, int G_, int c_) { nM = M / BM; nN = N / BM; nwg = nM * nN; G = G_; c = c_; }
    __host__ __device__ bool next(int i, Unit& u) const {
        const long L = (long)i * G + c; if (L >= nwg) return false;
        int wgid = (int)L; { const int q = nwg / NXCD, r = nwg % NXCD, xcd = wgid % NXCD, off = wgid / NXCD; wgid = (xcd < r ? xcd * (q + 1) : r * (q + 1) + (xcd - r) * q) + off; }
        const int nig = WGM * nN, gid = wgid / nig, fm = gid * WGM, gsz = (nM - fm) < WGM ? (nM - fm) : WGM;
        u.pm = fm + ((wgid % nig) % gsz); u.pn = (wgid % nig) / gsz; return true;
    }
    __device__ __forceinline__ void a_ready(const Unit&) const {}
    __device__ __forceinline__ void done(const Unit&) const {}
};

__device__ __forceinline__ unsigned cvt_pk_bf16(float lo, float hi) { unsigned r; asm volatile("v_cvt_pk_bf16_f32 %0, %1, %2" : "=v"(r) : "v"(lo), "v"(hi)); return r; }
struct RectOrder {
    int nM, nN, nwg, G, c, pm0, ne, epm0, epn;
    __device__ __forceinline__ void init(int nM_, int nN_, int G_, int c_, int pm0_ = 0, int ne_ = 0, int epm0_ = 0, int epn_ = 0) { nM = nM_; nN = nN_; nwg = nM * nN; G = G_; c = c_; pm0 = pm0_; ne = ne_; epm0 = epm0_; epn = epn_; }
    __device__ __forceinline__ bool next(int i, Unit& u) const {
        const long L = (long)i * G + c;
        if (L >= nwg) { const long x = L - nwg; if (x >= ne) return false; u.pm = epm0 + (int)x; u.pn = epn; return true; }
        int wgid = (int)L; { const int q = nwg / NXCD, r = nwg % NXCD, xcd = wgid % NXCD, off = wgid / NXCD; wgid = (xcd < r ? xcd * (q + 1) : r * (q + 1) + (xcd - r) * q) + off; }
        const int nig = WGM * nN, gid = wgid / nig, fm = gid * WGM, gsz = (nM - fm) < WGM ? (nM - fm) : WGM;
        u.pm = pm0 + fm + ((wgid % nig) % gsz); u.pn = (wgid % nig) / gsz; return true;
    }
    __device__ __forceinline__ void a_ready(const Unit&) const {}
    __device__ __forceinline__ void done(const Unit&) const {}
};
struct MoeOrder {
    int tc, nN, tile0, G, c; const PG8_LAS int* tbl;
    __device__ __forceinline__ bool next(int i, Unit& u) const {
        const int L = i * G + c; if (L >= tc * nN) return false;
        const int j = L / tc, pml = L - j * tc, t = tile0 + pml;
        int e = 0;
#pragma unroll
        for (int k = 1; k < 8; ++k) e += (t >= __builtin_amdgcn_readfirstlane(tbl[k])) ? 1 : 0;
        u.pm = __builtin_amdgcn_readfirstlane(pml); u.pn = __builtin_amdgcn_readfirstlane(e * nN + j); return true;
    }
    __device__ __forceinline__ void a_ready(const Unit&) const {}
    __device__ __forceinline__ void done(const Unit&) const {}
};

__device__ __forceinline__ float bflo(unsigned u) { return __uint_as_float(u << 16); }
__device__ __forceinline__ float bfhi(unsigned u) { return __uint_as_float(u & 0xffff0000u); }
__device__ __forceinline__ float sigm(float x) { return __builtin_amdgcn_rcpf(1.0f + __builtin_amdgcn_exp2f(-1.4426950408889634f * x)); }
__device__ __forceinline__ u32x4 pack8(const f32x4 a, const f32x4 b) { u32x4 w; w.x = cvt_pk_bf16(a[0], a[1]); w.y = cvt_pk_bf16(a[2], a[3]); w.z = cvt_pk_bf16(b[0], b[1]); w.w = cvt_pk_bf16(b[2], b[3]); return w; }

__device__ __forceinline__ unsigned gate4_u8(float a, float b, float c, float d) { return (unsigned)__float2int_rn(a * 255.0f) | ((unsigned)__float2int_rn(b * 255.0f) << 8) | ((unsigned)__float2int_rn(c * 255.0f) << 16) | ((unsigned)__float2int_rn(d * 255.0f) << 24); }
struct EpiPlain {
    static constexpr bool PERM = true, AFTER_DRAIN = false, IDEMPOTENT = true;
    bf16_t* O; int ld, nmod, row_off; float scale;
    __device__ __forceinline__ void operator()(const f32x4 (&acc)[2][2][4][2], const Unit& u, int wr, int wc, int fr, int fq) const {
        const int row0 = row_off + u.pm * BM + wr * 64 + fr, col0 = (u.pn % nmod) * BM + wc * 32 + 8 * fq;
#pragma unroll
        for (int ai = 0; ai < 2; ++ai)
#pragma unroll
            for (int m = 0; m < 4; ++m) { bf16_t* rowp = O + (size_t)(row0 + ai * HALF + m * 16) * ld + col0;
#pragma unroll
                for (int bj = 0; bj < 2; ++bj) *(u32x4*)(rowp + bj * HALF) = pack8(acc[ai][bj][m][0] * scale, acc[ai][bj][m][1] * scale); }
    }
};
template <bool FIRST> struct EpiMerge {
    static constexpr bool PERM = true, AFTER_DRAIN = false, IDEMPOTENT = FIRST;
    bf16_t* MG; const bf16_t* GT; int gcol0;
    __device__ __forceinline__ void operator()(const f32x4 (&acc)[2][2][4][2], const Unit& u, int wr, int wc, int fr, int fq) const {
        const int row0 = u.pm * BM + wr * 64 + fr, col0 = u.pn * BM + wc * 32 + 8 * fq;
#pragma unroll
        for (int ai = 0; ai < 2; ++ai)
#pragma unroll
            for (int m = 0; m < 4; ++m) { const size_t row = (size_t)(row0 + ai * HALF + m * 16);
#pragma unroll
                for (int bj = 0; bj < 2; ++bj) {
                    typedef unsigned u32x2_ __attribute__((ext_vector_type(2))); const u32x2_ g = *(const u32x2_*)((const unsigned char*)GT + row * 3072 + gcol0 + col0 + bj * HALF);
                    f32x4 v0 = acc[ai][bj][m][0], v1 = acc[ai][bj][m][1]; const float q = 1.0f / 255.0f;
                    v0[0] *= (float)(g.x & 255u) * q; v0[1] *= (float)((g.x >> 8) & 255u) * q; v0[2] *= (float)((g.x >> 16) & 255u) * q; v0[3] *= (float)(g.x >> 24) * q;
                    v1[0] *= (float)(g.y & 255u) * q; v1[1] *= (float)((g.y >> 8) & 255u) * q; v1[2] *= (float)((g.y >> 16) & 255u) * q; v1[3] *= (float)(g.y >> 24) * q;
                    bf16_t* dst = MG + row * 1024 + col0 + bj * HALF;
                    if (!FIRST) { const u32x4 o = *(const u32x4*)dst;
                        v0[0] += bflo(o.x); v0[1] += bfhi(o.x); v0[2] += bflo(o.y); v0[3] += bfhi(o.y); v1[0] += bflo(o.z); v1[1] += bfhi(o.z); v1[2] += bflo(o.w); v1[3] += bfhi(o.w); }
                    *(u32x4*)dst = pack8(v0, v1); } }
    }
};
__device__ __forceinline__ float u8f(unsigned w, int i) { return (float)((w >> (8 * i)) & 255u); }
struct EpiHorner {
    static constexpr bool PERM = true, AFTER_DRAIN = false, IDEMPOTENT = true;
    bf16_t* MG; const unsigned char* GT;
    __device__ __forceinline__ void mid(f32x4 (&acc)[2][2][4][2], const Unit& u, int s, int wr, int wc, int fr, int fq) const {
        typedef unsigned u32x2_ __attribute__((ext_vector_type(2)));
        const int row0 = u.pm * BM + wr * 64 + fr, col0 = u.pn * BM + wc * 32 + 8 * fq;
        u32x2_ ga[2][4][2], gb[2][4][2];
#pragma unroll
        for (int ai = 0; ai < 2; ++ai)
#pragma unroll
            for (int m = 0; m < 4; ++m) { const unsigned char* gp = GT + (size_t)(row0 + ai * HALF + m * 16) * 3072 + (s - 1) * 1024 + col0;
#pragma unroll
                for (int bj = 0; bj < 2; ++bj) { ga[ai][m][bj] = *(const u32x2_*)(gp + bj * HALF); gb[ai][m][bj] = *(const u32x2_*)(gp + 1024 + bj * HALF); } }
        asm volatile("" ::: "memory");
#pragma unroll
        for (int ai = 0; ai < 2; ++ai)
#pragma unroll
            for (int m = 0; m < 4; ++m)
#pragma unroll
                for (int bj = 0; bj < 2; ++bj) { const u32x2_ a = ga[ai][m][bj], b = gb[ai][m][bj];
                    f32x4& v0 = acc[ai][bj][m][0]; f32x4& v1 = acc[ai][bj][m][1];
#pragma unroll
                    for (int j = 0; j < 4; ++j) { const float n0 = s == 1 ? u8f(a.x, j) : fmaxf(u8f(a.x, j), 0.5f), n1 = s == 1 ? u8f(a.y, j) : fmaxf(u8f(a.y, j), 0.5f);
                        v0[j] *= n0 * __builtin_amdgcn_rcpf(fmaxf(u8f(b.x, j), 0.5f)); v1[j] *= n1 * __builtin_amdgcn_rcpf(fmaxf(u8f(b.y, j), 0.5f)); } }
    }
    __device__ __forceinline__ void operator()(const f32x4 (&acc)[2][2][4][2], const Unit& u, int wr, int wc, int fr, int fq) const {
        typedef unsigned u32x2_ __attribute__((ext_vector_type(2)));
        const int row0 = u.pm * BM + wr * 64 + fr, col0 = u.pn * BM + wc * 32 + 8 * fq; const float q = 1.0f / 255.0f;
        u32x2_ gg[2][4][2];
#pragma unroll
        for (int ai = 0; ai < 2; ++ai)
#pragma unroll
            for (int m = 0; m < 4; ++m)
#pragma unroll
                for (int bj = 0; bj < 2; ++bj) gg[ai][m][bj] = *(const u32x2_*)(GT + (size_t)(row0 + ai * HALF + m * 16) * 3072 + 2048 + col0 + bj * HALF);
        asm volatile("" ::: "memory");
#pragma unroll
        for (int ai = 0; ai < 2; ++ai)
#pragma unroll
            for (int m = 0; m < 4; ++m) { const size_t row = (size_t)(row0 + ai * HALF + m * 16);
#pragma unroll
                for (int bj = 0; bj < 2; ++bj) { const u32x2_ g = gg[ai][m][bj];
                    f32x4 v0 = acc[ai][bj][m][0], v1 = acc[ai][bj][m][1];
#pragma unroll
                    for (int j = 0; j < 4; ++j) { v0[j] *= fmaxf(u8f(g.x, j), 0.5f) * q; v1[j] *= fmaxf(u8f(g.y, j), 0.5f) * q; }
                    *(u32x4*)(MG + row * 1024 + col0 + bj * HALF) = pack8(v0, v1); } }
    }
};
__device__ __forceinline__ unsigned pack4_fp8(float a, float b, float c, float d) { int p = 0; p = __builtin_amdgcn_cvt_pk_fp8_f32(a, b, p, false); p = __builtin_amdgcn_cvt_pk_fp8_f32(c, d, p, true); return (unsigned)p; }
template <bool F8> struct EpiSwiglu {
    static constexpr bool PERM = true, AFTER_DRAIN = false, IDEMPOTENT = true;
    void* H; int ld, nmod; float scale;
    __device__ __forceinline__ void operator()(const f32x4 (&acc)[2][2][4][2], const Unit& u, int wr, int wc, int fr, int fq) const {
        const int row0 = u.pm * BM + wr * 64 + fr, col0 = (u.pn % nmod) * HALF + wc * 32 + 8 * fq;
#pragma unroll
        for (int ai = 0; ai < 2; ++ai)
#pragma unroll
            for (int m = 0; m < 4; ++m) {
                f32x4 h0, h1;
#pragma unroll
                for (int j = 0; j < 4; ++j) { const float g0 = acc[ai][0][m][0][j] * scale, g1 = acc[ai][0][m][1][j] * scale;
                    h0[j] = g0 * sigm(g0) * (acc[ai][1][m][0][j] * scale); h1[j] = g1 * sigm(g1) * (acc[ai][1][m][1][j] * scale); }
                const size_t off = (size_t)(row0 + ai * HALF + m * 16) * ld + col0;
                if constexpr (F8) { typedef unsigned u32x2_ __attribute__((ext_vector_type(2))); u32x2_ w; w.x = pack4_fp8(h0[0], h0[1], h0[2], h0[3]); w.y = pack4_fp8(h1[0], h1[1], h1[2], h1[3]); *(u32x2_*)((unsigned char*)H + off) = w; }
                else *(u32x4*)((bf16_t*)H + off) = pack8(h0, h1); }
    }
};
struct EpiIn {
    static constexpr bool PERM = true, AFTER_DRAIN = false, IDEMPOTENT = true;
    unsigned char* ws; size_t oQ, oKV, oFAB, oCIN, oGT, oROPE; float qscale;
    __device__ __forceinline__ void operator()(const f32x4 (&acc)[2][2][4][2], const Unit& u, int wr, int wc, int fr, int fq) const {
        const int pn = u.pn, lc0 = wc * 32 + 8 * fq, row0 = u.pm * BM + wr * 64 + fr;
        const bool ctxrow = u.pm >= 128;
        bf16_t* const Q = (bf16_t*)(ws + oQ); bf16_t* const KV = (bf16_t*)(ws + oKV); bf16_t* const FAB = (bf16_t*)(ws + oFAB); bf16_t* const CIN = (bf16_t*)(ws + oCIN); bf16_t* const GT = (bf16_t*)(ws + oGT);
        const float* const rope = (const float*)(ws + oROPE);
#pragma unroll
        for (int bj = 0; bj < 2; ++bj) {
            const int cc = bj * HALF + lc0;
            int mode, ld, dcol; bf16_t* dst;
            if (pn < 2) { mode = 2; dst = Q; ld = 512; dcol = pn * 256 + cc; }
            else if (pn == 2) { dst = KV; ld = 256; dcol = cc; mode = (bj == 0) ? 3 : 0; }
            else if (pn < 7) { mode = 0; dst = FAB; ld = 1024; dcol = (pn - 3) * 256 + cc; }
            else if (pn < 13) { mode = 0; dst = CIN; ld = 1536; dcol = (pn - 7) * 256 + cc; }
            else { mode = 1; dst = GT; ld = 3072; dcol = (pn - 13) * 256 + cc; }
            if (mode == 0) {
#pragma unroll
                for (int ai = 0; ai < 2; ++ai)
#pragma unroll
                    for (int m = 0; m < 4; ++m) *(u32x4*)(dst + (size_t)(row0 + ai * HALF + m * 16) * ld + dcol) = pack8(acc[ai][bj][m][0], acc[ai][bj][m][1]);
            } else if (mode == 1) {
#pragma unroll
                for (int ai = 0; ai < 2; ++ai)
#pragma unroll
                    for (int m = 0; m < 4; ++m) { const f32x4 v0 = acc[ai][bj][m][0], v1 = acc[ai][bj][m][1]; typedef unsigned u32x2_ __attribute__((ext_vector_type(2)));
                        u32x2_ w; w.x = gate4_u8(sigm(v0[0]), sigm(v0[1]), sigm(v0[2]), sigm(v0[3])); w.y = gate4_u8(sigm(v1[0]), sigm(v1[1]), sigm(v1[2]), sigm(v1[3]));
                        *(u32x2_*)((unsigned char*)GT + (size_t)(row0 + ai * HALF + m * 16) * 3072 + dcol) = w; }
            } else {
                const float qs = (mode == 2) ? qscale : 1.0f;
                const int i0 = (dcol & 63) >> 1;
#pragma unroll
                for (int ai = 0; ai < 2; ++ai) {
                    f32x4 t0[4], t1[4];
                    if (!ctxrow) {
#pragma unroll
                        for (int m = 0; m < 4; ++m) { const int s = (row0 + ai * HALF + m * 16) & 16383, pos = (i0 < 16) ? (s >> 6) : (s & 63);
                            const float* t = rope + (size_t)(pos * 16 + (i0 & 15)) * 2; t0[m] = *(const f32x4*)t; t1[m] = *(const f32x4*)(t + 4); }
                        asm volatile("" ::: "memory");
                    }
#pragma unroll
                    for (int m = 0; m < 4; ++m) { f32x4 v0 = acc[ai][bj][m][0], v1 = acc[ai][bj][m][1];
                        if (!ctxrow) { const f32x4 a = t0[m], b = t1[m];
                            f32x4 r0, r1;
                            r0[0] = v0[0] * a[0] - v0[1] * a[1]; r0[1] = v0[0] * a[1] + v0[1] * a[0]; r0[2] = v0[2] * a[2] - v0[3] * a[3]; r0[3] = v0[2] * a[3] + v0[3] * a[2];
                            r1[0] = v1[0] * b[0] - v1[1] * b[1]; r1[1] = v1[0] * b[1] + v1[1] * b[0]; r1[2] = v1[2] * b[2] - v1[3] * b[3]; r1[3] = v1[2] * b[3] + v1[3] * b[2];
                            v0 = r0; v1 = r1; }
                        v0 = v0 * qs; v1 = v1 * qs;
                        *(u32x4*)(dst + (size_t)(row0 + ai * HALF + m * 16) * ld + dcol) = pack8(v0, v1); }
                }
            }
        }
    }
};

template <class Epi, class Sched, bool ALIGN_EPI = false, bool SP2 = false, int DT = 0, bool SEG = false>
__device__ __forceinline__ void gemm_phase(PG8_LAS unsigned char* lds, const Gemm g, const Sched& S, const Epi& E, int wave_id  , int stagger_ticks = 0) {
    unsigned z_ = 0u; asm volatile("" : "+v"(z_)); int wid_ = wave_id; asm volatile("" : "+s"(wid_));
    const int lane_ = (int)__builtin_amdgcn_mbcnt_hi(~0u, __builtin_amdgcn_mbcnt_lo(~0u, z_));
    const int wid = wid_, lane = lane_, tid = wid * 64 + lane, wr = wid >> 2, wc = wid & 3, fr = lane & 15, fq = lane >> 4;
    constexpr bool FP8 = (DT == 1), I8 = (DT == 2);
    const int K = g.K, ldk = g.ld ? g.ld : K, pitch = DT ? ldk : 2 * ldk  , nt = (DT ? K : 2 * K) / 128;
#define PG8_PA(base, tt) (SEG ? (base) + ((tt) < 8 ? 0L : (tt) < 16 ? g.A1off : g.A2off) + (size_t)((tt) & 7) * kstep : (base) + (size_t)(tt) * kstep)
#define PG8_PB(base, tt) (SEG ? (base) + (size_t)((tt) >> 3) * g.Bseg + (size_t)((tt) & 7) * kstep : (base) + (size_t)(tt) * kstep)
    unsigned voffA, voffB;
    { int R, C; stage_rc(tid * 16, R, C); const int Rb = Epi::PERM ? ((R & ~31) + perm32(R & 31)) : R;
        voffA = (unsigned)(R * pitch + C * 2); voffB = (unsigned)(Rb * pitch + C * 2); }
    const size_t pstep = (size_t)64 * pitch;
    const size_t kstep = (size_t)(BK * 2);
    const size_t hstep = (size_t)HALF * pitch;
    const size_t tstep = 2 * hstep;
    const unsigned ldsw = (unsigned)wid * 1024u;
    const int aoff = lds_byte(wr * 64 + fr, fq * 8), boff = lds_byte(wc * 32 + fr, fq * 8);
#define PG8_SA(b, h) (((b) * 2 + (h)) * HTB)
#define PG8_SB(b, h) ((4 + (b) * 2 + (h)) * HTB)
#define PG8_STAGE(bufoff, gbase, voff) do { _Pragma("unroll") for (int _i = 0; _i < 2; ++_i) \
        __builtin_amdgcn_global_load_lds((const unsigned*)((const char*)(gbase) + _i * pstep + (voff)), (PG8_LAS unsigned*)(lds + (bufoff) + ldsw + _i * 8192), 16, 0, 0); } while (0)
#define PG8_LDA(dst, b, h) do { _Pragma("unroll") for (int m = 0; m < 4; ++m) _Pragma("unroll") for (int k = 0; k < 2; ++k) dst[m][k] = *(const PG8_LAS bf16x8*)(lds + PG8_SA(b, h) + aoff + m * 2048 + k * 1024); } while (0)
#define PG8_LDB(dst, b, h) do { _Pragma("unroll") for (int n = 0; n < 2; ++n) _Pragma("unroll") for (int k = 0; k < 2; ++k) dst[n][k] = *(const PG8_LAS bf16x8*)(lds + PG8_SB(b, h) + boff + n * 2048 + k * 1024); } while (0)
#define PG8_MMA(ai, bj, At, Bt) do { __builtin_amdgcn_s_setprio(1); _Pragma("unroll") for (int m = 0; m < 4; ++m) _Pragma("unroll") for (int n = 0; n < 2; ++n) { \
        if constexpr (FP8) { typedef int i32x4_ __attribute__((ext_vector_type(4))); \
            acc[ai][bj][m][n] = __builtin_amdgcn_mfma_scale_f32_16x16x128_f8f6f4(__builtin_shufflevector(__builtin_bit_cast(i32x4_, Bt[n][0]), __builtin_bit_cast(i32x4_, Bt[n][1]), 0, 1, 2, 3, 4, 5, 6, 7), \
                __builtin_shufflevector(__builtin_bit_cast(i32x4_, At[m][0]), __builtin_bit_cast(i32x4_, At[m][1]), 0, 1, 2, 3, 4, 5, 6, 7), acc[ai][bj][m][n], 0, 0, 0, 0, 0, 0); } \
        else if constexpr (I8) { typedef int i32x4_ __attribute__((ext_vector_type(4))); _Pragma("unroll") for (int k = 0; k < 2; ++k) \
            acc[ai][bj][m][n] = __builtin_bit_cast(f32x4, __builtin_amdgcn_mfma_i32_16x16x64_i8(__builtin_bit_cast(i32x4_, Bt[n][k]), __builtin_bit_cast(i32x4_, At[m][k]), __builtin_bit_cast(i32x4_, acc[ai][bj][m][n]), 0, 0, 0)); } \
        else { _Pragma("unroll") for (int k = 0; k < 2; ++k) acc[ai][bj][m][n] = __builtin_amdgcn_mfma_f32_16x16x32_bf16(Bt[n][k], At[m][k], acc[ai][bj][m][n], 0, 0, 0); } } \
        __builtin_amdgcn_s_setprio(0); } while (0)
#define PG8_WAIT_V(n) asm volatile("s_waitcnt vmcnt(" #n ")" ::: "memory")
#define PG8_WAIT_L(n) asm volatile("s_waitcnt lgkmcnt(" #n ")" ::: "memory")
#define PG8_BAR __builtin_amdgcn_s_barrier()
#define PG8_SCHED __builtin_amdgcn_sched_barrier(0)
    Unit cur, nxt; int ui = 0;
    if (!S.next(0, cur)) return;
    if (stagger_ticks > 0) { const unsigned long long t0_ = __builtin_amdgcn_s_memrealtime(); while (__builtin_amdgcn_s_memrealtime() - t0_ < (unsigned long long)stagger_ticks) __builtin_amdgcn_s_sleep(4); }
    f32x4 acc[2][2][4][2];
#pragma unroll
    for (int a = 0; a < 2; ++a)
#pragma unroll
        for (int b = 0; b < 2; ++b)
#pragma unroll
            for (int m = 0; m < 4; ++m)
#pragma unroll
                for (int n = 0; n < 2; ++n) acc[a][b][m][n] = (f32x4){0.f, 0.f, 0.f, 0.f};
    bf16x8 At[4][2], B0[2][2], B1[2][2];
    const char* cA = (const char*)g.A + (size_t)cur.pm * tstep; const char* cB = (const char*)g.Bt + (size_t)cur.pn * tstep;
    S.a_ready(cur);
    if constexpr (SP2) {
        PG8_STAGE(PG8_SB(0, 0), cB, voffB); PG8_STAGE(PG8_SB(0, 1), cB + hstep, voffB); PG8_STAGE(PG8_SA(0, 0), cA, voffA); PG8_STAGE(PG8_SA(0, 1), cA + hstep, voffA);
        if (wr == 1) PG8_BAR;
        PG8_WAIT_V(2); PG8_BAR;
        PG8_STAGE(PG8_SB(1, 0), cB + kstep, voffB); PG8_STAGE(PG8_SA(1, 0), cA + kstep, voffA); PG8_STAGE(PG8_SB(1, 1), cB + hstep + kstep, voffB);
        PG8_WAIT_V(6); PG8_BAR;
    } else {
        PG8_STAGE(PG8_SB(0, 0), cB, voffB); PG8_STAGE(PG8_SA(0, 0), cA, voffA); PG8_STAGE(PG8_SB(0, 1), cB + hstep, voffB); PG8_STAGE(PG8_SA(0, 1), cA + hstep, voffA);
        if (wr == 1) PG8_BAR;
        PG8_WAIT_V(4); PG8_BAR;
        PG8_STAGE(PG8_SB(1, 0), cB + kstep, voffB); PG8_STAGE(PG8_SA(1, 0), cA + kstep, voffA); PG8_STAGE(PG8_SB(1, 1), cB + hstep + kstep, voffB);
        PG8_WAIT_V(6); PG8_BAR;
    }
    for (;;) {
        const bool has_next = S.next(ui + 1, nxt);
        const char* nA = has_next ? (const char*)g.A + (size_t)nxt.pm * tstep : cA; const char* nB = has_next ? (const char*)g.Bt + (size_t)nxt.pn * tstep : cB;
#pragma unroll 1
        for (int t = 0; t < nt; t += 2) {
            const bool last = (t == nt - 2);
            if constexpr (SEG) { if (t == 8 || t == 16) { unsigned zm_ = 0u; asm volatile("" : "+v"(zm_)); const int lm_ = (int)__builtin_amdgcn_mbcnt_hi(~0u, __builtin_amdgcn_mbcnt_lo(~0u, zm_)); E.mid(acc, cur, t >> 3, wr, wc, lm_ & 15, lm_ >> 4); } }
            const char* a1 = PG8_PA(cA, t + 1);
            const char* a2 = last ? nA : PG8_PA(cA, t + 2); const char* b2 = last ? nB : PG8_PB(cB, t + 2);
            const char* a3 = a2 + kstep; const char* b3 = b2 + kstep;
            if (last && has_next) S.a_ready(nxt);
            if constexpr (SP2) {
            PG8_LDB(B0, 0, 0); PG8_LDB(B1, 0, 1); PG8_SCHED; PG8_LDA(At, 0, 0); PG8_STAGE(PG8_SA(1, 1), a1 + hstep, voffA);
            PG8_WAIT_V(8); PG8_WAIT_L(0); PG8_BAR; PG8_MMA(0, 0, At, B0); PG8_MMA(0, 1, At, B1); PG8_BAR; PG8_SCHED;
            PG8_LDA(At, 0, 1); PG8_STAGE(PG8_SB(0, 0), b2, voffB); PG8_STAGE(PG8_SB(0, 1), b2 + hstep, voffB); PG8_STAGE(PG8_SA(0, 0), a2, voffA);
            PG8_WAIT_V(8); PG8_WAIT_L(0); PG8_BAR; PG8_MMA(1, 0, At, B0); PG8_MMA(1, 1, At, B1); PG8_BAR; PG8_SCHED;
            PG8_LDB(B0, 1, 0); PG8_LDB(B1, 1, 1); PG8_SCHED; PG8_LDA(At, 1, 0); PG8_STAGE(PG8_SA(0, 1), a2 + hstep, voffA);
            PG8_WAIT_V(8); PG8_WAIT_L(0); PG8_BAR; PG8_MMA(0, 0, At, B0); PG8_MMA(0, 1, At, B1); PG8_BAR; PG8_SCHED;
            PG8_LDA(At, 1, 1); PG8_STAGE(PG8_SB(1, 0), b3, voffB); PG8_STAGE(PG8_SB(1, 1), b3 + hstep, voffB); PG8_STAGE(PG8_SA(1, 0), a3, voffA);
            PG8_WAIT_V(8); PG8_WAIT_L(0); PG8_BAR; PG8_MMA(1, 0, At, B0); PG8_MMA(1, 1, At, B1); PG8_BAR; PG8_SCHED;
            } else {
            PG8_LDB(B0, 0, 0); PG8_SCHED; PG8_LDA(At, 0, 0); PG8_STAGE(PG8_SA(1, 1), a1 + hstep, voffA);
            PG8_WAIT_L(8); PG8_BAR; PG8_WAIT_L(0); PG8_MMA(0, 0, At, B0); PG8_BAR; PG8_SCHED;
            PG8_LDB(B1, 0, 1); PG8_STAGE(PG8_SB(0, 0), b2, voffB);
            PG8_BAR; PG8_WAIT_L(0); PG8_MMA(0, 1, At, B1); PG8_BAR;
            PG8_LDA(At, 0, 1); PG8_STAGE(PG8_SA(0, 0), a2, voffA);
            PG8_BAR; PG8_WAIT_L(0); PG8_MMA(1, 0, At, B0); PG8_BAR; PG8_SCHED;
            PG8_STAGE(PG8_SB(0, 1), b2 + hstep, voffB);
            PG8_WAIT_V(6); PG8_BAR; PG8_MMA(1, 1, At, B1); PG8_BAR;
            PG8_LDB(B0, 1, 0); PG8_SCHED; PG8_LDA(At, 1, 0); PG8_STAGE(PG8_SA(0, 1), a2 + hstep, voffA);
            PG8_WAIT_L(8); PG8_BAR; PG8_WAIT_L(0); PG8_MMA(0, 0, At, B0); PG8_BAR; PG8_SCHED;
            PG8_LDB(B1, 1, 1); PG8_STAGE(PG8_SB(1, 0), b3, voffB);
            PG8_BAR; PG8_WAIT_L(0); PG8_MMA(0, 1, At, B1); PG8_BAR;
            PG8_LDA(At, 1, 1); PG8_STAGE(PG8_SA(1, 0), a3, voffA);
            PG8_BAR; PG8_WAIT_L(0); PG8_MMA(1, 0, At, B0); PG8_BAR; PG8_SCHED;
            PG8_STAGE(PG8_SB(1, 1), b3 + hstep, voffB);
            PG8_WAIT_V(6); PG8_BAR; PG8_MMA(1, 1, At, B1); PG8_BAR;
            }
        }
        if constexpr (ALIGN_EPI) { if (wr == 0) PG8_BAR; }
        if constexpr (!Epi::AFTER_DRAIN) { unsigned ze_ = 0u; asm volatile("" : "+v"(ze_)); const int le_ = (int)__builtin_amdgcn_mbcnt_hi(~0u, __builtin_amdgcn_mbcnt_lo(~0u, ze_));
            if constexpr (I8) {
                typedef int i32x4_ __attribute__((ext_vector_type(4)));
                const int fr_ = le_ & 15, fq_ = le_ >> 4; const float* rsp = g.rs + (size_t)cur.pm * BM + wr * 64 + fr_; const float* csp = g.cs + (size_t)cur.pn * BM + wc * 32 + 8 * fq_;
                f32x4 cv[2][2];
                _Pragma("unroll") for (int bj = 0; bj < 2; ++bj) _Pragma("unroll") for (int n = 0; n < 2; ++n) cv[bj][n] = *(const f32x4*)(csp + bj * HALF + 4 * n);
                _Pragma("unroll") for (int ai = 0; ai < 2; ++ai) _Pragma("unroll") for (int m = 0; m < 4; ++m) { const float rv = rsp[ai * HALF + m * 16];
                    _Pragma("unroll") for (int bj = 0; bj < 2; ++bj) _Pragma("unroll") for (int n = 0; n < 2; ++n)
                        acc[ai][bj][m][n] = __builtin_convertvector(__builtin_bit_cast(i32x4_, acc[ai][bj][m][n]), f32x4) * (cv[bj][n] * rv); }
            }
            E(acc, cur, wr, wc, le_ & 15, le_ >> 4);
#if defined(REP_EPI)
            if constexpr (Epi::IDEMPOTENT) { for (int r_ = 1; r_ < REP_EPI; ++r_) { asm volatile("" ::: "memory"); E(acc, cur, wr, wc, le_ & 15, le_ >> 4); } }
#endif
            S.done(cur); }
        if (!has_next) break;
#pragma unroll
        for (int a = 0; a < 2; ++a)
#pragma unroll
            for (int b = 0; b < 2; ++b)
#pragma unroll
                for (int m = 0; m < 4; ++m)
#pragma unroll
                    for (int n = 0; n < 2; ++n) acc[a][b][m][n] = (f32x4){0.f, 0.f, 0.f, 0.f};
        cur = nxt; cA = nA; cB = nB; ++ui;
        if constexpr (ALIGN_EPI) { if (wr == 1) PG8_BAR; }
    }
    PG8_WAIT_V(0);
    if constexpr (!ALIGN_EPI) { if (wr == 0) PG8_BAR; }
    PG8_BAR;
    if constexpr (Epi::AFTER_DRAIN) { E.fused(acc, cur, wr, wc, fr, fq, lds, wid, lane); S.done(cur); }
#undef PG8_PA
#undef PG8_PB
#undef PG8_SA
#undef PG8_SB
#undef PG8_STAGE
#undef PG8_LDA
#undef PG8_LDB
#undef PG8_MMA
#undef PG8_WAIT_V
#undef PG8_WAIT_L
#undef PG8_BAR
#undef PG8_SCHED
}
}
#define GAS __attribute__((address_space(1)))
#define LAS __attribute__((address_space(3)))
typedef pg8::bf16_t bf16_t;
typedef pg8::bf16x8 bf16x8;
typedef pg8::f32x4 f32x4;
typedef pg8::u32x4 u32x4;
typedef float f32x16 __attribute__((ext_vector_type(16)));
typedef float f32x2 __attribute__((ext_vector_type(2)));
typedef short s16x4 __attribute__((ext_vector_type(4)));
typedef unsigned u32x2 __attribute__((ext_vector_type(2)));
typedef GAS unsigned gu32;

typedef const __attribute__((address_space(4))) unsigned char* kptr_t;
__device__ __forceinline__ kptr_t kbase() { kptr_t p = (kptr_t)__builtin_amdgcn_kernarg_segment_ptr(); asm volatile("" : "+s"(p)); return p; }
#define IN_(i) (*(const float* const __attribute__((address_space(4)))*)(kbase() + 8 * (i)))
#define OUT_ (*(float* const __attribute__((address_space(4)))*)(kbase() + 200))
#define WS_ (*(unsigned char* const __attribute__((address_space(4)))*)(kbase() + 208))
constexpr int NWAVES = 8, NTHREADS = 512;
constexpr int D = 1024, SEQ = 16384, M_LAT = 32768, CTXL = 256, M_CTX = 512, MT = M_LAT + M_CTX;
constexpr int ZN = 6400, DFF = 2816, DEXP = 3584, NEXP = 8, NMOD = 6144;
constexpr float EPS = 1e-6f, LOG2E = 1.4426950408889634f, QSCALE = 0.125f * LOG2E;
constexpr int CHUNK_TILES = 128, CHUNK_MAX = 136, CHUNK_ROWS = CHUNK_MAX * 256;
constexpr float WSCALE8 = 64.0f;

constexpr size_t MiB = 1u << 20;
constexpr size_t WS_CTL = 0, CTL_BYTES = 1 * MiB;
constexpr size_t WS_MODV = 6 * MiB + 768 * 1024;
constexpr size_t WS_MODF = 1 * MiB;
constexpr size_t WS_CS = 1 * MiB + 152 * 1024;
constexpr size_t WS_RS = 1 * MiB + 864 * 1024;
constexpr size_t WS_ROPE = 1 * MiB + 256 * 1024;
constexpr size_t WS_G1 = 1 * MiB + 512 * 1024;
constexpr size_t WS_G2 = 1 * MiB + 768 * 1024;
constexpr size_t WS_HCTX = 2 * MiB;
constexpr size_t WS_ASG = 4 * MiB;
constexpr size_t WS_ELIST = 5 * MiB;
constexpr size_t WS_TW = 6 * MiB;
constexpr size_t WS_G3 = 6 * MiB + 512 * 1024;
constexpr size_t WS_WIN = 8 * MiB, WIN_BYTES = (size_t)ZN * D;
constexpr size_t WS_WY = 33 * MiB;
constexpr size_t WS_WO = 39 * MiB;
constexpr size_t WS_WFF_UP = 43 * MiB;
constexpr size_t WS_WFF_DN = 54 * MiB;
constexpr size_t WS_HN = 60 * MiB;
constexpr size_t WS_Q = 125 * MiB;
constexpr size_t WS_KV = WS_Q + (size_t)MT * 512 * 2;
constexpr size_t WS_FAB = 174 * MiB;
constexpr size_t WS_CIN = 239 * MiB;
constexpr size_t WS_GT = WS_CIN + (size_t)MT * 1536 * 2;
constexpr size_t WS_COUT = 434 * MiB;
constexpr size_t WS_ATT = WS_COUT + (size_t)MT * 512 * 2;
constexpr size_t WS_MIX = WS_GT;
constexpr size_t WS_HID0 = 125 * MiB;
constexpr size_t WS_F0 = 434 * MiB;
constexpr size_t WS_EXUP = 499 * MiB;
constexpr size_t WS_EXDN = 555 * MiB;
constexpr size_t WS_H2G = 209 * MiB;
constexpr size_t WS_HIDX = 244 * MiB;
constexpr size_t WS_YEXP = 363 * MiB;
constexpr size_t WS_NEED = 583 * MiB;
static_assert(WS_KV + (size_t)MT * 256 * 2 <= WS_FAB && WS_FAB + (size_t)MT * 1024 * 2 <= WS_CIN && WS_GT + (size_t)MT * 3072 <= WS_COUT && WS_ATT + (size_t)MT * 512 * 2 <= WS_EXUP, "ws map (mixer)");
static_assert(WS_HN + (size_t)MT * 1024 * 2 <= WS_Q && WS_WFF_DN + (size_t)1024 * DFF * 2 <= WS_HN && WS_WFF_UP + (size_t)2 * DFF * 1024 * 2 <= WS_WFF_DN, "ws map (weights)");
static_assert(WS_HID0 + (size_t)MT * DFF * 2 <= WS_MIX && WS_MIX + (size_t)MT * 1024 * 2 <= WS_F0 && WS_F0 + (size_t)MT * 1024 * 2 <= WS_EXUP && WS_EXUP + (size_t)8 * 7168 * 1024 <= WS_EXDN && WS_EXDN + (size_t)8 * 1024 * DEXP <= WS_NEED, "ws map (ffn)");
static_assert(WS_H2G + (size_t)CHUNK_ROWS * 1024 <= WS_HIDX && WS_HIDX + (size_t)CHUNK_ROWS * DEXP <= WS_YEXP && WS_YEXP + (size_t)264 * 256 * 1024 * 2 <= WS_EXUP, "ws map (moe)");
constexpr int CW_BAR = 4096;
constexpr int CW_CNT = 8192;
constexpr int CW_COLMAX = 16384;
constexpr int CW_FOLDMAX = CW_COLMAX + 2 * 6400 + 5632;

constexpr int RING_BYTES = 131072;
constexpr int MISC_OFF = RING_BYTES + 320;
constexpr int LDSX_OFF = RING_BYTES + 1024;
constexpr int LDS_BYTES = 147456;

#define LDS_WAIT() asm volatile("s_waitcnt lgkmcnt(0)" ::: "memory")
#define VM_WAIT() asm volatile("s_waitcnt vmcnt(0)" ::: "memory")

#define XB_TMO      128
#define XB_XCNT(j)  (256  + 64 * (j))
#define XB_XSUB(j)  (1280 + 64 * (j))
#define XB_XGEN(j)  (2304 + 64 * (j))
#define XB_TOP      3328
#define XB_TOPGEN   3392
#define XCD_BAR_WORDS 3456
#define XB_SPIN_CAP (1u << 22)

__device__ __forceinline__ unsigned xb_ld(unsigned* p)              { return __hip_atomic_load(p, __ATOMIC_RELAXED, __HIP_MEMORY_SCOPE_AGENT); }
__device__ __forceinline__ unsigned xb_add(unsigned* p, unsigned v) { return __hip_atomic_fetch_add(p, v, __ATOMIC_RELAXED, __HIP_MEMORY_SCOPE_AGENT); }
__device__ __forceinline__ unsigned xb_xcc_id() { return (unsigned)__builtin_amdgcn_s_getreg((3 << 11) | 20) & 0xFu; }
#define XB_SPIN(cond, bar) do { unsigned _sp = 0; while (cond) { __builtin_amdgcn_s_sleep(1); \
    if ((++_sp & 255u) == 0u) { if (xb_ld(&(bar)[XB_TMO])) break; if (_sp > XB_SPIN_CAP) { atomicAdd(&(bar)[XB_TMO], 1u); break; } } } } while (0)

struct XcdBarrier {
    unsigned* bar; unsigned x;
    volatile LAS unsigned* st;
};

__device__ __forceinline__ XcdBarrier xcd_barrier_post(unsigned* bar, volatile LAS unsigned* st) {
    XcdBarrier b; b.bar = bar; b.x = xb_xcc_id(); b.st = st;
    if (threadIdx.x == 0) (void)xb_add(&bar[XB_XCNT(b.x)], 1u);
    return b;
}
__device__ __forceinline__ void xcd_barrier_complete(unsigned* bar, unsigned x, unsigned& nloc, unsigned& nx) {
    const unsigned G = gridDim.x * gridDim.y * gridDim.z;
    unsigned sum, cnt, mine, sp = 0u;
    for (;;) {
        sum = 0u; cnt = 0u; mine = 0u;
#pragma unroll
        for (unsigned j = 0; j < 16; ++j) { const unsigned c = xb_ld(&bar[XB_XCNT(j)]); sum += c; cnt += (c > 0u) ? 1u : 0u; mine = (j == x) ? c : mine; }
        if (sum == G) break;
        __builtin_amdgcn_s_sleep(1);
        if ((++sp & 255u) == 0u) { if (xb_ld(&bar[XB_TMO])) break; if (sp > XB_SPIN_CAP) { atomicAdd(&bar[XB_TMO], 1u); break; } }
    }
    nloc = mine > 0u ? mine : 1u; nx = cnt > 0u ? cnt : 1u;
}

__device__ __forceinline__ void xcd_barrier(const XcdBarrier& b) {
    asm volatile("s_waitcnt vmcnt(0)" ::: "memory");
    __syncthreads();
    if (threadIdx.x == 0) {
        unsigned* bar = b.bar;
        __builtin_amdgcn_s_waitcnt(0);
        unsigned nloc = b.st[0], nx = b.st[1];
        if (nloc == 0u) { xcd_barrier_complete(bar, b.x, nloc, nx); b.st[0] = nloc; b.st[1] = nx; }
        const unsigned old = xb_add(&bar[XB_XSUB(b.x)], 1u);
        const unsigned gen = old / nloc;
        if (old + 1u == (gen + 1u) * nloc) {
            __builtin_amdgcn_fence(__ATOMIC_RELEASE, "agent");
            asm volatile("s_waitcnt vmcnt(0)" ::: "memory");
            const unsigned og = xb_add(&bar[XB_TOP], 1u);
            const unsigned tg = og / nx;
            if (og + 1u == (tg + 1u) * nx) xb_add(&bar[XB_TOPGEN], 1u);
            else XB_SPIN(xb_ld(&bar[XB_TOPGEN]) == tg, bar);
            __builtin_amdgcn_fence(__ATOMIC_ACQUIRE, "agent");
            xb_add(&bar[XB_XGEN(b.x)], 1u);
            asm volatile("s_waitcnt vmcnt(0)" ::: "memory");
        } else {
            XB_SPIN(xb_ld(&bar[XB_XGEN(b.x)]) == gen, bar);
            __builtin_amdgcn_fence(__ATOMIC_ACQUIRE, "agent");
            asm volatile("s_waitcnt vmcnt(0)" ::: "memory");
        }
    }
    __syncthreads();
}

struct Params { const float* in[25]; float* out; unsigned char* ws; };
struct Ctx {
    LAS unsigned char* lds;
    int tid, lane, wave, vcu, G;
};
__device__ __forceinline__ Ctx opaque(const Ctx& c) { Ctx o = c; asm volatile("" : "+s"(o.wave), "+s"(o.vcu), "+s"(o.G));
    unsigned z = 0u; asm volatile("" : "+v"(z)); o.lane = (int)__builtin_amdgcn_mbcnt_hi(~0u, __builtin_amdgcn_mbcnt_lo(~0u, z)); o.tid = o.wave * 64 + o.lane; return o; }
template <int O> __device__ __forceinline__ float lane_xor(float v) { return __int_as_float(__builtin_amdgcn_ds_swizzle(__float_as_int(v), (O << 10) | 0x1f)); }
__device__ __forceinline__ float half_sum(float v) { const auto r = __builtin_amdgcn_permlane32_swap(__float_as_uint(v), __float_as_uint(v), false, false); return __uint_as_float(r[0]) + __uint_as_float(r[1]); }
__device__ __forceinline__ float half_max(float v) { const auto r = __builtin_amdgcn_permlane32_swap(__float_as_uint(v), __float_as_uint(v), false, false); return fmaxf(__uint_as_float(r[0]), __uint_as_float(r[1])); }
__device__ __forceinline__ float wave_max(float v) {
    v = fmaxf(v, lane_xor<1>(v)); v = fmaxf(v, lane_xor<2>(v)); v = fmaxf(v, lane_xor<4>(v)); v = fmaxf(v, lane_xor<8>(v)); v = fmaxf(v, lane_xor<16>(v));
    return half_max(v);
}
__device__ __forceinline__ unsigned pack4_i8(float a, float b, float c, float d) {
    const int qa = __float2int_rn(a), qb = __float2int_rn(b), qc = __float2int_rn(c), qd = __float2int_rn(d);
    return (unsigned)(qa & 255) | ((unsigned)(qb & 255) << 8) | ((unsigned)(qc & 255) << 16) | ((unsigned)qd << 24);
}
__device__ __forceinline__ float wave_sum(float v) {
    v += lane_xor<1>(v); v += lane_xor<2>(v); v += lane_xor<4>(v); v += lane_xor<8>(v); v += lane_xor<16>(v);
    return half_sum(v);
}
__device__ __forceinline__ unsigned pk2(float lo, float hi) { return pg8::cvt_pk_bf16(lo, hi); }
__device__ __forceinline__ float bflo(unsigned u) { return __uint_as_float(u << 16); }
__device__ __forceinline__ float bfhi(unsigned u) { return __uint_as_float(u & 0xffff0000u); }

__device__ __forceinline__ void tr_item(const float* W, int ldw, int k0, int n0, bf16_t* WT, int ldt, int drow0, LAS float* scr, int lane) {
#pragma unroll 8
    for (int i = 0; i < 32; ++i) { const int kk = 2 * i + (lane >> 5); scr[kk * 33 + (lane & 31)] = W[(size_t)(k0 + kk) * ldw + n0 + (lane & 31)]; }
    LDS_WAIT(); asm volatile("" ::: "memory");
    const int c = lane & 7;
#pragma unroll
    for (int j = 0; j < 4; ++j) { const int n = (lane >> 3) + 8 * j; const LAS float* s = scr + (8 * c) * 33 + n;
        u32x4 o; o.x = pk2(s[0 * 33], s[1 * 33]); o.y = pk2(s[2 * 33], s[3 * 33]); o.z = pk2(s[4 * 33], s[5 * 33]); o.w = pk2(s[6 * 33], s[7 * 33]);
        *(GAS u32x4*)(WT + (size_t)(drow0 + n) * ldt + k0 + 8 * c) = o; }
    LDS_WAIT(); asm volatile("" ::: "memory");
}
__device__ __forceinline__ void tr_item8(const float* W, int ldw, int k0, int n0, unsigned char* WT, int ldt, int drow0, float scale, LAS float* scr, int lane) {
#pragma unroll 8
    for (int i = 0; i < 32; ++i) { const int kk = 2 * i + (lane >> 5); scr[kk * 33 + (lane & 31)] = W[(size_t)(k0 + kk) * ldw + n0 + (lane & 31)]; }
    LDS_WAIT(); asm volatile("" ::: "memory");
    const int c = lane & 7;
#pragma unroll
    for (int j = 0; j < 4; ++j) { const int n = (lane >> 3) + 8 * j; const LAS float* s = scr + (8 * c) * 33 + n;
        u32x2 o; o.x = pg8::pack4_fp8(s[0 * 33] * scale, s[1 * 33] * scale, s[2 * 33] * scale, s[3 * 33] * scale); o.y = pg8::pack4_fp8(s[4 * 33] * scale, s[5 * 33] * scale, s[6 * 33] * scale, s[7 * 33] * scale);
        *(GAS u32x2*)(WT + (size_t)(drow0 + n) * ldt + k0 + 8 * c) = o; }
    LDS_WAIT(); asm volatile("" ::: "memory");
}
__device__ __forceinline__ void amax_item(const float* W, int ldw, int k0, int n0, unsigned* cmax, int drow0, int lane) {
    float m = 0.f;
#pragma unroll 8
    for (int i = 0; i < 32; ++i) { const int kk = 2 * i + (lane >> 5); m = fmaxf(m, fabsf(W[(size_t)(k0 + kk) * ldw + n0 + (lane & 31)])); }
    m = half_max(m);
    if (lane < 32) atomicMax(cmax + drow0 + lane, __float_as_uint(m));
}
__device__ __forceinline__ void tr_item_i8(const float* W, int ldw, int k0, int n0, unsigned char* WT, int ldt, int drow0, const unsigned* cmax, float* cs, LAS float* scr, int lane) {
#pragma unroll 8
    for (int i = 0; i < 32; ++i) { const int kk = 2 * i + (lane >> 5); scr[kk * 33 + (lane & 31)] = W[(size_t)(k0 + kk) * ldw + n0 + (lane & 31)]; }
    LDS_WAIT(); asm volatile("" ::: "memory");
    const int c = lane & 7;
#pragma unroll
    for (int j = 0; j < 4; ++j) { const int n = (lane >> 3) + 8 * j; const LAS float* s = scr + (8 * c) * 33 + n;
        const float inv = 127.0f / fmaxf(__uint_as_float(cmax[drow0 + n]), 1e-30f);
        u32x2 o; o.x = pack4_i8(s[0 * 33] * inv, s[1 * 33] * inv, s[2 * 33] * inv, s[3 * 33] * inv); o.y = pack4_i8(s[4 * 33] * inv, s[5 * 33] * inv, s[6 * 33] * inv, s[7 * 33] * inv);
        *(GAS u32x2*)(WT + (size_t)(drow0 + n) * ldt + k0 + 8 * c) = o; }
    if (k0 == 0 && lane < 32) cs[drow0 + lane] = __uint_as_float(cmax[drow0 + lane]) * (1.0f / 127.0f);
    LDS_WAIT(); asm volatile("" ::: "memory");
}
__device__ __forceinline__ int gu_row(int n0, int up) { return (n0 >> 7) * 256 + up * 128 + (n0 & 127); }

__device__ __forceinline__ void p0_convert_item(int it, int pass, LAS float* scr, int lane) {
    unsigned char* ws = WS_;
    unsigned* const cmax = (unsigned*)(ws + WS_CTL) + CW_COLMAX; float* const cs = (float*)(ws + WS_CS);
    if (it < 5376) { const int l = it / 2688, r = it % 2688, kb = r / 168, j = r % 168; const int n0 = j < 24 ? 32 * j : 1280 + 32 * (j - 24), drow = n0 < 768 ? n0 : n0 + 512;
        const float* W = IN_(10) + (size_t)l * D * 5888;
        if (pass == 0) amax_item(W, 5888, 64 * kb, n0, cmax + l * ZN, drow, lane);
        else tr_item_i8(W, 5888, 64 * kb, n0, ws + WS_WIN + l * WIN_BYTES, D, drow, cmax + l * ZN, cs + l * ZN, scr, lane);
        return; }
    it -= 5376;
    if (it < 2816) { const int up = it / 1408, r = it % 1408, kb = r / 88, nb = r % 88;
        if (pass == 0) amax_item(IN_(17 + up), DFF, 64 * kb, 32 * nb, cmax + 2 * ZN, gu_row(32 * nb, up), lane);
        else tr_item_i8(IN_(17 + up), DFF, 64 * kb, 32 * nb, ws + WS_WFF_UP, D, gu_row(32 * nb, up), cmax + 2 * ZN, cs + 2 * ZN, scr, lane);
        return; }
    it -= 2816;
    if (pass != 0) return;
    if (it < 1536) { const int mi = it / 256, r = it % 256, l = mi / 3, i = mi % 3, kb = r / 32, nb = r % 32;
        tr_item(IN_(13 + i) + (size_t)l * 512 * 1024, 1024, 64 * kb, 32 * nb, (bf16_t*)(ws + WS_WY) + (size_t)(l * 3 + i) * 1024 * 512, 512, 32 * nb, scr, lane); return; }
    it -= 1536;
    if (it < 1024) { const int l = it / 512, r = it % 512, kb = r / 32, nb = r % 32;
        tr_item(IN_(16) + (size_t)l * D * D, D, 64 * kb, 32 * nb, (bf16_t*)(ws + WS_WO) + (size_t)l * D * D, D, 32 * nb, scr, lane); return; }
    it -= 1024;
    { const int kb = it / 32, nb = it % 32; tr_item(IN_(19), D, 64 * kb, 32 * nb, (bf16_t*)(ws + WS_WFF_DN), DFF, 32 * nb, scr, lane); }
}
constexpr int P0_I8_ITEMS = 5376 + 2816;
constexpr int P0_ITEMS = 5376 + 1536 + 1024 + 2816 + 1408;
__device__ __forceinline__ void expert_convert_item(int it, LAS float* scr, int lane) {
    unsigned char* ws = WS_;
    const int e = it / 5376, r0 = it % 5376, which = r0 / 1792, r = r0 % 1792;
    if (which < 2) { const int kb = r / 112, nb = r % 112;
        tr_item8(IN_(22 + which) + (size_t)e * D * DEXP, DEXP, 64 * kb, 32 * nb, ws + WS_EXUP + (size_t)e * 7168 * D, D, gu_row(32 * nb, which), WSCALE8, scr, lane); }
    else { const int kb = r / 32, nb = r % 32;
        tr_item8(IN_(24) + (size_t)e * DEXP * D, D, 64 * kb, 32 * nb, ws + WS_EXDN + (size_t)e * D * DEXP, DEXP, 32 * nb, WSCALE8, scr, lane); }
}
constexpr int EXP_ITEMS = 8 * 5376;
__device__ __forceinline__ void expert_convert_fill(const Ctx& C0, int bid, int lo, int hi) {
    if (bid < 8) return;
    const Ctx C = opaque(C0);
    LAS float* scr = (LAS float*)(C.lds + C.wave * 16384);
    for (int it = lo + (bid - 8) * NWAVES + C.wave; it < hi; it += (C.G - 8) * NWAVES) expert_convert_item(it, scr, C.lane);
}
__device__ __forceinline__ void p0_prologue(const Ctx& C0, int pass) {
    const Ctx C = opaque(C0);
    unsigned char* ws = WS_;
    LAS float* sil = (LAS float*)(C.lds + LDSX_OFF);
    LAS float* tab = (LAS float*)(C.lds + LDSX_OFF + 12288);
    for (int i = C.tid; i < 3072; i += NTHREADS) { const float v = i < 2048 ? IN_(1)[i] : IN_(3)[i - 2048]; sil[i] = v / (1.0f + __expf(-v)); }
    if (C.tid < 128) { float s, c; sincospif((float)C.tid / 64.0f, &s, &c); tab[2 * C.tid] = c; tab[2 * C.tid + 1] = s; }
    __syncthreads();
    if (pass == 0) {
    { const int gw0 = C.vcu * NWAVES + C.wave, NGW0 = C.G * NWAVES;
      for (int t = gw0; t < 8 * 2 * 96; t += NGW0) {
        const int kc = t / 192, l = (t % 192) / 96, col = (t % 96) * 64 + C.lane; const float* w = IN_(4) + (size_t)l * D * NMOD + (size_t)(kc * 128) * NMOD + col;
        float a0 = 0.f, a1 = 0.f, a2 = 0.f;
        for (int k = 0; k < 128; k += 32) { float wv[32];
#pragma unroll
            for (int j = 0; j < 32; ++j) wv[j] = w[(size_t)(k + j) * NMOD];
#pragma unroll
            for (int j = 0; j < 32; ++j) { const int kk = kc * 128 + k + j; a0 += sil[kk] * wv[j]; a1 += sil[1024 + kk] * wv[j]; a2 += sil[2048 + kk] * wv[j]; } }
        float* mv = (float*)(ws + WS_MODV) + (size_t)((kc * 2 + l) * 3) * NMOD + col;
        mv[0] = a0; mv[NMOD] = a1; mv[2 * NMOD] = a2;
      } }
    for (int idx = C.vcu * NTHREADS + C.tid; idx < 4096 + 65536 + 32768 + 16384 + 131072; idx += C.G * NTHREADS) {
        if (idx < 4096) { const int pos = idx >> 4, f = idx & 15; const float inv = 1.0f / powf(10000.0f, (float)(2 * f) / 32.0f), ang = (float)pos * inv;
            float* t = (float*)(ws + WS_ROPE) + 2 * idx; t[0] = cosf(ang); t[1] = sinf(ang); }
        else if (idx < 4096 + 65536) { const int i = idx - 4096, m = i >> 8, k = i & 255, k1 = m >> 1, part = m & 1, n1 = k & 127, isb = k >> 7; const int p = (k1 * n1) & 127;
            float s, c; sincospif((float)p / 64.0f, &s, &c); const float v = part == 0 ? (isb ? -s : c) : (isb ? -c : -s);
            ((bf16_t*)(ws + WS_G1))[i] = (bf16_t)pk2(v * 0.08838834764831845f, 0.f); }
        else if (idx >= 4096 + 65536 + 32768 + 16384) { const int i = idx - (4096 + 65536 + 32768 + 16384), k = i >> 9, kk = i & 511, n = kk & 255; float s, c; sincospif((float)((k * n) & 255) / 128.0f, &s, &c);
            ((bf16_t*)(ws + WS_G3))[i] = (bf16_t)pk2((kk < 256 ? c : -s) * 0.0625f, 0.f); }
        else if (idx >= 4096 + 65536 + 32768) { const int i = idx - (4096 + 65536 + 32768), n2 = i >> 7, k1 = i & 127; float s, c; sincospif((float)(k1 * n2) * (1.0f / 8192.0f), &s, &c);
            float* t = (float*)(ws + WS_TW) + 2 * i; t[0] = c; t[1] = s; }
        else { const int i = idx - 4096 - 65536, k2 = i >> 8, k = i & 255, n2 = k & 127, isi = k >> 7; const int p = (k2 * n2) & 127;
            float s, c; sincospif((float)p / 64.0f, &s, &c); ((bf16_t*)(ws + WS_G2))[i] = (bf16_t)pk2((isi ? s : c) * 0.08838834764831845f, 0.f); }
    }
    }
    LAS float* scr = (LAS float*)(C.lds + C.wave * 16384);
    const int gw = C.vcu * NWAVES + C.wave, NGW = C.G * NWAVES;
    for (int it = gw; it < (pass == 0 ? P0_ITEMS : P0_I8_ITEMS); it += NGW) p0_convert_item(it, pass, scr, C.lane);
    bf16_t* const TEMP = (bf16_t*)(ws + WS_HN); const float sc = 0.08838834764831845f;
    if (pass == 0) {
        const int r32 = C.lane & 31, hh = C.lane >> 5;
        for (int t = gw - (NGW - 256); t >= 0 && t < 2 * 4 * 32; t += NGW) {
            const int l = t >> 7, g = (t >> 5) & 3, k0 = (t & 31) * 32; const float* src = IN_(10) + (size_t)l * D * 5888 + (size_t)(k0 + r32) * 5888 + 768 + g * 128 + 8 * hh;
            bf16x8 bfr[8];
#pragma unroll
            for (int s2 = 0; s2 < 8; ++s2) { const f32x4 a = *(const GAS f32x4*)(src + 16 * s2), b = *(const GAS f32x4*)(src + 16 * s2 + 4);
                u32x4 w; w.x = pk2(a[0], a[1]); w.y = pk2(a[2], a[3]); w.z = pk2(b[0], b[1]); w.w = pk2(b[2], b[3]); bfr[s2] = __builtin_bit_cast(bf16x8, w); }
            float mx = 0.f;
#pragma unroll 1
            for (int jb = 0; jb < 8; ++jb) {
                const int part = jb >> 2, j = (32 * jb + r32) & 127;
                f32x16 acc;
#pragma unroll
                for (int i = 0; i < 16; ++i) acc[i] = 0.f;
#pragma unroll
                for (int s2 = 0; s2 < 8; ++s2) { int ib = (16 * s2 + 8 * hh) * j; asm volatile("" : "+v"(ib));
                    u32x4 w;
                    w.x = pk2(tab[2 * ((ib) & 127) + part], tab[2 * ((ib + j) & 127) + part]); w.y = pk2(tab[2 * ((ib + 2 * j) & 127) + part], tab[2 * ((ib + 3 * j) & 127) + part]);
                    w.z = pk2(tab[2 * ((ib + 4 * j) & 127) + part], tab[2 * ((ib + 5 * j) & 127) + part]); w.w = pk2(tab[2 * ((ib + 6 * j) & 127) + part], tab[2 * ((ib + 7 * j) & 127) + part]);
                    acc = __builtin_amdgcn_mfma_f32_32x32x16_bf16(__builtin_bit_cast(bf16x8, w), bfr[s2], acc, 0, 0, 0); }
#pragma unroll
                for (int i = 0; i < 16; ++i) { const float v = acc[i] * sc; mx = fmaxf(mx, fabsf(v)); const int jr = 32 * jb + (i & 3) + 8 * (i >> 2) + 4 * hh;
                    TEMP[((size_t)l * 1024 + (size_t)(jr >> 7) * 512 + g * 128 + (jr & 127)) * D + k0 + r32] = (bf16_t)pk2(v, 0.f); }
            }
            mx = wave_max(mx); if (C.lane == 0) atomicMax((unsigned*)(ws + WS_CTL) + CW_FOLDMAX + l, __float_as_uint(mx));
        }
    } else {
        for (int i = C.vcu * NTHREADS + C.tid; i < 2 * 1024 * 128; i += C.G * NTHREADS) {
            const int l = i >> 17, n = (i >> 7) & 1023, k8 = (i & 127) * 8; const float amax = fmaxf(__uint_as_float(((const unsigned*)(ws + WS_CTL))[CW_FOLDMAX + l]), 1e-30f), inv = 127.0f / amax;
            const u32x4 w = *(const GAS u32x4*)(TEMP + ((size_t)l * 1024 + n) * D + k8);
            u32x2 o; o.x = pack4_i8(bflo(w.x) * inv, bfhi(w.x) * inv, bflo(w.y) * inv, bfhi(w.y) * inv); o.y = pack4_i8(bflo(w.z) * inv, bfhi(w.z) * inv, bflo(w.w) * inv, bfhi(w.w) * inv);
            *(GAS u32x2*)(ws + WS_WIN + l * WIN_BYTES + (size_t)(768 + n) * D + k8) = o;
            if (k8 == 0) ((float*)(ws + WS_CS))[l * ZN + 768 + n] = amax * (1.0f / 127.0f);
        }
    }
}

__device__ __forceinline__ void norm_row(const float* xin, float* xout, bool has_br, const f32x4 (&br)[4], const float* gpost, const float* ga,
                                         const float* gpre, const float* sc, const float* sh, bf16_t* hn, int lane, f32x4 (&h2f)[4], bool hn_fp8 = false) {
    f32x4 x[4];
#pragma unroll
    for (int j = 0; j < 4; ++j) x[j] = *(const GAS f32x4*)(xin + 4 * lane + 256 * j);
    if (has_br) {
        float ss = 0.f;
#pragma unroll
        for (int j = 0; j < 4; ++j) ss += (br[j][0] * br[j][0] + br[j][1] * br[j][1]) + (br[j][2] * br[j][2] + br[j][3] * br[j][3]);
        const float rstd = 1.0f / sqrtf(wave_sum(ss) * (1.0f / D) + EPS);
#pragma unroll
        for (int j = 0; j < 4; ++j) { const f32x4 gp = *(const GAS f32x4*)(gpost + 4 * lane + 256 * j), gg = *(const GAS f32x4*)(ga + 4 * lane + 256 * j); x[j] = x[j] + gg * (br[j] * rstd * gp); }
    }
    if (xout) {
#pragma unroll
        for (int j = 0; j < 4; ++j) *(GAS f32x4*)(xout + 4 * lane + 256 * j) = x[j];
    }
    if (hn) {
        float ss = 0.f;
#pragma unroll
        for (int j = 0; j < 4; ++j) ss += (x[j][0] * x[j][0] + x[j][1] * x[j][1]) + (x[j][2] * x[j][2] + x[j][3] * x[j][3]);
        const float rstd = 1.0f / sqrtf(wave_sum(ss) * (1.0f / D) + EPS);
#pragma unroll
        for (int j = 0; j < 4; ++j) { const f32x4 gp = *(const GAS f32x4*)(gpre + 4 * lane + 256 * j), s1 = *(const GAS f32x4*)(sc + 4 * lane + 256 * j), s0 = *(const GAS f32x4*)(sh + 4 * lane + 256 * j);
            const f32x4 h = (x[j] * rstd * gp) * (s1 + 1.0f) + s0; h2f[j] = h;
            if (hn_fp8) *(GAS unsigned*)((unsigned char*)hn + 4 * lane + 256 * j) = pg8::pack4_fp8(h[0], h[1], h[2], h[3]);
            else { u32x2 w; w.x = pk2(h[0], h[1]); w.y = pk2(h[2], h[3]); *(GAS u32x2*)(hn + 4 * lane + 256 * j) = w; } }
    }
}
__device__ __forceinline__ void load_br(const bf16_t* p, int lane, f32x4 (&br)[4]) {
#pragma unroll
    for (int j = 0; j < 4; ++j) { const u32x2 w = *(const GAS u32x2*)(p + 4 * lane + 256 * j); br[j] = (f32x4){bflo(w.x), bfhi(w.x), bflo(w.y), bfhi(w.y)}; }
}
__device__ __forceinline__ int mod_set(int row) { return row >= M_LAT ? 2 : (row >> 14); }

template <bool PARTS> __device__ __forceinline__ f32x4 modv4(const float* modp, const float* modf, const float* bmod, int l, int set, int off) {
    if constexpr (!PARTS) return *(const GAS f32x4*)(modf + (size_t)(l * 3 + set) * NMOD + off);
    else { f32x4 s = *(const GAS f32x4*)(bmod + l * NMOD + off); const float* p = modp + (size_t)(l * 3 + set) * NMOD + off; f32x4 v[8];
#pragma unroll
        for (int kc = 0; kc < 8; ++kc) v[kc] = *(const GAS f32x4*)(p + (size_t)kc * 6 * NMOD);
#pragma unroll
        for (int kc = 0; kc < 8; ++kc) s = s + v[kc];
        return s; }
}
template <int MODE> __device__ __forceinline__ void phase_norm(const Ctx& C0, int l) {
    constexpr int NR = (MODE == 3) ? 2 : 4;
    const Ctx C = opaque(C0);
    const int gw = C.vcu * NWAVES + C.wave, NGW = C.G * NWAVES, lane = C.lane;
    unsigned char* const ws = WS_;
    const float* const modv = (const float*)(ws + WS_MODV); const float* const bmod = IN_(5);
    const float* const modf = (const float*)(ws + WS_MODF);
    if (MODE == 0) {
        float* mf = (float*)(ws + WS_MODF);
        for (int i = C.vcu * NTHREADS + C.tid; i < 2 * 3 * NMOD; i += C.G * NTHREADS) { const int li = i / (3 * NMOD), c = i % NMOD; float s = bmod[li * NMOD + c]; float v[8];
#pragma unroll
            for (int kc = 0; kc < 8; ++kc) v[kc] = modv[(size_t)kc * 6 * NMOD + i];
#pragma unroll
            for (int kc = 0; kc < 8; ++kc) s += v[kc];
            mf[i] = s; }
    }
    constexpr bool moe = (MODE == 4), comb = (MODE == 3), mid = (MODE == 1 || MODE == 4);
    const bool has_hn = (MODE != 3);
    const int nsets = (MODE == 0 || l == 0) ? 3 : 2;
    const float* const xsrc_lat = (MODE == 0 || MODE == 1) ? IN_(0) : (const float*)OUT_;
    float* const xdst_lat = OUT_;
    const float* const xsrc_ctx = (MODE == 2) ? (const float*)(ws + WS_HCTX) : IN_(2);
    float* const xdst_ctx = (float*)(ws + WS_HCTX);
    const bf16_t* const brbuf = mid ? (const bf16_t*)(ws + WS_MIX) : (const bf16_t*)(ws + WS_F0);
    const float* const gpost = mid ? IN_(7) + l * D : IN_(9) + l * D;
    const float* const gpre = (MODE == 0) ? IN_(6) : mid ? IN_(8) + l * D : IN_(6) + D;
    const int ga_off = mid ? 2048 : 5120, hl = (MODE == 2 || MODE == 3) ? 1 : l, sc_off = mid ? 4096 : 1024, sh_off = mid ? 3072 : 0;
    bf16_t* const HN = (bf16_t*)(ws + WS_HN); float* const RS = (float*)(ws + WS_RS);
    LAS unsigned* const lcnt = (LAS unsigned*)(C.lds + LDSX_OFF);
    LAS unsigned* const stage = (LAS unsigned*)(C.lds + LDSX_OFF + 256);
    LAS float* const wrl = (LAS float*)C.lds;
    const LAS int* const tbl = (const LAS int*)(C.lds + MISC_OFF) + 16;
    if (moe) { if (C.tid < 16) lcnt[C.tid] = 0u; const float* wsrc = IN_(20);
        __syncthreads();
        for (int i = C.tid; i < 8192; i += NTHREADS) wrl[(i & 7) * 1024 + (i >> 3)] = wsrc[i];
        __syncthreads(); }
    const float* const brt = IN_(21);
    const unsigned* const asg = (const unsigned*)(ws + WS_ASG); const bf16_t* const Y = (const bf16_t*)(ws + WS_YEXP);
    int it = 0;
    for (int set = 0; set < nsets; ++set) {
        f32x4 vA[4], vB[4], vS[4];
#pragma unroll
        for (int j = 0; j < 4; ++j) { const int c = 4 * lane + 256 * j;
            if (MODE != 0) vA[j] = modv4<MODE == 0>(modv, modf, bmod, l, set, ga_off + c) * *(const GAS f32x4*)(gpost + c); else vA[j] = (f32x4){0.f, 0.f, 0.f, 0.f};
            if (has_hn) { vB[j] = *(const GAS f32x4*)(gpre + c) * (modv4<MODE == 0>(modv, modf, bmod, hl, set, sc_off + c) + 1.0f); vS[j] = modv4<MODE == 0>(modv, modf, bmod, hl, set, sh_off + c); }
            else { vB[j] = (f32x4){0.f, 0.f, 0.f, 0.f}; vS[j] = vB[j]; } }
        const int base = set < 2 ? set * SEQ : M_LAT, n = set < 2 ? SEQ : M_CTX;
        const float* const xs = set < 2 ? xsrc_lat + (size_t)base * D : xsrc_ctx; float* const xd = set < 2 ? xdst_lat + (size_t)base * D : xdst_ctx;
        for (int i0 = gw; i0 < n; i0 += NGW * NR) {
            f32x4 x[NR][4]; u32x2 bw[NR][4], bw2[NR][4]; float cw0[NR], cw1[NR];
#pragma unroll
            for (int k = 0; k < NR; ++k) { const int ri = i0 + NGW * k; if (ri < n) {
#pragma unroll
                for (int j = 0; j < 4; ++j) x[k][j] = __builtin_nontemporal_load((const GAS f32x4*)(xs + (size_t)ri * D + 4 * lane + 256 * j));
                if (MODE != 0) {
                    if (comb) { const unsigned* a = asg + (size_t)(base + ri) * 8; const int e0 = (int)a[0], e1 = (int)a[3]; cw0[k] = __uint_as_float(a[2]); cw1[k] = __uint_as_float(a[5]);
                        const bf16_t* y0 = Y + ((size_t)tbl[e0] * 256 + a[1]) * D, * y1 = Y + ((size_t)tbl[e1] * 256 + a[4]) * D;
#pragma unroll
                        for (int j = 0; j < 4; ++j) { bw[k][j] = *(const GAS u32x2*)(y0 + 4 * lane + 256 * j); bw2[k][j] = *(const GAS u32x2*)(y1 + 4 * lane + 256 * j); } }
                    else {
#pragma unroll
                        for (int j = 0; j < 4; ++j) bw[k][j] = __builtin_nontemporal_load((const GAS u32x2*)(brbuf + (size_t)(base + ri) * D + 4 * lane + 256 * j)); } } }
              else {
#pragma unroll
                for (int j = 0; j < 4; ++j) { x[k][j] = (f32x4){0.f, 0.f, 0.f, 0.f}; bw[k][j] = (u32x2){0u, 0u}; bw2[k][j] = (u32x2){0u, 0u}; } cw0[k] = 0.f; cw1[k] = 0.f; } }
            if (MODE != 0) {
                float ss[NR]; f32x4 br[NR][4];
#pragma unroll
                for (int k = 0; k < NR; ++k) { ss[k] = 0.f;
#pragma unroll
                    for (int j = 0; j < 4; ++j) { f32x4 b = (f32x4){bflo(bw[k][j].x), bfhi(bw[k][j].x), bflo(bw[k][j].y), bfhi(bw[k][j].y)};
                        if (comb) { const f32x4 b2 = (f32x4){bflo(bw2[k][j].x), bfhi(bw2[k][j].x), bflo(bw2[k][j].y), bfhi(bw2[k][j].y)}; b = b * cw0[k] + b2 * cw1[k]; }
                        br[k][j] = b; ss[k] += (b[0] * b[0] + b[1] * b[1]) + (b[2] * b[2] + b[3] * b[3]); } }
#pragma unroll
                for (int k = 0; k < NR; ++k) ss[k] = wave_sum(ss[k]);
#pragma unroll
                for (int k = 0; k < NR; ++k) { const float rstd = 1.0f / sqrtf(ss[k] * (1.0f / D) + EPS);
#pragma unroll
                    for (int j = 0; j < 4; ++j) x[k][j] = x[k][j] + vA[j] * (br[k][j] * rstd); }
#pragma unroll
                for (int k = 0; k < NR; ++k) { const int ri = i0 + NGW * k; if (ri < n) {
#pragma unroll
                    for (int j = 0; j < 4; ++j) __builtin_nontemporal_store(x[k][j], (GAS f32x4*)(xd + (size_t)ri * D + 4 * lane + 256 * j)); } }
            }
            if (has_hn) {
                float s2[NR];
#pragma unroll
                for (int k = 0; k < NR; ++k) { s2[k] = 0.f;
#pragma unroll
                    for (int j = 0; j < 4; ++j) s2[k] += (x[k][j][0] * x[k][j][0] + x[k][j][1] * x[k][j][1]) + (x[k][j][2] * x[k][j][2] + x[k][j][3] * x[k][j][3]); }
#pragma unroll
                for (int k = 0; k < NR; ++k) s2[k] = wave_sum(s2[k]);
                float am[NR];
#pragma unroll
                for (int k = 0; k < NR; ++k) { const float rstd = 1.0f / sqrtf(s2[k] * (1.0f / D) + EPS); am[k] = 0.f;
#pragma unroll
                    for (int j = 0; j < 4; ++j) { x[k][j] = (x[k][j] * rstd) * vB[j] + vS[j];
                        am[k] = fmaxf(fmaxf(am[k], fmaxf(fabsf(x[k][j][0]), fabsf(x[k][j][1]))), fmaxf(fabsf(x[k][j][2]), fabsf(x[k][j][3]))); } }
                if (!moe) {
#pragma unroll
                    for (int k = 0; k < NR; ++k) am[k] = fmaxf(wave_max(am[k]), 1e-20f);
                }
#pragma unroll
                for (int k = 0; k < NR; ++k) { const int ri = i0 + NGW * k;
                    if (ri < n) {
                        if (moe) {
#pragma unroll
                            for (int j = 0; j < 4; ++j) *(GAS unsigned*)((unsigned char*)HN + (size_t)(base + ri) * D + 4 * lane + 256 * j) = pg8::pack4_fp8(x[k][j][0], x[k][j][1], x[k][j][2], x[k][j][3]); }
                        else {
                            const float inv = 127.0f / am[k];
#pragma unroll
                            for (int j = 0; j < 4; ++j) *(GAS unsigned*)((unsigned char*)HN + (size_t)(base + ri) * D + 4 * lane + 256 * j) = pack4_i8(x[k][j][0] * inv, x[k][j][1] * inv, x[k][j][2] * inv, x[k][j][3] * inv);
                            if (lane == 0) RS[base + ri] = am[k] * (1.0f / 127.0f); } } }
                if (moe) {
#pragma unroll
                    for (int k = 0; k < NR; ++k) { const int ri = i0 + NGW * k; if (ri < n) {
                        float lg[8];
#pragma unroll
                        for (int e = 0; e < 8; ++e) lg[e] = 0.f;
#pragma unroll
                        for (int e = 0; e < 8; ++e)
#pragma unroll
                            for (int j = 0; j < 4; ++j) { const f32x4 wv = *(const LAS f32x4*)(wrl + e * 1024 + 4 * lane + 256 * j); lg[e] += (x[k][j][0] * wv[0] + x[k][j][1] * wv[1]) + (x[k][j][2] * wv[2] + x[k][j][3] * wv[3]); }
                        float w4[4];
#pragma unroll
                        for (int j = 0; j < 4; ++j) { const auto r = __builtin_amdgcn_permlane32_swap(__float_as_uint(lg[j]), __float_as_uint(lg[4 + j]), false, false); w4[j] = __uint_as_float(r[0]) + __uint_as_float(r[1]); }
                        const bool b4 = (lane & 16) != 0, b3 = (lane & 8) != 0;
                        float w2[2];
#pragma unroll
                        for (int j = 0; j < 2; ++j) { const float keep = b4 ? w4[2 + j] : w4[j], send = b4 ? w4[j] : w4[2 + j]; w2[j] = keep + lane_xor<16>(send); }
                        float w1v; { const float keep = b3 ? w2[1] : w2[0], send = b3 ? w2[0] : w2[1]; w1v = keep + lane_xor<8>(send); }
                        w1v += lane_xor<4>(w1v); w1v += lane_xor<2>(w1v); w1v += lane_xor<1>(w1v);
                        float lgt[8];
#pragma unroll
                        for (int e = 0; e < 8; ++e) lgt[e] = __int_as_float(__builtin_amdgcn_readlane(__float_as_int(w1v), 8 * e)) + brt[e];
                        int e0 = 0; float v0 = lgt[0];
#pragma unroll
                        for (int e = 1; e < 8; ++e) if (lgt[e] > v0) { v0 = lgt[e]; e0 = e; }
                        int e1 = -1; float v1 = -INFINITY;
#pragma unroll
                        for (int e = 0; e < 8; ++e) if (e != e0 && lgt[e] > v1) { v1 = lgt[e]; e1 = e; }
                        const float pw1 = 1.0f / (1.0f + __expf(v0 - v1)), pw0 = 1.0f - pw1;
                        if (lane == 0) { const unsigned p0 = atomicAdd((unsigned*)&lcnt[e0], 1u), p1 = atomicAdd((unsigned*)&lcnt[e1], 1u);
                            LAS unsigned* st = stage + (C.wave * 24 + it) * 6; st[0] = (unsigned)e0; st[1] = p0; st[2] = __float_as_uint(pw0); st[3] = (unsigned)e1; st[4] = p1; st[5] = __float_as_uint(pw1); }
                        ++it; } }
                }
            }
        }
    }
    if (moe) {
        __syncthreads();
        if (C.tid < 8) lcnt[8 + C.tid] = __hip_atomic_fetch_add((unsigned*)(ws + WS_CTL) + CW_CNT + 64 * C.tid, lcnt[C.tid], __ATOMIC_RELAXED, __HIP_MEMORY_SCOPE_AGENT);
        __syncthreads();
        if (lane == 0) { int i2 = 0; int* elist = (int*)(ws + WS_ELIST); unsigned* asgw = (unsigned*)(ws + WS_ASG);
            for (int set = 0; set < 2; ++set)
                for (int i0 = gw; i0 < SEQ; i0 += NGW * NR)
                    for (int k = 0; k < NR; ++k) { const int ri = i0 + NGW * k; if (ri < SEQ) { const int row = set * SEQ + ri; const LAS unsigned* st = stage + (C.wave * 24 + i2) * 6; ++i2;
                        const unsigned e0 = st[0], p0 = st[1] + lcnt[8 + e0], e1 = st[3], p1 = st[4] + lcnt[8 + e1];
                        elist[e0 * M_LAT + p0] = row; elist[e1 * M_LAT + p1] = row;
                        unsigned* a = asgw + (size_t)row * 8; a[0] = e0; a[1] = p0; a[2] = st[2]; a[3] = e1; a[4] = p1; a[5] = st[5]; } } }
    }
}

constexpr int AT_S = 144;
__device__ __forceinline__ int crow(int r, int h) { return (r & 3) + 8 * (r >> 2) + 4 * h; }
__device__ __forceinline__ void phase_attention(const Ctx& C0, int l, bool with_ctx_q) {
    const Ctx C = opaque(C0);
    const bf16_t* Q = (const bf16_t*)(WS_ + WS_Q); const bf16_t* KV = (const bf16_t*)(WS_ + WS_KV); bf16_t* AO = (bf16_t*)(WS_ + WS_ATT);
    int lane_ = C.lane; asm volatile("" : "+v"(lane_)); const int lane = lane_, w = C.wave, r32 = lane & 31, hh = lane >> 5, qq = (lane & 15) >> 2, pp = lane & 3, blk = (lane >> 4) & 1;
    const int nunits = 1024 + (with_ctx_q ? 16 : 0); const float* sinks = IN_(11) + l * 8;
    for (int unit = C.vcu; unit < nunits; unit += C.G) {
        int b, head, hkv, qrowbase, q0, lo, nloc;
        if (unit < 1024) { const int g = unit & 3, qb = (unit >> 2) & 63; hkv = (unit >> 8) & 1; b = unit >> 9; head = hkv * 4 + g; q0 = qb * 256; qrowbase = b * SEQ + q0;
            lo = q0 - 128 < 0 ? 0 : q0 - 128; const int hi = q0 + 384 > SEQ ? SEQ : q0 + 384; nloc = (hi - lo) >> 6; }
        else { const int x = unit - 1024; b = x >> 3; head = x & 7; hkv = head >> 2; q0 = 0; lo = 0; nloc = 0; qrowbase = M_LAT + b * CTXL; }
        const int ntiles = nloc + 4, qw = q0 + 32 * w;
        bf16x8 qf[4];
        { const bf16_t* qp = Q + (size_t)(qrowbase + 32 * w + r32) * 512 + head * 64 + 8 * hh;
#pragma unroll
          for (int s = 0; s < 4; ++s) qf[s] = *(const GAS bf16x8*)(qp + 16 * s); }
        float m_run = sinks[head] * LOG2E, l_run = hh == 0 ? 1.0f : 0.0f;
        f32x16 o0, o1;
#pragma unroll
        for (int i = 0; i < 16; ++i) { o0[i] = 0.f; o1[i] = 0.f; }
        const int lrow = C.tid >> 3, lch = C.tid & 7;
        u32x4 kx, vx;
        { const int krow0 = nloc > 0 ? b * SEQ + lo : M_LAT + b * CTXL; const bf16_t* src = KV + (size_t)(krow0 + lrow) * 256 + hkv * 64 + lch * 8;
          kx = *(const GAS u32x4*)src; vx = *(const GAS u32x4*)(src + 128); }
        for (int t = 0; t < ntiles; ++t) {
            const bool local = t < nloc; const int kpos = lo + 64 * t;
            LAS unsigned char* Kt = C.lds + (t & 1) * (128 * AT_S); LAS unsigned char* Vt = Kt + 64 * AT_S;
            *(LAS u32x4*)(Kt + lrow * AT_S + lch * 16) = kx; *(LAS u32x4*)(Vt + lrow * AT_S + lch * 16) = vx;
            __syncthreads();
            if (t + 1 < ntiles) { const int t1 = t + 1; const int krow1 = t1 < nloc ? b * SEQ + lo + 64 * t1 : M_LAT + b * CTXL + 64 * (t1 - nloc);
                const bf16_t* src = KV + (size_t)(krow1 + lrow) * 256 + hkv * 64 + lch * 8; kx = *(const GAS u32x4*)src; vx = *(const GAS u32x4*)(src + 128); }
            const bool relevant = !local || (kpos + 63 >= qw - 128 && kpos <= qw + 31 + 128);
            if (relevant) {
                f32x16 p0, p1;
#pragma unroll
                for (int i = 0; i < 16; ++i) { p0[i] = 0.f; p1[i] = 0.f; }
#pragma unroll
                for (int s = 0; s < 4; ++s) {
                    const bf16x8 k0 = *(const LAS bf16x8*)(Kt + r32 * AT_S + (16 * s + 8 * hh) * 2), k1 = *(const LAS bf16x8*)(Kt + (32 + r32) * AT_S + (16 * s + 8 * hh) * 2);
                    p0 = __builtin_amdgcn_mfma_f32_32x32x16_bf16(k0, qf[s], p0, 0, 0, 0); p1 = __builtin_amdgcn_mfma_f32_32x32x16_bf16(k1, qf[s], p1, 0, 0, 0);
                }
                if (local) { const int qpos = qw + r32;
#pragma unroll
                    for (int i = 0; i < 16; ++i) { const int d0 = kpos + crow(i, hh) - qpos, d1 = d0 + 32;
                        if (d0 > 128 || d0 < -128) p0[i] = -INFINITY; if (d1 > 128 || d1 < -128) p1[i] = -INFINITY; } }
                float mt = fmaxf(p0[0], p1[0]);
#pragma unroll
                for (int i = 1; i < 16; ++i) mt = fmaxf(mt, fmaxf(p0[i], p1[i]));
                mt = half_max(mt);
                const float mn = fmaxf(m_run, mt), alpha = __builtin_amdgcn_exp2f(m_run - mn); m_run = mn;
                float ls = 0.f;
#pragma unroll
                for (int i = 0; i < 16; ++i) { p0[i] = __builtin_amdgcn_exp2f(p0[i] - mn); p1[i] = __builtin_amdgcn_exp2f(p1[i] - mn); ls += p0[i] + p1[i]; }
                l_run = l_run * alpha + ls;
#pragma unroll
                for (int i = 0; i < 16; ++i) { o0[i] *= alpha; o1[i] *= alpha; }
#pragma unroll
                for (int kb = 0; kb < 2; ++kb)
#pragma unroll
                    for (int s2 = 0; s2 < 2; ++s2) {
                        u32x4 pw;
                        if (kb == 0) { pw.x = pk2(p0[8 * s2 + 0], p0[8 * s2 + 1]); pw.y = pk2(p0[8 * s2 + 2], p0[8 * s2 + 3]); pw.z = pk2(p0[8 * s2 + 4], p0[8 * s2 + 5]); pw.w = pk2(p0[8 * s2 + 6], p0[8 * s2 + 7]); }
                        else { pw.x = pk2(p1[8 * s2 + 0], p1[8 * s2 + 1]); pw.y = pk2(p1[8 * s2 + 2], p1[8 * s2 + 3]); pw.z = pk2(p1[8 * s2 + 4], p1[8 * s2 + 5]); pw.w = pk2(p1[8 * s2 + 6], p1[8 * s2 + 7]); }
                        const bf16x8 pb = __builtin_bit_cast(bf16x8, pw);
                        const int kbase = 32 * kb + 16 * s2 + 4 * hh + qq;
#pragma unroll
                        for (int c = 0; c < 2; ++c) {
                            const LAS unsigned char* va = Vt + kbase * AT_S + (32 * c + 16 * blk + 4 * pp) * 2;
                            const s16x4 vlo = __builtin_amdgcn_ds_read_tr16_b64_v4i16((LAS s16x4*)va), vhi = __builtin_amdgcn_ds_read_tr16_b64_v4i16((LAS s16x4*)(va + 8 * AT_S));
                            const bf16x8 vf = __builtin_shufflevector(vlo, vhi, 0, 1, 2, 3, 4, 5, 6, 7);
                            if (c == 0) o0 = __builtin_amdgcn_mfma_f32_32x32x16_bf16(vf, pb, o0, 0, 0, 0); else o1 = __builtin_amdgcn_mfma_f32_32x32x16_bf16(vf, pb, o1, 0, 0, 0);
                        }
                    }
            }
        }
        const float linv = 1.0f / half_sum(l_run);
        bf16_t* op = AO + (size_t)(qrowbase + 32 * w + r32) * 512 + head * 64 + 4 * hh;
#pragma unroll
        for (int g = 0; g < 4; ++g) {
            u32x2 a, c2; a.x = pk2(o0[4 * g] * linv, o0[4 * g + 1] * linv); a.y = pk2(o0[4 * g + 2] * linv, o0[4 * g + 3] * linv);
            c2.x = pk2(o1[4 * g] * linv, o1[4 * g + 1] * linv); c2.y = pk2(o1[4 * g + 2] * linv, o1[4 * g + 3] * linv);
            *(GAS u32x2*)(op + 8 * g) = a; *(GAS u32x2*)(op + 32 + 8 * g) = c2; }
        __syncthreads();
    }
}

constexpr int FT_S = 144, FT_TILE = 256 * FT_S;
__device__ __forceinline__ float quad_swap1(float v) { return __int_as_float(__builtin_amdgcn_mov_dpp(__float_as_int(v), 0xB1, 0xF, 0xF, true)); }
template <int STAGE> __device__ __forceinline__ void phase_fft(const Ctx& C0) {
    const Ctx C = opaque(C0);
    unsigned char* const ws = WS_;
    const bf16_t* const SRC = (const bf16_t*)(ws + (STAGE == 1 ? WS_FAB : WS_HN)); const bf16_t* const GM = (const bf16_t*)(ws + (STAGE == 1 ? WS_G1 : WS_G2)); const float* const TW = (const float*)(ws + WS_TW);
    bf16_t* const DST = (bf16_t*)(ws + (STAGE == 1 ? WS_HN : WS_FAB));
    const int lane = C.lane, w = C.wave, r32 = lane & 31, hh = lane >> 5, qq = (lane & 15) >> 2, pp = lane & 3, blk = (lane >> 4) & 1;
    const int mrow = STAGE == 1 ? 32 * w + r32 : 32 * (w & 3) + r32;
    bf16x8 gf[16];
#pragma unroll
    for (int s = 0; s < 16; ++s) gf[s] = *(const GAS bf16x8*)(GM + (size_t)mrow * 256 + 16 * s + 8 * hh);
    u32x4 pf[4];
#define FFT_LOAD(unit_) do { const int b_ = (unit_) >> 10, q_ = ((unit_) >> 3) & 127, cb_ = (unit_) & 7; _Pragma("unroll") for (int i = 0; i < 4; ++i) { const int idx = C.tid + NTHREADS * i, k = idx >> 3, ch = idx & 7; \
        const int srow = b_ * SEQ + (STAGE == 1 ? 128 * (k & 127) + q_ : 128 * q_ + (k & 127)); pf[i] = *(const GAS u32x4*)(SRC + (size_t)srow * 1024 + (k >> 7) * 512 + cb_ * 64 + ch * 8); } } while (0)
    for (int unit = C.vcu; unit < 2048; unit += C.G) {
        const int b = unit >> 10, q = (unit >> 3) & 127, cb = unit & 7;
        LAS unsigned char* X = C.lds;
        __syncthreads();
        FFT_LOAD(unit);
#pragma unroll
        for (int i = 0; i < 4; ++i) { const int idx = C.tid + NTHREADS * i, k = idx >> 3, ch = idx & 7; *(LAS u32x4*)(X + k * FT_S + ch * 16) = pf[i]; }
        __syncthreads();
        if (STAGE == 1) {
            const int k1 = mrow >> 1, part = mrow & 1; const f32x2 tw = *(const GAS f32x2*)(TW + 2 * (q * 128 + k1)); const float tc = tw.x, ts = part ? -tw.y : tw.y;
            bf16_t* const drow = DST + (size_t)(b * SEQ + 128 * k1 + q) * 1024 + part * 512 + cb * 64 + 4 * hh;
#pragma unroll
            for (int cbk = 0; cbk < 2; ++cbk) {
                f32x16 acc;
#pragma unroll
                for (int i = 0; i < 16; ++i) acc[i] = 0.f;
#pragma unroll
                for (int s = 0; s < 16; ++s) {
                    const LAS unsigned char* xa = X + (16 * s + 8 * hh + qq) * FT_S + (32 * cbk + 16 * blk + 4 * pp) * 2;
                    const s16x4 lo = __builtin_amdgcn_ds_read_tr16_b64_v4i16((LAS s16x4*)xa), hi = __builtin_amdgcn_ds_read_tr16_b64_v4i16((LAS s16x4*)(xa + 4 * FT_S));
                    acc = __builtin_amdgcn_mfma_f32_32x32x16_bf16(__builtin_shufflevector(lo, hi, 0, 1, 2, 3, 4, 5, 6, 7), gf[s], acc, 0, 0, 0);
                }
#pragma unroll
                for (int g = 0; g < 4; ++g) { float o[4];
#pragma unroll
                    for (int j = 0; j < 4; ++j) { const float own = acc[4 * g + j]; o[j] = own * tc + lane_xor<1>(own) * ts; }
                    u32x2 wv; wv.x = pk2(o[0], o[1]); wv.y = pk2(o[2], o[3]); *(GAS u32x2*)(drow + 32 * cbk + 8 * g) = wv; }
            }
        } else {
            const int cbk = w >> 2;
            f32x16 acc;
#pragma unroll
            for (int i = 0; i < 16; ++i) acc[i] = 0.f;
#pragma unroll
            for (int s = 0; s < 16; ++s) {
                const LAS unsigned char* xa = X + (16 * s + 8 * hh + qq) * FT_S + (32 * cbk + 16 * blk + 4 * pp) * 2;
                const s16x4 lo = __builtin_amdgcn_ds_read_tr16_b64_v4i16((LAS s16x4*)xa), hi = __builtin_amdgcn_ds_read_tr16_b64_v4i16((LAS s16x4*)(xa + 4 * FT_S));
                acc = __builtin_amdgcn_mfma_f32_32x32x16_bf16(__builtin_shufflevector(lo, hi, 0, 1, 2, 3, 4, 5, 6, 7), gf[s], acc, 0, 0, 0);
            }
            bf16_t* const drow = DST + (size_t)(b * SEQ + q + 128 * mrow) * 512 + cb * 64 + 32 * cbk + 4 * hh;
#pragma unroll
            for (int g = 0; g < 4; ++g) { u32x2 wv; wv.x = pk2(acc[4 * g], acc[4 * g + 1]); wv.y = pk2(acc[4 * g + 2], acc[4 * g + 3]); *(GAS u32x2*)(drow + 8 * g) = wv; }
        }
    }
#undef FFT_LOAD
    __syncthreads();
}
__device__ __forceinline__ void phase_ctx_dft(const Ctx& C0) {
    const Ctx C = opaque(C0);
    unsigned char* const ws = WS_;
    const bf16_t* const FAB = (const bf16_t*)(ws + WS_FAB); const bf16_t* const G3 = (const bf16_t*)(ws + WS_G3); bf16_t* const FN = (bf16_t*)(ws + WS_FAB);
    const int lane = C.lane, w = C.wave, r32 = lane & 31, hh = lane >> 5, qq = (lane & 15) >> 2, pp = lane & 3, blk = (lane >> 4) & 1, mrow = 32 * w + r32;
    LAS unsigned char* const X = C.lds;
    for (int unit = C.vcu; unit < 16; unit += C.G) {
        const int b = unit >> 3, cb = unit & 7;
        f32x16 acc0, acc1;
#pragma unroll
        for (int i = 0; i < 16; ++i) { acc0[i] = 0.f; acc1[i] = 0.f; }
#pragma unroll 1
        for (int h = 0; h < 2; ++h) {
            bf16x8 gf[16];
#pragma unroll
            for (int s = 0; s < 16; ++s) gf[s] = *(const GAS bf16x8*)(G3 + (size_t)mrow * 512 + h * 256 + 16 * s + 8 * hh);
            __syncthreads();
#pragma unroll
            for (int i = 0; i < 4; ++i) { const int idx = C.tid + NTHREADS * i, k = idx >> 3, ch = idx & 7;
                *(LAS u32x4*)(X + k * FT_S + ch * 16) = *(const GAS u32x4*)(FAB + (size_t)(M_LAT + b * CTXL + k) * 1024 + h * 512 + cb * 64 + ch * 8); }
            __syncthreads();
#pragma unroll
            for (int s = 0; s < 16; ++s) {
                const LAS unsigned char* xa = X + (16 * s + 8 * hh + qq) * FT_S + (16 * blk + 4 * pp) * 2;
                const s16x4 lo0 = __builtin_amdgcn_ds_read_tr16_b64_v4i16((LAS s16x4*)xa), hi0 = __builtin_amdgcn_ds_read_tr16_b64_v4i16((LAS s16x4*)(xa + 4 * FT_S));
                const s16x4 lo1 = __builtin_amdgcn_ds_read_tr16_b64_v4i16((LAS s16x4*)(xa + 64)), hi1 = __builtin_amdgcn_ds_read_tr16_b64_v4i16((LAS s16x4*)(xa + 64 + 4 * FT_S));
                acc0 = __builtin_amdgcn_mfma_f32_32x32x16_bf16(__builtin_shufflevector(lo0, hi0, 0, 1, 2, 3, 4, 5, 6, 7), gf[s], acc0, 0, 0, 0);
                acc1 = __builtin_amdgcn_mfma_f32_32x32x16_bf16(__builtin_shufflevector(lo1, hi1, 0, 1, 2, 3, 4, 5, 6, 7), gf[s], acc1, 0, 0, 0);
            }
        }
        bf16_t* const drow = FN + (size_t)(M_LAT + b * CTXL + mrow) * 512 + cb * 64 + 4 * hh;
#pragma unroll
        for (int g = 0; g < 4; ++g) { u32x2 wv; wv.x = pk2(acc0[4 * g], acc0[4 * g + 1]); wv.y = pk2(acc0[4 * g + 2], acc0[4 * g + 3]); *(GAS u32x2*)(drow + 8 * g) = wv;
            wv.x = pk2(acc1[4 * g], acc1[4 * g + 1]); wv.y = pk2(acc1[4 * g + 2], acc1[4 * g + 3]); *(GAS u32x2*)(drow + 32 + 8 * g) = wv; }
    }
    __syncthreads();
}
__device__ __forceinline__ void unpack8(const u32x4 w, float (&f)[8]) { f[0] = bflo(w.x); f[1] = bfhi(w.x); f[2] = bflo(w.y); f[3] = bfhi(w.y); f[4] = bflo(w.z); f[5] = bfhi(w.z); f[6] = bflo(w.w); f[7] = bfhi(w.w); }
__device__ __forceinline__ void phase_conv(const Ctx& C0, int l, int nrows) {
    const Ctx C = opaque(C0);
    const bf16_t* CIN = (const bf16_t*)(WS_ + WS_CIN); bf16_t* CO = (bf16_t*)(WS_ + WS_COUT); const float* wc = IN_(12) + l * 3 * 512;
    for (int it = C.vcu * NTHREADS + C.tid; it < nrows * 64; it += C.G * NTHREADS) {
        const int row = it >> 6, c0 = (it & 63) * 8; const bool lat = row < M_LAT;
        const int s = lat ? (row & (SEQ - 1)) : ((row - M_LAT) & (CTXL - 1)), last = lat ? SEQ - 1 : CTXL - 1;
        const bf16_t* p = CIN + (size_t)row * 1536 + c0;
        float xm[8], cm[8], x0[8], cc0[8], xp[8], cp[8], bb[8];
        const u32x4 z = (u32x4){0u, 0u, 0u, 0u};
        unpack8(s > 0 ? *(const GAS u32x4*)(p - 1536) : z, xm); unpack8(s > 0 ? *(const GAS u32x4*)(p - 1536 + 1024) : z, cm);
        unpack8(*(const GAS u32x4*)p, x0); unpack8(*(const GAS u32x4*)(p + 1024), cc0); unpack8(*(const GAS u32x4*)(p + 512), bb);
        unpack8(s < last ? *(const GAS u32x4*)(p + 1536) : z, xp); unpack8(s < last ? *(const GAS u32x4*)(p + 1536 + 1024) : z, cp);
        float y[8];
#pragma unroll
        for (int j = 0; j < 8; ++j) y[j] = bb[j] * (xm[j] * cm[j] * wc[c0 + j] + x0[j] * cc0[j] * wc[512 + c0 + j] + xp[j] * cp[j] * wc[1024 + c0 + j]);
        u32x4 o; o.x = pk2(y[0], y[1]); o.y = pk2(y[2], y[3]); o.z = pk2(y[4], y[5]); o.w = pk2(y[6], y[7]);
        *(GAS u32x4*)(CO + (size_t)row * 512 + c0) = o;
    }
}
__device__ __forceinline__ void phase_moe_gather(const Ctx& C0, int chunk, int ntiles) {
    const Ctx C = opaque(C0);
    const unsigned char* HN = WS_ + WS_HN; unsigned char* H2G = WS_ + WS_H2G; const int* EL = (const int*)(WS_ + WS_ELIST);
    const LAS int* tbl = (const LAS int*)(C.lds + MISC_OFF) + 16;
    const int gw = C.vcu * NWAVES + C.wave, NGW = C.G * NWAVES;
    for (int rl = gw; rl < CHUNK_ROWS; rl += NGW) {
        const int R = chunk * CHUNK_TILES * 256 + rl, t = R >> 8; if (t >= ntiles) break;
        int e = 0;
#pragma unroll
        for (int k = 1; k < 8; ++k) e += (t >= tbl[k]) ? 1 : 0;
        const int pos = R - tbl[e] * 256, ce = tbl[8 + e];
        u32x4 v0 = (u32x4){0u, 0u, 0u, 0u};
        if (pos < ce) { const int tok = EL[e * M_LAT + pos]; v0 = *(const GAS u32x4*)(HN + (size_t)tok * D + C.lane * 16); }
        *(GAS u32x4*)(H2G + (size_t)rl * D + C.lane * 16) = v0;
    }
}

#ifndef REP_PRO
#define REP_PRO 1
#endif
#ifndef REP_GEMM
#define REP_GEMM 1
#endif
#ifndef REP_ATT
#define REP_ATT 1
#endif
#ifndef REP_F1
#define REP_F1 1
#endif
#ifndef REP_F2
#define REP_F2 1
#endif
#ifndef REP_CV
#define REP_CV 1
#endif
#ifndef REP_CD
#define REP_CD 1
#endif
#ifndef REP_AUX
#define REP_AUX 1
#endif
#ifndef REP_GIN
#define REP_GIN REP_GEMM
#endif
#ifndef REP_GMG
#define REP_GMG REP_GEMM
#endif
#ifndef REP_GO
#define REP_GO REP_GEMM
#endif
#ifndef REP_GUP
#define REP_GUP REP_GEMM
#endif
#ifndef REP_GDN
#define REP_GDN REP_GEMM
#endif
#ifndef REP_GMU
#define REP_GMU REP_GEMM
#endif
#ifndef REP_GMD
#define REP_GMD REP_GEMM
#endif
#define REPEAT(N) for (int rep_ = 0; rep_ < (N); ++rep_)
#ifndef GIN_ALIGN
#define GIN_ALIGN true
#endif
constexpr int FILL1 = 11264, FILL2 = 20480;
#ifndef STAGGER_TICKS
#define STAGGER_TICKS 0
#endif
#define STAG(bid) ((((bid) >> 3) & 1) ? STAGGER_TICKS : 0)
__global__ void __launch_bounds__(NTHREADS, 2) dit_fwd(Params P) {
    extern __shared__ __attribute__((aligned(16))) unsigned char lds_raw[];
    Ctx C;
    C.lds = (LAS unsigned char*)lds_raw;
    C.wave = __builtin_amdgcn_readfirstlane((int)threadIdx.x >> 6); C.lane = 0; C.tid = 0;
    C.G = gridDim.x; { const int bx = blockIdx.x; C.vcu = (C.G % 8 == 0) ? (bx % 8) * (C.G / 8) + bx / 8 : bx; }
    volatile LAS unsigned* MISC = (volatile LAS unsigned*)(C.lds + MISC_OFF);
    if (threadIdx.x < 32) MISC[threadIdx.x] = 0u;
    __syncthreads();
    (void)xcd_barrier_post((unsigned*)(WS_ + WS_CTL) + CW_BAR, MISC + 8);
#define GRID_BAR() do { XcdBarrier b_; b_.bar = (unsigned*)(WS_ + WS_CTL) + CW_BAR; b_.x = xb_xcc_id(); b_.st = (volatile LAS unsigned*)(C.lds + MISC_OFF) + 8; xcd_barrier(b_); } while (0)
    LAS unsigned char* ring = C.lds;
    const int bid = (int)blockIdx.x;

    REPEAT(REP_PRO) p0_prologue(C, 0);
    GRID_BAR();
    p0_prologue(C, 1);
    REPEAT(REP_AUX) phase_norm<0>(C, 0);
    GRID_BAR();

    for (int l = 0; l < 2; ++l) {
        const int nM = (l == 0) ? MT / 256 : M_LAT / 256;
        REPEAT(REP_GIN) {
            unsigned char* ws = WS_;
            pg8::Gemm g{(const bf16_t*)(ws + WS_HN), (const bf16_t*)(ws + WS_WIN + l * WIN_BYTES), MT, ZN, D, 0, 0, 0, 0, (const float*)(ws + WS_RS), (const float*)(ws + WS_CS) + l * ZN};
            pg8::RectOrder S; if (l == 0) S.init(MT / 256, ZN / 256, C.G, bid); else S.init(M_LAT / 256, ZN / 256, C.G, bid, 0, 2, M_LAT / 256, 2);
            pg8::EpiIn E{ws, WS_Q, WS_KV, WS_FAB, WS_CIN, WS_GT, WS_ROPE, QSCALE};
            pg8::gemm_phase<pg8::EpiIn, pg8::RectOrder, GIN_ALIGN, true, 2>(ring, g, S, E, C.wave, STAG(bid));
        }
        GRID_BAR();
        REPEAT(REP_ATT) phase_attention(C, l, l == 0);
        REPEAT(REP_F1) phase_fft<1>(C);
        REPEAT(REP_CV) phase_conv(C, l, nM * 256);
        GRID_BAR();
        REPEAT(REP_F2) phase_fft<2>(C);
        if (l == 0) REPEAT(REP_CD) phase_ctx_dft(C);
        GRID_BAR();
        REPEAT(REP_GMG) {
            unsigned char* ws = WS_;
            pg8::RectOrder S; S.init(nM, 4, C.G, bid);
            pg8::Gemm g{(const bf16_t*)(ws + WS_ATT), (const bf16_t*)(ws + WS_WY) + (size_t)l * 3 * 1024 * 512, MT, D, 1536, 512, (long)WS_FAB - (long)WS_ATT, (long)WS_COUT - (long)WS_ATT, (long)1024 * 512 * 2};
            pg8::EpiHorner E{(bf16_t*)(ws + WS_HN), (const unsigned char*)(ws + WS_GT)};
            pg8::gemm_phase<pg8::EpiHorner, pg8::RectOrder, true, true, 0, true>(ring, g, S, E, C.wave);
        }
        if (l == 0) expert_convert_fill(C, bid, 0, FILL1);
        GRID_BAR();
        REPEAT(REP_GO) {
            unsigned char* ws = WS_;
            pg8::Gemm g{(const bf16_t*)(ws + WS_HN), (const bf16_t*)(ws + WS_WO) + (size_t)l * D * D, MT, D, D}; pg8::RectOrder S; S.init(nM, 4, C.G, bid);
            pg8::EpiPlain E{(bf16_t*)(ws + WS_MIX), D, 4, 0, 1.0f};
            pg8::gemm_phase<pg8::EpiPlain, pg8::RectOrder, true, true>(ring, g, S, E, C.wave);
        }
        if (l == 0) expert_convert_fill(C, bid, FILL1, FILL2);
        GRID_BAR();
        if (l == 0) phase_norm<1>(C, 0); else phase_norm<4>(C, 1);
        GRID_BAR();
        if (l == 0) {
            REPEAT(REP_GUP) { unsigned char* ws = WS_;
              pg8::Gemm g{(const bf16_t*)(ws + WS_HN), (const bf16_t*)(ws + WS_WFF_UP), MT, 2 * DFF, D, 0, 0, 0, 0, (const float*)(ws + WS_RS), (const float*)(ws + WS_CS) + 2 * ZN}; pg8::RectOrder S; S.init(nM, 2 * DFF / 256, C.G, bid);
              pg8::EpiSwiglu<false> E{(void*)(ws + WS_HID0), DFF, 2 * DFF / 256, 1.0f};
              pg8::gemm_phase<pg8::EpiSwiglu<false>, pg8::RectOrder, true, true, 2>(ring, g, S, E, C.wave, STAG(bid)); }
            GRID_BAR();
            REPEAT(REP_GDN) { unsigned char* ws = WS_;
              pg8::Gemm g{(const bf16_t*)(ws + WS_HID0), (const bf16_t*)(ws + WS_WFF_DN), MT, D, DFF}; pg8::RectOrder S; S.init(nM, 4, C.G, bid);
              pg8::EpiPlain E{(bf16_t*)(ws + WS_F0), D, 4, 0, 1.0f};
              pg8::gemm_phase<pg8::EpiPlain, pg8::RectOrder, true, true>(ring, g, S, E, C.wave); }
            expert_convert_fill(C, bid, FILL2, EXP_ITEMS);
            GRID_BAR();
        } else {
            if (threadIdx.x == 0) { const unsigned* ctl = (const unsigned*)(WS_ + WS_CTL); unsigned tb = 0u;
                for (int e = 0; e < 8; ++e) { const unsigned c = __hip_atomic_load(ctl + CW_CNT + 64 * e, __ATOMIC_RELAXED, __HIP_MEMORY_SCOPE_AGENT); MISC[16 + e] = tb; MISC[24 + e] = c; tb += (c + 255u) >> 8; } }
            __syncthreads();
            const int T = __builtin_amdgcn_readfirstlane((int)(MISC[23] + ((MISC[31] + 255u) >> 8))), nchunks = T > CHUNK_TILES ? 2 : 1;
            const LAS int* tbl = (const LAS int*)(C.lds + MISC_OFF) + 16;
            for (int ch = 0; ch < nchunks; ++ch) {
                const int tc = ch == 0 ? (T < CHUNK_TILES ? T : CHUNK_TILES) : T - CHUNK_TILES;
                REPEAT(REP_AUX) phase_moe_gather(C, ch, T);
                GRID_BAR();
                REPEAT(REP_GMU) { unsigned char* ws = WS_;
                  pg8::Gemm g{(const bf16_t*)(ws + WS_H2G), (const bf16_t*)(ws + WS_EXUP), CHUNK_ROWS, 8 * 7168, D};
                  pg8::MoeOrder S{tc, 28, ch * CHUNK_TILES, C.G, bid, tbl};
                  pg8::EpiSwiglu<true> E{(void*)(ws + WS_HIDX), DEXP, 28, 1.0f / WSCALE8};
                  pg8::gemm_phase<pg8::EpiSwiglu<true>, pg8::MoeOrder, true, true, true>(ring, g, S, E, C.wave, STAG(bid)); }
                GRID_BAR();
                REPEAT(REP_GMD) { unsigned char* ws = WS_;
                  pg8::Gemm g{(const bf16_t*)(ws + WS_HIDX), (const bf16_t*)(ws + WS_EXDN), CHUNK_ROWS, 8 * 1024, DEXP};
                  pg8::MoeOrder S{tc, 4, ch * CHUNK_TILES, C.G, bid, tbl};
                  pg8::EpiPlain E{(bf16_t*)(ws + WS_YEXP), D, 4, ch * CHUNK_TILES * 256, 1.0f / WSCALE8};
                  pg8::gemm_phase<pg8::EpiPlain, pg8::MoeOrder, true, true, true>(ring, g, S, E, C.wave); }
                GRID_BAR();
            }
        }
        if (l == 0) phase_norm<2>(C, 0); else phase_norm<3>(C, 1);
        if (l == 0) GRID_BAR();
    }
#undef GRID_BAR
}

extern "C" void kernel_launch(void* const* d_in, const int* in_sizes, int n_in, void* d_out, int out_size, void* d_ws, size_t ws_size, hipStream_t stream) {
    static int grid = 0;
    if (grid == 0) {
        if (n_in != 25 || in_sizes[0] != M_LAT * D || out_size != M_LAT * D || ws_size < WS_NEED) {
            fprintf(stderr, "kernel_launch: built for 25 inputs, x/out of %d floats, >= %zu bytes of workspace; got n_in %d, in0 %d, out %d, ws %zu; nothing launched\n", M_LAT * D, (size_t)WS_NEED, n_in, n_in > 0 ? in_sizes[0] : -1, out_size, ws_size);
            grid = -1; return; }
        int dev = 0, cus = 0, per_cu = 0;
        if (hipGetDevice(&dev) != hipSuccess || hipDeviceGetAttribute(&cus, hipDeviceAttributeMultiprocessorCount, dev) != hipSuccess) { fprintf(stderr, "kernel_launch: device query failed\n"); grid = -1; return; }
        if (hipFuncSetAttribute((const void*)dit_fwd, hipFuncAttributeMaxDynamicSharedMemorySize, LDS_BYTES) != hipSuccess) { fprintf(stderr, "kernel_launch: hipFuncSetAttribute failed\n"); grid = -1; return; }
        if (hipOccupancyMaxActiveBlocksPerMultiprocessor(&per_cu, (const void*)dit_fwd, NTHREADS, LDS_BYTES) != hipSuccess || per_cu < 1) { fprintf(stderr, "kernel_launch: occupancy query says %d workgroups per CU; nothing launched\n", per_cu); (void)hipGetLastError(); grid = -1; return; }
        (void)hipGetLastError();
        grid = cus;
        if (grid < 192 || grid > 304) { fprintf(stderr, "kernel_launch: unexpected CU count %d\n", cus); grid = -1; return; }
    }
    if (grid < 0) return;
    if (hipMemsetAsync((char*)d_ws + WS_CTL, 0, CTL_BYTES, stream) != hipSuccess) { fprintf(stderr, "kernel_launch: memset failed\n"); return; }
    Params p{};
    for (int i = 0; i < 25; ++i) p.in[i] = (const float*)d_in[i];
    p.out = (float*)d_out; p.ws = (unsigned char*)d_ws;
    hipLaunchKernelGGL(dit_fwd, dim3(grid), dim3(NTHREADS), LDS_BYTES, stream, p);
    const hipError_t le = hipPeekAtLastError();
    if (le != hipSuccess) fprintf(stderr, "kernel_launch: launch failed: %s\n", hipGetErrorName(le));
}
```

```cpp
#include <hip/hip_runtime.h>
#include <cstdio>
#include <cstdint>
#include <cmath>
namespace pg8 {
#define PG8_LAS __attribute__((address_space(3)))
typedef unsigned short bf16_t;
typedef short bf16x8 __attribute__((ext_vector_type(8)));
typedef float f32x4 __attribute__((ext_vector_type(4)));
typedef unsigned u32x4 __attribute__((ext_vector_type(4)));
constexpr int BM = 256, BK = 64, HALF = 128, HTB = HALF * BK * 2  , STAGE_BYTES = 8 * HTB, NXCD = 8, WGM = 8;

__host__ __device__ __forceinline__ int lds_byte(int r, int c) { const int st = (r >> 4) * 2 + (c >> 5), rr = r & 15, cc = c & 31, ob = rr * 64 + cc * 2; return st * 1024 + (ob ^ (((ob >> 9) & 1) << 5)); }
__host__ __device__ __forceinline__ void stage_rc(int b, int& R, int& C) { const int st = b / 1024, sb = b % 1024, swz = sb ^ (((sb >> 9) & 1) << 5); R = (st >> 1) * 16 + swz / 64; C = (st & 1) * 32 + (swz % 64) / 2; }
__host__ __device__ __forceinline__ int perm32(int rho) { const int n = rho >> 4, i = rho & 15; return 8 * (i >> 2) + 4 * n + (i & 3); }

struct Unit { int pm, pn; };
struct Gemm { const bf16_t* A; const bf16_t* Bt; int M, N, K; int ld = 0; long A1off = 0, A2off = 0, Bseg = 0; const float* rs = nullptr; const float* cs = nullptr; };

struct StaticOrder {
    int nM, nN, nwg, G, c;
    __host__ __device__ void init(int M, int N, int G_, int c_) { nM = M / BM; nN = N / BM; nwg = nM * nN; G = G_; c = c_; }
    __host__ __device__ bool next(int i, Unit& u) const {
        const long L = (long)i * G + c; if (L >= nwg) return false;
        int wgid = (int)L; { const int q = nwg / NXCD, r = nwg % NXCD, xcd = wgid % NXCD, off = wgid / NXCD; wgid = (xcd < r ? xcd * (q + 1) : r * (q + 1) + (xcd - r) * q) + off; }
        const int nig = WGM * nN, gid = wgid / nig, fm = gid * WGM, gsz = (nM - fm) < WGM ? (nM - fm) : WGM;
        u.pm = fm + ((wgid % nig) % gsz); u.pn = (wgid % nig) / gsz; return true;
    }
    __device__ __forceinline__ void a_ready(const Unit&) const {}
    __device__ __forceinline__ void done(const Unit&) const {}
};

__device__ __forceinline__ unsigned cvt_pk_bf16(float lo, float hi) { unsigned r; asm volatile("v_cvt_pk_bf16_f32 %0, %1, %2" : "=v"(r) : "v"(lo), "v"(hi)); return r; }
struct RectOrder {
    int nM, nN, nwg, G, c, pm0, ne, epm0, epn;
    __device__ __forceinline__ void init(int nM_, int nN_, int G_, int c_, int pm0_ = 0, int ne_ = 0, int epm0_ = 0, int epn_ = 0) { nM = nM_; nN = nN_; nwg = nM * nN; G = G_; c = c_; pm0 = pm0_; ne = ne_; epm0 = epm0_; epn = epn_; }
    __device__ __forceinline__ bool next(int i, Unit& u) const {
        const long L = (long)i * G + c;
        if (L >= nwg) { const long x = L - nwg; if (x >= ne) return false; u.pm = epm0 + (int)x; u.pn = epn; return true; }
        int wgid = (int)L; { const int q = nwg / NXCD, r = nwg % NXCD, xcd = wgid % NXCD, off = wgid / NXCD; wgid = (xcd < r ? xcd * (q + 1) : r * (q + 1) + (xcd - r) * q) + off; }
        const int nig = WGM * nN, gid = wgid / nig, fm = gid * WGM, gsz = (nM - fm) < WGM ? (nM - fm) : WGM;
        u.pm = pm0 + fm + ((wgid % nig) % gsz); u.pn = (wgid % nig) / gsz; return true;
    }
    __device__ __forceinline__ void a_ready(const Unit&) const {}
    __device__ __forceinline__ void done(const Unit&) const {}
};
struct MoeOrder {
    int tc, nN, tile0, G, c; const PG8_LAS int* tbl;
    __device__ __forceinline__ bool next(int i, Unit& u) const {
        const int L = i * G + c, nwg = tc * nN; if (L >= nwg) return false;
        int wgid = L; { const int q = nwg / NXCD, r = nwg % NXCD, xcd = wgid % NXCD, off = wgid / NXCD; wgid = (xcd < r ? xcd * (q + 1) : r * (q + 1) + (xcd - r) * q) + off; }
        const int nig = WGM * nN, gid = wgid / nig, fm = gid * WGM, gsz = (tc - fm) < WGM ? (tc - fm) : WGM, w = wgid - gid * nig;
        const int j = w / gsz, pml = fm + (w - j * gsz), t = tile0 + pml;
        int e = 0;
#pragma unroll
        for (int k = 1; k < 8; ++k) e += (t >= __builtin_amdgcn_readfirstlane(tbl[k])) ? 1 : 0;
        u.pm = __builtin_amdgcn_readfirstlane(pml); u.pn = __builtin_amdgcn_readfirstlane(e * nN + j); return true;
    }
    __device__ __forceinline__ void a_ready(const Unit&) const {}
    __device__ __forceinline__ void done(const Unit&) const {}
};

__device__ __forceinline__ float bflo(unsigned u) { return __uint_as_float(u << 16); }
__device__ __forceinline__ float bfhi(unsigned u) { return __uint_as_float(u & 0xffff0000u); }
__device__ __forceinline__ float sigm(float x) { return __builtin_amdgcn_rcpf(1.0f + __builtin_amdgcn_exp2f(-1.4426950408889634f * x)); }
__device__ __forceinline__ u32x4 pack8(const f32x4 a, const f32x4 b) { u32x4 w; w.x = cvt_pk_bf16(a[0], a[1]); w.y = cvt_pk_bf16(a[2], a[3]); w.z = cvt_pk_bf16(b[0], b[1]); w.w = cvt_pk_bf16(b[2], b[3]); return w; }

__device__ __forceinline__ unsigned gate4_u8(float a, float b, float c, float d) { return (unsigned)__float2int_rn(a * 255.0f) | ((unsigned)__float2int_rn(b * 255.0f) << 8) | ((unsigned)__float2int_rn(c * 255.0f) << 16) | ((unsigned)__float2int_rn(d * 255.0f) << 24); }
struct EpiPlain {
    static constexpr bool PERM = true, AFTER_DRAIN = false, IDEMPOTENT = true; static constexpr int NST = 16;
    bf16_t* O; int ld, nmod, row_off; float scale;
    __device__ __forceinline__ void operator()(const f32x4 (&acc)[2][2][4][2], const Unit& u, int wr, int wc, int fr, int fq) const {
        const int row0 = row_off + u.pm * BM + wr * 64 + fr, col0 = (u.pn % nmod) * BM + wc * 32 + 8 * fq;
#pragma unroll
        for (int ai = 0; ai < 2; ++ai)
#pragma unroll
            for (int m = 0; m < 4; ++m) { bf16_t* rowp = O + (size_t)(row0 + ai * HALF + m * 16) * ld + col0;
#pragma unroll
                for (int bj = 0; bj < 2; ++bj) *(u32x4*)(rowp + bj * HALF) = pack8(acc[ai][bj][m][0] * scale, acc[ai][bj][m][1] * scale); }
    }
};
template <bool FIRST> struct EpiMerge {
    static constexpr bool PERM = true, AFTER_DRAIN = false, IDEMPOTENT = FIRST; static constexpr int NST = 16;
    bf16_t* MG; const bf16_t* GT; int gcol0;
    __device__ __forceinline__ void operator()(const f32x4 (&acc)[2][2][4][2], const Unit& u, int wr, int wc, int fr, int fq) const {
        const int row0 = u.pm * BM + wr * 64 + fr, col0 = u.pn * BM + wc * 32 + 8 * fq;
#pragma unroll
        for (int ai = 0; ai < 2; ++ai)
#pragma unroll
            for (int m = 0; m < 4; ++m) { const size_t row = (size_t)(row0 + ai * HALF + m * 16);
#pragma unroll
                for (int bj = 0; bj < 2; ++bj) {
                    typedef unsigned u32x2_ __attribute__((ext_vector_type(2))); const u32x2_ g = *(const u32x2_*)((const unsigned char*)GT + row * 3072 + gcol0 + col0 + bj * HALF);
                    f32x4 v0 = acc[ai][bj][m][0], v1 = acc[ai][bj][m][1]; const float q = 1.0f / 255.0f;
                    v0[0] *= (float)(g.x & 255u) * q; v0[1] *= (float)((g.x >> 8) & 255u) * q; v0[2] *= (float)((g.x >> 16) & 255u) * q; v0[3] *= (float)(g.x >> 24) * q;
                    v1[0] *= (float)(g.y & 255u) * q; v1[1] *= (float)((g.y >> 8) & 255u) * q; v1[2] *= (float)((g.y >> 16) & 255u) * q; v1[3] *= (float)(g.y >> 24) * q;
                    bf16_t* dst = MG + row * 1024 + col0 + bj * HALF;
                    if (!FIRST) { const u32x4 o = *(const u32x4*)dst;
                        v0[0] += bflo(o.x); v0[1] += bfhi(o.x); v0[2] += bflo(o.y); v0[3] += bfhi(o.y); v1[0] += bflo(o.z); v1[1] += bfhi(o.z); v1[2] += bflo(o.w); v1[3] += bfhi(o.w); }
                    *(u32x4*)dst = pack8(v0, v1); } }
    }
};
__device__ __forceinline__ float u8f(unsigned w, int i) { return (float)((w >> (8 * i)) & 255u); }
struct EpiHorner {
    static constexpr bool PERM = true, AFTER_DRAIN = false, IDEMPOTENT = true; static constexpr int NST = 16;
    bf16_t* MG; const unsigned char* GT;
    __device__ __forceinline__ void mid(f32x4 (&acc)[2][2][4][2], const Unit& u, int s, int wr, int wc, int fr, int fq) const {
        typedef unsigned u32x2_ __attribute__((ext_vector_type(2)));
        const int row0 = u.pm * BM + wr * 64 + fr, col0 = u.pn * BM + wc * 32 + 8 * fq;
        u32x4 ga[2][4], gb[2][4];
        const unsigned char* gp = GT + ((size_t)(u.pm * 3 + (s - 1)) * 4 + u.pn) * 65536 + (size_t)((wr * 4 + wc) * 8192 + (fq * 16 + fr) * 16);
#pragma unroll
        for (int ai = 0; ai < 2; ++ai)
#pragma unroll
            for (int m = 0; m < 4; ++m) { ga[ai][m] = *(const u32x4*)(gp + (ai * 4 + m) * 1024); gb[ai][m] = *(const u32x4*)(gp + 4 * 65536 + (ai * 4 + m) * 1024); }
        asm volatile("" ::: "memory");
#pragma unroll
        for (int ai = 0; ai < 2; ++ai)
#pragma unroll
            for (int m = 0; m < 4; ++m)
#pragma unroll
                for (int bj = 0; bj < 2; ++bj) { u32x2_ a, b; a.x = bj ? ga[ai][m].z : ga[ai][m].x; a.y = bj ? ga[ai][m].w : ga[ai][m].y; b.x = bj ? gb[ai][m].z : gb[ai][m].x; b.y = bj ? gb[ai][m].w : gb[ai][m].y;
                    f32x4& v0 = acc[ai][bj][m][0]; f32x4& v1 = acc[ai][bj][m][1];
#pragma unroll
                    for (int j = 0; j < 4; ++j) { const float n0 = s == 1 ? u8f(a.x, j) : fmaxf(u8f(a.x, j), 0.5f), n1 = s == 1 ? u8f(a.y, j) : fmaxf(u8f(a.y, j), 0.5f);
                        v0[j] *= n0 * __builtin_amdgcn_rcpf(fmaxf(u8f(b.x, j), 0.5f)); v1[j] *= n1 * __builtin_amdgcn_rcpf(fmaxf(u8f(b.y, j), 0.5f)); } }
    }
    __device__ __forceinline__ void operator()(const f32x4 (&acc)[2][2][4][2], const Unit& u, int wr, int wc, int fr, int fq) const {
        typedef unsigned u32x2_ __attribute__((ext_vector_type(2)));
        const int row0 = u.pm * BM + wr * 64 + fr, col0 = u.pn * BM + wc * 32 + 8 * fq; const float q = 1.0f / 255.0f;
        u32x4 gg[2][4];
        const unsigned char* gp = GT + ((size_t)(u.pm * 3 + 2) * 4 + u.pn) * 65536 + (size_t)((wr * 4 + wc) * 8192 + (fq * 16 + fr) * 16);
#pragma unroll
        for (int ai = 0; ai < 2; ++ai)
#pragma unroll
            for (int m = 0; m < 4; ++m) gg[ai][m] = *(const u32x4*)(gp + (ai * 4 + m) * 1024);
        asm volatile("" ::: "memory");
#pragma unroll
        for (int ai = 0; ai < 2; ++ai)
#pragma unroll
            for (int m = 0; m < 4; ++m) { const size_t row = (size_t)(row0 + ai * HALF + m * 16);
#pragma unroll
                for (int bj = 0; bj < 2; ++bj) { u32x2_ g; g.x = bj ? gg[ai][m].z : gg[ai][m].x; g.y = bj ? gg[ai][m].w : gg[ai][m].y;
                    f32x4 v0 = acc[ai][bj][m][0], v1 = acc[ai][bj][m][1];
#pragma unroll
                    for (int j = 0; j < 4; ++j) { v0[j] *= fmaxf(u8f(g.x, j), 0.5f) * q; v1[j] *= fmaxf(u8f(g.y, j), 0.5f) * q; }
                    *(u32x4*)(MG + row * 1024 + col0 + bj * HALF) = pack8(v0, v1); } }
    }
};
__device__ __forceinline__ unsigned pack4_fp8(float a, float b, float c, float d) { int p = 0; p = __builtin_amdgcn_cvt_pk_fp8_f32(a, b, p, false); p = __builtin_amdgcn_cvt_pk_fp8_f32(c, d, p, true); return (unsigned)p; }
template <bool F8> struct EpiSwiglu {
    static constexpr bool PERM = true, AFTER_DRAIN = false, IDEMPOTENT = true; static constexpr int NST = 8;
    void* H; int ld, nmod; float scale;
    __device__ __forceinline__ void operator()(const f32x4 (&acc)[2][2][4][2], const Unit& u, int wr, int wc, int fr, int fq) const {
        const int row0 = u.pm * BM + wr * 64 + fr, col0 = (u.pn % nmod) * HALF + wc * 32 + 8 * fq;
#pragma unroll
        for (int ai = 0; ai < 2; ++ai)
#pragma unroll
            for (int m = 0; m < 4; ++m) {
                f32x4 h0, h1;
#pragma unroll
                for (int j = 0; j < 4; ++j) { const float g0 = acc[ai][0][m][0][j] * scale, g1 = acc[ai][0][m][1][j] * scale;
                    h0[j] = g0 * sigm(g0) * (acc[ai][1][m][0][j] * scale); h1[j] = g1 * sigm(g1) * (acc[ai][1][m][1][j] * scale); }
                const size_t off = (size_t)(row0 + ai * HALF + m * 16) * ld + col0;
                if constexpr (F8) { typedef unsigned u32x2_ __attribute__((ext_vector_type(2))); u32x2_ w; w.x = pack4_fp8(h0[0], h0[1], h0[2], h0[3]); w.y = pack4_fp8(h1[0], h1[1], h1[2], h1[3]); *(u32x2_*)((unsigned char*)H + off) = w; }
                else *(u32x4*)((bf16_t*)H + off) = pack8(h0, h1); }
    }
};
struct EpiIn {
    static constexpr bool PERM = true, AFTER_DRAIN = false, IDEMPOTENT = true; static constexpr int NST = 16;
    unsigned char* ws; size_t oQ, oKV, oFAB, oCIN, oGT, oROPE; float qscale;
    __device__ __forceinline__ void operator()(const f32x4 (&acc)[2][2][4][2], const Unit& u, int wr, int wc, int fr, int fq) const {
        const int pn = u.pn, lc0 = wc * 32 + 8 * fq, row0 = u.pm * BM + wr * 64 + fr;
        const bool ctxrow = u.pm >= 128;
        bf16_t* const Q = (bf16_t*)(ws + oQ); bf16_t* const KV = (bf16_t*)(ws + oKV); bf16_t* const FAB = (bf16_t*)(ws + oFAB); bf16_t* const CIN = (bf16_t*)(ws + oCIN); bf16_t* const GT = (bf16_t*)(ws + oGT);
        const float* const rope = (const float*)(ws + oROPE);
#pragma unroll
        for (int bj = 0; bj < 2; ++bj) {
            const int cc = bj * HALF + lc0;
            int mode, ld, dcol; bf16_t* dst;
            if (pn < 2) { mode = 2; dst = Q; ld = 512; dcol = pn * 256 + cc; }
            else if (pn == 2) { dst = KV; ld = 256; dcol = cc; mode = (bj == 0) ? 3 : 0; }
            else if (pn < 7) { mode = 0; dst = FAB; ld = 1024; dcol = (pn - 3) * 256 + cc; }
            else if (pn < 13) { mode = 0; dst = CIN; ld = 1536; dcol = (pn - 7) * 256 + cc; }
            else { mode = 1; dst = GT; ld = 3072; dcol = (pn - 13) * 256 + cc; }
            if (mode == 0) {
#pragma unroll
                for (int ai = 0; ai < 2; ++ai)
#pragma unroll
                    for (int m = 0; m < 4; ++m) *(u32x4*)(dst + (size_t)(row0 + ai * HALF + m * 16) * ld + dcol) = pack8(acc[ai][bj][m][0], acc[ai][bj][m][1]);
            } else if (mode == 1) {
#pragma unroll
                for (int ai = 0; ai < 2; ++ai)
#pragma unroll
                    for (int m = 0; m < 4; ++m) { const f32x4 v0 = acc[ai][bj][m][0], v1 = acc[ai][bj][m][1]; typedef unsigned u32x2_ __attribute__((ext_vector_type(2)));
                        u32x2_ w; w.x = gate4_u8(sigm(v0[0]), sigm(v0[1]), sigm(v0[2]), sigm(v0[3])); w.y = gate4_u8(sigm(v1[0]), sigm(v1[1]), sigm(v1[2]), sigm(v1[3]));
                        *(u32x2_*)((unsigned char*)GT + ((size_t)(u.pm * 3 + ((pn - 13) >> 2)) * 4 + ((pn - 13) & 3)) * 65536 + (size_t)(((wr * 4 + wc) * 8 + ai * 4 + m) * 1024 + (fq * 16 + fr) * 16 + bj * 8)) = w; }
            } else {
                const float qs = (mode == 2) ? qscale : 1.0f;
                const int i0 = (dcol & 63) >> 1;
#pragma unroll
                for (int ai = 0; ai < 2; ++ai) {
                    f32x4 t0[4], t1[4];
                    if (!ctxrow) {
#pragma unroll
                        for (int m = 0; m < 4; ++m) { const int s = (row0 + ai * HALF + m * 16) & 16383, pos = (i0 < 16) ? (s >> 6) : (s & 63);
                            const float* t = rope + (size_t)(pos * 16 + (i0 & 15)) * 2; t0[m] = *(const f32x4*)t; t1[m] = *(const f32x4*)(t + 4); }
                        asm volatile("" ::: "memory");
                    }
#pragma unroll
                    for (int m = 0; m < 4; ++m) { f32x4 v0 = acc[ai][bj][m][0], v1 = acc[ai][bj][m][1];
                        if (!ctxrow) { const f32x4 a = t0[m], b = t1[m];
                            f32x4 r0, r1;
                            r0[0] = v0[0] * a[0] - v0[1] * a[1]; r0[1] = v0[0] * a[1] + v0[1] * a[0]; r0[2] = v0[2] * a[2] - v0[3] * a[3]; r0[3] = v0[2] * a[3] + v0[3] * a[2];
                            r1[0] = v1[0] * b[0] - v1[1] * b[1]; r1[1] = v1[0] * b[1] + v1[1] * b[0]; r1[2] = v1[2] * b[2] - v1[3] * b[3]; r1[3] = v1[2] * b[3] + v1[3] * b[2];
                            v0 = r0; v1 = r1; }
                        v0 = v0 * qs; v1 = v1 * qs;
                        *(u32x4*)(dst + (size_t)(row0 + ai * HALF + m * 16) * ld + dcol) = pack8(v0, v1); }
                }
            }
        }
    }
};

template <class Epi, class Sched, bool ALIGN_EPI = false, bool SP2 = false, int DT = 0, bool SEG = false>
__device__ __forceinline__ void gemm_phase(PG8_LAS unsigned char* lds, const Gemm g, const Sched& S, const Epi& E, int wave_id  , int stagger_ticks = 0, int amp_id = 0  ) {
    unsigned z_ = 0u; asm volatile("" : "+v"(z_)); int wid_ = wave_id; asm volatile("" : "+s"(wid_));
    const int lane_ = (int)__builtin_amdgcn_mbcnt_hi(~0u, __builtin_amdgcn_mbcnt_lo(~0u, z_));
    const int wid = wid_, lane = lane_, tid = wid * 64 + lane, wr = wid >> 2, wc = wid & 3, fr = lane & 15, fq = lane >> 4;
    constexpr bool FP8 = (DT == 1), I8 = (DT == 2); constexpr bool RELAX = false;
    const int K = g.K, ldk = g.ld ? g.ld : K, pitch = DT ? ldk : 2 * ldk  , nt = (DT ? K : 2 * K) / 128;
#define PG8_PA(base, tt) (SEG ? (base) + ((tt) < 8 ? 0L : (tt) < 16 ? g.A1off : g.A2off) + (size_t)((tt) & 7) * kstep : (base) + (size_t)(tt) * kstep)
#define PG8_PB(base, tt) (SEG ? (base) + (size_t)((tt) >> 3) * g.Bseg + (size_t)((tt) & 7) * kstep : (base) + (size_t)(tt) * kstep)
    unsigned voffA, voffB;
    { int R, C; stage_rc(tid * 16, R, C); const int Rb = Epi::PERM ? ((R & ~31) + perm32(R & 31)) : R;
        voffA = (unsigned)(R * pitch + C * 2); voffB = (unsigned)(Rb * pitch + C * 2); }
    const size_t pstep = (size_t)64 * pitch;
    const size_t kstep = (size_t)(BK * 2);
    const size_t hstep = (size_t)HALF * pitch;
    const size_t tstep = 2 * hstep;
    const unsigned ldsw = (unsigned)wid * 1024u;
    const int aoff = lds_byte(wr * 64 + fr, fq * 8), boff = lds_byte(wc * 32 + fr, fq * 8);
#define PG8_SA(b, h) (((b) * 2 + (h)) * HTB)
#define PG8_SB(b, h) ((4 + (b) * 2 + (h)) * HTB)
#define PG8_STAGE(bufoff, gbase, voff) do { _Pragma("unroll") for (int _i = 0; _i < 2; ++_i) \
        __builtin_amdgcn_global_load_lds((const unsigned*)((const char*)(gbase) + _i * pstep + (voff)), (PG8_LAS unsigned*)(lds + (bufoff) + ldsw + _i * 8192), 16, 0, 0); } while (0)
#define PG8_LDA(dst, b, h) do { _Pragma("unroll") for (int m = 0; m < 4; ++m) _Pragma("unroll") for (int k = 0; k < 2; ++k) dst[m][k] = *(const PG8_LAS bf16x8*)(lds + PG8_SA(b, h) + aoff + m * 2048 + k * 1024); } while (0)
#define PG8_LDB(dst, b, h) do { _Pragma("unroll") for (int n = 0; n < 2; ++n) _Pragma("unroll") for (int k = 0; k < 2; ++k) dst[n][k] = *(const PG8_LAS bf16x8*)(lds + PG8_SB(b, h) + boff + n * 2048 + k * 1024); } while (0)
#define PG8_MMA(ai, bj, At, Bt) do { __builtin_amdgcn_s_setprio(1); _Pragma("unroll") for (int m = 0; m < 4; ++m) _Pragma("unroll") for (int n = 0; n < 2; ++n) { \
        if constexpr (FP8) { typedef int i32x4_ __attribute__((ext_vector_type(4))); \
            acc[ai][bj][m][n] = __builtin_amdgcn_mfma_scale_f32_16x16x128_f8f6f4(__builtin_shufflevector(__builtin_bit_cast(i32x4_, Bt[n][0]), __builtin_bit_cast(i32x4_, Bt[n][1]), 0, 1, 2, 3, 4, 5, 6, 7), \
                __builtin_shufflevector(__builtin_bit_cast(i32x4_, At[m][0]), __builtin_bit_cast(i32x4_, At[m][1]), 0, 1, 2, 3, 4, 5, 6, 7), acc[ai][bj][m][n], 0, 0, 0, 0, 0, 0); } \
        else if constexpr (I8) { typedef int i32x4_ __attribute__((ext_vector_type(4))); _Pragma("unroll") for (int k = 0; k < 2; ++k) \
            acc[ai][bj][m][n] = __builtin_bit_cast(f32x4, __builtin_amdgcn_mfma_i32_16x16x64_i8(__builtin_bit_cast(i32x4_, Bt[n][k]), __builtin_bit_cast(i32x4_, At[m][k]), __builtin_bit_cast(i32x4_, acc[ai][bj][m][n]), 0, 0, 0)); } \
        else { _Pragma("unroll") for (int k = 0; k < 2; ++k) acc[ai][bj][m][n] = __builtin_amdgcn_mfma_f32_16x16x32_bf16(Bt[n][k], At[m][k], acc[ai][bj][m][n], 0, 0, 0); } } \
        __builtin_amdgcn_s_setprio(0); } while (0)
#define PG8_SC_OFF 135168
#define PG8_STAGE_SC(u_, un_) do { if constexpr (I8) { const float* sp_ = wid < 4 ? g.rs + (size_t)(un_).pm * BM + wid * 64 : g.cs + (size_t)(un_).pn * BM + (wid - 4) * 64; \
        __builtin_amdgcn_global_load_lds((const unsigned*)(sp_ + lane), (PG8_LAS unsigned*)(lds + PG8_SC_OFF + ((u_) & 1) * 2048 + wid * 256), 4, 0, 0); } } while (0)
#define PG8_WAIT_V(n) asm volatile("s_waitcnt vmcnt(" #n ")" ::: "memory")
#define PG8_WAIT_L(n) asm volatile("s_waitcnt lgkmcnt(" #n ")" ::: "memory")
#define PG8_BAR __builtin_amdgcn_s_barrier()
#define PG8_SCHED __builtin_amdgcn_sched_barrier(0)
#define PG8_WAIT_VN(x) asm volatile("s_waitcnt vmcnt(%0)" :: "n"(x) : "memory")
#define PG8_WAIT_SEL(rx_, WR_) do { if (rx_) PG8_WAIT_VN(WR_); else PG8_WAIT_VN(8); } while (0)
#define PG8_ITER2(rx_, WR_) do { \
              \
            PG8_LDB(B0, 0, 0); PG8_LDB(B1, 0, 1); PG8_SCHED; PG8_LDA(At, 0, 0); if (!(rx_)) PG8_STAGE(PG8_SA(1, 1), a1 + hstep, voffA); \
            PG8_WAIT_SEL(rx_, WR_); PG8_WAIT_L(0); PG8_BAR; PG8_MMA(0, 0, At, B0); PG8_MMA(0, 1, At, B1); PG8_BAR; PG8_SCHED; \
              \
            PG8_LDA(At, 0, 1); PG8_STAGE(PG8_SB(0, 0), b2, voffB); PG8_STAGE(PG8_SB(0, 1), b2 + hstep, voffB); PG8_STAGE(PG8_SA(0, 0), a2, voffA); \
            PG8_WAIT_SEL(rx_, WR_); PG8_WAIT_L(0); PG8_BAR; PG8_MMA(1, 0, At, B0); PG8_MMA(1, 1, At, B1); PG8_BAR; PG8_SCHED; \
              \
            PG8_LDB(B0, 1, 0); PG8_LDB(B1, 1, 1); PG8_SCHED; PG8_LDA(At, 1, 0); PG8_STAGE(PG8_SA(0, 1), a2 + hstep, voffA); \
            PG8_WAIT_SEL(rx_, WR_); PG8_WAIT_L(0); PG8_BAR; PG8_MMA(0, 0, At, B0); PG8_MMA(0, 1, At, B1); PG8_BAR; PG8_SCHED; \
              \
            PG8_LDA(At, 1, 1); PG8_STAGE(PG8_SB(1, 0), b3, voffB); PG8_STAGE(PG8_SB(1, 1), b3 + hstep, voffB); PG8_STAGE(PG8_SA(1, 0), a3, voffA); \
            PG8_WAIT_VN(8); PG8_WAIT_L(0); PG8_BAR; PG8_MMA(1, 0, At, B0); PG8_MMA(1, 1, At, B1); PG8_BAR; PG8_SCHED; } while (0)
    Unit cur, nxt; int ui = 0;
#if defined(AMP_SEC)
    unsigned long long amp_acc = 0, amp_t0 = __builtin_amdgcn_s_memrealtime();
#define AMP_MARK(sec) do { const unsigned long long t_ = __builtin_amdgcn_s_memrealtime(); if (AMP_SEC == (sec)) amp_acc += t_ - amp_t0; amp_t0 = t_; } while (0)
#else
#define AMP_MARK(sec) do { } while (0)
#endif
    if (!S.next(0, cur)) return;
    if (stagger_ticks > 0) { const unsigned long long t0_ = __builtin_amdgcn_s_memrealtime(); while (__builtin_amdgcn_s_memrealtime() - t0_ < (unsigned long long)stagger_ticks) __builtin_amdgcn_s_sleep(4); }
    f32x4 acc[2][2][4][2];
#pragma unroll
    for (int a = 0; a < 2; ++a)
#pragma unroll
        for (int b = 0; b < 2; ++b)
#pragma unroll
            for (int m = 0; m < 4; ++m)
#pragma unroll
                for (int n = 0; n < 2; ++n) acc[a][b][m][n] = (f32x4){0.f, 0.f, 0.f, 0.f};
    bf16x8 At[4][2], B0[2][2], B1[2][2];
    const char* cA = (const char*)g.A + (size_t)cur.pm * tstep; const char* cB = (const char*)g.Bt + (size_t)cur.pn * tstep;
    S.a_ready(cur);
    PG8_STAGE_SC(0, cur);
    if constexpr (SP2) {
        PG8_STAGE(PG8_SB(0, 0), cB, voffB); PG8_STAGE(PG8_SB(0, 1), cB + hstep, voffB); PG8_STAGE(PG8_SA(0, 0), cA, voffA); PG8_STAGE(PG8_SA(0, 1), cA + hstep, voffA);
        if (wr == 1) PG8_BAR;
        PG8_WAIT_V(2); PG8_BAR;
        PG8_STAGE(PG8_SB(1, 0), cB + kstep, voffB); PG8_STAGE(PG8_SA(1, 0), cA + kstep, voffA); PG8_STAGE(PG8_SB(1, 1), cB + hstep + kstep, voffB);
        PG8_WAIT_V(6); PG8_BAR;
    } else {
        PG8_STAGE(PG8_SB(0, 0), cB, voffB); PG8_STAGE(PG8_SA(0, 0), cA, voffA); PG8_STAGE(PG8_SB(0, 1), cB + hstep, voffB); PG8_STAGE(PG8_SA(0, 1), cA + hstep, voffA);
        if (wr == 1) PG8_BAR;
        PG8_WAIT_V(4); PG8_BAR;
        PG8_STAGE(PG8_SB(1, 0), cB + kstep, voffB); PG8_STAGE(PG8_SA(1, 0), cA + kstep, voffA); PG8_STAGE(PG8_SB(1, 1), cB + hstep + kstep, voffB);
        PG8_WAIT_V(6); PG8_BAR;
    }
    for (;;) {
        const bool has_next = S.next(ui + 1, nxt);
        const char* nA = has_next ? (const char*)g.A + (size_t)nxt.pm * tstep : cA; const char* nB = has_next ? (const char*)g.Bt + (size_t)nxt.pn * tstep : cB;
        AMP_MARK(ui == 0 ? 4 : 3);
#if defined(REP_K)
        for (int rk_ = REP_K - 1; rk_ >= 0; --rk_) {
        const char* nA_ = nA; const char* nB_ = nB; if (rk_) { nA = cA; nB = cB; }
#endif
#pragma unroll 1
        for (int t = 0; t < nt; t += 2) {
            const bool last = (t == nt - 2);
            const bool rx = SP2 && RELAX && ui > 0 && t == 0; constexpr int WR = 8 + Epi::NST + (I8 ? 1 : 0);
            if constexpr (SEG) { if (t == 8 || t == 16) { unsigned zm_ = 0u; asm volatile("" : "+v"(zm_)); const int lm_ = (int)__builtin_amdgcn_mbcnt_hi(~0u, __builtin_amdgcn_mbcnt_lo(~0u, zm_)); E.mid(acc, cur, t >> 3, wr, wc, lm_ & 15, lm_ >> 4); } }
            const char* a1 = PG8_PA(cA, t + 1);
            const char* a2 = last ? nA : PG8_PA(cA, t + 2); const char* b2 = last ? nB : PG8_PB(cB, t + 2);
            const char* a3 = a2 + kstep; const char* b3 = b2 + kstep;
            #if defined(REP_K)
            if (last && has_next && rk_ == 0) S.a_ready(nxt);
#else
            if (last && has_next) S.a_ready(nxt);
#endif
            if constexpr (SP2) {
            PG8_ITER2(rx, WR);
            } else {
            PG8_LDB(B0, 0, 0); PG8_SCHED; PG8_LDA(At, 0, 0); PG8_STAGE(PG8_SA(1, 1), a1 + hstep, voffA);
            PG8_WAIT_L(8); PG8_BAR; PG8_WAIT_L(0); PG8_MMA(0, 0, At, B0); PG8_BAR; PG8_SCHED;
            PG8_LDB(B1, 0, 1); PG8_STAGE(PG8_SB(0, 0), b2, voffB);
            PG8_BAR; PG8_WAIT_L(0); PG8_MMA(0, 1, At, B1); PG8_BAR;
            PG8_LDA(At, 0, 1); PG8_STAGE(PG8_SA(0, 0), a2, voffA);
            PG8_BAR; PG8_WAIT_L(0); PG8_MMA(1, 0, At, B0); PG8_BAR; PG8_SCHED;
            PG8_STAGE(PG8_SB(0, 1), b2 + hstep, voffB);
            PG8_WAIT_V(6); PG8_BAR; PG8_MMA(1, 1, At, B1); PG8_BAR;
            PG8_LDB(B0, 1, 0); PG8_SCHED; PG8_LDA(At, 1, 0); PG8_STAGE(PG8_SA(0, 1), a2 + hstep, voffA);
            PG8_WAIT_L(8); PG8_BAR; PG8_WAIT_L(0); PG8_MMA(0, 0, At, B0); PG8_BAR; PG8_SCHED;
            PG8_LDB(B1, 1, 1); PG8_STAGE(PG8_SB(1, 0), b3, voffB);
            PG8_BAR; PG8_WAIT_L(0); PG8_MMA(0, 1, At, B1); PG8_BAR;
            PG8_LDA(At, 1, 1); PG8_STAGE(PG8_SA(1, 0), a3, voffA);
            PG8_BAR; PG8_WAIT_L(0); PG8_MMA(1, 0, At, B0); PG8_BAR; PG8_SCHED;
            PG8_STAGE(PG8_SB(1, 1), b3 + hstep, voffB);
            PG8_WAIT_V(6); PG8_BAR; PG8_MMA(1, 1, At, B1); PG8_BAR;
            }
        }
#if defined(REP_K)
        nA = nA_; nB = nB_;
        if (rk_) { _Pragma("unroll") for (int a = 0; a < 2; ++a) _Pragma("unroll") for (int b = 0; b < 2; ++b) _Pragma("unroll") for (int m = 0; m < 4; ++m) _Pragma("unroll") for (int n = 0; n < 2; ++n) acc[a][b][m][n] = (f32x4){0.f, 0.f, 0.f, 0.f}; }
        }
#endif
        AMP_MARK(1);
        if constexpr (SP2 && RELAX) { if (has_next) PG8_STAGE(PG8_SA(1, 1), nA + kstep + hstep, voffA); }
        if constexpr (ALIGN_EPI) { if (wr == 0) PG8_BAR; }
        if constexpr (!Epi::AFTER_DRAIN) { unsigned ze_ = 0u; asm volatile("" : "+v"(ze_)); const int le_ = (int)__builtin_amdgcn_mbcnt_hi(~0u, __builtin_amdgcn_mbcnt_lo(~0u, ze_));
            if constexpr (I8) {
                typedef int i32x4_ __attribute__((ext_vector_type(4)));
                const int fr_ = le_ & 15, fq_ = le_ >> 4; const PG8_LAS float* rsp = (const PG8_LAS float*)(lds + PG8_SC_OFF + (ui & 1) * 2048) + wr * 64 + fr_; const PG8_LAS float* csp = (const PG8_LAS float*)(lds + PG8_SC_OFF + (ui & 1) * 2048) + 256 + wc * 32 + 8 * fq_;
                f32x4 cv[2][2];
                _Pragma("unroll") for (int bj = 0; bj < 2; ++bj) _Pragma("unroll") for (int n = 0; n < 2; ++n) cv[bj][n] = *(const PG8_LAS f32x4*)(csp + bj * HALF + 4 * n);
                _Pragma("unroll") for (int ai = 0; ai < 2; ++ai) _Pragma("unroll") for (int m = 0; m < 4; ++m) { const float rv = rsp[ai * HALF + m * 16];
                    _Pragma("unroll") for (int bj = 0; bj < 2; ++bj) _Pragma("unroll") for (int n = 0; n < 2; ++n)
                        acc[ai][bj][m][n] = __builtin_convertvector(__builtin_bit_cast(i32x4_, acc[ai][bj][m][n]), f32x4) * (cv[bj][n] * rv); }
            }
            E(acc, cur, wr, wc, le_ & 15, le_ >> 4);
#if defined(REP_EPI)
            if constexpr (Epi::IDEMPOTENT) { for (int r_ = 1; r_ < REP_EPI; ++r_) { asm volatile("" ::: "memory"); E(acc, cur, wr, wc, le_ & 15, le_ >> 4); } }
#endif
            S.done(cur); AMP_MARK(2); }
        if (!has_next) break;
#pragma unroll
        for (int a = 0; a < 2; ++a)
#pragma unroll
            for (int b = 0; b < 2; ++b)
#pragma unroll
                for (int m = 0; m < 4; ++m)
#pragma unroll
                    for (int n = 0; n < 2; ++n) acc[a][b][m][n] = (f32x4){0.f, 0.f, 0.f, 0.f};
        cur = nxt; cA = nA; cB = nB; ++ui;
        PG8_STAGE_SC(ui, cur);
        if constexpr (ALIGN_EPI) { if (wr == 1) PG8_BAR; }
    }
    PG8_WAIT_V(0);
    if constexpr (!ALIGN_EPI) { if (wr == 0) PG8_BAR; }
    PG8_BAR;
    if constexpr (Epi::AFTER_DRAIN) { E.fused(acc, cur, wr, wc, fr, fq, lds, wid, lane); S.done(cur); }
#if defined(AMP_SEC)
    AMP_MARK(5);
#if defined(AMP_ID)
    if (amp_id != AMP_ID) amp_acc = 0;
#endif
    { const unsigned long long t1_ = __builtin_amdgcn_s_memrealtime(); while (__builtin_amdgcn_s_memrealtime() - t1_ < amp_acc) __builtin_amdgcn_s_sleep(2); }
    PG8_BAR;
#endif
#undef PG8_PA
#undef PG8_PB
#undef PG8_SA
#undef PG8_SB
#undef PG8_STAGE
#undef PG8_LDA
#undef PG8_LDB
#undef PG8_MMA
#undef PG8_WAIT_V
#undef PG8_WAIT_L
#undef PG8_BAR
#undef PG8_SCHED
}
}
#define GAS __attribute__((address_space(1)))
#define LAS __attribute__((address_space(3)))
typedef pg8::bf16_t bf16_t;
typedef pg8::bf16x8 bf16x8;
typedef pg8::f32x4 f32x4;
typedef pg8::u32x4 u32x4;
typedef float f32x16 __attribute__((ext_vector_type(16)));
typedef float f32x2 __attribute__((ext_vector_type(2)));
typedef short s16x4 __attribute__((ext_vector_type(4)));
typedef unsigned u32x2 __attribute__((ext_vector_type(2)));
typedef GAS unsigned gu32;

typedef const __attribute__((address_space(4))) unsigned char* kptr_t;
__device__ __forceinline__ kptr_t kbase() { kptr_t p = (kptr_t)__builtin_amdgcn_kernarg_segment_ptr(); asm volatile("" : "+s"(p)); return p; }
#define IN_(i) (*(const float* const __attribute__((address_space(4)))*)(kbase() + 8 * (i)))
#define OUT_ (*(float* const __attribute__((address_space(4)))*)(kbase() + 200))
#define WS_ (*(unsigned char* const __attribute__((address_space(4)))*)(kbase() + 208))
constexpr int NWAVES = 8, NTHREADS = 512;
constexpr int D = 1024, SEQ = 16384, M_LAT = 32768, CTXL = 256, M_CTX = 512, MT = M_LAT + M_CTX;
constexpr int ZN = 6400, DFF = 2816, DEXP = 3584, NEXP = 8, NMOD = 6144;
constexpr float EPS = 1e-6f, LOG2E = 1.4426950408889634f, QSCALE = 0.125f * LOG2E;
constexpr int CHUNK_TILES = 128, CHUNK_MAX = 136, CHUNK_ROWS = CHUNK_MAX * 256;
constexpr float WSCALE8 = 64.0f;

constexpr size_t MiB = 1u << 20;
constexpr size_t WS_CTL = 0, CTL_BYTES = 1 * MiB;
constexpr size_t WS_MODV = 6 * MiB + 768 * 1024;
constexpr size_t WS_MODF = 1 * MiB;
constexpr size_t WS_CS = 1 * MiB + 152 * 1024;
constexpr size_t WS_RS = 1 * MiB + 864 * 1024;
constexpr size_t WS_ROPE = 1 * MiB + 256 * 1024;
constexpr size_t WS_G1 = 1 * MiB + 512 * 1024;
constexpr size_t WS_G2 = 1 * MiB + 768 * 1024;
constexpr size_t WS_HCTX = 2 * MiB;
constexpr size_t WS_ASG = 4 * MiB;
constexpr size_t WS_ELIST = 5 * MiB;
constexpr size_t WS_TW = 6 * MiB;
constexpr size_t WS_G3 = 6 * MiB + 512 * 1024;
constexpr size_t WS_WIN = 8 * MiB, WIN_BYTES = (size_t)ZN * D;
constexpr size_t WS_WY = 33 * MiB;
constexpr size_t WS_WO = 39 * MiB;
constexpr size_t WS_WFF_UP = 43 * MiB;
constexpr size_t WS_WFF_DN = 54 * MiB;
constexpr size_t WS_HN = 60 * MiB;
constexpr size_t WS_Q = 125 * MiB;
constexpr size_t WS_KV = WS_Q + (size_t)MT * 512 * 2;
constexpr size_t WS_FAB = 174 * MiB;
constexpr size_t WS_CIN = 239 * MiB;
constexpr size_t WS_GT = WS_CIN + (size_t)MT * 1536 * 2;
constexpr size_t WS_COUT = 434 * MiB;
constexpr size_t WS_ATT = WS_COUT + (size_t)MT * 512 * 2;
constexpr size_t WS_MIX = WS_GT;
constexpr size_t WS_HID0 = 125 * MiB;
constexpr size_t WS_F0 = 434 * MiB;
constexpr size_t WS_EXUP = 499 * MiB;
constexpr size_t WS_EXDN = 555 * MiB;
constexpr size_t WS_H2G = 209 * MiB;
constexpr size_t WS_HIDX = 244 * MiB;
constexpr size_t WS_YEXP = 363 * MiB;
constexpr size_t WS_NEED = 583 * MiB;
static_assert(WS_KV + (size_t)MT * 256 * 2 <= WS_FAB && WS_FAB + (size_t)MT * 1024 * 2 <= WS_CIN && WS_GT + (size_t)MT * 3072 <= WS_COUT && WS_ATT + (size_t)MT * 512 * 2 <= WS_EXUP, "ws map (mixer)");
static_assert(WS_HN + (size_t)MT * 1024 * 2 <= WS_Q && WS_WFF_DN + (size_t)1024 * DFF * 2 <= WS_HN && WS_WFF_UP + (size_t)2 * DFF * 1024 * 2 <= WS_WFF_DN, "ws map (weights)");
static_assert(WS_HID0 + (size_t)MT * DFF * 2 <= WS_MIX && WS_MIX + (size_t)MT * 1024 * 2 <= WS_F0 && WS_F0 + (size_t)MT * 1024 * 2 <= WS_EXUP && WS_EXUP + (size_t)8 * 7168 * 1024 <= WS_EXDN && WS_EXDN + (size_t)8 * 1024 * DEXP <= WS_NEED, "ws map (ffn)");
static_assert(WS_H2G + (size_t)CHUNK_ROWS * 1024 <= WS_HIDX && WS_HIDX + (size_t)CHUNK_ROWS * DEXP <= WS_YEXP && WS_YEXP + (size_t)264 * 256 * 1024 * 2 <= WS_EXUP, "ws map (moe)");
constexpr int CW_BAR = 4096;
constexpr int CW_CNT = 8192;
constexpr int CW_COLMAX = 16384;
constexpr int CW_FOLDMAX = CW_COLMAX + 2 * 6400 + 5632;

constexpr int RING_BYTES = 131072;
constexpr int MISC_OFF = RING_BYTES + 320;
constexpr int LDSX_OFF = RING_BYTES + 1024;
constexpr int LDS_BYTES = 147456;

#define LDS_WAIT() asm volatile("s_waitcnt lgkmcnt(0)" ::: "memory")
#define VM_WAIT() asm volatile("s_waitcnt vmcnt(0)" ::: "memory")

#define XB_TMO      128
#define XB_XCNT(j)  (256  + 64 * (j))
#define XB_XSUB(j)  (1280 + 64 * (j))
#define XB_XGEN(j)  (2304 + 64 * (j))
#define XB_TOP      3328
#define XB_TOPGEN   3392
#define XCD_BAR_WORDS 3456
#define XB_SPIN_CAP (1u << 22)

__device__ __forceinline__ unsigned xb_ld(unsigned* p)              { return __hip_atomic_load(p, __ATOMIC_RELAXED, __HIP_MEMORY_SCOPE_AGENT); }
__device__ __forceinline__ unsigned xb_add(unsigned* p, unsigned v) { return __hip_atomic_fetch_add(p, v, __ATOMIC_RELAXED, __HIP_MEMORY_SCOPE_AGENT); }
__device__ __forceinline__ unsigned xb_xcc_id() { return (unsigned)__builtin_amdgcn_s_getreg((3 << 11) | 20) & 0xFu; }
#define XB_SPIN(cond, bar) do { unsigned _sp = 0; while (cond) { __builtin_amdgcn_s_sleep(1); \
    if ((++_sp & 255u) == 0u) { if (xb_ld(&(bar)[XB_TMO])) break; if (_sp > XB_SPIN_CAP) { atomicAdd(&(bar)[XB_TMO], 1u); break; } } } } while (0)

struct XcdBarrier {
    unsigned* bar; unsigned x;
    volatile LAS unsigned* st;
};

__device__ __forceinline__ XcdBarrier xcd_barrier_post(unsigned* bar, volatile LAS unsigned* st) {
    XcdBarrier b; b.bar = bar; b.x = xb_xcc_id(); b.st = st;
    if (threadIdx.x == 0) (void)xb_add(&bar[XB_XCNT(b.x)], 1u);
    return b;
}
__device__ __forceinline__ void xcd_barrier_complete(unsigned* bar, unsigned x, unsigned& nloc, unsigned& nx) {
    const unsigned G = gridDim.x * gridDim.y * gridDim.z;
    unsigned sum, cnt, mine, sp = 0u;
    for (;;) {
        sum = 0u; cnt = 0u; mine = 0u;
#pragma unroll
        for (unsigned j = 0; j < 16; ++j) { const unsigned c = xb_ld(&bar[XB_XCNT(j)]); sum += c; cnt += (c > 0u) ? 1u : 0u; mine = (j == x) ? c : mine; }
        if (sum == G) break;
        __builtin_amdgcn_s_sleep(1);
        if ((++sp & 255u) == 0u) { if (xb_ld(&bar[XB_TMO])) break; if (sp > XB_SPIN_CAP) { atomicAdd(&bar[XB_TMO], 1u); break; } }
    }
    nloc = mine > 0u ? mine : 1u; nx = cnt > 0u ? cnt : 1u;
}

__device__ __forceinline__ void xcd_barrier(const XcdBarrier& b) {
    asm volatile("s_waitcnt vmcnt(0)" ::: "memory");
    __syncthreads();
    if (threadIdx.x == 0) {
        unsigned* bar = b.bar;
        __builtin_amdgcn_s_waitcnt(0);
        unsigned nloc = b.st[0], nx = b.st[1];
        if (nloc == 0u) { xcd_barrier_complete(bar, b.x, nloc, nx); b.st[0] = nloc; b.st[1] = nx; }
        const unsigned old = xb_add(&bar[XB_XSUB(b.x)], 1u);
        const unsigned gen = old / nloc;
        if (old + 1u == (gen + 1u) * nloc) {
            __builtin_amdgcn_fence(__ATOMIC_RELEASE, "agent");
            asm volatile("s_waitcnt vmcnt(0)" ::: "memory");
            const unsigned og = xb_add(&bar[XB_TOP], 1u);
            const unsigned tg = og / nx;
            if (og + 1u == (tg + 1u) * nx) xb_add(&bar[XB_TOPGEN], 1u);
            else XB_SPIN(xb_ld(&bar[XB_TOPGEN]) == tg, bar);
            __builtin_amdgcn_fence(__ATOMIC_ACQUIRE, "agent");
            xb_add(&bar[XB_XGEN(b.x)], 1u);
            asm volatile("s_waitcnt vmcnt(0)" ::: "memory");
        } else {
            XB_SPIN(xb_ld(&bar[XB_XGEN(b.x)]) == gen, bar);
            __builtin_amdgcn_fence(__ATOMIC_ACQUIRE, "agent");
            asm volatile("s_waitcnt vmcnt(0)" ::: "memory");
        }
    }
    __syncthreads();
}

struct Params { const float* in[25]; float* out; unsigned char* ws; };
struct Ctx {
    LAS unsigned char* lds;
    int tid, lane, wave, vcu, G;
};
__device__ __forceinline__ Ctx opaque(const Ctx& c) { Ctx o = c; asm volatile("" : "+s"(o.wave), "+s"(o.vcu), "+s"(o.G));
    unsigned z = 0u; asm volatile("" : "+v"(z)); o.lane = (int)__builtin_amdgcn_mbcnt_hi(~0u, __builtin_amdgcn_mbcnt_lo(~0u, z)); o.tid = o.wave * 64 + o.lane; return o; }
template <int O> __device__ __forceinline__ float lane_xor(float v) { return __int_as_float(__builtin_amdgcn_ds_swizzle(__float_as_int(v), (O << 10) | 0x1f)); }
__device__ __forceinline__ float half_sum(float v) { const auto r = __builtin_amdgcn_permlane32_swap(__float_as_uint(v), __float_as_uint(v), false, false); return __uint_as_float(r[0]) + __uint_as_float(r[1]); }
__device__ __forceinline__ float half_max(float v) { const auto r = __builtin_amdgcn_permlane32_swap(__float_as_uint(v), __float_as_uint(v), false, false); return fmaxf(__uint_as_float(r[0]), __uint_as_float(r[1])); }
__device__ __forceinline__ float wave_max(float v) {
    v = fmaxf(v, lane_xor<1>(v)); v = fmaxf(v, lane_xor<2>(v)); v = fmaxf(v, lane_xor<4>(v)); v = fmaxf(v, lane_xor<8>(v)); v = fmaxf(v, lane_xor<16>(v));
    return half_max(v);
}
__device__ __forceinline__ unsigned pack4_i8(float a, float b, float c, float d) {
    const int qa = __float2int_rn(a), qb = __float2int_rn(b), qc = __float2int_rn(c), qd = __float2int_rn(d);
    return (unsigned)(qa & 255) | ((unsigned)(qb & 255) << 8) | ((unsigned)(qc & 255) << 16) | ((unsigned)qd << 24);
}
__device__ __forceinline__ float wave_sum(float v) {
    v += lane_xor<1>(v); v += lane_xor<2>(v); v += lane_xor<4>(v); v += lane_xor<8>(v); v += lane_xor<16>(v);
    return half_sum(v);
}
__device__ __forceinline__ unsigned pk2(float lo, float hi) { return pg8::cvt_pk_bf16(lo, hi); }
__device__ __forceinline__ float bflo(unsigned u) { return __uint_as_float(u << 16); }
__device__ __forceinline__ float bfhi(unsigned u) { return __uint_as_float(u & 0xffff0000u); }

__device__ __forceinline__ void tr_item(const float* W, int ldw, int k0, int n0, bf16_t* WT, int ldt, int drow0, LAS float* scr, int lane) {
#pragma unroll 8
    for (int i = 0; i < 32; ++i) { const int kk = 2 * i + (lane >> 5); scr[kk * 33 + (lane & 31)] = W[(size_t)(k0 + kk) * ldw + n0 + (lane & 31)]; }
    LDS_WAIT(); asm volatile("" ::: "memory");
    const int c = lane & 7;
#pragma unroll
    for (int j = 0; j < 4; ++j) { const int n = (lane >> 3) + 8 * j; const LAS float* s = scr + (8 * c) * 33 + n;
        u32x4 o; o.x = pk2(s[0 * 33], s[1 * 33]); o.y = pk2(s[2 * 33], s[3 * 33]); o.z = pk2(s[4 * 33], s[5 * 33]); o.w = pk2(s[6 * 33], s[7 * 33]);
        *(GAS u32x4*)(WT + (size_t)(drow0 + n) * ldt + k0 + 8 * c) = o; }
    LDS_WAIT(); asm volatile("" ::: "memory");
}
__device__ __forceinline__ void tr_item8(const float* W, int ldw, int k0, int n0, unsigned char* WT, int ldt, int drow0, float scale, LAS float* scr, int lane) {
#pragma unroll 8
    for (int i = 0; i < 32; ++i) { const int kk = 2 * i + (lane >> 5); scr[kk * 33 + (lane & 31)] = W[(size_t)(k0 + kk) * ldw + n0 + (lane & 31)]; }
    LDS_WAIT(); asm volatile("" ::: "memory");
    const int c = lane & 7;
#pragma unroll
    for (int j = 0; j < 4; ++j) { const int n = (lane >> 3) + 8 * j; const LAS float* s = scr + (8 * c) * 33 + n;
        u32x2 o; o.x = pg8::pack4_fp8(s[0 * 33] * scale, s[1 * 33] * scale, s[2 * 33] * scale, s[3 * 33] * scale); o.y = pg8::pack4_fp8(s[4 * 33] * scale, s[5 * 33] * scale, s[6 * 33] * scale, s[7 * 33] * scale);
        *(GAS u32x2*)(WT + (size_t)(drow0 + n) * ldt + k0 + 8 * c) = o; }
    LDS_WAIT(); asm volatile("" ::: "memory");
}
__device__ __forceinline__ void amax_item(const float* W, int ldw, int k0, int n0, unsigned* cmax, int drow0, int lane) {
    float m = 0.f;
#pragma unroll 8
    for (int i = 0; i < 32; ++i) { const int kk = 2 * i + (lane >> 5); m = fmaxf(m, fabsf(W[(size_t)(k0 + kk) * ldw + n0 + (lane & 31)])); }
    m = half_max(m);
    if (lane < 32) atomicMax(cmax + drow0 + lane, __float_as_uint(m));
}
__device__ __forceinline__ void tr_item_i8(const float* W, int ldw, int k0, int n0, unsigned char* WT, int ldt, int drow0, const unsigned* cmax, float* cs, LAS float* scr, int lane) {
#pragma unroll 8
    for (int i = 0; i < 32; ++i) { const int kk = 2 * i + (lane >> 5); scr[kk * 33 + (lane & 31)] = W[(size_t)(k0 + kk) * ldw + n0 + (lane & 31)]; }
    LDS_WAIT(); asm volatile("" ::: "memory");
    const int c = lane & 7;
#pragma unroll
    for (int j = 0; j < 4; ++j) { const int n = (lane >> 3) + 8 * j; const LAS float* s = scr + (8 * c) * 33 + n;
        const float inv = 127.0f / fmaxf(__uint_as_float(cmax[drow0 + n]), 1e-30f);
        u32x2 o; o.x = pack4_i8(s[0 * 33] * inv, s[1 * 33] * inv, s[2 * 33] * inv, s[3 * 33] * inv); o.y = pack4_i8(s[4 * 33] * inv, s[5 * 33] * inv, s[6 * 33] * inv, s[7 * 33] * inv);
        *(GAS u32x2*)(WT + (size_t)(drow0 + n) * ldt + k0 + 8 * c) = o; }
    if (k0 == 0 && lane < 32) cs[drow0 + lane] = __uint_as_float(cmax[drow0 + lane]) * (1.0f / 127.0f);
    LDS_WAIT(); asm volatile("" ::: "memory");
}
__device__ __forceinline__ int gu_row(int n0, int up) { return (n0 >> 7) * 256 + up * 128 + (n0 & 127); }

__device__ __forceinline__ void p0_convert_item(int it, int pass, LAS float* scr, int lane) {
    unsigned char* ws = WS_;
    unsigned* const cmax = (unsigned*)(ws + WS_CTL) + CW_COLMAX; float* const cs = (float*)(ws + WS_CS);
    if (it < 5376) { const int l = it / 2688, r = it % 2688, kb = r / 168, j = r % 168; const int n0 = j < 24 ? 32 * j : 1280 + 32 * (j - 24), drow = n0 < 768 ? n0 : n0 + 512;
        const float* W = IN_(10) + (size_t)l * D * 5888;
        if (pass == 0) amax_item(W, 5888, 64 * kb, n0, cmax + l * ZN, drow, lane);
        else tr_item_i8(W, 5888, 64 * kb, n0, ws + WS_WIN + l * WIN_BYTES, D, drow, cmax + l * ZN, cs + l * ZN, scr, lane);
        return; }
    it -= 5376;
    if (it < 2816) { const int up = it / 1408, r = it % 1408, kb = r / 88, nb = r % 88;
        if (pass == 0) amax_item(IN_(17 + up), DFF, 64 * kb, 32 * nb, cmax + 2 * ZN, gu_row(32 * nb, up), lane);
        else tr_item_i8(IN_(17 + up), DFF, 64 * kb, 32 * nb, ws + WS_WFF_UP, D, gu_row(32 * nb, up), cmax + 2 * ZN, cs + 2 * ZN, scr, lane);
        return; }
    it -= 2816;
    if (pass != 0) return;
    if (it < 1536) { const int mi = it / 256, r = it % 256, l = mi / 3, i = mi % 3, kb = r / 32, nb = r % 32;
        tr_item(IN_(13 + i) + (size_t)l * 512 * 1024, 1024, 64 * kb, 32 * nb, (bf16_t*)(ws + WS_WY) + (size_t)(l * 3 + i) * 1024 * 512, 512, 32 * nb, scr, lane); return; }
    it -= 1536;
    if (it < 1024) { const int l = it / 512, r = it % 512, kb = r / 32, nb = r % 32;
        tr_item(IN_(16) + (size_t)l * D * D, D, 64 * kb, 32 * nb, (bf16_t*)(ws + WS_WO) + (size_t)l * D * D, D, 32 * nb, scr, lane); return; }
    it -= 1024;
    { const int kb = it / 32, nb = it % 32; tr_item(IN_(19), D, 64 * kb, 32 * nb, (bf16_t*)(ws + WS_WFF_DN), DFF, 32 * nb, scr, lane); }
}
constexpr int P0_I8_ITEMS = 5376 + 2816;
constexpr int P0_ITEMS = 5376 + 1536 + 1024 + 2816 + 1408;
__device__ __forceinline__ void expert_convert_item(int it, LAS float* scr, int lane) {
    unsigned char* ws = WS_;
    const int e = it / 5376, r0 = it % 5376, which = r0 / 1792, r = r0 % 1792;
    if (which < 2) { const int kb = r / 112, nb = r % 112;
        tr_item8(IN_(22 + which) + (size_t)e * D * DEXP, DEXP, 64 * kb, 32 * nb, ws + WS_EXUP + (size_t)e * 7168 * D, D, gu_row(32 * nb, which), WSCALE8, scr, lane); }
    else { const int kb = r / 32, nb = r % 32;
        tr_item8(IN_(24) + (size_t)e * DEXP * D, D, 64 * kb, 32 * nb, ws + WS_EXDN + (size_t)e * D * DEXP, DEXP, 32 * nb, WSCALE8, scr, lane); }
}
constexpr int EXP_ITEMS = 8 * 5376;
__device__ __forceinline__ void expert_convert_fill(const Ctx& C0, int bid, int lo, int hi) {
    if (bid < 8) return;
    const Ctx C = opaque(C0);
    LAS float* scr = (LAS float*)(C.lds + C.wave * 16384);
    for (int it = lo + (bid - 8) * NWAVES + C.wave; it < hi; it += (C.G - 8) * NWAVES) expert_convert_item(it, scr, C.lane);
}
__device__ __forceinline__ void p0_prologue(const Ctx& C0, int pass) {
    const Ctx C = opaque(C0);
    unsigned char* ws = WS_;
    LAS float* sil = (LAS float*)(C.lds + LDSX_OFF);
    LAS float* tab = (LAS float*)(C.lds + LDSX_OFF + 12288);
    for (int i = C.tid; i < 3072; i += NTHREADS) { const float v = i < 2048 ? IN_(1)[i] : IN_(3)[i - 2048]; sil[i] = v / (1.0f + __expf(-v)); }
    if (C.tid < 128) { float s, c; sincospif((float)C.tid / 64.0f, &s, &c); tab[2 * C.tid] = c; tab[2 * C.tid + 1] = s; }
    __syncthreads();
    if (pass == 0) {
    { const int gw0 = C.vcu * NWAVES + C.wave, NGW0 = C.G * NWAVES;
      for (int t = gw0; t < 8 * 2 * 96; t += NGW0) {
        const int kc = t / 192, l = (t % 192) / 96, col = (t % 96) * 64 + C.lane; const float* w = IN_(4) + (size_t)l * D * NMOD + (size_t)(kc * 128) * NMOD + col;
        float a0 = 0.f, a1 = 0.f, a2 = 0.f;
        for (int k = 0; k < 128; k += 32) { float wv[32];
#pragma unroll
            for (int j = 0; j < 32; ++j) wv[j] = w[(size_t)(k + j) * NMOD];
#pragma unroll
            for (int j = 0; j < 32; ++j) { const int kk = kc * 128 + k + j; a0 += sil[kk] * wv[j]; a1 += sil[1024 + kk] * wv[j]; a2 += sil[2048 + kk] * wv[j]; } }
        float* mv = (float*)(ws + WS_MODV) + (size_t)((kc * 2 + l) * 3) * NMOD + col;
        mv[0] = a0; mv[NMOD] = a1; mv[2 * NMOD] = a2;
      } }
    for (int idx = C.vcu * NTHREADS + C.tid; idx < 4096 + 65536 + 32768 + 16384 + 131072; idx += C.G * NTHREADS) {
        if (idx < 4096) { const int pos = idx >> 4, f = idx & 15; const float inv = 1.0f / powf(10000.0f, (float)(2 * f) / 32.0f), ang = (float)pos * inv;
            float* t = (float*)(ws + WS_ROPE) + 2 * idx; t[0] = cosf(ang); t[1] = sinf(ang); }
        else if (idx < 4096 + 65536) { const int i = idx - 4096, m = i >> 8, k = i & 255, k1 = m >> 1, part = m & 1, n1 = k & 127, isb = k >> 7; const int p = (k1 * n1) & 127;
            float s, c; sincospif((float)p / 64.0f, &s, &c); const float v = part == 0 ? (isb ? -s : c) : (isb ? -c : -s);
            ((bf16_t*)(ws + WS_G1))[i] = (bf16_t)pk2(v * 0.08838834764831845f, 0.f); }
        else if (idx >= 4096 + 65536 + 32768 + 16384) { const int i = idx - (4096 + 65536 + 32768 + 16384), k = i >> 9, kk = i & 511, n = kk & 255; float s, c; sincospif((float)((k * n) & 255) / 128.0f, &s, &c);
            ((bf16_t*)(ws + WS_G3))[i] = (bf16_t)pk2((kk < 256 ? c : -s) * 0.0625f, 0.f); }
        else if (idx >= 4096 + 65536 + 32768) { const int i = idx - (4096 + 65536 + 32768), n2 = i >> 7, k1 = i & 127; float s, c; sincospif((float)(k1 * n2) * (1.0f / 8192.0f), &s, &c);
            float* t = (float*)(ws + WS_TW) + 2 * i; t[0] = c; t[1] = s; }
        else { const int i = idx - 4096 - 65536, k2 = i >> 8, k = i & 255, n2 = k & 127, isi = k >> 7; const int p = (k2 * n2) & 127;
            float s, c; sincospif((float)p / 64.0f, &s, &c); ((bf16_t*)(ws + WS_G2))[i] = (bf16_t)pk2((isi ? s : c) * 0.08838834764831845f, 0.f); }
    }
    }
    LAS float* scr = (LAS float*)(C.lds + C.wave * 16384);
    const int gw = C.vcu * NWAVES + C.wave, NGW = C.G * NWAVES;
    for (int it = gw; it < (pass == 0 ? P0_ITEMS : P0_I8_ITEMS); it += NGW) p0_convert_item(it, pass, scr, C.lane);
    bf16_t* const TEMP = (bf16_t*)(ws + WS_HN); const float sc = 0.08838834764831845f;
    if (pass == 0) {
        const int r32 = C.lane & 31, hh = C.lane >> 5;
        for (int t = gw - (NGW - 256); t >= 0 && t < 2 * 4 * 32; t += NGW) {
            const int l = t >> 7, g = (t >> 5) & 3, k0 = (t & 31) * 32; const float* src = IN_(10) + (size_t)l * D * 5888 + (size_t)(k0 + r32) * 5888 + 768 + g * 128 + 8 * hh;
            bf16x8 bfr[8];
#pragma unroll
            for (int s2 = 0; s2 < 8; ++s2) { const f32x4 a = *(const GAS f32x4*)(src + 16 * s2), b = *(const GAS f32x4*)(src + 16 * s2 + 4);
                u32x4 w; w.x = pk2(a[0], a[1]); w.y = pk2(a[2], a[3]); w.z = pk2(b[0], b[1]); w.w = pk2(b[2], b[3]); bfr[s2] = __builtin_bit_cast(bf16x8, w); }
            float mx = 0.f;
#pragma unroll 1
            for (int jb = 0; jb < 8; ++jb) {
                const int part = jb >> 2, j = (32 * jb + r32) & 127;
                f32x16 acc;
#pragma unroll
                for (int i = 0; i < 16; ++i) acc[i] = 0.f;
#pragma unroll
                for (int s2 = 0; s2 < 8; ++s2) { int ib = (16 * s2 + 8 * hh) * j; asm volatile("" : "+v"(ib));
                    u32x4 w;
                    w.x = pk2(tab[2 * ((ib) & 127) + part], tab[2 * ((ib + j) & 127) + part]); w.y = pk2(tab[2 * ((ib + 2 * j) & 127) + part], tab[2 * ((ib + 3 * j) & 127) + part]);
                    w.z = pk2(tab[2 * ((ib + 4 * j) & 127) + part], tab[2 * ((ib + 5 * j) & 127) + part]); w.w = pk2(tab[2 * ((ib + 6 * j) & 127) + part], tab[2 * ((ib + 7 * j) & 127) + part]);
                    acc = __builtin_amdgcn_mfma_f32_32x32x16_bf16(__builtin_bit_cast(bf16x8, w), bfr[s2], acc, 0, 0, 0); }
#pragma unroll
                for (int i = 0; i < 16; ++i) { const float v = acc[i] * sc; mx = fmaxf(mx, fabsf(v)); const int jr = 32 * jb + (i & 3) + 8 * (i >> 2) + 4 * hh;
                    TEMP[((size_t)l * 1024 + (size_t)(jr >> 7) * 512 + g * 128 + (jr & 127)) * D + k0 + r32] = (bf16_t)pk2(v, 0.f); }
            }
            mx = wave_max(mx); if (C.lane == 0) atomicMax((unsigned*)(ws + WS_CTL) + CW_FOLDMAX + l, __float_as_uint(mx));
        }
    } else {
        for (int i = C.vcu * NTHREADS + C.tid; i < 2 * 1024 * 128; i += C.G * NTHREADS) {
            const int l = i >> 17, n = (i >> 7) & 1023, k8 = (i & 127) * 8; const float amax = fmaxf(__uint_as_float(((const unsigned*)(ws + WS_CTL))[CW_FOLDMAX + l]), 1e-30f), inv = 127.0f / amax;
            const u32x4 w = *(const GAS u32x4*)(TEMP + ((size_t)l * 1024 + n) * D + k8);
            u32x2 o; o.x = pack4_i8(bflo(w.x) * inv, bfhi(w.x) * inv, bflo(w.y) * inv, bfhi(w.y) * inv); o.y = pack4_i8(bflo(w.z) * inv, bfhi(w.z) * inv, bflo(w.w) * inv, bfhi(w.w) * inv);
            *(GAS u32x2*)(ws + WS_WIN + l * WIN_BYTES + (size_t)(768 + n) * D + k8) = o;
            if (k8 == 0) ((float*)(ws + WS_CS))[l * ZN + 768 + n] = amax * (1.0f / 127.0f);
        }
    }
}

__device__ __forceinline__ void norm_row(const float* xin, float* xout, bool has_br, const f32x4 (&br)[4], const float* gpost, const float* ga,
                                         const float* gpre, const float* sc, const float* sh, bf16_t* hn, int lane, f32x4 (&h2f)[4], bool hn_fp8 = false) {
    f32x4 x[4];
#pragma unroll
    for (int j = 0; j < 4; ++j) x[j] = *(const GAS f32x4*)(xin + 4 * lane + 256 * j);
    if (has_br) {
        float ss = 0.f;
#pragma unroll
        for (int j = 0; j < 4; ++j) ss += (br[j][0] * br[j][0] + br[j][1] * br[j][1]) + (br[j][2] * br[j][2] + br[j][3] * br[j][3]);
        const float rstd = 1.0f / sqrtf(wave_sum(ss) * (1.0f / D) + EPS);
#pragma unroll
        for (int j = 0; j < 4; ++j) { const f32x4 gp = *(const GAS f32x4*)(gpost + 4 * lane + 256 * j), gg = *(const GAS f32x4*)(ga + 4 * lane + 256 * j); x[j] = x[j] + gg * (br[j] * rstd * gp); }
    }
    if (xout) {
#pragma unroll
        for (int j = 0; j < 4; ++j) *(GAS f32x4*)(xout + 4 * lane + 256 * j) = x[j];
    }
    if (hn) {
        float ss = 0.f;
#pragma unroll
        for (int j = 0; j < 4; ++j) ss += (x[j][0] * x[j][0] + x[j][1] * x[j][1]) + (x[j][2] * x[j][2] + x[j][3] * x[j][3]);
        const float rstd = 1.0f / sqrtf(wave_sum(ss) * (1.0f / D) + EPS);
#pragma unroll
        for (int j = 0; j < 4; ++j) { const f32x4 gp = *(const GAS f32x4*)(gpre + 4 * lane + 256 * j), s1 = *(const GAS f32x4*)(sc + 4 * lane + 256 * j), s0 = *(const GAS f32x4*)(sh + 4 * lane + 256 * j);
            const f32x4 h = (x[j] * rstd * gp) * (s1 + 1.0f) + s0; h2f[j] = h;
            if (hn_fp8) *(GAS unsigned*)((unsigned char*)hn + 4 * lane + 256 * j) = pg8::pack4_fp8(h[0], h[1], h[2], h[3]);
            else { u32x2 w; w.x = pk2(h[0], h[1]); w.y = pk2(h[2], h[3]); *(GAS u32x2*)(hn + 4 * lane + 256 * j) = w; } }
    }
}
__device__ __forceinline__ void load_br(const bf16_t* p, int lane, f32x4 (&br)[4]) {
#pragma unroll
    for (int j = 0; j < 4; ++j) { const u32x2 w = *(const GAS u32x2*)(p + 4 * lane + 256 * j); br[j] = (f32x4){bflo(w.x), bfhi(w.x), bflo(w.y), bfhi(w.y)}; }
}
__device__ __forceinline__ int mod_set(int row) { return row >= M_LAT ? 2 : (row >> 14); }

template <bool PARTS> __device__ __forceinline__ f32x4 modv4(const float* modp, const float* modf, const float* bmod, int l, int set, int off) {
    if constexpr (!PARTS) return *(const GAS f32x4*)(modf + (size_t)(l * 3 + set) * NMOD + off);
    else { f32x4 s = *(const GAS f32x4*)(bmod + l * NMOD + off); const float* p = modp + (size_t)(l * 3 + set) * NMOD + off; f32x4 v[8];
#pragma unroll
        for (int kc = 0; kc < 8; ++kc) v[kc] = *(const GAS f32x4*)(p + (size_t)kc * 6 * NMOD);
#pragma unroll
        for (int kc = 0; kc < 8; ++kc) s = s + v[kc];
        return s; }
}
template <int MODE> __device__ __forceinline__ void phase_norm(const Ctx& C0, int l) {
    constexpr int NR = (MODE == 3) ? 2 : 4;
    const Ctx C = opaque(C0);
    const int gw = C.vcu * NWAVES + C.wave, NGW = C.G * NWAVES, lane = C.lane;
    unsigned char* const ws = WS_;
    const float* const modv = (const float*)(ws + WS_MODV); const float* const bmod = IN_(5);
    const float* const modf = (const float*)(ws + WS_MODF);
    if (MODE == 0) {
        float* mf = (float*)(ws + WS_MODF);
        for (int i = C.vcu * NTHREADS + C.tid; i < 2 * 3 * NMOD; i += C.G * NTHREADS) { const int li = i / (3 * NMOD), c = i % NMOD; float s = bmod[li * NMOD + c]; float v[8];
#pragma unroll
            for (int kc = 0; kc < 8; ++kc) v[kc] = modv[(size_t)kc * 6 * NMOD + i];
#pragma unroll
            for (int kc = 0; kc < 8; ++kc) s += v[kc];
            mf[i] = s; }
    }
    constexpr bool moe = (MODE == 4), comb = (MODE == 3), mid = (MODE == 1 || MODE == 4);
    const bool has_hn = (MODE != 3);
    const int nsets = (MODE == 0 || l == 0) ? 3 : 2;
    const float* const xsrc_lat = (MODE == 0 || MODE == 1) ? IN_(0) : (const float*)OUT_;
    float* const xdst_lat = OUT_;
    const float* const xsrc_ctx = (MODE == 2) ? (const float*)(ws + WS_HCTX) : IN_(2);
    float* const xdst_ctx = (float*)(ws + WS_HCTX);
    const bf16_t* const brbuf = mid ? (const bf16_t*)(ws + WS_MIX) : (const bf16_t*)(ws + WS_F0);
    const float* const gpost = mid ? IN_(7) + l * D : IN_(9) + l * D;
    const float* const gpre = (MODE == 0) ? IN_(6) : mid ? IN_(8) + l * D : IN_(6) + D;
    const int ga_off = mid ? 2048 : 5120, hl = (MODE == 2 || MODE == 3) ? 1 : l, sc_off = mid ? 4096 : 1024, sh_off = mid ? 3072 : 0;
    bf16_t* const HN = (bf16_t*)(ws + WS_HN); float* const RS = (float*)(ws + WS_RS);
    LAS unsigned* const lcnt = (LAS unsigned*)(C.lds + LDSX_OFF);
    LAS unsigned* const stage = (LAS unsigned*)(C.lds + LDSX_OFF + 256);
    LAS float* const wrl = (LAS float*)C.lds;
    const LAS int* const tbl = (const LAS int*)(C.lds + MISC_OFF) + 16;
    if (moe) { if (C.tid < 16) lcnt[C.tid] = 0u; const float* wsrc = IN_(20);
        __syncthreads();
        for (int i = C.tid; i < 8192; i += NTHREADS) wrl[(i & 7) * 1024 + (i >> 3)] = wsrc[i];
        __syncthreads(); }
    const float* const brt = IN_(21);
    const unsigned* const asg = (const unsigned*)(ws + WS_ASG); const bf16_t* const Y = (const bf16_t*)(ws + WS_YEXP);
    int it = 0;
    for (int set = 0; set < nsets; ++set) {
        f32x4 vA[4], vB[4], vS[4];
#pragma unroll
        for (int j = 0; j < 4; ++j) { const int c = 4 * lane + 256 * j;
            if (MODE != 0) vA[j] = modv4<MODE == 0>(modv, modf, bmod, l, set, ga_off + c) * *(const GAS f32x4*)(gpost + c); else vA[j] = (f32x4){0.f, 0.f, 0.f, 0.f};
            if (has_hn) { vB[j] = *(const GAS f32x4*)(gpre + c) * (modv4<MODE == 0>(modv, modf, bmod, hl, set, sc_off + c) + 1.0f); vS[j] = modv4<MODE == 0>(modv, modf, bmod, hl, set, sh_off + c); }
            else { vB[j] = (f32x4){0.f, 0.f, 0.f, 0.f}; vS[j] = vB[j]; } }
        const int base = set < 2 ? set * SEQ : M_LAT, n = set < 2 ? SEQ : M_CTX;
        const float* const xs = set < 2 ? xsrc_lat + (size_t)base * D : xsrc_ctx; float* const xd = set < 2 ? xdst_lat + (size_t)base * D : xdst_ctx;
        for (int i0 = gw; i0 < n; i0 += NGW * NR) {
            f32x4 x[NR][4]; u32x2 bw[NR][4], bw2[NR][4]; float cw0[NR], cw1[NR];
#pragma unroll
            for (int k = 0; k < NR; ++k) { const int ri = i0 + NGW * k; if (ri < n) {
#pragma unroll
                for (int j = 0; j < 4; ++j) x[k][j] = __builtin_nontemporal_load((const GAS f32x4*)(xs + (size_t)ri * D + 4 * lane + 256 * j));
                if (MODE != 0) {
                    if (comb) { const unsigned* a = asg + (size_t)(base + ri) * 8; const int e0 = (int)a[0], e1 = (int)a[3]; cw0[k] = __uint_as_float(a[2]); cw1[k] = __uint_as_float(a[5]);
                        const bf16_t* y0 = Y + ((size_t)tbl[e0] * 256 + a[1]) * D, * y1 = Y + ((size_t)tbl[e1] * 256 + a[4]) * D;
#pragma unroll
                        for (int j = 0; j < 4; ++j) { bw[k][j] = *(const GAS u32x2*)(y0 + 4 * lane + 256 * j); bw2[k][j] = *(const GAS u32x2*)(y1 + 4 * lane + 256 * j); } }
                    else {
#pragma unroll
                        for (int j = 0; j < 4; ++j) bw[k][j] = __builtin_nontemporal_load((const GAS u32x2*)(brbuf + (size_t)(base + ri) * D + 4 * lane + 256 * j)); } } }
              else {
#pragma unroll
                for (int j = 0; j < 4; ++j) { x[k][j] = (f32x4){0.f, 0.f, 0.f, 0.f}; bw[k][j] = (u32x2){0u, 0u}; bw2[k][j] = (u32x2){0u, 0u}; } cw0[k] = 0.f; cw1[k] = 0.f; } }
            if (MODE != 0) {
                float ss[NR]; f32x4 br[NR][4];
#pragma unroll
                for (int k = 0; k < NR; ++k) { ss[k] = 0.f;
#pragma unroll
                    for (int j = 0; j < 4; ++j) { f32x4 b = (f32x4){bflo(bw[k][j].x), bfhi(bw[k][j].x), bflo(bw[k][j].y), bfhi(bw[k][j].y)};
                        if (comb) { const f32x4 b2 = (f32x4){bflo(bw2[k][j].x), bfhi(bw2[k][j].x), bflo(bw2[k][j].y), bfhi(bw2[k][j].y)}; b = b * cw0[k] + b2 * cw1[k]; }
                        br[k][j] = b; ss[k] += (b[0] * b[0] + b[1] * b[1]) + (b[2] * b[2] + b[3] * b[3]); } }
#pragma unroll
                for (int k = 0; k < NR; ++k) ss[k] = wave_sum(ss[k]);
#pragma unroll
                for (int k = 0; k < NR; ++k) { const float rstd = 1.0f / sqrtf(ss[k] * (1.0f / D) + EPS);
#pragma unroll
                    for (int j = 0; j < 4; ++j) x[k][j] = x[k][j] + vA[j] * (br[k][j] * rstd); }
#pragma unroll
                for (int k = 0; k < NR; ++k) { const int ri = i0 + NGW * k; if (ri < n) {
#pragma unroll
                    for (int j = 0; j < 4; ++j) __builtin_nontemporal_store(x[k][j], (GAS f32x4*)(xd + (size_t)ri * D + 4 * lane + 256 * j)); } }
            }
            if (has_hn) {
                float s2[NR];
#pragma unroll
                for (int k = 0; k < NR; ++k) { s2[k] = 0.f;
#pragma unroll
                    for (int j = 0; j < 4; ++j) s2[k] += (x[k][j][0] * x[k][j][0] + x[k][j][1] * x[k][j][1]) + (x[k][j][2] * x[k][j][2] + x[k][j][3] * x[k][j][3]); }
#pragma unroll
                for (int k = 0; k < NR; ++k) s2[k] = wave_sum(s2[k]);
                float am[NR];
#pragma unroll
                for (int k = 0; k < NR; ++k) { const float rstd = 1.0f / sqrtf(s2[k] * (1.0f / D) + EPS); am[k] = 0.f;
#pragma unroll
                    for (int j = 0; j < 4; ++j) { x[k][j] = (x[k][j] * rstd) * vB[j] + vS[j];
                        am[k] = fmaxf(fmaxf(am[k], fmaxf(fabsf(x[k][j][0]), fabsf(x[k][j][1]))), fmaxf(fabsf(x[k][j][2]), fabsf(x[k][j][3]))); } }
                if (!moe) {
#pragma unroll
                    for (int k = 0; k < NR; ++k) am[k] = fmaxf(wave_max(am[k]), 1e-20f);
                }
#pragma unroll
                for (int k = 0; k < NR; ++k) { const int ri = i0 + NGW * k;
                    if (ri < n) {
                        if (moe) {
#pragma unroll
                            for (int j = 0; j < 4; ++j) *(GAS unsigned*)((unsigned char*)HN + (size_t)(base + ri) * D + 4 * lane + 256 * j) = pg8::pack4_fp8(x[k][j][0], x[k][j][1], x[k][j][2], x[k][j][3]); }
                        else {
                            const float inv = 127.0f / am[k];
#pragma unroll
                            for (int j = 0; j < 4; ++j) *(GAS unsigned*)((unsigned char*)HN + (size_t)(base + ri) * D + 4 * lane + 256 * j) = pack4_i8(x[k][j][0] * inv, x[k][j][1] * inv, x[k][j][2] * inv, x[k][j][3] * inv);
                            if (lane == 0) RS[base + ri] = am[k] * (1.0f / 127.0f); } } }
                if (moe) {
#pragma unroll
                    for (int k = 0; k < NR; ++k) { const int ri = i0 + NGW * k; if (ri < n) {
                        float lg[8];
#pragma unroll
                        for (int e = 0; e < 8; ++e) lg[e] = 0.f;
#pragma unroll
                        for (int e = 0; e < 8; ++e)
#pragma unroll
                            for (int j = 0; j < 4; ++j) { const f32x4 wv = *(const LAS f32x4*)(wrl + e * 1024 + 4 * lane + 256 * j); lg[e] += (x[k][j][0] * wv[0] + x[k][j][1] * wv[1]) + (x[k][j][2] * wv[2] + x[k][j][3] * wv[3]); }
                        float w4[4];
#pragma unroll
                        for (int j = 0; j < 4; ++j) { const auto r = __builtin_amdgcn_permlane32_swap(__float_as_uint(lg[j]), __float_as_uint(lg[4 + j]), false, false); w4[j] = __uint_as_float(r[0]) + __uint_as_float(r[1]); }
                        const bool b4 = (lane & 16) != 0, b3 = (lane & 8) != 0;
                        float w2[2];
#pragma unroll
                        for (int j = 0; j < 2; ++j) { const float keep = b4 ? w4[2 + j] : w4[j], send = b4 ? w4[j] : w4[2 + j]; w2[j] = keep + lane_xor<16>(send); }
                        float w1v; { const float keep = b3 ? w2[1] : w2[0], send = b3 ? w2[0] : w2[1]; w1v = keep + lane_xor<8>(send); }
                        w1v += lane_xor<4>(w1v); w1v += lane_xor<2>(w1v); w1v += lane_xor<1>(w1v);
                        float lgt[8];
#pragma unroll
                        for (int e = 0; e < 8; ++e) lgt[e] = __int_as_float(__builtin_amdgcn_readlane(__float_as_int(w1v), 8 * e)) + brt[e];
                        int e0 = 0; float v0 = lgt[0];
#pragma unroll
                        for (int e = 1; e < 8; ++e) if (lgt[e] > v0) { v0 = lgt[e]; e0 = e; }
                        int e1 = -1; float v1 = -INFINITY;
#pragma unroll
                        for (int e = 0; e < 8; ++e) if (e != e0 && lgt[e] > v1) { v1 = lgt[e]; e1 = e; }
                        const float pw1 = 1.0f / (1.0f + __expf(v0 - v1)), pw0 = 1.0f - pw1;
                        if (lane == 0) { const unsigned p0 = atomicAdd((unsigned*)&lcnt[e0], 1u), p1 = atomicAdd((unsigned*)&lcnt[e1], 1u);
                            LAS unsigned* st = stage + (C.wave * 24 + it) * 6; st[0] = (unsigned)e0; st[1] = p0; st[2] = __float_as_uint(pw0); st[3] = (unsigned)e1; st[4] = p1; st[5] = __float_as_uint(pw1); }
                        ++it; } }
                }
            }
        }
    }
    if (moe) {
        __syncthreads();
        if (C.tid < 8) lcnt[8 + C.tid] = __hip_atomic_fetch_add((unsigned*)(ws + WS_CTL) + CW_CNT + 64 * C.tid, lcnt[C.tid], __ATOMIC_RELAXED, __HIP_MEMORY_SCOPE_AGENT);
        __syncthreads();
        if (lane == 0) { int i2 = 0; int* elist = (int*)(ws + WS_ELIST); unsigned* asgw = (unsigned*)(ws + WS_ASG);
            for (int set = 0; set < 2; ++set)
                for (int i0 = gw; i0 < SEQ; i0 += NGW * NR)
                    for (int k = 0; k < NR; ++k) { const int ri = i0 + NGW * k; if (ri < SEQ) { const int row = set * SEQ + ri; const LAS unsigned* st = stage + (C.wave * 24 + i2) * 6; ++i2;
                        const unsigned e0 = st[0], p0 = st[1] + lcnt[8 + e0], e1 = st[3], p1 = st[4] + lcnt[8 + e1];
                        elist[e0 * M_LAT + p0] = row; elist[e1 * M_LAT + p1] = row;
                        unsigned* a = asgw + (size_t)row * 8; a[0] = e0; a[1] = p0; a[2] = st[2]; a[3] = e1; a[4] = p1; a[5] = st[5]; } } }
    }
}

constexpr int AT_S = 144;
__device__ __forceinline__ int crow(int r, int h) { return (r & 3) + 8 * (r >> 2) + 4 * h; }
__device__ __forceinline__ void phase_attention(const Ctx& C0, int l, bool with_ctx_q) {
    const Ctx C = opaque(C0);
    const bf16_t* Q = (const bf16_t*)(WS_ + WS_Q); const bf16_t* KV = (const bf16_t*)(WS_ + WS_KV); bf16_t* AO = (bf16_t*)(WS_ + WS_ATT);
    int lane_ = C.lane; asm volatile("" : "+v"(lane_)); const int lane = lane_, w = C.wave, r32 = lane & 31, hh = lane >> 5, qq = (lane & 15) >> 2, pp = lane & 3, blk = (lane >> 4) & 1;
    const int nunits = 1024 + (with_ctx_q ? 16 : 0); const float* sinks = IN_(11) + l * 8;
    for (int unit = C.vcu; unit < nunits; unit += C.G) {
        int b, head, hkv, qrowbase, q0, lo, nloc;
        if (unit < 1024) { const int g = unit & 3, qb = (unit >> 2) & 63; hkv = (unit >> 8) & 1; b = unit >> 9; head = hkv * 4 + g; q0 = qb * 256; qrowbase = b * SEQ + q0;
            lo = q0 - 128 < 0 ? 0 : q0 - 128; const int hi = q0 + 384 > SEQ ? SEQ : q0 + 384; nloc = (hi - lo) >> 6; }
        else { const int x = unit - 1024; b = x >> 3; head = x & 7; hkv = head >> 2; q0 = 0; lo = 0; nloc = 0; qrowbase = M_LAT + b * CTXL; }
        const int ntiles = nloc + 4, qw = q0 + 32 * w;
        bf16x8 qf[4];
        { const bf16_t* qp = Q + (size_t)(qrowbase + 32 * w + r32) * 512 + head * 64 + 8 * hh;
#pragma unroll
          for (int s = 0; s < 4; ++s) qf[s] = *(const GAS bf16x8*)(qp + 16 * s); }
        float m_run = sinks[head] * LOG2E, l_run = hh == 0 ? 1.0f : 0.0f;
        f32x16 o0, o1;
#pragma unroll
        for (int i = 0; i < 16; ++i) { o0[i] = 0.f; o1[i] = 0.f; }
        const int lrow = C.tid >> 3, lch = C.tid & 7;
        u32x4 kx, vx;
        { const int krow0 = nloc > 0 ? b * SEQ + lo : M_LAT + b * CTXL; const bf16_t* src = KV + (size_t)(krow0 + lrow) * 256 + hkv * 64 + lch * 8;
          kx = *(const GAS u32x4*)src; vx = *(const GAS u32x4*)(src + 128); }
        for (int t = 0; t < ntiles; ++t) {
            const bool local = t < nloc; const int kpos = lo + 64 * t;
            LAS unsigned char* Kt = C.lds + (t & 1) * (128 * AT_S); LAS unsigned char* Vt = Kt + 64 * AT_S;
            *(LAS u32x4*)(Kt + lrow * AT_S + lch * 16) = kx; *(LAS u32x4*)(Vt + lrow * AT_S + lch * 16) = vx;
            __syncthreads();
            if (t + 1 < ntiles) { const int t1 = t + 1; const int krow1 = t1 < nloc ? b * SEQ + lo + 64 * t1 : M_LAT + b * CTXL + 64 * (t1 - nloc);
                const bf16_t* src = KV + (size_t)(krow1 + lrow) * 256 + hkv * 64 + lch * 8; kx = *(const GAS u32x4*)src; vx = *(const GAS u32x4*)(src + 128); }
            const bool relevant = !local || (kpos + 63 >= qw - 128 && kpos <= qw + 31 + 128);
            if (relevant) {
                f32x16 p0, p1;
#pragma unroll
                for (int i = 0; i < 16; ++i) { p0[i] = 0.f; p1[i] = 0.f; }
#pragma unroll
                for (int s = 0; s < 4; ++s) {
                    const bf16x8 k0 = *(const LAS bf16x8*)(Kt + r32 * AT_S + (16 * s + 8 * hh) * 2), k1 = *(const LAS bf16x8*)(Kt + (32 + r32) * AT_S + (16 * s + 8 * hh) * 2);
                    p0 = __builtin_amdgcn_mfma_f32_32x32x16_bf16(k0, qf[s], p0, 0, 0, 0); p1 = __builtin_amdgcn_mfma_f32_32x32x16_bf16(k1, qf[s], p1, 0, 0, 0);
                }
                if (local) { const int qpos = qw + r32;
#pragma unroll
                    for (int i = 0; i < 16; ++i) { const int d0 = kpos + crow(i, hh) - qpos, d1 = d0 + 32;
                        if (d0 > 128 || d0 < -128) p0[i] = -INFINITY; if (d1 > 128 || d1 < -128) p1[i] = -INFINITY; } }
                float mt = fmaxf(p0[0], p1[0]);
#pragma unroll
                for (int i = 1; i < 16; ++i) mt = fmaxf(mt, fmaxf(p0[i], p1[i]));
                mt = half_max(mt);
                const float mn = fmaxf(m_run, mt), alpha = __builtin_amdgcn_exp2f(m_run - mn); m_run = mn;
                float ls = 0.f;
#pragma unroll
                for (int i = 0; i < 16; ++i) { p0[i] = __builtin_amdgcn_exp2f(p0[i] - mn); p1[i] = __builtin_amdgcn_exp2f(p1[i] - mn); ls += p0[i] + p1[i]; }
                l_run = l_run * alpha + ls;
#pragma unroll
                for (int i = 0; i < 16; ++i) { o0[i] *= alpha; o1[i] *= alpha; }
#pragma unroll
                for (int kb = 0; kb < 2; ++kb)
#pragma unroll
                    for (int s2 = 0; s2 < 2; ++s2) {
                        u32x4 pw;
                        if (kb == 0) { pw.x = pk2(p0[8 * s2 + 0], p0[8 * s2 + 1]); pw.y = pk2(p0[8 * s2 + 2], p0[8 * s2 + 3]); pw.z = pk2(p0[8 * s2 + 4], p0[8 * s2 + 5]); pw.w = pk2(p0[8 * s2 + 6], p0[8 * s2 + 7]); }
                        else { pw.x = pk2(p1[8 * s2 + 0], p1[8 * s2 + 1]); pw.y = pk2(p1[8 * s2 + 2], p1[8 * s2 + 3]); pw.z = pk2(p1[8 * s2 + 4], p1[8 * s2 + 5]); pw.w = pk2(p1[8 * s2 + 6], p1[8 * s2 + 7]); }
                        const bf16x8 pb = __builtin_bit_cast(bf16x8, pw);
                        const int kbase = 32 * kb + 16 * s2 + 4 * hh + qq;
#pragma unroll
                        for (int c = 0; c < 2; ++c) {
                            const LAS unsigned char* va = Vt + kbase * AT_S + (32 * c + 16 * blk + 4 * pp) * 2;
                            const s16x4 vlo = __builtin_amdgcn_ds_read_tr16_b64_v4i16((LAS s16x4*)va), vhi = __builtin_amdgcn_ds_read_tr16_b64_v4i16((LAS s16x4*)(va + 8 * AT_S));
                            const bf16x8 vf = __builtin_shufflevector(vlo, vhi, 0, 1, 2, 3, 4, 5, 6, 7);
                            if (c == 0) o0 = __builtin_amdgcn_mfma_f32_32x32x16_bf16(vf, pb, o0, 0, 0, 0); else o1 = __builtin_amdgcn_mfma_f32_32x32x16_bf16(vf, pb, o1, 0, 0, 0);
                        }
                    }
            }
        }
        const float linv = 1.0f / half_sum(l_run);
        bf16_t* op = AO + (size_t)(qrowbase + 32 * w + r32) * 512 + head * 64 + 4 * hh;
#pragma unroll
        for (int g = 0; g < 4; ++g) {
            u32x2 a, c2; a.x = pk2(o0[4 * g] * linv, o0[4 * g + 1] * linv); a.y = pk2(o0[4 * g + 2] * linv, o0[4 * g + 3] * linv);
            c2.x = pk2(o1[4 * g] * linv, o1[4 * g + 1] * linv); c2.y = pk2(o1[4 * g + 2] * linv, o1[4 * g + 3] * linv);
            *(GAS u32x2*)(op + 8 * g) = a; *(GAS u32x2*)(op + 32 + 8 * g) = c2; }
        __syncthreads();
    }
}

constexpr int FT_S = 144, FT_TILE = 256 * FT_S;
__device__ __forceinline__ float quad_swap1(float v) { return __int_as_float(__builtin_amdgcn_mov_dpp(__float_as_int(v), 0xB1, 0xF, 0xF, true)); }
template <int STAGE> __device__ __forceinline__ void phase_fft(const Ctx& C0) {
    const Ctx C = opaque(C0);
    unsigned char* const ws = WS_;
    const bf16_t* const SRC = (const bf16_t*)(ws + (STAGE == 1 ? WS_FAB : WS_HN)); const bf16_t* const GM = (const bf16_t*)(ws + (STAGE == 1 ? WS_G1 : WS_G2)); const float* const TW = (const float*)(ws + WS_TW);
    bf16_t* const DST = (bf16_t*)(ws + (STAGE == 1 ? WS_HN : WS_FAB));
    const int lane = C.lane, w = C.wave, r32 = lane & 31, hh = lane >> 5, qq = (lane & 15) >> 2, pp = lane & 3, blk = (lane >> 4) & 1;
    const int mrow = STAGE == 1 ? 32 * w + r32 : 32 * (w & 3) + r32;
    bf16x8 gf[16];
#pragma unroll
    for (int s = 0; s < 16; ++s) gf[s] = *(const GAS bf16x8*)(GM + (size_t)mrow * 256 + 16 * s + 8 * hh);
    u32x4 pf[4];
#define FFT_LOAD(unit_) do { const int b_ = (unit_) >> 10, q_ = ((unit_) >> 3) & 127, cb_ = (unit_) & 7; _Pragma("unroll") for (int i = 0; i < 4; ++i) { const int idx = C.tid + NTHREADS * i, k = idx >> 3, ch = idx & 7; \
        const int srow = b_ * SEQ + (STAGE == 1 ? 128 * (k & 127) + q_ : 128 * q_ + (k & 127)); pf[i] = *(const GAS u32x4*)(SRC + (size_t)srow * 1024 + (k >> 7) * 512 + cb_ * 64 + ch * 8); } } while (0)
    for (int unit = C.vcu; unit < 2048; unit += C.G) {
        const int b = unit >> 10, q = (unit >> 3) & 127, cb = unit & 7;
        LAS unsigned char* X = C.lds;
        __syncthreads();
        FFT_LOAD(unit);
#pragma unroll
        for (int i = 0; i < 4; ++i) { const int idx = C.tid + NTHREADS * i, k = idx >> 3, ch = idx & 7; *(LAS u32x4*)(X + k * FT_S + ch * 16) = pf[i]; }
        __syncthreads();
        if (STAGE == 1) {
            const int k1 = mrow >> 1, part = mrow & 1; const f32x2 tw = *(const GAS f32x2*)(TW + 2 * (q * 128 + k1)); const float tc = tw.x, ts = part ? -tw.y : tw.y;
            bf16_t* const drow = DST + (size_t)(b * SEQ + 128 * k1 + q) * 1024 + part * 512 + cb * 64 + 4 * hh;
#pragma unroll
            for (int cbk = 0; cbk < 2; ++cbk) {
                f32x16 acc;
#pragma unroll
                for (int i = 0; i < 16; ++i) acc[i] = 0.f;
#pragma unroll
                for (int s = 0; s < 16; ++s) {
                    const LAS unsigned char* xa = X + (16 * s + 8 * hh + qq) * FT_S + (32 * cbk + 16 * blk + 4 * pp) * 2;
                    const s16x4 lo = __builtin_amdgcn_ds_read_tr16_b64_v4i16((LAS s16x4*)xa), hi = __builtin_amdgcn_ds_read_tr16_b64_v4i16((LAS s16x4*)(xa + 4 * FT_S));
                    acc = __builtin_amdgcn_mfma_f32_32x32x16_bf16(__builtin_shufflevector(lo, hi, 0, 1, 2, 3, 4, 5, 6, 7), gf[s], acc, 0, 0, 0);
                }
#pragma unroll
                for (int g = 0; g < 4; ++g) { float o[4];
#pragma unroll
                    for (int j = 0; j < 4; ++j) { const float own = acc[4 * g + j]; o[j] = own * tc + lane_xor<1>(own) * ts; }
                    u32x2 wv; wv.x = pk2(o[0], o[1]); wv.y = pk2(o[2], o[3]); *(GAS u32x2*)(drow + 32 * cbk + 8 * g) = wv; }
            }
        } else {
            const int cbk = w >> 2;
            f32x16 acc;
#pragma unroll
            for (int i = 0; i < 16; ++i) acc[i] = 0.f;
#pragma unroll
            for (int s = 0; s < 16; ++s) {
                const LAS unsigned char* xa = X + (16 * s + 8 * hh + qq) * FT_S + (32 * cbk + 16 * blk + 4 * pp) * 2;
                const s16x4 lo = __builtin_amdgcn_ds_read_tr16_b64_v4i16((LAS s16x4*)xa), hi = __builtin_amdgcn_ds_read_tr16_b64_v4i16((LAS s16x4*)(xa + 4 * FT_S));
                acc = __builtin_amdgcn_mfma_f32_32x32x16_bf16(__builtin_shufflevector(lo, hi, 0, 1, 2, 3, 4, 5, 6, 7), gf[s], acc, 0, 0, 0);
            }
            bf16_t* const drow = DST + (size_t)(b * SEQ + q + 128 * mrow) * 512 + cb * 64 + 32 * cbk + 4 * hh;
#pragma unroll
            for (int g = 0; g < 4; ++g) { u32x2 wv; wv.x = pk2(acc[4 * g], acc[4 * g + 1]); wv.y = pk2(acc[4 * g + 2], acc[4 * g + 3]); *(GAS u32x2*)(drow + 8 * g) = wv; }
        }
    }
#undef FFT_LOAD
    __syncthreads();
}
__device__ __forceinline__ void phase_ctx_dft(const Ctx& C0) {
    const Ctx C = opaque(C0);
    unsigned char* const ws = WS_;
    const bf16_t* const FAB = (const bf16_t*)(ws + WS_FAB); const bf16_t* const G3 = (const bf16_t*)(ws + WS_G3); bf16_t* const FN = (bf16_t*)(ws + WS_FAB);
    const int lane = C.lane, w = C.wave, r32 = lane & 31, hh = lane >> 5, qq = (lane & 15) >> 2, pp = lane & 3, blk = (lane >> 4) & 1, mrow = 32 * w + r32;
    LAS unsigned char* const X = C.lds;
    for (int unit = C.vcu; unit < 16; unit += C.G) {
        const int b = unit >> 3, cb = unit & 7;
        f32x16 acc0, acc1;
#pragma unroll
        for (int i = 0; i < 16; ++i) { acc0[i] = 0.f; acc1[i] = 0.f; }
#pragma unroll 1
        for (int h = 0; h < 2; ++h) {
            bf16x8 gf[16];
#pragma unroll
            for (int s = 0; s < 16; ++s) gf[s] = *(const GAS bf16x8*)(G3 + (size_t)mrow * 512 + h * 256 + 16 * s + 8 * hh);
            __syncthreads();
#pragma unroll
            for (int i = 0; i < 4; ++i) { const int idx = C.tid + NTHREADS * i, k = idx >> 3, ch = idx & 7;
                *(LAS u32x4*)(X + k * FT_S + ch * 16) = *(const GAS u32x4*)(FAB + (size_t)(M_LAT + b * CTXL + k) * 1024 + h * 512 + cb * 64 + ch * 8); }
            __syncthreads();
#pragma unroll
            for (int s = 0; s < 16; ++s) {
                const LAS unsigned char* xa = X + (16 * s + 8 * hh + qq) * FT_S + (16 * blk + 4 * pp) * 2;
                const s16x4 lo0 = __builtin_amdgcn_ds_read_tr16_b64_v4i16((LAS s16x4*)xa), hi0 = __builtin_amdgcn_ds_read_tr16_b64_v4i16((LAS s16x4*)(xa + 4 * FT_S));
                const s16x4 lo1 = __builtin_amdgcn_ds_read_tr16_b64_v4i16((LAS s16x4*)(xa + 64)), hi1 = __builtin_amdgcn_ds_read_tr16_b64_v4i16((LAS s16x4*)(xa + 64 + 4 * FT_S));
                acc0 = __builtin_amdgcn_mfma_f32_32x32x16_bf16(__builtin_shufflevector(lo0, hi0, 0, 1, 2, 3, 4, 5, 6, 7), gf[s], acc0, 0, 0, 0);
                acc1 = __builtin_amdgcn_mfma_f32_32x32x16_bf16(__builtin_shufflevector(lo1, hi1, 0, 1, 2, 3, 4, 5, 6, 7), gf[s], acc1, 0, 0, 0);
            }
        }
        bf16_t* const drow = FN + (size_t)(M_LAT + b * CTXL + mrow) * 512 + cb * 64 + 4 * hh;
#pragma unroll
        for (int g = 0; g < 4; ++g) { u32x2 wv; wv.x = pk2(acc0[4 * g], acc0[4 * g + 1]); wv.y = pk2(acc0[4 * g + 2], acc0[4 * g + 3]); *(GAS u32x2*)(drow + 8 * g) = wv;
            wv.x = pk2(acc1[4 * g], acc1[4 * g + 1]); wv.y = pk2(acc1[4 * g + 2], acc1[4 * g + 3]); *(GAS u32x2*)(drow + 32 + 8 * g) = wv; }
    }
    __syncthreads();
}
__device__ __forceinline__ void unpack8(const u32x4 w, float (&f)[8]) { f[0] = bflo(w.x); f[1] = bfhi(w.x); f[2] = bflo(w.y); f[3] = bfhi(w.y); f[4] = bflo(w.z); f[5] = bfhi(w.z); f[6] = bflo(w.w); f[7] = bfhi(w.w); }
__device__ __forceinline__ void phase_conv(const Ctx& C0, int l, int nrows) {
    const Ctx C = opaque(C0);
    const bf16_t* CIN = (const bf16_t*)(WS_ + WS_CIN); bf16_t* CO = (bf16_t*)(WS_ + WS_COUT); const float* wc = IN_(12) + l * 3 * 512;
    for (int it = C.vcu * NTHREADS + C.tid; it < nrows * 64; it += C.G * NTHREADS) {
        const int row = it >> 6, c0 = (it & 63) * 8; const bool lat = row < M_LAT;
        const int s = lat ? (row & (SEQ - 1)) : ((row - M_LAT) & (CTXL - 1)), last = lat ? SEQ - 1 : CTXL - 1;
        const bf16_t* p = CIN + (size_t)row * 1536 + c0;
        float xm[8], cm[8], x0[8], cc0[8], xp[8], cp[8], bb[8];
        const u32x4 z = (u32x4){0u, 0u, 0u, 0u};
        unpack8(s > 0 ? *(const GAS u32x4*)(p - 1536) : z, xm); unpack8(s > 0 ? *(const GAS u32x4*)(p - 1536 + 1024) : z, cm);
        unpack8(*(const GAS u32x4*)p, x0); unpack8(*(const GAS u32x4*)(p + 1024), cc0); unpack8(*(const GAS u32x4*)(p + 512), bb);
        unpack8(s < last ? *(const GAS u32x4*)(p + 1536) : z, xp); unpack8(s < last ? *(const GAS u32x4*)(p + 1536 + 1024) : z, cp);
        float y[8];
#pragma unroll
        for (int j = 0; j < 8; ++j) y[j] = bb[j] * (xm[j] * cm[j] * wc[c0 + j] + x0[j] * cc0[j] * wc[512 + c0 + j] + xp[j] * cp[j] * wc[1024 + c0 + j]);
        u32x4 o; o.x = pk2(y[0], y[1]); o.y = pk2(y[2], y[3]); o.z = pk2(y[4], y[5]); o.w = pk2(y[6], y[7]);
        *(GAS u32x4*)(CO + (size_t)row * 512 + c0) = o;
    }
}
__device__ __forceinline__ void phase_moe_gather(const Ctx& C0, int chunk, int ntiles) {
    const Ctx C = opaque(C0);
    const unsigned char* HN = WS_ + WS_HN; unsigned char* H2G = WS_ + WS_H2G; const int* EL = (const int*)(WS_ + WS_ELIST);
    const LAS int* tbl = (const LAS int*)(C.lds + MISC_OFF) + 16;
    const int gw = C.vcu * NWAVES + C.wave, NGW = C.G * NWAVES;
    for (int rl = gw; rl < CHUNK_ROWS; rl += NGW) {
        const int R = chunk * CHUNK_TILES * 256 + rl, t = R >> 8; if (t >= ntiles) break;
        int e = 0;
#pragma unroll
        for (int k = 1; k < 8; ++k) e += (t >= tbl[k]) ? 1 : 0;
        const int pos = R - tbl[e] * 256, ce = tbl[8 + e];
        u32x4 v0 = (u32x4){0u, 0u, 0u, 0u};
        if (pos < ce) { const int tok = EL[e * M_LAT + pos]; v0 = *(const GAS u32x4*)(HN + (size_t)tok * D + C.lane * 16); }
        *(GAS u32x4*)(H2G + (size_t)rl * D + C.lane * 16) = v0;
    }
}

#ifndef REP_PRO
#define REP_PRO 1
#endif
#ifndef REP_GEMM
#define REP_GEMM 1
#endif
#ifndef REP_ATT
#define REP_ATT 1
#endif
#ifndef REP_F1
#define REP_F1 1
#endif
#ifndef REP_F2
#define REP_F2 1
#endif
#ifndef REP_CV
#define REP_CV 1
#endif
#ifndef REP_CD
#define REP_CD 1
#endif
#ifndef REP_AUX
#define REP_AUX 1
#endif
#ifndef REP_GIN
#define REP_GIN REP_GEMM
#endif
#ifndef REP_GMG
#define REP_GMG REP_GEMM
#endif
#ifndef REP_GO
#define REP_GO REP_GEMM
#endif
#ifndef REP_GUP
#define REP_GUP REP_GEMM
#endif
#ifndef REP_GDN
#define REP_GDN REP_GEMM
#endif
#ifndef REP_GMU
#define REP_GMU REP_GEMM
#endif
#ifndef REP_GMD
#define REP_GMD REP_GEMM
#endif
#define REPEAT(N) for (int rep_ = 0; rep_ < (N); ++rep_)
#ifndef GIN_ALIGN
#define GIN_ALIGN true
#endif
constexpr int FILL1 = 11264, FILL2 = 20480;
#ifndef STAGGER_TICKS
#define STAGGER_TICKS 0
#endif
#define STAG(bid) ((((bid) >> 3) & 1) ? STAGGER_TICKS : 0)
__global__ void __launch_bounds__(NTHREADS, 2) dit_fwd(Params P) {
    extern __shared__ __attribute__((aligned(16))) unsigned char lds_raw[];
    Ctx C;
    C.lds = (LAS unsigned char*)lds_raw;
    C.wave = __builtin_amdgcn_readfirstlane((int)threadIdx.x >> 6); C.lane = 0; C.tid = 0;
    C.G = gridDim.x; { const int bx = blockIdx.x; C.vcu = (C.G % 8 == 0) ? (bx % 8) * (C.G / 8) + bx / 8 : bx; }
    volatile LAS unsigned* MISC = (volatile LAS unsigned*)(C.lds + MISC_OFF);
    if (threadIdx.x < 32) MISC[threadIdx.x] = 0u;
    __syncthreads();
    (void)xcd_barrier_post((unsigned*)(WS_ + WS_CTL) + CW_BAR, MISC + 8);
#define GRID_BAR() do { XcdBarrier b_; b_.bar = (unsigned*)(WS_ + WS_CTL) + CW_BAR; b_.x = xb_xcc_id(); b_.st = (volatile LAS unsigned*)(C.lds + MISC_OFF) + 8; xcd_barrier(b_); } while (0)
    LAS unsigned char* ring = C.lds;
    const int bid = (int)blockIdx.x;

    REPEAT(REP_PRO) p0_prologue(C, 0);
    GRID_BAR();
    p0_prologue(C, 1);
    REPEAT(REP_AUX) phase_norm<0>(C, 0);
    GRID_BAR();

    for (int l = 0; l < 2; ++l) {
        const int nM = (l == 0) ? MT / 256 : M_LAT / 256;
        REPEAT(REP_GIN) {
            unsigned char* ws = WS_;
            pg8::Gemm g{(const bf16_t*)(ws + WS_HN), (const bf16_t*)(ws + WS_WIN + l * WIN_BYTES), MT, ZN, D, 0, 0, 0, 0, (const float*)(ws + WS_RS), (const float*)(ws + WS_CS) + l * ZN};
            pg8::RectOrder S; if (l == 0) S.init(MT / 256, ZN / 256, C.G, bid); else S.init(M_LAT / 256, ZN / 256, C.G, bid, 0, 2, M_LAT / 256, 2);
            pg8::EpiIn E{ws, WS_Q, WS_KV, WS_FAB, WS_CIN, WS_GT, WS_ROPE, QSCALE};
            pg8::gemm_phase<pg8::EpiIn, pg8::RectOrder, GIN_ALIGN, true, 2>(ring, g, S, E, C.wave, STAG(bid), 1 + 10 * l);
        }
        GRID_BAR();
        REPEAT(REP_ATT) phase_attention(C, l, l == 0);
        REPEAT(REP_F1) phase_fft<1>(C);
        REPEAT(REP_CV) phase_conv(C, l, nM * 256);
        GRID_BAR();
        REPEAT(REP_F2) phase_fft<2>(C);
        if (l == 0) REPEAT(REP_CD) phase_ctx_dft(C);
        GRID_BAR();
        REPEAT(REP_GMG) {
            unsigned char* ws = WS_;
            pg8::RectOrder S; S.init(nM, 4, C.G, bid);
            pg8::Gemm g{(const bf16_t*)(ws + WS_ATT), (const bf16_t*)(ws + WS_WY) + (size_t)l * 3 * 1024 * 512, MT, D, 1536, 512, (long)WS_FAB - (long)WS_ATT, (long)WS_COUT - (long)WS_ATT, (long)1024 * 512 * 2};
            pg8::EpiHorner E{(bf16_t*)(ws + WS_HN), (const unsigned char*)(ws + WS_GT)};
            pg8::gemm_phase<pg8::EpiHorner, pg8::RectOrder, true, true, 0, true>(ring, g, S, E, C.wave, 0, 2 + 10 * l);
        }
        if (l == 0) expert_convert_fill(C, bid, 0, FILL1);
        GRID_BAR();
        REPEAT(REP_GO) {
            unsigned char* ws = WS_;
            pg8::Gemm g{(const bf16_t*)(ws + WS_HN), (const bf16_t*)(ws + WS_WO) + (size_t)l * D * D, MT, D, D}; pg8::RectOrder S; S.init(nM, 4, C.G, bid);
            pg8::EpiPlain E{(bf16_t*)(ws + WS_MIX), D, 4, 0, 1.0f};
            pg8::gemm_phase<pg8::EpiPlain, pg8::RectOrder, true, true>(ring, g, S, E, C.wave, 0, 3 + 10 * l);
        }
        if (l == 0) expert_convert_fill(C, bid, FILL1, FILL2);
        GRID_BAR();
        if (l == 0) phase_norm<1>(C, 0); else phase_norm<4>(C, 1);
        GRID_BAR();
        if (l == 0) {
            REPEAT(REP_GUP) { unsigned char* ws = WS_;
              pg8::Gemm g{(const bf16_t*)(ws + WS_HN), (const bf16_t*)(ws + WS_WFF_UP), MT, 2 * DFF, D, 0, 0, 0, 0, (const float*)(ws + WS_RS), (const float*)(ws + WS_CS) + 2 * ZN}; pg8::RectOrder S; S.init(nM, 2 * DFF / 256, C.G, bid);
              pg8::EpiSwiglu<false> E{(void*)(ws + WS_HID0), DFF, 2 * DFF / 256, 1.0f};
              pg8::gemm_phase<pg8::EpiSwiglu<false>, pg8::RectOrder, true, true, 2>(ring, g, S, E, C.wave, STAG(bid), 4); }
            GRID_BAR();
            REPEAT(REP_GDN) { unsigned char* ws = WS_;
              pg8::Gemm g{(const bf16_t*)(ws + WS_HID0), (const bf16_t*)(ws + WS_WFF_DN), MT, D, DFF}; pg8::RectOrder S; S.init(nM, 4, C.G, bid);
              pg8::EpiPlain E{(bf16_t*)(ws + WS_F0), D, 4, 0, 1.0f};
              pg8::gemm_phase<pg8::EpiPlain, pg8::RectOrder, true, true>(ring, g, S, E, C.wave, 0, 5); }
            expert_convert_fill(C, bid, FILL2, EXP_ITEMS);
            GRID_BAR();
        } else {
            if (threadIdx.x == 0) { const unsigned* ctl = (const unsigned*)(WS_ + WS_CTL); unsigned tb = 0u;
                for (int e = 0; e < 8; ++e) { const unsigned c = __hip_atomic_load(ctl + CW_CNT + 64 * e, __ATOMIC_RELAXED, __HIP_MEMORY_SCOPE_AGENT); MISC[16 + e] = tb; MISC[24 + e] = c; tb += (c + 255u) >> 8; } }
            __syncthreads();
            const int T = __builtin_amdgcn_readfirstlane((int)(MISC[23] + ((MISC[31] + 255u) >> 8))), nchunks = T > CHUNK_TILES ? 2 : 1;
            const LAS int* tbl = (const LAS int*)(C.lds + MISC_OFF) + 16;
            for (int ch = 0; ch < nchunks; ++ch) {
                const int tc = ch == 0 ? (T < CHUNK_TILES ? T : CHUNK_TILES) : T - CHUNK_TILES;
                REPEAT(REP_AUX) phase_moe_gather(C, ch, T);
                GRID_BAR();
                REPEAT(REP_GMU) { unsigned char* ws = WS_;
                  pg8::Gemm g{(const bf16_t*)(ws + WS_H2G), (const bf16_t*)(ws + WS_EXUP), CHUNK_ROWS, 8 * 7168, D};
                  pg8::MoeOrder S{tc, 28, ch * CHUNK_TILES, C.G, bid, tbl};
                  pg8::EpiSwiglu<true> E{(void*)(ws + WS_HIDX), DEXP, 28, 1.0f / WSCALE8};
                  pg8::gemm_phase<pg8::EpiSwiglu<true>, pg8::MoeOrder, true, true, true>(ring, g, S, E, C.wave, STAG(bid), 6); }
                GRID_BAR();
                REPEAT(REP_GMD) { unsigned char* ws = WS_;
                  pg8::Gemm g{(const bf16_t*)(ws + WS_HIDX), (const bf16_t*)(ws + WS_EXDN), CHUNK_ROWS, 8 * 1024, DEXP};
                  pg8::MoeOrder S{tc, 4, ch * CHUNK_TILES, C.G, bid, tbl};
                  pg8::EpiPlain E{(bf16_t*)(ws + WS_YEXP), D, 4, ch * CHUNK_TILES * 256, 1.0f / WSCALE8};
                  pg8::gemm_phase<pg8::EpiPlain, pg8::MoeOrder, true, true, true>(ring, g, S, E, C.wave, 0, 7); }
                GRID_BAR();
            }
        }
        if (l == 0) phase_norm<2>(C, 0); else phase_norm<3>(C, 1);
        if (l == 0) GRID_BAR();
    }
#undef GRID_BAR
}

extern "C" void kernel_launch(void* const* d_in, const int* in_sizes, int n_in, void* d_out, int out_size, void* d_ws, size_t ws_size, hipStream_t stream) {
    static int grid = 0;
    if (grid == 0) {
        if (n_in != 25 || in_sizes[0] != M_LAT * D || out_size != M_LAT * D || ws_size < WS_NEED) {
            fprintf(stderr, "kernel_launch: built for 25 inputs, x/out of %d floats, >= %zu bytes of workspace; got n_in %d, in0 %d, out %d, ws %zu; nothing launched\n", M_LAT * D, (size_t)WS_NEED, n_in, n_in > 0 ? in_sizes[0] : -1, out_size, ws_size);
            grid = -1; return; }
        int dev = 0, cus = 0, per_cu = 0;
        if (hipGetDevice(&dev) != hipSuccess || hipDeviceGetAttribute(&cus, hipDeviceAttributeMultiprocessorCount, dev) != hipSuccess) { fprintf(stderr, "kernel_launch: device query failed\n"); grid = -1; return; }
        if (hipFuncSetAttribute((const void*)dit_fwd, hipFuncAttributeMaxDynamicSharedMemorySize, LDS_BYTES) != hipSuccess) { fprintf(stderr, "kernel_launch: hipFuncSetAttribute failed\n"); grid = -1; return; }
        if (hipOccupancyMaxActiveBlocksPerMultiprocessor(&per_cu, (const void*)dit_fwd, NTHREADS, LDS_BYTES) != hipSuccess || per_cu < 1) { fprintf(stderr, "kernel_launch: occupancy query says %d workgroups per CU; nothing launched\n", per_cu); (void)hipGetLastError(); grid = -1; return; }
        (void)hipGetLastError();
        grid = cus;
        if (grid < 192 || grid > 304) { fprintf(stderr, "kernel_launch: unexpected CU count %d\n", cus); grid = -1; return; }
    }
    if (grid < 0) return;
    if (hipMemsetAsync((char*)d_ws + WS_CTL, 0, CTL_BYTES, stream) != hipSuccess) { fprintf(stderr, "kernel_launch: memset failed\n"); return; }
    Params p{};
    for (int i = 0; i < 25; ++i) p.in[i] = (const float*)d_in[i];
    p.out = (float*)d_out; p.ws = (unsigned char*)d_ws;
    hipLaunchKernelGGL(dit_fwd, dim3(grid), dim3(NTHREADS), LDS_BYTES, stream, p);
    const hipError_t le = hipPeekAtLastError();
    if (le != hipSuccess) fprintf(stderr, "kernel_launch: launch failed: %s\n", hipGetErrorName(le));
}
```
